# Optimizing an MI355X kernel written in HIP

```python
import jax
import jax.numpy as jnp
from jax import lax
import numpy as np


D_MODEL = 1024
BATCH = 4
SEQ = 8192
DEPTH = 1

N_META = 16
CHUNK = 128
PAD_FRONT = CHUNK - N_META
D_MIX = D_MODEL
RET_HEADS = 4
RET_DK = D_MIX // 2 // RET_HEADS
RET_DV = D_MIX // 2 // RET_HEADS
MLSTM_HEADS = 4
MLSTM_DH = D_MIX // 2 // MLSTM_HEADS
CONV_K = 5
N_EXPERTS = 16
EC_CAPACITY = 2
D_FF = 128 * ((8 * D_MODEL // 3 + 127) // 128)
ROPE_BASE = 10000.0
EPS = 1e-6
NEG = -1e30
RET_QK = RET_HEADS * RET_DK
RET_V = RET_HEADS * RET_DV
ML_W = MLSTM_HEADS * MLSTM_DH
N_GATES = 4 * MLSTM_HEADS
PROJ_SIZES = (RET_QK, RET_QK, RET_V, RET_V, ML_W, ML_W, ML_W, ML_W, N_GATES)
PROJ_COLS = sum(PROJ_SIZES)
SPLIT_AT = tuple(int(s) for s in np.cumsum(PROJ_SIZES)[:-1])

kernel_name = 'hybrid_retention_mlstm_ec_block'


def _rmsnorm(x, g):
    xf = x.astype(jnp.float32)
    y = xf * lax.rsqrt(jnp.mean(xf * xf, axis=-1, keepdims=True) + EPS)
    return (y * g.astype(jnp.float32)).astype(x.dtype)


def _head_norm(y, g):
    mu = jnp.mean(y, axis=-1, keepdims=True)
    yc = y - mu
    var = jnp.mean(yc * yc, axis=-1, keepdims=True)
    out = (yc * lax.rsqrt(var + EPS)).reshape(y.shape[:2] + (-1,))
    return out * g.astype(jnp.float32)


def _rotary(x, pos):
    half = x.shape[-1] // 2
    inv = ROPE_BASE ** (-jnp.arange(half, dtype=jnp.float32) / half)
    ang = pos[:, None] * inv[None, :]
    cos = jnp.cos(ang)[None, :, None, :]
    sin = jnp.sin(ang)[None, :, None, :]
    x1, x2 = x[..., :half], x[..., half:]
    return jnp.concatenate([x1 * cos - x2 * sin, x2 * cos + x1 * sin], axis=-1)


def _pad_front(t, value=0.0):
    widths = [(0, 0)] * t.ndim
    widths[1] = (PAD_FRONT, 0)
    return jnp.pad(t, widths, constant_values=value)


def _flip(t):
    return jnp.flip(t, axis=1)


def _centred_conv(u, w, b):
    c = u.shape[-1]
    out = lax.conv_general_dilated(
        u, w.astype(u.dtype)[:, None, :], window_strides=(1,),
        padding=((CONV_K // 2, CONV_K // 2),),
        dimension_numbers=('NWC', 'WIO', 'NWC'), feature_group_count=c)
    return out + b.astype(u.dtype)


def _retention_dir(q, k, v, log_gamma):
    b_, t_, h_, dk = q.shape
    dv = v.shape[-1]
    nc = t_ // CHUNK
    q = q.reshape(b_, nc, CHUNK, h_, dk)
    k = k.reshape(b_, nc, CHUNK, h_, dk)
    v = v.reshape(b_, nc, CHUNK, h_, dv)
    idx = jnp.arange(CHUNK, dtype=jnp.float32)
    diff = idx[:, None] - idx[None, :]
    decay = jnp.where(diff >= 0, jnp.exp(log_gamma[:, None, None] * jnp.maximum(diff, 0.0)), 0.0)
    scores = jnp.einsum('bclhd,bcmhd->bchlm', q, k) * decay
    intra = jnp.einsum('bchlm,bcmhe->bclhe', scores, v)
    zeta = jnp.exp(log_gamma[:, None] * (CHUNK - 1.0 - idx)[None, :])
    upd = jnp.einsum('bclhd,bclhe,hl->bchde', k, v, zeta)
    g_chunk = jnp.exp(log_gamma * CHUNK)[:, None, None]

    def step(state, u_c):
        return g_chunk * state + u_c, state

    r0 = jnp.zeros((b_, h_, dk, dv), jnp.float32)
    _, r_prev = lax.scan(step, r0, jnp.moveaxis(upd, 1, 0))
    r_prev = jnp.moveaxis(r_prev, 0, 1)
    xi = jnp.exp(log_gamma[:, None] * (idx + 1.0)[None, :])
    cross = jnp.einsum('bclhd,bchde,hl->bclhe', q, r_prev, xi)
    return (intra + cross).reshape(b_, t_, h_, dv)


def _mlstm_dir(q, k, v, log_i, log_f):
    b_, t_, h_, d = q.shape
    nc = t_ // CHUNK
    q = q.reshape(b_, nc, CHUNK, h_, d)
    k = k.reshape(b_, nc, CHUNK, h_, d)
    v = v.reshape(b_, nc, CHUNK, h_, d)
    li = jnp.moveaxis(log_i.reshape(b_, nc, CHUNK, h_), 3, 2)
    lf = jnp.moveaxis(log_f.reshape(b_, nc, CHUNK, h_), 3, 2)
    bcum = jnp.cumsum(lf, axis=-1)
    b_last = bcum[..., -1]
    causal = jnp.tril(jnp.ones((CHUNK, CHUNK), dtype=bool))
    log_d = jnp.where(causal, bcum[..., :, None] - bcum[..., None, :] + li[..., None, :], NEG)
    log_u = b_last[..., None] - bcum + li
    a = jnp.max(log_u, axis=-1)
    w_u = jnp.exp(log_u - a[..., None])
    upd_c = jnp.einsum('bchl,bclhe,bclhd->bched', w_u, v, k)
    upd_n = jnp.einsum('bchl,bclhd->bchd', w_u, k)

    def step(carry, inp):
        c_st, n_st, m_st = carry
        uc, un, bl, ac = inp
        m_new = jnp.maximum(bl + m_st, ac)
        f = jnp.exp(bl + m_st - m_new)
        g = jnp.exp(ac - m_new)
        c_new = f[..., None, None] * c_st + g[..., None, None] * uc
        n_new = f[..., None] * n_st + g[..., None] * un
        return (c_new, n_new, m_new), (c_st, n_st, m_st)

    init = (jnp.zeros((b_, h_, d, d), jnp.float32),
            jnp.zeros((b_, h_, d), jnp.float32),
            jnp.zeros((b_, h_), jnp.float32))
    xs = (jnp.moveaxis(upd_c, 1, 0), jnp.moveaxis(upd_n, 1, 0),
          jnp.moveaxis(b_last, 1, 0), jnp.moveaxis(a, 1, 0))
    _, (c_prev, n_prev, m_prev) = lax.scan(step, init, xs)
    c_prev = jnp.moveaxis(c_prev, 0, 1)
    n_prev = jnp.moveaxis(n_prev, 0, 1)
    m_prev = jnp.moveaxis(m_prev, 0, 1)
    log_inter = bcum + m_prev[..., None]
    m_row = jnp.maximum(log_inter, jnp.max(log_d, axis=-1))
    s = jnp.einsum('bclhd,bcmhd->bchlm', q, k) * jnp.exp(log_d - m_row[..., None])
    w_inter = jnp.exp(log_inter - m_row)
    num = (jnp.einsum('bchlm,bcmhe->bclhe', s, v)
           + jnp.einsum('bclhd,bched,bchl->bclhe', q, c_prev, w_inter))
    den = jnp.sum(s, axis=-1) + jnp.einsum('bclhd,bchd,bchl->bchl', q, n_prev, w_inter)
    denom = jnp.maximum(jnp.abs(den), jnp.exp(-m_row))
    h = num / jnp.moveaxis(denom, 2, 3)[..., None]
    return h.reshape(b_, t_, h_, d)


def _token_mixer(h, norm_g, w_in, b_gates, conv_w, conv_b, ret_decay_logit,
                 ret_gn_g, mlstm_gn_g, w_out):
    b_, n_, _ = h.shape
    f32 = jnp.float32
    u = _rmsnorm(h, norm_g)
    proj = jnp.einsum('bnd,dk->bnk', u, w_in)
    rq, rk, rv, rg, mq, mk, mv, mo, gate_pre = jnp.split(proj, SPLIT_AT, axis=-1)

    pos = jnp.arange(n_, dtype=f32)
    rq = _rotary(rq.reshape(b_, n_, RET_HEADS, RET_DK).astype(f32), pos) * (RET_DK ** -0.5)
    rk = _rotary(rk.reshape(b_, n_, RET_HEADS, RET_DK).astype(f32), pos)
    rv = rv.reshape(b_, n_, RET_HEADS, RET_DV).astype(f32)
    rq, rk, rv = _pad_front(rq), _pad_front(rk), _pad_front(rv)
    log_gamma = jax.nn.log_sigmoid(ret_decay_logit.astype(f32))
    ret = (_retention_dir(rq, rk, rv, log_gamma[0])
           + _flip(_retention_dir(_flip(rq), _flip(rk), _flip(rv), log_gamma[1])))
    ret = ret[:, PAD_FRONT:]
    y_ret = _head_norm(ret, ret_gn_g) * jax.nn.silu(rg.astype(f32))

    qk = jax.nn.silu(_centred_conv(jnp.concatenate([mq, mk], axis=-1), conv_w, conv_b))
    mq, mk = jnp.split(qk, 2, axis=-1)
    mq = mq.reshape(b_, n_, MLSTM_HEADS, MLSTM_DH).astype(f32) * (MLSTM_DH ** -0.5)
    mk = mk.reshape(b_, n_, MLSTM_HEADS, MLSTM_DH).astype(f32)
    mv = mv.reshape(b_, n_, MLSTM_HEADS, MLSTM_DH).astype(f32)
    gts = gate_pre.astype(f32) + b_gates.astype(f32)
    log_i = gts[..., :2 * MLSTM_HEADS].reshape(b_, n_, 2, MLSTM_HEADS)
    log_f = jax.nn.log_sigmoid(gts[..., 2 * MLSTM_HEADS:]).reshape(b_, n_, 2, MLSTM_HEADS)
    mq, mk, mv = _pad_front(mq), _pad_front(mk), _pad_front(mv)
    log_i = _pad_front(log_i, NEG)
    log_f = _pad_front(log_f, 0.0)
    h_f = _mlstm_dir(mq, mk, mv, log_i[:, :, 0], log_f[:, :, 0])
    h_b = _flip(_mlstm_dir(_flip(mq), _flip(mk), _flip(mv),
                           _flip(log_i[:, :, 1]), _flip(log_f[:, :, 1])))
    hm = (h_f + h_b)[:, PAD_FRONT:]
    hm = jax.nn.sigmoid(mo.astype(f32)).reshape(b_, n_, MLSTM_HEADS, MLSTM_DH) * hm
    y_m = _head_norm(hm, mlstm_gn_g)

    y = jnp.concatenate([y_ret, y_m], axis=-1).astype(h.dtype)
    return jnp.einsum('bnk,kd->bnd', y, w_out)


def _expert_choice_ffn(h, norm_g, w_router, w_gate, w_up, w_down):
    b_, n_, _ = h.shape
    u = _rmsnorm(h, norm_g)
    aff = jax.nn.softmax(jnp.einsum('bnd,de->bne', u, w_router).astype(jnp.float32), axis=-1)
    cap = EC_CAPACITY * n_ // N_EXPERTS
    g, idx = lax.top_k(jnp.swapaxes(aff, 1, 2), cap)
    xs = jax.vmap(lambda ub, ib: ub[ib])(u, idx)
    hid = (jax.nn.silu(jnp.einsum('becd,edf->becf', xs, w_gate))
           * jnp.einsum('becd,edf->becf', xs, w_up))
    y = jnp.einsum('becf,efd->becd', hid, w_down) * g[..., None].astype(h.dtype)
    return jnp.zeros_like(h).at[jnp.arange(b_)[:, None, None], idx].add(y)


def setup_inputs(seed: int = 0) -> dict:
    key = jax.random.key(seed)
    ks = jax.random.split(key, 17)
    f32 = jnp.float32
    nrm = jax.random.normal
    x = nrm(ks[0], (BATCH, SEQ, D_MODEL), f32)
    meta_tokens = nrm(ks[1], (N_META, D_MODEL), f32)
    mix_norm_g = 1.0 + 0.05 * nrm(ks[2], (DEPTH, D_MODEL), f32)
    w_in = nrm(ks[3], (DEPTH, D_MODEL, PROJ_COLS), f32) * (D_MODEL ** -0.5)
    f_bias = jnp.tile(jnp.linspace(3.0, 6.0, MLSTM_HEADS, dtype=f32), 2)
    base_gates = jnp.concatenate([jnp.zeros((2 * MLSTM_HEADS,), f32), f_bias])
    b_gates = base_gates[None, :] + 0.1 * nrm(ks[4], (DEPTH, N_GATES), f32)
    conv_w = nrm(ks[5], (DEPTH, CONV_K, 2 * ML_W), f32) * (CONV_K ** -0.5)
    conv_b = 0.01 * nrm(ks[6], (DEPTH, 2 * ML_W), f32)
    scales = 5.0 + jnp.arange(RET_HEADS, dtype=f32)
    gamma_logit = jnp.log(2.0 ** scales - 1.0)
    ret_decay_logit = gamma_logit[None, None, :] + 0.05 * nrm(ks[7], (DEPTH, 2, RET_HEADS), f32)
    ret_gn_g = 1.0 + 0.05 * nrm(ks[8], (DEPTH, RET_V), f32)
    mlstm_gn_g = 1.0 + 0.05 * nrm(ks[9], (DEPTH, ML_W), f32)
    w_out = nrm(ks[10], (DEPTH, D_MIX, D_MODEL), f32) * (D_MIX ** -0.5)
    ffn_norm_g = 1.0 + 0.05 * nrm(ks[11], (DEPTH, D_MODEL), f32)
    w_router = nrm(ks[12], (DEPTH, D_MODEL, N_EXPERTS), f32) * (D_MODEL ** -0.5)
    w_gate = nrm(ks[13], (DEPTH, N_EXPERTS, D_MODEL, D_FF), f32) * (D_MODEL ** -0.5)
    w_up = nrm(ks[14], (DEPTH, N_EXPERTS, D_MODEL, D_FF), f32) * (D_MODEL ** -0.5)
    w_down = nrm(ks[15], (DEPTH, N_EXPERTS, D_FF, D_MODEL), f32) * (D_FF ** -0.5)
    final_norm_g = 1.0 + 0.05 * nrm(ks[16], (D_MODEL,), f32)
    return {'x': x, 'meta_tokens': meta_tokens, 'mix_norm_g': mix_norm_g, 'w_in': w_in,
            'b_gates': b_gates, 'conv_w': conv_w, 'conv_b': conv_b,
            'ret_decay_logit': ret_decay_logit, 'ret_gn_g': ret_gn_g, 'mlstm_gn_g': mlstm_gn_g,
            'w_out': w_out, 'ffn_norm_g': ffn_norm_g, 'w_router': w_router, 'w_gate': w_gate,
            'w_up': w_up, 'w_down': w_down, 'final_norm_g': final_norm_g}


def reference(x, meta_tokens, mix_norm_g, w_in, b_gates, conv_w, conv_b, ret_decay_logit,
              ret_gn_g, mlstm_gn_g, w_out, ffn_norm_g, w_router, w_gate, w_up, w_down,
              final_norm_g):
    b_ = x.shape[0]
    meta = jnp.broadcast_to(meta_tokens.astype(x.dtype)[None], (b_, N_META, x.shape[-1]))
    h = jnp.concatenate([meta, x], axis=1)
    for l in range(DEPTH):
        h = h + _token_mixer(h, mix_norm_g[l], w_in[l], b_gates[l], conv_w[l], conv_b[l],
                             ret_decay_logit[l], ret_gn_g[l], mlstm_gn_g[l], w_out[l])
        h = h + _expert_choice_ffn(h, ffn_norm_g[l], w_router[l], w_gate[l], w_up[l], w_down[l])
    h = _rmsnorm(h, final_norm_g)
    return h[:, N_META:]
```

```cpp
#include <hip/hip_runtime.h>
#include <hip/hip_cooperative_groups.h>
#include <cstdio>
#include <cstdint>
namespace cg = cooperative_groups;

#ifndef MK_SPLIT
#define MK_SPLIT 1
#endif

#define GAS __attribute__((address_space(1)))
#define LAS __attribute__((address_space(3)))
typedef unsigned short bf16;
typedef short bf16x8 __attribute__((ext_vector_type(8)));
typedef float f32x4 __attribute__((ext_vector_type(4)));
typedef float f32x2 __attribute__((ext_vector_type(2)));
typedef unsigned u32x4 __attribute__((ext_vector_type(4)));
typedef unsigned u32x2 __attribute__((ext_vector_type(2)));

constexpr int NB = 4, SEQ = 8192, D = 1024, NMETA = 16, CHK = 128, PADF = 112;
constexpr int NTOK = NMETA + SEQ;
constexpr int PP = NTOK + PADF;
constexpr int NCH = PP / CHK;
constexpr int R = NB * PP;
constexpr int PCOLS = 4112, PC = 4096;
constexpr int NE = 16, CAP = 1026, DFF = 2816, EROWS = NB * CAP, EROWSP = 4352;
constexpr int NH = 4;
constexpr float EPS = 1e-6f, NEGF = -1e30f;
constexpr int EHALF = 8;

constexpr size_t MiB = 1u << 20;
constexpr size_t WS_ROPE = 1 * MiB, WS_GATES = 6 * MiB, WS_AFF = 9 * MiB, WS_IDX = 12 * MiB, WS_GV = 13 * MiB, WS_SLOT = 14 * MiB;
constexpr size_t WS_H1META = 17 * MiB, WS_UN = 18 * MiB, WS_SCAL = 21 * MiB, WS_WINT = 22 * MiB, WS_WOUTT = 30 * MiB;
constexpr size_t WS_ACT1 = 32 * MiB;
constexpr size_t WS_ACT2 = 97 * MiB;
constexpr size_t WS_PROJ = 162 * MiB;
constexpr size_t WS_STATE = 422 * MiB;
constexpr size_t WS_YE = 97 * MiB;
constexpr size_t WS_WEXP = 233 * MiB;
constexpr size_t WS_HID = 497 * MiB;
constexpr size_t WS_END = 684 * MiB;
constexpr size_t WEXP_ONE = (size_t)NE * DFF * D * 2;
static_assert(WS_PROJ + (size_t)R * PC * 2 <= WS_STATE && WS_STATE + (size_t)64 * NCH * 16384 * 4 <= WS_END, "mixer map");
static_assert(WS_YE + (size_t)NE * EROWSP * D * 2 <= WS_WEXP && WS_WEXP + 3 * WEXP_ONE <= WS_HID && WS_HID + (size_t)EHALF * EROWSP * DFF * 2 <= WS_END, "ffn map");

constexpr int LDS_BYTES = 155648;
constexpr int TP = 136;
constexpr int T0_OFF = 0, T1_OFF = 34816, T2_OFF = 69632, T3_OFF = 104448, VEC_OFF = 139264;

__device__ __forceinline__ unsigned f2bf(float f) { unsigned u = __builtin_bit_cast(unsigned, f); return (u + 0x7fffu + ((u >> 16) & 1u)) >> 16; }
__device__ __forceinline__ unsigned pk2(float lo, float hi) { return f2bf(lo) | (f2bf(hi) << 16); }
__device__ __forceinline__ float bf2f(unsigned b) { return __builtin_bit_cast(float, b << 16); }
__device__ __forceinline__ float bflo(unsigned w) { return __builtin_bit_cast(float, w << 16); }
__device__ __forceinline__ float bfhi(unsigned w) { return __builtin_bit_cast(float, w & 0xffff0000u); }
__device__ __forceinline__ float wave_sum(float v) {
#pragma unroll
    for (int o = 1; o < 64; o <<= 1) v += __shfl_xor(v, o);
    return v;
}
__device__ __forceinline__ float wave_max(float v) {
#pragma unroll
    for (int o = 1; o < 64; o <<= 1) v = fmaxf(v, __shfl_xor(v, o));
    return v;
}
__device__ __forceinline__ float sigmoidf_(float x) { return 1.0f / (1.0f + __expf(-x)); }
__device__ __forceinline__ float siluf_(float x) { return x / (1.0f + __expf(-x)); }
__device__ __forceinline__ float logsigmoidf_(float x) { return fminf(x, 0.0f) - log1pf(__expf(-fabsf(x))); }
#define LDS_WAIT() asm volatile("s_waitcnt lgkmcnt(0)" ::: "memory")

namespace pg8 {
constexpr int BM = 256, BK = 64, HALF = 128, HTB = HALF * BK * 2, STAGE_BYTES = 8 * HTB;
__device__ __forceinline__ int lds_byte(int r, int c) { const int st = (r >> 4) * 2 + (c >> 5), rr = r & 15, cc = c & 31, ob = rr * 64 + cc * 2; return st * 1024 + (ob ^ (((ob >> 9) & 1) << 5)); }
__device__ __forceinline__ void stage_rc(int b, int& Rr, int& C) { const int st = b / 1024, sb = b % 1024, swz = sb ^ (((sb >> 9) & 1) << 5); Rr = (st >> 1) * 16 + swz / 64; C = (st & 1) * 32 + (swz % 64) / 2; }
__device__ __forceinline__ int perm32(int rho) { const int n = rho >> 4, i = rho & 15; return 8 * (i >> 2) + 4 * n + (i & 3); }
__device__ __forceinline__ unsigned cvt_pk_bf16(float lo, float hi) { unsigned r; asm volatile("v_cvt_pk_bf16_f32 %0, %1, %2" : "=v"(r) : "v"(lo), "v"(hi)); return r; }

struct Unit { int pm, pn, e; };
struct UAddr { const char* a0; const char* a1; const char* b0; const char* b1; };

template <class Epi, class Sched>
__device__ __forceinline__ void gemm_phase(LAS unsigned char* lds, const int K, const Sched& S, const Epi& E) {
    const int tid = threadIdx.x, wid = __builtin_amdgcn_readfirstlane(tid >> 6), lane = tid & 63, wr = wid >> 2, wc = wid & 3, fr = lane & 15, fq = lane >> 4;
    const int nt = K / BK;
    unsigned voffB[2], voffA0 = 0, voffA1 = 0, colb = 0;
    int sR0, sC0;
    {   int sR1, sC1; stage_rc(tid * 16, sR0, sC0); stage_rc(tid * 16 + 8192, sR1, sC1);
        const int Rb0 = Epi::PERM ? ((sR0 & ~31) + perm32(sR0 & 31)) : sR0, Rb1 = Epi::PERM ? ((sR1 & ~31) + perm32(sR1 & 31)) : sR1;
        voffB[0] = (unsigned)(Rb0 * S.ldb + sC0) * 2u; voffB[1] = (unsigned)(Rb1 * S.ldb + sC1) * 2u;
        if constexpr (!Sched::GATHER) { voffA0 = (unsigned)(sR0 * S.lda + sC0) * 2u; voffA1 = (unsigned)(sR1 * S.lda + sC1) * 2u; } else colb = (unsigned)sC0 * 2u; }
    LAS unsigned* const tab = (LAS unsigned*)(lds + STAGE_BYTES);
    const LAS unsigned* const tabp = tab + sR0;
    const size_t kstep = (size_t)(BK * 2);
    const unsigned ldsw = (unsigned)wid * 1024u;
    const int aoff = lds_byte(wr * 64 + fr, fq * 8), boff = lds_byte(wc * 32 + fr, fq * 8);
#define PG8_SA(b, h) (((b) * 2 + (h)) * HTB)
#define PG8_SB(b, h) ((4 + (b) * 2 + (h)) * HTB)
#define PG8_STAGE(bufoff, gbase, v0, v1) do { \
        __builtin_amdgcn_global_load_lds((const unsigned*)((const char*)(gbase) + (v0)), (LAS unsigned*)(lds + (bufoff) + ldsw), 16, 0, 0); \
        __builtin_amdgcn_global_load_lds((const unsigned*)((const char*)(gbase) + (v1)), (LAS unsigned*)(lds + (bufoff) + ldsw + 8192), 16, 0, 0); } while (0)
#define PG8_STAGE_A(bufoff, gbase, slot, h) do { if constexpr (Sched::GATHER) { const unsigned _r0 = tabp[(slot) * 256 + (h) * 128] + colb, _r1 = tabp[(slot) * 256 + (h) * 128 + 64] + colb; PG8_STAGE(bufoff, gbase, _r0, _r1); } \
        else PG8_STAGE(bufoff, gbase, voffA0, voffA1); } while (0)
#define PG8_LDA(dst, b, h) do { _Pragma("unroll") for (int m = 0; m < 4; ++m) _Pragma("unroll") for (int k = 0; k < 2; ++k) dst[m][k] = *(const LAS bf16x8*)(lds + PG8_SA(b, h) + aoff + m * 2048 + k * 1024); } while (0)
#define PG8_LDB(dst, b, h) do { _Pragma("unroll") for (int n = 0; n < 2; ++n) _Pragma("unroll") for (int k = 0; k < 2; ++k) dst[n][k] = *(const LAS bf16x8*)(lds + PG8_SB(b, h) + boff + n * 2048 + k * 1024); } while (0)
#define PG8_MMA(ai, bj, At, Bt) do { __builtin_amdgcn_s_setprio(1); _Pragma("unroll") for (int m = 0; m < 4; ++m) _Pragma("unroll") for (int n = 0; n < 2; ++n) _Pragma("unroll") for (int k = 0; k < 2; ++k) \
        acc[ai][bj][m][n] = __builtin_amdgcn_mfma_f32_16x16x32_bf16(Bt[n][k], At[m][k], acc[ai][bj][m][n], 0, 0, 0); __builtin_amdgcn_s_setprio(0); } while (0)
#define PG8_WAIT_V(n) asm volatile("s_waitcnt vmcnt(" #n ")" ::: "memory")
#define PG8_WAIT_L(n) asm volatile("s_waitcnt lgkmcnt(" #n ")" ::: "memory")
#define PG8_BAR __builtin_amdgcn_s_barrier()
#define PG8_SCHED __builtin_amdgcn_sched_barrier(0)
    Unit cur, nxt; int ui = 0;
    if (!S.next(0, cur)) return;
    f32x4 acc[2][2][4][2];
#pragma unroll
    for (int a = 0; a < 2; ++a)
#pragma unroll
        for (int b = 0; b < 2; ++b)
#pragma unroll
            for (int m = 0; m < 4; ++m)
#pragma unroll
                for (int n = 0; n < 2; ++n) acc[a][b][m][n] = (f32x4){0.f, 0.f, 0.f, 0.f};
    bf16x8 At[4][2], B0[2][2], B1[2][2];
    UAddr cu, nx;
    S.addr(cur, cu);
    if constexpr (Sched::GATHER) { if (tid < 256) tab[tid] = S.rowoff(cur, tid); __syncthreads(); }
    PG8_STAGE(PG8_SB(0, 0), cu.b0, voffB[0], voffB[1]); PG8_STAGE(PG8_SB(0, 1), cu.b1, voffB[0], voffB[1]); PG8_STAGE_A(PG8_SA(0, 0), cu.a0, 0, 0); PG8_STAGE_A(PG8_SA(0, 1), cu.a1, 0, 1);
    if (wr == 1) PG8_BAR;
    PG8_WAIT_V(2); PG8_BAR;
    PG8_STAGE(PG8_SB(1, 0), cu.b0 + kstep, voffB[0], voffB[1]); PG8_STAGE_A(PG8_SA(1, 0), cu.a0 + kstep, 0, 0); PG8_STAGE(PG8_SB(1, 1), cu.b1 + kstep, voffB[0], voffB[1]);
    PG8_WAIT_V(6); PG8_BAR;
    for (;;) {
        const bool has_next = S.next(ui + 1, nxt);
        const int cs = ui & 1, ns = has_next ? (cs ^ 1) : cs;
        if (has_next) { S.addr(nxt, nx); if constexpr (Sched::GATHER) { if (tid < 256) tab[(cs ^ 1) * 256 + tid] = S.rowoff(nxt, tid); } } else nx = cu;
        for (int t = 0; t < nt; t += 2) {
            const bool last = (t == nt - 2);
            const char* a1h1 = cu.a1 + (size_t)(t + 1) * kstep;
            const char* a2h0 = last ? nx.a0 : cu.a0 + (size_t)(t + 2) * kstep; const char* a2h1 = last ? nx.a1 : cu.a1 + (size_t)(t + 2) * kstep;
            const char* b2h0 = last ? nx.b0 : cu.b0 + (size_t)(t + 2) * kstep; const char* b2h1 = last ? nx.b1 : cu.b1 + (size_t)(t + 2) * kstep;
            const int s2 = last ? ns : cs;
            PG8_LDB(B0, 0, 0); PG8_LDB(B1, 0, 1); PG8_SCHED; PG8_LDA(At, 0, 0); PG8_STAGE_A(PG8_SA(1, 1), a1h1, cs, 1);
            PG8_WAIT_V(8); PG8_WAIT_L(0); PG8_BAR; PG8_MMA(0, 0, At, B0); PG8_MMA(0, 1, At, B1); PG8_BAR; PG8_SCHED;
            PG8_LDA(At, 0, 1); PG8_STAGE(PG8_SB(0, 0), b2h0, voffB[0], voffB[1]); PG8_STAGE(PG8_SB(0, 1), b2h1, voffB[0], voffB[1]); PG8_STAGE_A(PG8_SA(0, 0), a2h0, s2, 0);
            PG8_WAIT_V(8); PG8_WAIT_L(0); PG8_BAR; PG8_MMA(1, 0, At, B0); PG8_MMA(1, 1, At, B1); PG8_BAR; PG8_SCHED;
            PG8_LDB(B0, 1, 0); PG8_LDB(B1, 1, 1); PG8_SCHED; PG8_LDA(At, 1, 0); PG8_STAGE_A(PG8_SA(0, 1), a2h1, s2, 1);
            PG8_WAIT_V(8); PG8_WAIT_L(0); PG8_BAR; PG8_MMA(0, 0, At, B0); PG8_MMA(0, 1, At, B1); PG8_BAR; PG8_SCHED;
            PG8_LDA(At, 1, 1); PG8_STAGE(PG8_SB(1, 0), b2h0 + kstep, voffB[0], voffB[1]); PG8_STAGE(PG8_SB(1, 1), b2h1 + kstep, voffB[0], voffB[1]); PG8_STAGE_A(PG8_SA(1, 0), a2h0 + kstep, s2, 0);
            PG8_WAIT_V(8); PG8_WAIT_L(0); PG8_BAR; PG8_MMA(1, 0, At, B0); PG8_MMA(1, 1, At, B1); PG8_BAR; PG8_SCHED;
        }
        if (wr == 0) PG8_BAR;
        E(acc, cur, wr, wc, fr, fq);
        if (!has_next) break;
#pragma unroll
        for (int a = 0; a < 2; ++a)
#pragma unroll
            for (int b = 0; b < 2; ++b)
#pragma unroll
                for (int m = 0; m < 4; ++m)
#pragma unroll
                    for (int n = 0; n < 2; ++n) acc[a][b][m][n] = (f32x4){0.f, 0.f, 0.f, 0.f};
        cur = nxt; cu = nx; ++ui;
        if (wr == 1) PG8_BAR;
    }
    PG8_WAIT_V(0);
    PG8_BAR;
#undef PG8_SA
#undef PG8_SB
#undef PG8_STAGE
#undef PG8_STAGE_A
#undef PG8_LDA
#undef PG8_LDB
#undef PG8_MMA
#undef PG8_WAIT_V
#undef PG8_WAIT_L
#undef PG8_BAR
#undef PG8_SCHED
}

struct DenseOrder {
    static constexpr bool GATHER = false;
    const bf16* A; const bf16* Bt; int lda, ldb; int nM, nN, nwg, G, c;
    __device__ __forceinline__ unsigned rowoff(const Unit&, int) const { return 0u; }
    __device__ __forceinline__ bool next(int i, Unit& u) const {
        const long L = (long)i * G + c; if (L >= nwg) return false;
        int wgid = (int)L; { const int q = nwg / 8, r = nwg % 8, xcd = wgid % 8, off = wgid / 8; wgid = (xcd < r ? xcd * (q + 1) : r * (q + 1) + (xcd - r) * q) + off; }
        const int nig = 8 * nN, gid = wgid / nig, fm = gid * 8, gsz = (nM - fm) < 8 ? (nM - fm) : 8;
        u.pm = fm + ((wgid % nig) % gsz); u.pn = (wgid % nig) / gsz; u.e = 0; return true;
    }
    __device__ __forceinline__ void addr(const Unit& u, UAddr& g) const {
        g.a0 = (const char*)(A + (size_t)u.pm * 256 * lda); g.a1 = g.a0 + (size_t)128 * lda * 2;
        g.b0 = (const char*)(Bt + (size_t)u.pn * 256 * ldb); g.b1 = g.b0 + (size_t)128 * ldb * 2;
    }
};
struct FfnUpOrder {
    static constexpr bool GATHER = true;
    const bf16* U2; const int* IDX; const bf16* WgT; const bf16* WuT; int lda, ldb; int e0; int nunits, G, c;
    __device__ __forceinline__ bool next(int i, Unit& u) const {
        const int L = i * G + c; if (L >= nunits) return false;
        const int el = L / (22 * 17), rem = L - el * (22 * 17); u.e = e0 + el; u.pn = rem / 17; u.pm = rem - u.pn * 17; return true;
    }
    __device__ __forceinline__ unsigned rowoff(const Unit& u, int rr) const {
        const int j = u.pm * 256 + rr;
        if (j >= EROWS) return 0u;
        const int b = j / CAP, slot = j - b * CAP; const int n = IDX[(b * NE + u.e) * CAP + slot];
        return (unsigned)(b * PP + PADF + n) * (unsigned)(D * 2);
    }
    __device__ __forceinline__ void addr(const Unit& u, UAddr& g) const {
        g.a0 = (const char*)U2; g.a1 = g.a0;
        g.b0 = (const char*)(WgT + ((size_t)u.e * DFF + (size_t)u.pn * 128) * D); g.b1 = (const char*)(WuT + ((size_t)u.e * DFF + (size_t)u.pn * 128) * D);
    }
};
struct FfnDownOrder {
    static constexpr bool GATHER = false;
    const bf16* HID; const bf16* WdT; int lda, ldb; int e0; int nunits, G, c;
    __device__ __forceinline__ unsigned rowoff(const Unit&, int) const { return 0u; }
    __device__ __forceinline__ bool next(int i, Unit& u) const {
        const int L = i * G + c; if (L >= nunits) return false;
        const int el = L / (4 * 17), rem = L - el * (4 * 17); u.e = e0 + el; u.pn = rem / 17; u.pm = rem - u.pn * 17; return true;
    }
    __device__ __forceinline__ void addr(const Unit& u, UAddr& g) const {
        g.a0 = (const char*)(HID + ((size_t)(u.e - e0) * EROWSP + (size_t)u.pm * 256) * DFF); g.a1 = g.a0 + (size_t)128 * DFF * 2;
        g.b0 = (const char*)(WdT + ((size_t)u.e * D + (size_t)u.pn * 256) * DFF); g.b1 = g.b0 + (size_t)128 * DFF * 2;
    }
};

struct EpiStoreBf16 {
    static constexpr bool PERM = true;
    bf16* O; int ldc; size_t estride;
    __device__ __forceinline__ void operator()(const f32x4 (&acc)[2][2][4][2], const Unit& u, int wr, int wc, int fr, int fq) const {
        bf16* base = O + (size_t)u.e * estride + (size_t)(u.pm * 256 + wr * 64 + fr) * ldc + u.pn * 256 + wc * 32 + 8 * fq;
#pragma unroll
        for (int ai = 0; ai < 2; ++ai)
#pragma unroll
            for (int m = 0; m < 4; ++m) { bf16* rowp = base + (size_t)(ai * 128 + m * 16) * ldc;
#pragma unroll
                for (int bj = 0; bj < 2; ++bj) { const f32x4 v0 = acc[ai][bj][m][0], v1 = acc[ai][bj][m][1];
                    u32x4 w; w.x = cvt_pk_bf16(v0[0], v0[1]); w.y = cvt_pk_bf16(v0[2], v0[3]); w.z = cvt_pk_bf16(v1[0], v1[1]); w.w = cvt_pk_bf16(v1[2], v1[3]);
                    *(u32x4*)(rowp + bj * 128) = w; } }
    }
};
struct EpiSwiglu {
    static constexpr bool PERM = true;
    bf16* HID; int e0;
    __device__ __forceinline__ void operator()(const f32x4 (&acc)[2][2][4][2], const Unit& u, int wr, int wc, int fr, int fq) const {
        bf16* base = HID + ((size_t)(u.e - e0) * EROWSP + (size_t)(u.pm * 256 + wr * 64 + fr)) * DFF + u.pn * 128 + wc * 32 + 8 * fq;
#pragma unroll
        for (int ai = 0; ai < 2; ++ai)
#pragma unroll
            for (int m = 0; m < 4; ++m) { bf16* rowp = base + (size_t)(ai * 128 + m * 16) * DFF;
                float h[8];
#pragma unroll
                for (int n = 0; n < 2; ++n)
#pragma unroll
                    for (int j = 0; j < 4; ++j) { const float g = acc[ai][0][m][n][j], up = acc[ai][1][m][n][j]; h[n * 4 + j] = siluf_(g) * up; }
                u32x4 w; w.x = cvt_pk_bf16(h[0], h[1]); w.y = cvt_pk_bf16(h[2], h[3]); w.z = cvt_pk_bf16(h[4], h[5]); w.w = cvt_pk_bf16(h[6], h[7]);
                *(u32x4*)rowp = w; }
    }
};
struct EpiResid {
    static constexpr bool PERM = false;
    const float* x; const float* meta; float* out; float* h1meta;
    __device__ __forceinline__ void operator()(const f32x4 (&acc)[2][2][4][2], const Unit& u, int wr, int wc, int fr, int fq) const {
        const int col0 = u.pn * 256 + wc * 32 + 4 * fq;
#pragma unroll
        for (int ai = 0; ai < 2; ++ai)
#pragma unroll
            for (int m = 0; m < 4; ++m) {
                const int row = u.pm * 256 + ai * 128 + wr * 64 + m * 16 + fr; const int b = row / PP, p = row - b * PP;
                if (p >= PADF) {
                    const float* src; float* dst;
                    if (p < CHK) { src = meta + (size_t)(p - PADF) * D; dst = h1meta + (size_t)(b * NMETA + p - PADF) * D; }
                    else { src = x + ((size_t)b * SEQ + (p - CHK)) * D; dst = out + ((size_t)b * SEQ + (p - CHK)) * D; }
#pragma unroll
                    for (int bj = 0; bj < 2; ++bj)
#pragma unroll
                        for (int n = 0; n < 2; ++n) { const int col = col0 + bj * 128 + n * 16; const f32x4 hv = *(const f32x4*)(src + col); *(f32x4*)(dst + col) = hv + acc[ai][bj][m][n]; }
                }
            }
    }
};
}

struct Ctx {
    LAS unsigned char* lds; int tid, lane, wave, vcu, G;
    const float *x, *meta, *mix_g, *w_in, *b_gates, *conv_w, *conv_b, *ret_logit, *ret_gn, *ml_gn, *w_out, *ffn_g, *w_router, *w_gate, *w_up, *w_down, *fin_g;
    float* out; unsigned char* ws;
};

__device__ __forceinline__ void transpose_item(const float* W, int K, int N, int ldw, bf16* WT, LAS float* scr, int item, int lane) {
    const int nblk = N / 32, kb = item / nblk, nb = item % nblk, k0 = 64 * kb, n0 = 32 * nb;
#pragma unroll 8
    for (int i = 0; i < 32; ++i) { const int kk = 2 * i + (lane >> 5); scr[kk * 33 + (lane & 31)] = W[(size_t)(k0 + kk) * ldw + n0 + (lane & 31)]; }
    LDS_WAIT(); asm volatile("" ::: "memory");
    const int c = lane & 7;
#pragma unroll
    for (int j = 0; j < 4; ++j) { const int n = (lane >> 3) + 8 * j; const LAS float* s = scr + (8 * c) * 33 + n;
        u32x4 o; o.x = pk2(s[0 * 33], s[1 * 33]); o.y = pk2(s[2 * 33], s[3 * 33]); o.z = pk2(s[4 * 33], s[5 * 33]); o.w = pk2(s[6 * 33], s[7 * 33]);
        *(u32x4*)(WT + (size_t)(n0 + n) * K + k0 + 8 * c) = o; }
    LDS_WAIT(); asm volatile("" ::: "memory");
}
__device__ __forceinline__ void stage_w16(Ctx& F, const float* src, int ld, LAS float* Wt) {
    for (int idx = F.tid; idx < 4096; idx += 512) { const int k = idx >> 2, q = idx & 3; const f32x4 v = *(const f32x4*)(src + (size_t)k * ld + q * 4);
        Wt[(q * 4 + 0) * 1024 + k] = v.x; Wt[(q * 4 + 1) * 1024 + k] = v.y; Wt[(q * 4 + 2) * 1024 + k] = v.z; Wt[(q * 4 + 3) * 1024 + k] = v.w; }
}
__device__ __forceinline__ void rms_row(const float* row, const float* g, int lane, f32x4 (&u)[4]) {
    float s = 0.f;
#pragma unroll
    for (int jj = 0; jj < 4; ++jj) { u[jj] = *(const f32x4*)(row + jj * 256 + lane * 4); s += u[jj].x * u[jj].x + u[jj].y * u[jj].y + u[jj].z * u[jj].z + u[jj].w * u[jj].w; }
    const float rstd = rsqrtf(wave_sum(s) * (1.0f / D) + EPS);
#pragma unroll
    for (int jj = 0; jj < 4; ++jj) { const f32x4 gv = *(const f32x4*)(g + jj * 256 + lane * 4); u[jj] = u[jj] * rstd * gv; }
}
__device__ __forceinline__ void store_row_bf16(bf16* dst, int lane, const f32x4 (&u)[4]) {
#pragma unroll
    for (int jj = 0; jj < 4; ++jj) { u32x2 w; w.x = pk2(u[jj].x, u[jj].y); w.y = pk2(u[jj].z, u[jj].w); *(u32x2*)(dst + jj * 256 + lane * 4) = w; }
}
__device__ __forceinline__ void dots16(const f32x4 (&u)[4], const LAS float* Wt, int lane, float (&o)[16]) {
#pragma unroll
    for (int j = 0; j < 16; ++j) { float s = 0.f;
#pragma unroll
        for (int jj = 0; jj < 4; ++jj) { const f32x4 w = *(const LAS f32x4*)(Wt + j * 1024 + jj * 256 + lane * 4); s += u[jj].x * w.x + u[jj].y * w.y + u[jj].z * w.z + u[jj].w * w.w; }
        o[j] = wave_sum(s); }
}

__device__ __forceinline__ void phase_prep(Ctx& F) {
    bf16* WINT = (bf16*)(F.ws + WS_WINT); bf16* WOUTT = (bf16*)(F.ws + WS_WOUTT);
    LAS float* scr = (LAS float*)(F.lds + F.wave * 16384);
    const int gw = F.vcu * 8 + F.wave, NGW = F.G * 8;
    constexpr int I_IN = (D / 64) * (PC / 32), I_OUT = (D / 64) * (D / 32);
    for (int it = gw; it < I_IN + I_OUT; it += NGW) {
        if (it < I_IN) transpose_item(F.w_in, D, PC, PCOLS, WINT, scr, it, F.lane);
        else transpose_item(F.w_out, D, D, D, WOUTT, scr, it - I_IN, F.lane);
    }
    f32x2* rope = (f32x2*)(F.ws + WS_ROPE);
    for (int idx = (F.vcu * 512 + F.tid); idx < NTOK * 64; idx += F.G * 512) {
        const int n = idx >> 6, i = idx & 63;
        const float inv = (float)exp(-(double)i * (9.210340371976184 / 64.0));
        const float angf = (float)n * inv;
        const double xd = (double)angf; const double kq = rint(xd * 0.6366197723675814);
        double r = fma(-kq, 1.5707963267948966, xd); r = fma(-kq, 6.123233995736766e-17, r);
        const double r2 = r * r;
        double sn = -1.0 / 1307674368000.0; sn = fma(sn, r2, 1.0 / 6227020800.0); sn = fma(sn, r2, -1.0 / 39916800.0); sn = fma(sn, r2, 1.0 / 362880.0); sn = fma(sn, r2, -1.0 / 5040.0); sn = fma(sn, r2, 1.0 / 120.0); sn = fma(sn, r2, -1.0 / 6.0); sn = fma(sn * r2, r, r);
        double cs = 1.0 / 20922789888000.0; cs = fma(cs, r2, -1.0 / 87178291200.0); cs = fma(cs, r2, 1.0 / 479001600.0); cs = fma(cs, r2, -1.0 / 3628800.0); cs = fma(cs, r2, 1.0 / 40320.0); cs = fma(cs, r2, -1.0 / 720.0); cs = fma(cs, r2, 1.0 / 24.0); cs = fma(cs, r2, -0.5); cs = fma(cs, r2, 1.0);
        const int q = ((int)kq) & 3;
        const double c = (q == 0) ? cs : (q == 1) ? -sn : (q == 2) ? -cs : sn;
        const double s = (q == 0) ? sn : (q == 1) ? cs : (q == 2) ? -sn : -cs;
        rope[idx] = (f32x2){(float)c, (float)s};
    }
    __syncthreads();
    LAS float* Wt = (LAS float*)F.lds;
    stage_w16(F, F.w_in + PC, PCOLS, Wt);
    __syncthreads();
    bf16* U1 = (bf16*)(F.ws + WS_ACT1); float* GATES = (float*)(F.ws + WS_GATES);
    for (int r = gw; r < R; r += NGW) {
        const int b = r / PP, p = r - b * PP;
        bf16* urow = U1 + (size_t)r * D; float* grow = GATES + (size_t)r * 16;
        if (p < PADF) {
#pragma unroll
            for (int jj = 0; jj < 4; ++jj) *(u32x2*)(urow + jj * 256 + F.lane * 4) = (u32x2){0u, 0u};
            if (F.lane < 16) grow[F.lane] = (F.lane < 8) ? NEGF : 0.0f;
            continue;
        }
        const float* src = (p < CHK) ? F.meta + (size_t)(p - PADF) * D : F.x + ((size_t)b * SEQ + (p - CHK)) * D;
        f32x4 u[4]; rms_row(src, F.mix_g, F.lane, u);
        store_row_bf16(urow, F.lane, u);
        float o[16]; dots16(u, Wt, F.lane, o);
        float mine = 0.f;
#pragma unroll
        for (int j = 0; j < 16; ++j) mine = (F.lane == j) ? o[j] : mine;
        if (F.lane < 16) { float gv = mine + F.b_gates[F.lane]; if (F.lane >= 8) gv = logsigmoidf_(gv); grow[F.lane] = gv; }
    }
}

__device__ __forceinline__ void phase_rope_conv(Ctx& F) {
    bf16* PROJ = (bf16*)(F.ws + WS_PROJ); bf16* QKC = (bf16*)(F.ws + WS_ACT1); const f32x2* rope = (const f32x2*)(F.ws + WS_ROPE);
    const int gw = F.vcu * 8 + F.wave, NGW = F.G * 8, lane = F.lane;
    const float qs = 0.08838834764831845f;
    for (int r = gw; r < R; r += NGW) {
        const int b = r / PP, p = r - b * PP;
        bf16* qrow = QKC + (size_t)r * D;
        if (p < PADF) {
#pragma unroll
            for (int jj = 0; jj < 2; ++jj) *(u32x4*)(qrow + jj * 512 + lane * 8) = (u32x4){0u, 0u, 0u, 0u};
            continue;
        }
        const int n = p - PADF;
        {
            const int combo = lane >> 3, i0 = (lane & 7) * 8; const int cbase = (combo >> 2) * 512 + (combo & 3) * 128 + i0;
            bf16* pr = PROJ + (size_t)r * PC + cbase;
            const u32x4 a = *(const u32x4*)pr, c = *(const u32x4*)(pr + 64);
            const float sc = (combo < 4) ? qs : 1.0f;
            const f32x2* tb = rope + (size_t)n * 64 + i0;
            unsigned aw[4] = {a.x, a.y, a.z, a.w}, cw[4] = {c.x, c.y, c.z, c.w}; unsigned o1[4], o2[4];
#pragma unroll
            for (int j = 0; j < 4; ++j) {
                const f32x2 t0 = tb[2 * j], t1 = tb[2 * j + 1];
                const float x1a = bflo(aw[j]), x1b = bfhi(aw[j]), x2a = bflo(cw[j]), x2b = bfhi(cw[j]);
                o1[j] = pk2((x1a * t0.x - x2a * t0.y) * sc, (x1b * t1.x - x2b * t1.y) * sc);
                o2[j] = pk2((x2a * t0.x + x1a * t0.y) * sc, (x2b * t1.x + x1b * t1.y) * sc);
            }
            *(u32x4*)pr = (u32x4){o1[0], o1[1], o1[2], o1[3]}; *(u32x4*)(pr + 64) = (u32x4){o2[0], o2[1], o2[2], o2[3]};
        }
#pragma unroll
        for (int jj = 0; jj < 2; ++jj) {
            const int ch0 = jj * 512 + lane * 8;
            float acc[8];
#pragma unroll
            for (int i = 0; i < 8; ++i) acc[i] = F.conv_b[ch0 + i];
#pragma unroll
            for (int j = 0; j < 5; ++j) {
                const int pj = p + j - 2;
                if (pj >= PADF && pj < PP) {
                    const u32x4 v = *(const u32x4*)(PROJ + (size_t)(r + j - 2) * PC + 2048 + ch0);
                    const f32x4 w0 = *(const f32x4*)(F.conv_w + j * 1024 + ch0), w1 = *(const f32x4*)(F.conv_w + j * 1024 + ch0 + 4);
                    acc[0] += bflo(v.x) * w0.x; acc[1] += bfhi(v.x) * w0.y; acc[2] += bflo(v.y) * w0.z; acc[3] += bfhi(v.y) * w0.w;
                    acc[4] += bflo(v.z) * w1.x; acc[5] += bfhi(v.z) * w1.y; acc[6] += bflo(v.w) * w1.z; acc[7] += bfhi(v.w) * w1.w;
                }
            }
            const float sc = (jj == 0) ? qs : 1.0f;
#pragma unroll
            for (int i = 0; i < 8; ++i) acc[i] = siluf_(acc[i]) * sc;
            *(u32x4*)(qrow + ch0) = (u32x4){pk2(acc[0], acc[1]), pk2(acc[2], acc[3]), pk2(acc[4], acc[5]), pk2(acc[6], acc[7])};
        }
    }
}

__device__ __forceinline__ void load_tile(int tid_, LAS bf16* T, const bf16* src, size_t stride) {
#pragma unroll
    for (int i = 0; i < 4; ++i) { const int q = tid_ + 512 * i, row = q >> 4, ch = q & 15; const u32x4 v = *(const u32x4*)(src + (size_t)row * stride + ch * 8); *(LAS u32x4*)(T + row * TP + ch * 8) = v; }
}
__device__ __forceinline__ void load_state_tile(int tid_, LAS bf16* T, const float* src) {
#pragma unroll
    for (int i = 0; i < 8; ++i) { const int q = tid_ + 512 * i, row = q >> 5, c4 = q & 31; const f32x4 v = *(const f32x4*)(src + row * 128 + c4 * 4); *(LAS u32x2*)(T + row * TP + c4 * 4) = (u32x2){pk2(v.x, v.y), pk2(v.z, v.w)}; }
}
template <bool AG, bool BG>
__device__ __forceinline__ void mm128(const LAS bf16* A, const LAS bf16* B, int w, int fr, int fq, f32x4 (&acc)[2][4]) {
    const int m0 = 32 * (w >> 1), n0 = 64 * (w & 1);
#pragma unroll
    for (int ks = 0; ks < 4; ++ks) {
        const int k0 = ks * 32 + 8 * fq;
        bf16x8 a[2], b[4];
#pragma unroll
        for (int mt = 0; mt < 2; ++mt) {
            if (!AG) a[mt] = *(const LAS bf16x8*)(A + (m0 + 16 * mt + fr) * TP + k0);
            else {
#pragma unroll
                for (int j = 0; j < 8; ++j) a[mt][j] = (short)A[(k0 + j) * TP + m0 + 16 * mt + fr]; }
        }
#pragma unroll
        for (int nt = 0; nt < 4; ++nt) {
            if (!BG) b[nt] = *(const LAS bf16x8*)(B + (n0 + 16 * nt + fr) * TP + k0);
            else {
#pragma unroll
                for (int j = 0; j < 8; ++j) b[nt][j] = (short)B[(k0 + j) * TP + n0 + 16 * nt + fr]; }
        }
#pragma unroll
        for (int mt = 0; mt < 2; ++mt)
#pragma unroll
            for (int nt = 0; nt < 4; ++nt) acc[mt][nt] = __builtin_amdgcn_mfma_f32_16x16x32_bf16(a[mt], b[nt], acc[mt][nt], 0, 0, 0);
    }
}
__device__ __forceinline__ void zero_acc(f32x4 (&acc)[2][4]) {
#pragma unroll
    for (int mt = 0; mt < 2; ++mt)
#pragma unroll
        for (int nt = 0; nt < 4; ++nt) acc[mt][nt] = (f32x4){0.f, 0.f, 0.f, 0.f};
}
template <bool MAXOP, bool REV>
__device__ __forceinline__ void scan128(const LAS float* x, LAS float* out, int lane) {
    const int i0 = REV ? 127 - 2 * lane : 2 * lane, i1 = REV ? 126 - 2 * lane : 2 * lane + 1;
    const float a0 = x[i0], a1r = x[i1]; const float a1 = MAXOP ? fmaxf(a0, a1r) : a0 + a1r;
    float s = a1;
#pragma unroll
    for (int o = 1; o < 64; o <<= 1) { const float t = __shfl_up(s, o); if (lane >= o) s = MAXOP ? fmaxf(t, s) : t + s; }
    float ex = __shfl_up(s, 1); if (lane == 0) ex = MAXOP ? -3.0e38f : 0.0f;
    out[i0] = MAXOP ? fmaxf(ex, a0) : ex + a0; out[i1] = s;
}
__device__ __forceinline__ int state_idx(int b, int h, int grp, int dir) { return ((b * NH + h) * 2 + grp) * 2 + dir; }

__device__ __forceinline__ void phase_chunk_a(Ctx& F) {
    const bf16* PROJ = (const bf16*)(F.ws + WS_PROJ); const bf16* QKC = (const bf16*)(F.ws + WS_ACT1); const float* GATES = (const float*)(F.ws + WS_GATES);
    float* STATE = (float*)(F.ws + WS_STATE); float* UN = (float*)(F.ws + WS_UN); float* SCAL = (float*)(F.ws + WS_SCAL);
    LAS bf16* T0 = (LAS bf16*)(F.lds + T0_OFF); LAS bf16* T1 = (LAS bf16*)(F.lds + T1_OFF); LAS bf16* T2 = (LAS bf16*)(F.lds + T2_OFF); LAS bf16* T3 = (LAS bf16*)(F.lds + T3_OFF);
    LAS float* VEC = (LAS float*)(F.lds + VEC_OFF);
    const int w = F.wave;
    for (int u = F.vcu; u < NB * NCH * NH * 2; u += F.G) {
        int tid = F.tid; asm volatile("" : "+v"(tid));
        const int lane = tid & 63, fr = lane & 15, fq = lane >> 4;
        const int grp = u & 1, h = (u >> 1) & 3, bc_ = u >> 3, c = bc_ % NCH, b = bc_ / NCH;
        const size_t r0 = (size_t)b * PP + (size_t)c * CHK;
        __syncthreads();
        if (grp == 0) { load_tile(tid, T1, PROJ + r0 * PC + 512 + h * 128, PC); load_tile(tid, T2, PROJ + r0 * PC + 1024 + h * 128, PC); }
        else {
            load_tile(tid, T1, QKC + r0 * D + 512 + h * 128, D); load_tile(tid, T2, PROJ + r0 * PC + 3072 + h * 128, PC);
            if (tid < 256) { const int l = tid & 127, dir = tid >> 7; VEC[dir * 128 + l] = GATES[(r0 + l) * 16 + dir * 4 + h]; VEC[(2 + dir) * 128 + l] = GATES[(r0 + l) * 16 + 8 + dir * 4 + h]; }
        }
        __syncthreads();
        if (grp == 0) {
            if (tid < 256) { const int l = tid & 127, dir = tid >> 7; const float lg = logsigmoidf_(F.ret_logit[dir * NH + h]);
                VEC[(18 + dir) * 128 + l] = __expf(lg * (dir == 0 ? (float)(127 - l) : (float)l)); }
        } else {
            if (w < 2) { const int dir = w;
                if (dir == 0) scan128<false, false>(VEC + 2 * 128, VEC + 4 * 128, lane); else scan128<false, true>(VEC + 3 * 128, VEC + 5 * 128, lane);
                LDS_WAIT();
                const LAS float* bc = VEC + (4 + dir) * 128; const LAS float* li = VEC + dir * 128;
                const float blast = (dir == 0) ? bc[127] : bc[0];
                const float lu0 = blast - bc[2 * lane] + li[2 * lane], lu1 = blast - bc[2 * lane + 1] + li[2 * lane + 1];
                const float a = wave_max(fmaxf(lu0, lu1));
                VEC[(18 + dir) * 128 + 2 * lane] = __expf(lu0 - a); VEC[(18 + dir) * 128 + 2 * lane + 1] = __expf(lu1 - a);
                if (lane == 0) { const int sidx = state_idx(b, h, 1, dir); SCAL[sidx * NCH + c] = a; SCAL[64 * NCH + sidx * NCH + c] = blast; }
            }
        }
        __syncthreads();
#pragma unroll
        for (int i = 0; i < 4; ++i) { const int q = tid + 512 * i, row = q >> 4, ch = q & 15; const u32x4 v = *(const LAS u32x4*)(T2 + row * TP + ch * 8);
            const float wf = VEC[18 * 128 + row], wb = VEC[19 * 128 + row]; const unsigned vw[4] = {v.x, v.y, v.z, v.w}; unsigned of[4], ob[4];
#pragma unroll
            for (int j = 0; j < 4; ++j) { const float lo = bflo(vw[j]), hi = bfhi(vw[j]); of[j] = pk2(lo * wf, hi * wf); ob[j] = pk2(lo * wb, hi * wb); }
            *(LAS u32x4*)(T0 + row * TP + ch * 8) = (u32x4){of[0], of[1], of[2], of[3]}; *(LAS u32x4*)(T3 + row * TP + ch * 8) = (u32x4){ob[0], ob[1], ob[2], ob[3]}; }
        __syncthreads();
#pragma unroll
        for (int dir = 0; dir < 2; ++dir) {
            f32x4 acc[2][4]; zero_acc(acc);
            mm128<true, true>(dir == 0 ? T0 : T3, T1, w, fr, fq, acc);
            float* dst = STATE + ((size_t)state_idx(b, h, grp, dir) * NCH + c) * 16384;
#pragma unroll
            for (int mt = 0; mt < 2; ++mt)
#pragma unroll
                for (int nt = 0; nt < 4; ++nt)
#pragma unroll
                    for (int rg = 0; rg < 4; ++rg) dst[(32 * (w >> 1) + 16 * mt + 4 * fq + rg) * 128 + 64 * (w & 1) + 16 * nt + fr] = acc[mt][nt][rg];
        }
        if (grp == 1 && tid < 256) {
            const int d = tid & 127, dir = tid >> 7; float s = 0.f;
            for (int l = 0; l < 128; ++l) s += VEC[(18 + dir) * 128 + l] * bf2f(T1[l * TP + d]);
            UN[((size_t)state_idx(b, h, 1, dir) * NCH + c) * 128 + d] = s;
        }
    }
}

__device__ __forceinline__ void scan_coef(const float* SCAL, int sidx, int grp, int c, float g128, float& m_run, float& fc, float& gc, float& mprev) {
    if (grp == 0) { fc = g128; gc = 1.0f; mprev = 0.f; return; }
    const float a = SCAL[sidx * NCH + c], bl = SCAL[64 * NCH + sidx * NCH + c];
    mprev = m_run; const float mn = fmaxf(bl + m_run, a); fc = __expf(bl + m_run - mn); gc = __expf(a - mn); m_run = mn;
}
__device__ __forceinline__ void phase_scan(Ctx& F) {
    float* STATE = (float*)(F.ws + WS_STATE); float* UN = (float*)(F.ws + WS_UN); float* SCAL = (float*)(F.ws + WS_SCAL);
    const int gt = F.vcu * 512 + F.tid, NT = F.G * 512;
    for (int q = gt; q < 64 * 4096; q += NT) {
        const int sidx = q >> 12, e4 = q & 4095, dir = sidx & 1, grp = (sidx >> 1) & 1, h = (sidx >> 2) & 3;
        const float g128 = (grp == 0) ? __expf(128.0f * logsigmoidf_(F.ret_logit[dir * NH + h])) : 0.f;
        f32x4* base = (f32x4*)(STATE + (size_t)sidx * NCH * 16384) + e4;
        f32x4 run = (f32x4){0.f, 0.f, 0.f, 0.f}; float m_run = 0.f;
        for (int c5 = 0; c5 < NCH; c5 += 5) {
            f32x4 uu[5];
#pragma unroll
            for (int j = 0; j < 5; ++j) { const int c = dir ? NCH - 1 - (c5 + j) : c5 + j; uu[j] = base[(size_t)c * 4096]; }
#pragma unroll
            for (int j = 0; j < 5; ++j) { const int c = dir ? NCH - 1 - (c5 + j) : c5 + j; float fc, gc, mp; scan_coef(SCAL, sidx, grp, c, g128, m_run, fc, gc, mp);
                base[(size_t)c * 4096] = run; run = run * fc + uu[j] * gc;
                if (grp == 1 && e4 == 0) SCAL[128 * NCH + sidx * NCH + c] = mp; }
        }
    }
    for (int q = gt; q < 64 * 128; q += NT) {
        const int sidx = q >> 7, d = q & 127, dir = sidx & 1, grp = (sidx >> 1) & 1;
        if (grp == 0) continue;
        float* base = UN + (size_t)sidx * NCH * 128 + d; float run = 0.f, m_run = 0.f;
        for (int cc = 0; cc < NCH; ++cc) { const int c = dir ? NCH - 1 - cc : cc; float fc, gc, mp; scan_coef(SCAL, sidx, 1, c, 0.f, m_run, fc, gc, mp);
            const float uv = base[c * 128]; base[c * 128] = run; run = run * fc + uv * gc; }
    }
}

__device__ __forceinline__ void phase_chunk_c(Ctx& F) {
    const bf16* PROJ = (const bf16*)(F.ws + WS_PROJ); const bf16* QKC = (const bf16*)(F.ws + WS_ACT1); const float* GATES = (const float*)(F.ws + WS_GATES);
    const float* STATE = (const float*)(F.ws + WS_STATE); const float* UN = (const float*)(F.ws + WS_UN); const float* SCAL = (const float*)(F.ws + WS_SCAL);
    bf16* Y = (bf16*)(F.ws + WS_ACT2);
    LAS bf16* T0 = (LAS bf16*)(F.lds + T0_OFF); LAS bf16* T1 = (LAS bf16*)(F.lds + T1_OFF); LAS bf16* T2 = (LAS bf16*)(F.lds + T2_OFF); LAS bf16* T3 = (LAS bf16*)(F.lds + T3_OFF);
    LAS float* VEC = (LAS float*)(F.lds + VEC_OFF); LAS float* OT = (LAS float*)(F.lds);
    const int w = F.wave;
    const int m0 = 32 * (w >> 1), n0 = 64 * (w & 1);
    for (int u = F.vcu; u < NB * NCH * NH * 2; u += F.G) {
        int tid = F.tid; asm volatile("" : "+v"(tid));
        const int lane = tid & 63, fr = lane & 15, fq = lane >> 4;
        const int grp = u & 1, h = (u >> 1) & 3, bc_ = u >> 3, c = bc_ % NCH, b = bc_ / NCH;
        const size_t r0 = (size_t)b * PP + (size_t)c * CHK;
        __syncthreads();
        f32x4 accO[2][4];
        if (grp == 0) {
            load_tile(tid, T0, PROJ + r0 * PC + h * 128, PC); load_tile(tid, T1, PROJ + r0 * PC + 512 + h * 128, PC); load_tile(tid, T2, PROJ + r0 * PC + 1024 + h * 128, PC);
            const float l2f = logsigmoidf_(F.ret_logit[h]) * 1.4426950408889634f, l2b = logsigmoidf_(F.ret_logit[NH + h]) * 1.4426950408889634f;
            __syncthreads();
            {   f32x4 accS[2][4]; zero_acc(accS); mm128<false, false>(T0, T1, w, fr, fq, accS);
#pragma unroll
                for (int mt = 0; mt < 2; ++mt)
#pragma unroll
                    for (int nt = 0; nt < 4; ++nt)
#pragma unroll
                        for (int rg = 0; rg < 4; ++rg) { const int l = m0 + 16 * mt + 4 * fq + rg, m = n0 + 16 * nt + fr;
                            const float fac = (l > m) ? exp2f(l2f * (float)(l - m)) : (l < m) ? exp2f(l2b * (float)(m - l)) : 2.0f;
                            T3[l * TP + m] = (bf16)f2bf(accS[mt][nt][rg] * fac); }
            }
            __syncthreads();
            load_state_tile(tid, T1, STATE + ((size_t)state_idx(b, h, 0, 0) * NCH + c) * 16384);
            __syncthreads();
            zero_acc(accO); mm128<false, false>(T0, T1, w, fr, fq, accO);
#pragma unroll
            for (int mt = 0; mt < 2; ++mt)
#pragma unroll
                for (int rg = 0; rg < 4; ++rg) { const int l = m0 + 16 * mt + 4 * fq + rg; const float xf = exp2f(l2f * (float)(l + 1));
#pragma unroll
                    for (int nt = 0; nt < 4; ++nt) accO[mt][nt][rg] *= xf; }
            __syncthreads();
            load_state_tile(tid, T1, STATE + ((size_t)state_idx(b, h, 0, 1) * NCH + c) * 16384);
            __syncthreads();
            {   f32x4 accX[2][4]; zero_acc(accX); mm128<false, false>(T0, T1, w, fr, fq, accX);
#pragma unroll
                for (int mt = 0; mt < 2; ++mt)
#pragma unroll
                    for (int rg = 0; rg < 4; ++rg) { const int l = m0 + 16 * mt + 4 * fq + rg; const float xb = exp2f(l2b * (float)(128 - l));
#pragma unroll
                        for (int nt = 0; nt < 4; ++nt) accO[mt][nt][rg] += xb * accX[mt][nt][rg]; }
            }
            mm128<false, true>(T3, T2, w, fr, fq, accO);
        } else {
            load_tile(tid, T0, QKC + r0 * D + h * 128, D); load_tile(tid, T1, QKC + r0 * D + 512 + h * 128, D); load_tile(tid, T2, PROJ + r0 * PC + 3072 + h * 128, PC);
            if (tid < 256) { const int l = tid & 127, dir = tid >> 7; VEC[dir * 128 + l] = GATES[(r0 + l) * 16 + dir * 4 + h]; VEC[(2 + dir) * 128 + l] = GATES[(r0 + l) * 16 + 8 + dir * 4 + h]; }
            __syncthreads();
            if (w < 2) { const int dir = w;
                if (dir == 0) scan128<false, false>(VEC + 2 * 128, VEC + 4 * 128, lane); else scan128<false, true>(VEC + 3 * 128, VEC + 5 * 128, lane);
                LDS_WAIT();
                VEC[(6 + dir) * 128 + 2 * lane] = VEC[dir * 128 + 2 * lane] - VEC[(4 + dir) * 128 + 2 * lane];
                VEC[(6 + dir) * 128 + 2 * lane + 1] = VEC[dir * 128 + 2 * lane + 1] - VEC[(4 + dir) * 128 + 2 * lane + 1];
                LDS_WAIT();
                if (dir == 0) scan128<true, false>(VEC + 6 * 128, VEC + 8 * 128, lane); else scan128<true, true>(VEC + 7 * 128, VEC + 9 * 128, lane);
            }
            __syncthreads();
            if (tid < 256) { const int l = tid & 127, dir = tid >> 7; const float mprev = SCAL[128 * NCH + state_idx(b, h, 1, dir) * NCH + c];
                const float bcl = VEC[(4 + dir) * 128 + l], linter = bcl + mprev, mrow = fmaxf(linter, bcl + VEC[(8 + dir) * 128 + l]);
                VEC[(10 + dir) * 128 + l] = bcl - mrow; VEC[(12 + dir) * 128 + l] = __expf(linter - mrow); VEC[(14 + dir) * 128 + l] = __expf(-mrow); }
            zero_acc(accO);
#pragma unroll 1
            for (int dir = 0; dir < 2; ++dir) {
                int tid2 = tid; asm volatile("" : "+v"(tid2));
                const int lane = tid2 & 63, fr = lane & 15, fq = lane >> 4;
                if (dir == 1) load_tile(tid2, T1, QKC + r0 * D + 512 + h * 128, D);
                __syncthreads();
                const LAS float* E1 = VEC + (10 + dir) * 128; const LAS float* GG = VEC + (6 + dir) * 128; const LAS float* WI = VEC + (12 + dir) * 128; const LAS float* FL = VEC + (14 + dir) * 128;
                {   f32x4 accS[2][4]; zero_acc(accS); mm128<false, false>(T0, T1, w, fr, fq, accS);
#pragma unroll
                    for (int mt = 0; mt < 2; ++mt)
#pragma unroll
                        for (int nt = 0; nt < 4; ++nt)
#pragma unroll
                            for (int rg = 0; rg < 4; ++rg) { const int l = m0 + 16 * mt + 4 * fq + rg, m = n0 + 16 * nt + fr;
                                const bool ok = dir == 0 ? (m <= l) : (m >= l);
                                const float pv = ok ? accS[mt][nt][rg] * __expf(E1[l] + GG[m]) : 0.0f;
                                T3[l * TP + m] = (bf16)f2bf(pv); }
                }
                __syncthreads();
                const int sidx = state_idx(b, h, 1, dir);
                load_state_tile(tid2, T1, STATE + ((size_t)sidx * NCH + c) * 16384);
                if (tid2 < 128) VEC[17 * 128 + tid2] = UN[((size_t)sidx * NCH + c) * 128 + tid2];
                __syncthreads();
                f32x4 accN[2][4]; zero_acc(accN); mm128<false, false>(T0, T1, w, fr, fq, accN);
#pragma unroll
                for (int mt = 0; mt < 2; ++mt)
#pragma unroll
                    for (int rg = 0; rg < 4; ++rg) { const float wi = WI[m0 + 16 * mt + 4 * fq + rg];
#pragma unroll
                        for (int nt = 0; nt < 4; ++nt) accN[mt][nt][rg] *= wi; }
                mm128<false, true>(T3, T2, w, fr, fq, accN);
#pragma unroll 1
                for (int rr = 0; rr < 16; ++rr) { const int l = 16 * w + rr;
                    float ps = bf2f(T3[l * TP + lane]) + bf2f(T3[l * TP + lane + 64]);
                    float qn = bf2f(T0[l * TP + lane]) * VEC[17 * 128 + lane] + bf2f(T0[l * TP + lane + 64]) * VEC[17 * 128 + lane + 64];
                    ps = wave_sum(ps); qn = wave_sum(qn);
                    const float den = ps + WI[l] * qn;
                    if (lane == 0) VEC[16 * 128 + l] = 1.0f / fmaxf(fabsf(den), FL[l]); }
                __syncthreads();
#pragma unroll
                for (int mt = 0; mt < 2; ++mt)
#pragma unroll
                    for (int rg = 0; rg < 4; ++rg) { const float inv = VEC[16 * 128 + m0 + 16 * mt + 4 * fq + rg];
#pragma unroll
                        for (int nt = 0; nt < 4; ++nt) accO[mt][nt][rg] += accN[mt][nt][rg] * inv; }
            }
        }
        __syncthreads();
#pragma unroll
        for (int mt = 0; mt < 2; ++mt)
#pragma unroll
            for (int nt = 0; nt < 4; ++nt)
#pragma unroll
                for (int rg = 0; rg < 4; ++rg) OT[(m0 + 16 * mt + 4 * fq + rg) * 132 + n0 + 16 * nt + fr] = accO[mt][nt][rg];
        __syncthreads();
        for (int rr = 0; rr < 16; ++rr) { const int l = 16 * w + rr; const size_t r = r0 + l;
            bf16* yrow = Y + r * D + grp * 512 + h * 128;
            if (c == 0 && l < PADF) { yrow[lane] = 0; yrow[lane + 64] = 0; continue; }
            float v0 = OT[l * 132 + lane], v1 = OT[l * 132 + lane + 64];
            if (grp == 1) { const bf16* mo = PROJ + r * PC + 3584 + h * 128; v0 *= sigmoidf_(bf2f(mo[lane])); v1 *= sigmoidf_(bf2f(mo[lane + 64])); }
            const float mu = wave_sum(v0 + v1) * (1.0f / 128.0f); const float d0 = v0 - mu, d1 = v1 - mu;
            const float rstd = rsqrtf(wave_sum(d0 * d0 + d1 * d1) * (1.0f / 128.0f) + EPS);
            const float* gn = (grp == 0 ? F.ret_gn : F.ml_gn) + h * 128;
            float y0 = d0 * rstd * gn[lane], y1 = d1 * rstd * gn[lane + 64];
            if (grp == 0) { const bf16* rg_ = PROJ + r * PC + 1536 + h * 128; y0 *= siluf_(bf2f(rg_[lane])); y1 *= siluf_(bf2f(rg_[lane + 64])); }
            yrow[lane] = (bf16)f2bf(y0); yrow[lane + 64] = (bf16)f2bf(y1); }
    }
}

__device__ __forceinline__ void phase_router(Ctx& F) {
    const int gw = F.vcu * 8 + F.wave, NGW = F.G * 8;
    {
        bf16* WgT = (bf16*)(F.ws + WS_WEXP); bf16* WuT = (bf16*)(F.ws + WS_WEXP + WEXP_ONE); bf16* WdT = (bf16*)(F.ws + WS_WEXP + 2 * WEXP_ONE);
        LAS float* scr = (LAS float*)(F.lds + 65536 + F.wave * 8704);
        constexpr int I_ONE = (D / 64) * (DFF / 32);
        for (int it = gw; it < 3 * NE * I_ONE; it += NGW) {
            const int mat = it / (NE * I_ONE), rem = it - mat * (NE * I_ONE), e = rem / I_ONE, item = rem - e * I_ONE;
            if (mat == 0) transpose_item(F.w_gate + (size_t)e * D * DFF, D, DFF, DFF, WgT + (size_t)e * DFF * D, scr, item, F.lane);
            else if (mat == 1) transpose_item(F.w_up + (size_t)e * D * DFF, D, DFF, DFF, WuT + (size_t)e * DFF * D, scr, item, F.lane);
            else transpose_item(F.w_down + (size_t)e * DFF * D, DFF, D, D, WdT + (size_t)e * D * DFF, scr, item, F.lane);
        }
    }
    LAS float* Wt = (LAS float*)F.lds;
    stage_w16(F, F.w_router, 16, Wt);
    __syncthreads();
    bf16* U2 = (bf16*)(F.ws + WS_ACT1); float* AFF = (float*)(F.ws + WS_AFF); const float* H1M = (const float*)(F.ws + WS_H1META);
    for (int r = gw; r < R; r += NGW) {
        const int b = r / PP, p = r - b * PP; bf16* urow = U2 + (size_t)r * D;
        if (p < PADF) {
#pragma unroll
            for (int jj = 0; jj < 4; ++jj) *(u32x2*)(urow + jj * 256 + F.lane * 4) = (u32x2){0u, 0u};
            continue;
        }
        const float* src = (p < CHK) ? H1M + (size_t)(b * NMETA + p - PADF) * D : F.out + ((size_t)b * SEQ + (p - CHK)) * D;
        f32x4 u[4]; rms_row(src, F.ffn_g, F.lane, u);
        store_row_bf16(urow, F.lane, u);
        float o[16]; dots16(u, Wt, F.lane, o);
        float mx = o[0];
#pragma unroll
        for (int j = 1; j < 16; ++j) mx = fmaxf(mx, o[j]);
        float sum = 0.f, mine = 0.f;
#pragma unroll
        for (int j = 0; j < 16; ++j) { const float ev = expf(o[j] - mx); sum += ev; mine = (F.lane == j) ? ev : mine; }
        if (F.lane < 16) AFF[((size_t)b * NE + F.lane) * NTOK + (p - PADF)] = mine / sum;
    }
}

__device__ __forceinline__ void phase_topk(Ctx& F) {
    const float* AFF = (const float*)(F.ws + WS_AFF); int* IDX = (int*)(F.ws + WS_IDX); float* GV = (float*)(F.ws + WS_GV); int* SLOT = (int*)(F.ws + WS_SLOT);
    LAS unsigned* keys = (LAS unsigned*)F.lds; LAS unsigned* hist = keys + 8448; LAS unsigned* misc = hist + 256; LAS unsigned* wtot = misc + 16;
    const int tid = F.tid, lane = F.lane, w = F.wave;
    for (int u = F.vcu; u < NB * NE; u += F.G) {
        const int b = u >> 4, e = u & 15; const float* a = AFF + (size_t)u * NTOK;
        __syncthreads();
        for (int i = tid; i < NTOK; i += 512) keys[i] = __builtin_bit_cast(unsigned, a[i]);
        unsigned prefix = 0u, need = CAP;
        for (int pass = 0; pass < 4; ++pass) {
            const int shift = 24 - 8 * pass;
            if (tid < 256) hist[tid] = 0u;
            __syncthreads();
            for (int i = tid; i < NTOK; i += 512) { const unsigned k = keys[i]; if (pass == 0 || (k >> (shift + 8)) == (prefix >> (shift + 8))) atomicAdd((unsigned*)&hist[(k >> shift) & 255u], 1u); }
            __syncthreads();
            if (tid == 0) { unsigned cum = 0u; int sel = 0; for (int bin = 255; bin >= 0; --bin) { const unsigned hc = hist[bin]; if (cum + hc >= need) { sel = bin; break; } cum += hc; }
                misc[0] = prefix | ((unsigned)sel << shift); misc[1] = need - cum; }
            __syncthreads();
            prefix = misc[0]; need = misc[1];
            __syncthreads();
        }
        const int i0 = tid * 17, i1 = (i0 + 17 < NTOK) ? i0 + 17 : NTOK;
        unsigned cg_ = 0u, ce = 0u;
        for (int i = i0; i < i1; ++i) { const unsigned k = keys[i]; cg_ += (k > prefix) ? 1u : 0u; ce += (k == prefix) ? 1u : 0u; }
        unsigned sg = cg_, se = ce;
#pragma unroll
        for (int o = 1; o < 64; o <<= 1) { const unsigned tg = __shfl_up(sg, o), te = __shfl_up(se, o); if (lane >= o) { sg += tg; se += te; } }
        if (lane == 63) { wtot[w] = sg; wtot[8 + w] = se; }
        __syncthreads();
        unsigned og = 0u, oe = 0u;
        for (int j = 0; j < w; ++j) { og += wtot[j]; oe += wtot[8 + j]; }
        unsigned gb = og + sg - cg_, eb = oe + se - ce;
        for (int i = i0; i < i1; ++i) { const unsigned k = keys[i]; int slot = -1;
            if (k > prefix) { slot = (int)(gb + (eb < need ? eb : need)); ++gb; }
            else if (k == prefix) { if (eb < need) slot = (int)(gb + eb); ++eb; }
            SLOT[((size_t)b * NTOK + i) * NE + e] = slot;
            if (slot >= 0) { IDX[(size_t)u * CAP + slot] = i; GV[(size_t)u * CAP + slot] = __builtin_bit_cast(float, k); } }
    }
}

__device__ __forceinline__ void phase_final(Ctx& F) {
    const int* SLOT = (const int*)(F.ws + WS_SLOT); const float* GV = (const float*)(F.ws + WS_GV); const bf16* YE = (const bf16*)(F.ws + WS_YE);
    const int gw = F.vcu * 8 + F.wave, NGW = F.G * 8, lane = F.lane;
    for (int t = gw; t < NB * SEQ; t += NGW) {
        const int b = t / SEQ, s = t - b * SEQ, n = s + NMETA;
        float* row = F.out + (size_t)t * D;
        f32x4 v[4];
#pragma unroll
        for (int jj = 0; jj < 4; ++jj) v[jj] = *(const f32x4*)(row + jj * 256 + lane * 4);
        const int myslot = (lane < 16) ? SLOT[((size_t)b * NTOK + n) * NE + lane] : -1;
        for (int e = 0; e < NE; ++e) {
            const int slot = __shfl(myslot, e);
            if (slot >= 0) {
                const float g = GV[((size_t)b * NE + e) * CAP + slot];
                const bf16* yr = YE + ((size_t)e * EROWSP + (size_t)b * CAP + slot) * D;
#pragma unroll
                for (int jj = 0; jj < 4; ++jj) { const u32x2 yw = *(const u32x2*)(yr + jj * 256 + lane * 4);
                    v[jj].x += g * bflo(yw.x); v[jj].y += g * bfhi(yw.x); v[jj].z += g * bflo(yw.y); v[jj].w += g * bfhi(yw.y); }
            }
        }
        float ss = 0.f;
#pragma unroll
        for (int jj = 0; jj < 4; ++jj) ss += v[jj].x * v[jj].x + v[jj].y * v[jj].y + v[jj].z * v[jj].z + v[jj].w * v[jj].w;
        const float rstd = rsqrtf(wave_sum(ss) * (1.0f / D) + EPS);
#pragma unroll
        for (int jj = 0; jj < 4; ++jj) { const f32x4 gv = *(const f32x4*)(F.fin_g + jj * 256 + lane * 4); *(f32x4*)(row + jj * 256 + lane * 4) = v[jj] * rstd * gv; }
    }
}

constexpr int N_PHASES = 14;
struct Args { const float* in[17]; float* out; unsigned char* ws; };
template <int LO, int HI> __global__ void __launch_bounds__(512, 2) mk_fwd(Args args) {
    extern __shared__ __attribute__((aligned(16))) unsigned char lds_raw[];
    Ctx F;
    F.lds = (LAS unsigned char*)lds_raw;
    F.tid = threadIdx.x; F.lane = F.tid & 63; F.wave = __builtin_amdgcn_readfirstlane(F.tid >> 6);
    F.G = gridDim.x; { const int bx = blockIdx.x; F.vcu = (F.G % 8 == 0) ? (bx % 8) * (F.G / 8) + bx / 8 : bx; }
    F.x = args.in[0]; F.meta = args.in[1]; F.mix_g = args.in[2]; F.w_in = args.in[3]; F.b_gates = args.in[4]; F.conv_w = args.in[5]; F.conv_b = args.in[6];
    F.ret_logit = args.in[7]; F.ret_gn = args.in[8]; F.ml_gn = args.in[9]; F.w_out = args.in[10]; F.ffn_g = args.in[11]; F.w_router = args.in[12];
    F.w_gate = args.in[13]; F.w_up = args.in[14]; F.w_down = args.in[15]; F.fin_g = args.in[16];
    F.out = args.out; F.ws = args.ws;
#if MK_SPLIT
#define GRID_BAR() do {} while (0)
#else
    cg::grid_group grid = cg::this_grid();
#define GRID_BAR() grid.sync()
#endif
#define IN(k) (LO <= (k) && (k) < HI)
#define SEAM(k) do { if (IN(k) && IN((k) + 1)) GRID_BAR(); } while (0)

    if (IN(0)) { phase_prep(F); } SEAM(0);
    if (IN(1)) {
        pg8::DenseOrder S{(const bf16*)(F.ws + WS_ACT1), (const bf16*)(F.ws + WS_WINT), D, D, R / 256, PC / 256, (R / 256) * (PC / 256), F.G, (int)blockIdx.x};
        pg8::EpiStoreBf16 E{(bf16*)(F.ws + WS_PROJ), PC, 0};
        pg8::gemm_phase(F.lds, D, S, E);
    } SEAM(1);
    if (IN(2)) { phase_rope_conv(F); } SEAM(2);
    if (IN(3)) { phase_chunk_a(F); } SEAM(3);
    if (IN(4)) { phase_scan(F); } SEAM(4);
    if (IN(5)) { phase_chunk_c(F); } SEAM(5);
    if (IN(6)) {
        pg8::DenseOrder S{(const bf16*)(F.ws + WS_ACT2), (const bf16*)(F.ws + WS_WOUTT), D, D, R / 256, D / 256, (R / 256) * (D / 256), F.G, (int)blockIdx.x};
        pg8::EpiResid E{F.x, F.meta, F.out, (float*)(F.ws + WS_H1META)};
        pg8::gemm_phase(F.lds, D, S, E);
    } SEAM(6);
    if (IN(7)) { phase_router(F); } SEAM(7);
    if (IN(8)) { phase_topk(F); } SEAM(8);
#pragma unroll
    for (int hf = 0; hf < 2; ++hf) {
        if (IN(9 + 2 * hf)) {
            pg8::FfnUpOrder S{(const bf16*)(F.ws + WS_ACT1), (const int*)(F.ws + WS_IDX), (const bf16*)(F.ws + WS_WEXP), (const bf16*)(F.ws + WS_WEXP + WEXP_ONE), D, D, hf * EHALF, EHALF * 22 * 17, F.G, F.vcu};
            pg8::EpiSwiglu E{(bf16*)(F.ws + WS_HID), hf * EHALF};
            pg8::gemm_phase(F.lds, D, S, E);
        } SEAM(9 + 2 * hf);
        if (IN(10 + 2 * hf)) {
            pg8::FfnDownOrder S{(const bf16*)(F.ws + WS_HID), (const bf16*)(F.ws + WS_WEXP + 2 * WEXP_ONE), DFF, DFF, hf * EHALF, EHALF * 4 * 17, F.G, F.vcu};
            pg8::EpiStoreBf16 E{(bf16*)(F.ws + WS_YE), D, (size_t)EROWSP * D};
            pg8::gemm_phase(F.lds, DFF, S, E);
        } SEAM(10 + 2 * hf);
    }
    if (IN(13)) { phase_final(F); }
#undef IN
#undef SEAM
}

template <int PH> static void launch_split(int grid, hipStream_t stream, const Args& a) {
    if constexpr (PH < N_PHASES) {
        static bool attr = false;
        if (!attr) { (void)hipFuncSetAttribute((const void*)mk_fwd<PH, PH + 1>, hipFuncAttributeMaxDynamicSharedMemorySize, LDS_BYTES); attr = true; }
        hipLaunchKernelGGL((mk_fwd<PH, PH + 1>), dim3(grid), dim3(512), LDS_BYTES, stream, a);
        launch_split<PH + 1>(grid, stream, a);
    }
}
extern "C" void kernel_launch(void* const* d_in, const int* in_sizes, int n_in, void* d_out, int out_size, void* d_ws, size_t ws_size, hipStream_t stream) {
    static int grid = 0;
    if (grid == 0) {
        if (n_in != 17 || out_size != NB * SEQ * D || ws_size < WS_END) { fprintf(stderr, "kernel_launch: unexpected shapes (n_in %d out %d ws %zu need %zu)\n", n_in, out_size, ws_size, (size_t)WS_END); grid = -1; return; }
        int dev = 0, cus = 0;
        if (hipGetDevice(&dev) != hipSuccess || hipDeviceGetAttribute(&cus, hipDeviceAttributeMultiprocessorCount, dev) != hipSuccess) { grid = -1; return; }
#if !MK_SPLIT
        int per_cu = 0;
        if (hipFuncSetAttribute((const void*)mk_fwd<0, N_PHASES>, hipFuncAttributeMaxDynamicSharedMemorySize, LDS_BYTES) != hipSuccess) { fprintf(stderr, "kernel_launch: hipFuncSetAttribute failed\n"); grid = -1; return; }
        if (hipOccupancyMaxActiveBlocksPerMultiprocessor(&per_cu, (const void*)mk_fwd<0, N_PHASES>, 512, LDS_BYTES) != hipSuccess || per_cu < 1) { fprintf(stderr, "kernel_launch: occupancy query says %d\n", per_cu); }
#endif
        (void)hipGetLastError();
        grid = cus;
    }
    if (grid < 0) return;
    Args a{};
    for (int i = 0; i < 17; ++i) a.in[i] = (const float*)d_in[i];
    a.out = (float*)d_out; a.ws = (unsigned char*)d_ws;
#if MK_SPLIT
    launch_split<0>(grid, stream, a);
#else
    void* kargs[] = {&a};
    hipError_t e = hipLaunchCooperativeKernel((const void*)mk_fwd<0, N_PHASES>, dim3(grid), dim3(512), kargs, LDS_BYTES, stream);
    if (e != hipSuccess) fprintf(stderr, "cooperative launch failed: %s (grid %d)\n", hipGetErrorString(e), grid);
#endif
}
```

```cpp
#include <hip/hip_runtime.h>
#include <hip/hip_cooperative_groups.h>
#include <cstdio>
#include <cstdint>
namespace cg = cooperative_groups;

#ifndef MK_SPLIT
#define MK_SPLIT 0
#endif
#ifndef PROBE_MASK
#define PROBE_MASK 0
#endif
#ifndef MK_BARRIER
#define MK_BARRIER 1
#endif

#define GAS __attribute__((address_space(1)))
#define LAS __attribute__((address_space(3)))
typedef unsigned short bf16;
typedef short bf16x8 __attribute__((ext_vector_type(8)));
typedef float f32x4 __attribute__((ext_vector_type(4)));
typedef float f32x2 __attribute__((ext_vector_type(2)));
typedef unsigned u32x4 __attribute__((ext_vector_type(4)));
typedef unsigned u32x2 __attribute__((ext_vector_type(2)));
typedef int i32x8 __attribute__((ext_vector_type(8)));
typedef int i32x4 __attribute__((ext_vector_type(4)));

constexpr int NB = 4, SEQ = 8192, D = 1024, NMETA = 16, CHK = 128, PADF = 112;
constexpr int NTOK = NMETA + SEQ;
constexpr int PP = NTOK + PADF;
constexpr int NCH = PP / CHK;
constexpr int R = NB * PP;
constexpr int PCOLS = 4112, PC = 4096;
constexpr int NE = 16, CAP = 1026, DFF = 2816, EROWS = NB * CAP, EROWSP = 4352;
constexpr int NH = 4;
constexpr float EPS = 1e-6f, NEGF = -1e30f;
constexpr int WSC_UP = 0x7A7A7A7A, WSC_DN = 0x79797979;
constexpr float WPRE_UP = 32.0f, WPRE_DN = 64.0f;

constexpr size_t MiB = 1u << 20;
constexpr size_t WS_ROPE = 1 * MiB, WS_GATES = 6 * MiB, WS_AFF = 9 * MiB, WS_IDX = 12 * MiB, WS_GV = 13 * MiB, WS_SLOT = 14 * MiB;
constexpr size_t WS_H1META = 17 * MiB, WS_UN = 18 * MiB, WS_SCAL = 21 * MiB, WS_WINT = 22 * MiB, WS_WOUTT = 30 * MiB;
constexpr size_t WS_ACT1 = 32 * MiB;
constexpr size_t WS_ACT2 = 97 * MiB;
constexpr size_t WS_PROJ = 162 * MiB;
constexpr size_t WS_STATE = 422 * MiB;
constexpr size_t WS_YE = 97 * MiB;
constexpr size_t WS_WEXP = 233 * MiB;
constexpr size_t WS_HID = 365 * MiB;
constexpr size_t WS_WD8 = 568 * MiB;
constexpr size_t WS_DELTA = 612 * MiB;
constexpr size_t WS_END = 684 * MiB;
constexpr size_t WEXP_ONE = (size_t)NE * DFF * D;
static_assert(WS_PROJ + (size_t)R * PC * 2 <= WS_STATE && WS_STATE + (size_t)64 * NCH * 16384 * 4 <= WS_END, "mixer map");
static_assert(WS_YE + (size_t)NE * EROWSP * D * 2 <= WS_WEXP && WS_WEXP + 2 * WEXP_ONE <= WS_HID && WS_WD8 + WEXP_ONE <= WS_DELTA && WS_DELTA + (size_t)NB * SEQ * D * 2 <= WS_END && WS_HID + (size_t)NE * 4096 * DFF <= WS_END, "ffn map");

constexpr int LDS_BYTES = 155648;
constexpr int TP = 136;
constexpr int T0_OFF = 0, T1_OFF = 34816, T2_OFF = 69632, T3_OFF = 104448, VEC_OFF = 139264;

__device__ __forceinline__ unsigned f2bf(float f) { unsigned u = __builtin_bit_cast(unsigned, f); return (u + 0x7fffu + ((u >> 16) & 1u)) >> 16; }
__device__ __forceinline__ unsigned pk2(float lo, float hi) { unsigned r; asm("v_cvt_pk_bf16_f32 %0, %1, %2" : "=v"(r) : "v"(lo), "v"(hi)); return r; }
__device__ __forceinline__ unsigned cvtpk(float lo, float hi) { unsigned r; asm("v_cvt_pk_bf16_f32 %0, %1, %2" : "=v"(r) : "v"(lo), "v"(hi)); return r; }
__device__ __forceinline__ unsigned pk4_fp8(float a, float b, float c, float d) { int p = __builtin_amdgcn_cvt_pk_fp8_f32(a, b, 0, false); p = __builtin_amdgcn_cvt_pk_fp8_f32(c, d, p, true); return (unsigned)p; }
__device__ __forceinline__ float bf2f(unsigned b) { return __builtin_bit_cast(float, b << 16); }
__device__ __forceinline__ float bflo(unsigned w) { return __builtin_bit_cast(float, w << 16); }
__device__ __forceinline__ float bfhi(unsigned w) { return __builtin_bit_cast(float, w & 0xffff0000u); }
template <bool MAXOP>
__device__ __forceinline__ float wave_scan_incl(float v) {
    const int idn = __builtin_bit_cast(int, MAXOP ? -3.0e38f : 0.0f);
#define DPP_STEP(ctrl, rmask) { const float t = __builtin_bit_cast(float, __builtin_amdgcn_update_dpp(idn, __builtin_bit_cast(int, v), ctrl, rmask, 0xF, false)); v = MAXOP ? fmaxf(v, t) : v + t; }
    DPP_STEP(0x111, 0xF) DPP_STEP(0x112, 0xF) DPP_STEP(0x114, 0xF) DPP_STEP(0x118, 0xF) DPP_STEP(0x142, 0xA) DPP_STEP(0x143, 0xC)
#undef DPP_STEP
    return v;
}
__device__ __forceinline__ float wave_sum(float v) { v = wave_scan_incl<false>(v); return __builtin_bit_cast(float, __builtin_amdgcn_readlane(__builtin_bit_cast(int, v), 63)); }
__device__ __forceinline__ float wave_max(float v) { v = wave_scan_incl<true>(v); return __builtin_bit_cast(float, __builtin_amdgcn_readlane(__builtin_bit_cast(int, v), 63)); }
__device__ __forceinline__ float sigmoidf_(float x) { return __builtin_amdgcn_rcpf(1.0f + __expf(-x)); }
__device__ __forceinline__ float siluf_(float x) { return x * __builtin_amdgcn_rcpf(1.0f + __expf(-x)); }
__device__ __forceinline__ float logsigmoidf_(float x) { return fminf(x, 0.0f) - log1pf(__expf(-fabsf(x))); }
#define LDS_WAIT() asm volatile("s_waitcnt lgkmcnt(0)" ::: "memory")

namespace pg8 {
constexpr int BM = 256, BK = 64, HALF = 128, HTB = HALF * BK * 2, STAGE_BYTES = 8 * HTB;
__device__ __forceinline__ int lds_byte(int r, int c) { const int st = (r >> 4) * 2 + (c >> 5), rr = r & 15, cc = c & 31, ob = rr * 64 + cc * 2; return st * 1024 + (ob ^ (((ob >> 9) & 1) << 5)); }
__device__ __forceinline__ void stage_rc(int b, int& Rr, int& C) { const int st = b / 1024, sb = b % 1024, swz = sb ^ (((sb >> 9) & 1) << 5); Rr = (st >> 1) * 16 + swz / 64; C = (st & 1) * 32 + (swz % 64) / 2; }
__device__ __forceinline__ int perm32(int rho) { const int n = rho >> 4, i = rho & 15; return 8 * (i >> 2) + 4 * n + (i & 3); }
__device__ __forceinline__ unsigned cvt_pk_bf16(float lo, float hi) { unsigned r; asm volatile("v_cvt_pk_bf16_f32 %0, %1, %2" : "=v"(r) : "v"(lo), "v"(hi)); return r; }

struct Unit { int pm, pn, e, row0; };
struct UAddr { const char* a0; const char* a1; const char* b0; const char* b1; };

template <class Epi, class Sched>
__device__ __forceinline__ void gemm_phase(LAS unsigned char* lds, const int K, const Sched& S, const Epi& E) {
    int tid_ = threadIdx.x; asm volatile("" : "+v"(tid_));
    const int tid = tid_, wid = __builtin_amdgcn_readfirstlane(tid >> 6), lane = tid & 63, wr = wid >> 2, wc = wid & 3, fr = lane & 15, fq = lane >> 4;
    const int nt = K / BK;
    unsigned voffB[2], voffA0 = 0, voffA1 = 0, colb = 0;
    int sR0, sC0;
    {   int sR1, sC1; stage_rc(tid * 16, sR0, sC0); stage_rc(tid * 16 + 8192, sR1, sC1);
        const int Rb0 = Epi::PERM ? ((sR0 & ~31) + perm32(sR0 & 31)) : sR0, Rb1 = Epi::PERM ? ((sR1 & ~31) + perm32(sR1 & 31)) : sR1;
        voffB[0] = (unsigned)(Rb0 * S.ldb + sC0) * 2u; voffB[1] = (unsigned)(Rb1 * S.ldb + sC1) * 2u;
        if constexpr (!Sched::GATHER) { voffA0 = (unsigned)(sR0 * S.lda + sC0) * 2u; voffA1 = (unsigned)(sR1 * S.lda + sC1) * 2u; } else colb = (unsigned)sC0 * 2u; }
    LAS unsigned* const tab = (LAS unsigned*)(lds + STAGE_BYTES);
    const LAS unsigned* const tabp = tab + sR0;
    const size_t kstep = (size_t)(BK * 2);
    const unsigned ldsw = (unsigned)wid * 1024u;
    constexpr bool FP8 = Sched::FP8;
    const int aoff = FP8 ? lds_byte(wr * 64 + fr, fq * 16) : lds_byte(wr * 64 + fr, fq * 8), boff = FP8 ? lds_byte(wc * 32 + fr, fq * 16) : lds_byte(wc * 32 + fr, fq * 8);
    int wsc_v = S.wscale, one_v = 0x7F7F7F7F; asm volatile("" : "+v"(wsc_v), "+v"(one_v));
#define PG8_SA(b, h) (((b) * 2 + (h)) * HTB)
#define PG8_SB(b, h) ((4 + (b) * 2 + (h)) * HTB)
#define PG8_STAGE(bufoff, gbase, v0, v1) do { \
        __builtin_amdgcn_global_load_lds((const unsigned*)((const char*)(gbase) + (v0)), (LAS unsigned*)(lds + (bufoff) + ldsw), 16, 0, 0); \
        __builtin_amdgcn_global_load_lds((const unsigned*)((const char*)(gbase) + (v1)), (LAS unsigned*)(lds + (bufoff) + ldsw + 8192), 16, 0, 0); } while (0)
#define PG8_STAGE_A(bufoff, gbase, slot, h) do { if constexpr (Sched::GATHER) { const unsigned _r0 = tabp[(slot) * 256 + (h) * 128] + colb, _r1 = tabp[(slot) * 256 + (h) * 128 + 64] + colb; PG8_STAGE(bufoff, gbase, _r0, _r1); } \
        else PG8_STAGE(bufoff, gbase, voffA0, voffA1); } while (0)
#define PG8_LD32(p) __builtin_shufflevector(*(const LAS i32x4*)(p), *(const LAS i32x4*)((p) + 16), 0, 1, 2, 3, 4, 5, 6, 7)
#define PG8_LDA(dst, b, h) do { if constexpr (FP8) { _Pragma("unroll") for (int m = 0; m < 4; ++m) dst##8[m] = PG8_LD32(lds + PG8_SA(b, h) + aoff + m * 2048); } \
        else { _Pragma("unroll") for (int m = 0; m < 4; ++m) _Pragma("unroll") for (int k = 0; k < 2; ++k) dst[m][k] = *(const LAS bf16x8*)(lds + PG8_SA(b, h) + aoff + m * 2048 + k * 1024); } } while (0)
#define PG8_LDB(dst, b, h) do { if constexpr (FP8) { _Pragma("unroll") for (int n = 0; n < 2; ++n) dst##8[n] = PG8_LD32(lds + PG8_SB(b, h) + boff + n * 2048); } \
        else { _Pragma("unroll") for (int n = 0; n < 2; ++n) _Pragma("unroll") for (int k = 0; k < 2; ++k) dst[n][k] = *(const LAS bf16x8*)(lds + PG8_SB(b, h) + boff + n * 2048 + k * 1024); } } while (0)
#define PG8_MMA_FULL(ai, bj, At, Bt) do { __builtin_amdgcn_s_setprio(1); \
        if constexpr (FP8) { _Pragma("unroll") for (int m = 0; m < 4; ++m) _Pragma("unroll") for (int n = 0; n < 2; ++n) \
            asm volatile("v_mfma_scale_f32_16x16x128_f8f6f4 %0, %1, %2, %0, %3, %4 op_sel_hi:[0,0,0]" : "+v"(acc[ai][bj][m][n]) : "v"(Bt##8[n]), "v"(At##8[m]), "v"(wsc_v), "v"(one_v)); } \
        else { _Pragma("unroll") for (int m = 0; m < 4; ++m) _Pragma("unroll") for (int n = 0; n < 2; ++n) _Pragma("unroll") for (int k = 0; k < 2; ++k) \
            acc[ai][bj][m][n] = __builtin_amdgcn_mfma_f32_16x16x32_bf16(Bt[n][k], At[m][k], acc[ai][bj][m][n], 0, 0, 0); } \
        __builtin_amdgcn_s_setprio(0); } while (0)
#define PG8_MMA_THIN(ai, bj, At, Bt) do { if (!FP8 && (ai) == 0 && wr == 0) { _Pragma("unroll") for (int n = 0; n < 2; ++n) _Pragma("unroll") for (int k = 0; k < 2; ++k) \
        acc[0][bj][0][n] = __builtin_amdgcn_mfma_f32_16x16x32_bf16(Bt[n][k], At[0][k], acc[0][bj][0][n], 0, 0, 0); } } while (0)
#define PG8_WAIT_V(n) asm volatile("s_waitcnt vmcnt(" #n ")" ::: "memory")
#define PG8_WAIT_L(n) asm volatile("s_waitcnt lgkmcnt(" #n ")" ::: "memory")
#define PG8_BAR __builtin_amdgcn_s_barrier()
#define PG8_SCHED __builtin_amdgcn_sched_barrier(0)
    Unit cur, nxt; int ui = 0;
    if (!S.next(0, cur)) return;
    f32x4 acc[2][2][4][2];
#pragma unroll
    for (int a = 0; a < 2; ++a)
#pragma unroll
        for (int b = 0; b < 2; ++b)
#pragma unroll
            for (int m = 0; m < 4; ++m)
#pragma unroll
                for (int n = 0; n < 2; ++n) acc[a][b][m][n] = (f32x4){0.f, 0.f, 0.f, 0.f};
    bf16x8 At[4][2], B0[2][2], B1[2][2]; i32x8 At8[4], B08[2], B18[2];
    UAddr cu, nx;
    S.addr(cur, cu);
    if constexpr (Sched::GATHER) {
        if (tid < 256) __builtin_amdgcn_global_load_lds((const unsigned*)(S.rowoff_ptr(cur) + tid), (LAS unsigned*)(tab + wid * 64), 4, 0, 0);
        asm volatile("s_waitcnt vmcnt(0)" ::: "memory"); __syncthreads(); }
    PG8_STAGE(PG8_SB(0, 0), cu.b0, voffB[0], voffB[1]); PG8_STAGE(PG8_SB(0, 1), cu.b1, voffB[0], voffB[1]); PG8_STAGE_A(PG8_SA(0, 0), cu.a0, 0, 0); PG8_STAGE_A(PG8_SA(0, 1), cu.a1, 0, 1);
    if (wr == 1) PG8_BAR;
    PG8_WAIT_V(2); PG8_BAR;
    PG8_STAGE(PG8_SB(1, 0), cu.b0 + kstep, voffB[0], voffB[1]); PG8_STAGE_A(PG8_SA(1, 0), cu.a0 + kstep, 0, 0); PG8_STAGE(PG8_SB(1, 1), cu.b1 + kstep, voffB[0], voffB[1]);
    PG8_WAIT_V(6); PG8_BAR;
    for (;;) {
        const bool has_next = S.next(ui + 1, nxt);
        const bool thin = Sched::HAS_THIN && S.thin(cur);
        const int cs = ui & 1, ns = has_next ? (cs ^ 1) : cs;
        if (has_next) { S.addr(nxt, nx); if constexpr (Sched::GATHER) { if (tid < 256) __builtin_amdgcn_global_load_lds((const unsigned*)(S.rowoff_ptr(nxt) + tid), (LAS unsigned*)(tab + (cs ^ 1) * 256 + wid * 64), 4, 0, 0); } } else nx = cu;
#define PG8_KLOOP(MMA) \
        for (int t = 0; t < nt; t += 2) { \
            const bool last = (t == nt - 2); \
            const char* a1h1 = cu.a1 + (size_t)(t + 1) * kstep; \
            const char* a2h0 = last ? nx.a0 : cu.a0 + (size_t)(t + 2) * kstep; const char* a2h1 = last ? nx.a1 : cu.a1 + (size_t)(t + 2) * kstep; \
            const char* b2h0 = last ? nx.b0 : cu.b0 + (size_t)(t + 2) * kstep; const char* b2h1 = last ? nx.b1 : cu.b1 + (size_t)(t + 2) * kstep; \
            const int s2 = last ? ns : cs; \
              \
            PG8_LDB(B0, 0, 0); PG8_LDB(B1, 0, 1); PG8_SCHED; PG8_LDA(At, 0, 0); PG8_STAGE_A(PG8_SA(1, 1), a1h1, cs, 1); \
            PG8_WAIT_V(8); PG8_WAIT_L(0); PG8_BAR; MMA(0, 0, At, B0); MMA(0, 1, At, B1); PG8_BAR; PG8_SCHED; \
              \
            PG8_LDA(At, 0, 1); PG8_STAGE(PG8_SB(0, 0), b2h0, voffB[0], voffB[1]); PG8_STAGE(PG8_SB(0, 1), b2h1, voffB[0], voffB[1]); PG8_STAGE_A(PG8_SA(0, 0), a2h0, s2, 0); \
            PG8_WAIT_V(8); PG8_WAIT_L(0); PG8_BAR; MMA(1, 0, At, B0); MMA(1, 1, At, B1); PG8_BAR; PG8_SCHED; \
              \
            PG8_LDB(B0, 1, 0); PG8_LDB(B1, 1, 1); PG8_SCHED; PG8_LDA(At, 1, 0); PG8_STAGE_A(PG8_SA(0, 1), a2h1, s2, 1); \
            PG8_WAIT_V(8); PG8_WAIT_L(0); PG8_BAR; MMA(0, 0, At, B0); MMA(0, 1, At, B1); PG8_BAR; PG8_SCHED; \
              \
            PG8_LDA(At, 1, 1); PG8_STAGE(PG8_SB(1, 0), b2h0 + kstep, voffB[0], voffB[1]); PG8_STAGE(PG8_SB(1, 1), b2h1 + kstep, voffB[0], voffB[1]); PG8_STAGE_A(PG8_SA(1, 0), a2h0 + kstep, s2, 0); \
            PG8_WAIT_V(8); PG8_WAIT_L(0); PG8_BAR; MMA(1, 0, At, B0); MMA(1, 1, At, B1); PG8_BAR; PG8_SCHED; \
        }
        if (Sched::HAS_THIN && thin) { PG8_KLOOP(PG8_MMA_THIN) } else { PG8_KLOOP(PG8_MMA_FULL) }
#undef PG8_KLOOP
        if (wr == 0) PG8_BAR;
        if constexpr (FP8) asm volatile("s_nop 15\n\ts_nop 15" ::: "memory");
        { int fr_e = fr, fq_e = fq; asm volatile("" : "+v"(fr_e), "+v"(fq_e));
          E(acc, cur, wr, wc, fr_e, fq_e); }
        if (!has_next) break;
#pragma unroll
        for (int a = 0; a < 2; ++a)
#pragma unroll
            for (int b = 0; b < 2; ++b)
#pragma unroll
                for (int m = 0; m < 4; ++m)
#pragma unroll
                    for (int n = 0; n < 2; ++n) acc[a][b][m][n] = (f32x4){0.f, 0.f, 0.f, 0.f};
        cur = nxt; cu = nx; ++ui;
        if (wr == 1) PG8_BAR;
    }
    PG8_WAIT_V(0);
    PG8_BAR;
#undef PG8_SA
#undef PG8_SB
#undef PG8_STAGE
#undef PG8_STAGE_A
#undef PG8_LDA
#undef PG8_LDB
#undef PG8_MMA_THIN
#undef PG8_LD32
#undef PG8_MMA_FULL
#undef PG8_WAIT_V
#undef PG8_WAIT_L
#undef PG8_BAR
#undef PG8_SCHED
}

struct DenseOrder {
    static constexpr bool GATHER = false, HAS_THIN = false, FP8 = false; static constexpr int wscale = 0;
    __device__ __forceinline__ bool thin(const Unit&) const { return false; }
    const bf16* A; const bf16* Bt; int lda, ldb; int nM, nN, nwg, G, c;
    __device__ __forceinline__ const unsigned* rowoff_ptr(const Unit&) const { return nullptr; }
    __device__ __forceinline__ bool next(int i, Unit& u) const {
        const long L = (long)i * G + c; if (L >= nwg) return false;
        int wgid = (int)L; { const int q = nwg / 8, r = nwg % 8, xcd = wgid % 8, off = wgid / 8; wgid = (xcd < r ? xcd * (q + 1) : r * (q + 1) + (xcd - r) * q) + off; }
        const int nig = 8 * nN, gid = wgid / nig, fm = gid * 8, gsz = (nM - fm) < 8 ? (nM - fm) : 8;
        u.pm = fm + ((wgid % nig) % gsz); u.pn = (wgid % nig) / gsz; u.e = 0; u.row0 = (u.pm >> 5) * PP + CHK + 256 * (u.pm & 31); return true;
    }
    __device__ __forceinline__ void addr(const Unit& u, UAddr& g) const {
        g.a0 = (const char*)(A + (size_t)u.row0 * lda); g.a1 = g.a0 + (size_t)128 * lda * 2;
        g.b0 = (const char*)(Bt + (size_t)u.pn * 256 * ldb); g.b1 = g.b0 + (size_t)128 * ldb * 2;
    }
};
struct FfnUpOrder {
    static constexpr bool GATHER = true, HAS_THIN = false, FP8 = true; static constexpr int wscale = WSC_UP;
    __device__ __forceinline__ bool thin(const Unit&) const { return false; }
    const unsigned char* U2; const unsigned* ROWOFF; const unsigned char* WgT; const unsigned char* WuT; int lda, ldb; int nunits, G, c;
    __device__ __forceinline__ bool next(int i, Unit& u) const {
        const int L = i * G + c; if (L >= nunits) return false;
        const int e = L / (22 * 16), rem = L - e * (22 * 16); u.e = e;
        if (rem < 320) { const int blk = rem >> 5, idx = rem & 31, h = blk / 5, pq = blk - 5 * h; u.pn = 4 * pq + (idx >> 3); u.pm = 8 * h + (idx & 7); }
        else { const int r = rem - 320, h = r >> 4, idx = r & 15; u.pn = 20 + (idx >> 3); u.pm = 8 * h + (idx & 7); }
        u.row0 = u.pm * 256; return true;
    }
    __device__ __forceinline__ const unsigned* rowoff_ptr(const Unit& u) const { return ROWOFF + u.e * 4096 + u.pm * 256; }
    __device__ __forceinline__ void addr(const Unit& u, UAddr& g) const {
        g.a0 = (const char*)U2; g.a1 = g.a0;
        g.b0 = (const char*)(WgT + ((size_t)u.e * DFF + (size_t)u.pn * 128) * D); g.b1 = (const char*)(WuT + ((size_t)u.e * DFF + (size_t)u.pn * 128) * D);
    }
};
struct FfnDownOrder {
    static constexpr bool GATHER = false, HAS_THIN = false, FP8 = true; static constexpr int wscale = WSC_DN;
    __device__ __forceinline__ bool thin(const Unit&) const { return false; }
    const unsigned char* HID; const unsigned char* WdT; int lda, ldb; int nunits, G, c;
    __device__ __forceinline__ const unsigned* rowoff_ptr(const Unit&) const { return nullptr; }
    __device__ __forceinline__ bool next(int i, Unit& u) const {
        const int L = i * G + c; if (L >= nunits) return false;
        u.e = L >> 6; const int rem = L & 63; u.pn = rem >> 4; u.pm = rem & 15; u.row0 = u.pm * 256; return true;
    }
    __device__ __forceinline__ void addr(const Unit& u, UAddr& g) const {
        g.a0 = (const char*)(HID + ((size_t)u.e * 4096 + (size_t)u.pm * 256) * DFF); g.a1 = g.a0 + (size_t)128 * DFF;
        g.b0 = (const char*)(WdT + ((size_t)u.e * D + (size_t)u.pn * 256) * DFF); g.b1 = g.b0 + (size_t)128 * DFF;
    }
};

struct EpiStoreBf16 {
    static constexpr bool PERM = true;
    bf16* O; int ldc; size_t estride;
    __device__ __forceinline__ void operator()(const f32x4 (&acc)[2][2][4][2], const Unit& u, int wr, int wc, int fr, int fq) const {
        bf16* base = O + (size_t)u.e * estride + (size_t)(u.pm * 256 + wr * 64 + fr) * ldc + u.pn * 256 + wc * 32 + 8 * fq;
#pragma unroll
        for (int ai = 0; ai < 2; ++ai)
#pragma unroll
            for (int m = 0; m < 4; ++m) { bf16* rowp = base + (size_t)(ai * 128 + m * 16) * ldc;
#pragma unroll
                for (int bj = 0; bj < 2; ++bj) { const f32x4 v0 = acc[ai][bj][m][0], v1 = acc[ai][bj][m][1];
                    u32x4 w; w.x = cvt_pk_bf16(v0[0], v0[1]); w.y = cvt_pk_bf16(v0[2], v0[3]); w.z = cvt_pk_bf16(v1[0], v1[1]); w.w = cvt_pk_bf16(v1[2], v1[3]);
                    *(u32x4*)(rowp + bj * 128) = w; } }
    }
};
struct EpiProj {
    static constexpr bool PERM = true;
    bf16* O; const f32x2* rope;
    __device__ __forceinline__ void operator()(const f32x4 (&acc)[2][2][4][2], const Unit& u, int wr, int wc, int fr, int fq) const {
        const int row0 = u.row0 + wr * 64 + fr;
        if (u.pn >= 4) {
            bf16* base = O + (size_t)row0 * PC + u.pn * 256 + wc * 32 + 8 * fq;
#pragma unroll
            for (int ai = 0; ai < 2; ++ai)
#pragma unroll
                for (int m = 0; m < 4; ++m) { bf16* rowp = base + (size_t)(ai * 128 + m * 16) * PC;
#pragma unroll
                    for (int bj = 0; bj < 2; ++bj) { const f32x4 v0 = acc[ai][bj][m][0], v1 = acc[ai][bj][m][1];
                        u32x4 w; w.x = cvt_pk_bf16(v0[0], v0[1]); w.y = cvt_pk_bf16(v0[2], v0[3]); w.z = cvt_pk_bf16(v1[0], v1[1]); w.w = cvt_pk_bf16(v1[2], v1[3]);
                        *(u32x4*)(rowp + bj * 128) = w; } }
        } else {
            const float sc = (u.pn < 2) ? 0.08838834764831845f : 1.0f; const int d0 = 16 * wc + 4 * fq;
#pragma unroll
            for (int ai = 0; ai < 2; ++ai)
#pragma unroll
                for (int m = 0; m < 4; ++m) { const int row = row0 + ai * 128 + m * 16; const int b = row / PP, p = row - b * PP; const int n = p - PADF;
                    const f32x2* tb = rope + (size_t)n * 64 + d0; const f32x2 t0 = tb[0], t1 = tb[1], t2 = tb[2], t3 = tb[3];
                    bf16* rowp = O + (size_t)row * PC + u.pn * 256 + d0;
#pragma unroll
                    for (int bj = 0; bj < 2; ++bj) { const f32x4 x1 = acc[ai][bj][m][0], x2 = acc[ai][bj][m][1];
                        u32x2 o1, o2;
                        o1.x = cvt_pk_bf16((x1[0] * t0.x - x2[0] * t0.y) * sc, (x1[1] * t1.x - x2[1] * t1.y) * sc); o1.y = cvt_pk_bf16((x1[2] * t2.x - x2[2] * t2.y) * sc, (x1[3] * t3.x - x2[3] * t3.y) * sc);
                        o2.x = cvt_pk_bf16((x2[0] * t0.x + x1[0] * t0.y) * sc, (x2[1] * t1.x + x1[1] * t1.y) * sc); o2.y = cvt_pk_bf16((x2[2] * t2.x + x1[2] * t2.y) * sc, (x2[3] * t3.x + x1[3] * t3.y) * sc);
                        *(u32x2*)(rowp + bj * 128) = o1; *(u32x2*)(rowp + bj * 128 + 64) = o2; } }
        }
    }
};
struct EpiSwiglu {
    static constexpr bool PERM = true;
    unsigned char* HID;
    __device__ __forceinline__ void operator()(const f32x4 (&acc)[2][2][4][2], const Unit& u, int wr, int wc, int fr, int fq) const {
        unsigned char* base = HID + ((size_t)u.e * 4096 + (size_t)(u.pm * 256 + wr * 64 + fr)) * DFF + u.pn * 128 + wc * 32 + 8 * fq;
#pragma unroll
        for (int ai = 0; ai < 2; ++ai)
#pragma unroll
            for (int m = 0; m < 4; ++m) { unsigned char* rowp = base + (size_t)(ai * 128 + m * 16) * DFF;
                float h[8];
#pragma unroll
                for (int n = 0; n < 2; ++n)
#pragma unroll
                    for (int j = 0; j < 4; ++j) { const float g = acc[ai][0][m][n][j], up = acc[ai][1][m][n][j]; h[n * 4 + j] = fminf(fmaxf(siluf_(g) * up, -448.0f), 448.0f); }
                *(u32x2*)rowp = (u32x2){pk4_fp8(h[0], h[1], h[2], h[3]), pk4_fp8(h[4], h[5], h[6], h[7])}; }
    }
};
struct EpiDelta {
    static constexpr bool PERM = true;
    bf16* O;
    __device__ __forceinline__ void operator()(const f32x4 (&acc)[2][2][4][2], const Unit& u, int wr, int wc, int fr, int fq) const {
        const int tok0 = (u.pm >> 5) * SEQ + 256 * (u.pm & 31) + wr * 64 + fr;
        bf16* base = O + (size_t)tok0 * D + u.pn * 256 + wc * 32 + 8 * fq;
#pragma unroll
        for (int ai = 0; ai < 2; ++ai)
#pragma unroll
            for (int m = 0; m < 4; ++m) { bf16* rowp = base + (size_t)(ai * 128 + m * 16) * D;
#pragma unroll
                for (int bj = 0; bj < 2; ++bj) { const f32x4 v0 = acc[ai][bj][m][0], v1 = acc[ai][bj][m][1];
                    u32x4 w; w.x = cvt_pk_bf16(v0[0], v0[1]); w.y = cvt_pk_bf16(v0[2], v0[3]); w.z = cvt_pk_bf16(v1[0], v1[1]); w.w = cvt_pk_bf16(v1[2], v1[3]);
                    *(u32x4*)(rowp + bj * 128) = w; } }
    }
};
}

struct Ctx {
    LAS unsigned char* lds; int tid, lane, wave, vcu, G;
    const float *x, *meta, *mix_g, *w_in, *b_gates, *conv_w, *conv_b, *ret_logit, *ret_gn, *ml_gn, *w_out, *ffn_g, *w_router, *w_gate, *w_up, *w_down, *fin_g;
    float* out; unsigned char* ws;
};

__device__ __forceinline__ int rope_row(int c) { if (c >= 1024) return c; const int d = c & 127, dd = d & 63; return (c & ~127) | (8 * (dd >> 2) + (d >> 6) * 4 + (dd & 3)); }
template <bool PAIRPERM = false>
__device__ __forceinline__ void transpose_item(const float* W, int K, int N, int ldw, bf16* WT, LAS float* scr, int item, int lane) {
    const int nblk = N / 32, kb = item / nblk, nb = item % nblk, k0 = 64 * kb, n0 = 32 * nb;
#pragma unroll 8
    for (int i = 0; i < 32; ++i) { const int kk = 2 * i + (lane >> 5); scr[kk * 33 + (lane & 31)] = W[(size_t)(k0 + kk) * ldw + n0 + (lane & 31)]; }
    LDS_WAIT(); asm volatile("" ::: "memory");
    const int c = lane & 7;
#pragma unroll
    for (int j = 0; j < 4; ++j) { const int n = (lane >> 3) + 8 * j; const LAS float* s = scr + (8 * c) * 33 + n;
        u32x4 o; o.x = pk2(s[0 * 33], s[1 * 33]); o.y = pk2(s[2 * 33], s[3 * 33]); o.z = pk2(s[4 * 33], s[5 * 33]); o.w = pk2(s[6 * 33], s[7 * 33]);
        *(u32x4*)(WT + (size_t)(PAIRPERM ? rope_row(n0 + n) : (n0 + n)) * K + k0 + 8 * c) = o; }
    LDS_WAIT(); asm volatile("" ::: "memory");
}
constexpr int F8SCR = 0;
__device__ __forceinline__ void transpose_item_f8(const float* W, int K, int N, int ldw, unsigned char* WT, LAS float*  , int item, int lane, float pre) {
    const int nblk = N / 64, kb = item / nblk, nb = item % nblk, k0 = 64 * kb + 16 * (lane >> 4), n0 = 64 * nb + 4 * (lane & 15);
    const float* src = W + (size_t)k0 * ldw + n0;
    f32x4 v[16];
#pragma unroll
    for (int i = 0; i < 16; ++i) v[i] = *(const f32x4*)(src + (size_t)i * ldw) * pre;
#pragma unroll
    for (int j = 0; j < 4; ++j) {
        u32x4 o;
        o.x = pk4_fp8(v[0][j], v[1][j], v[2][j], v[3][j]); o.y = pk4_fp8(v[4][j], v[5][j], v[6][j], v[7][j]); o.z = pk4_fp8(v[8][j], v[9][j], v[10][j], v[11][j]); o.w = pk4_fp8(v[12][j], v[13][j], v[14][j], v[15][j]);
        *(u32x4*)(WT + (size_t)(n0 + j) * K + k0) = o; }
}
__device__ __forceinline__ void row_load(const float* row, int lane, f32x4 (&u)[4]) {
#pragma unroll
    for (int jj = 0; jj < 4; ++jj) u[jj] = *(const f32x4*)(row + jj * 256 + lane * 4);
}
__device__ __forceinline__ void row_load_h1(const float* xrow, const bf16* drow, int lane, f32x4 (&u)[4]) {
    u32x2 dv[4];
#pragma unroll
    for (int jj = 0; jj < 4; ++jj) { u[jj] = *(const f32x4*)(xrow + jj * 256 + lane * 4); dv[jj] = *(const u32x2*)(drow + jj * 256 + lane * 4); }
#pragma unroll
    for (int jj = 0; jj < 4; ++jj) { u[jj].x += bflo(dv[jj].x); u[jj].y += bfhi(dv[jj].x); u[jj].z += bflo(dv[jj].y); u[jj].w += bfhi(dv[jj].y); }
}
__device__ __forceinline__ void rms_apply(const float* g, int lane, f32x4 (&u)[4]) {
    float s = 0.f;
#pragma unroll
    for (int jj = 0; jj < 4; ++jj) s += u[jj].x * u[jj].x + u[jj].y * u[jj].y + u[jj].z * u[jj].z + u[jj].w * u[jj].w;
    const float rstd = rsqrtf(wave_sum(s) * (1.0f / D) + EPS);
#pragma unroll
    for (int jj = 0; jj < 4; ++jj) { const f32x4 gv = *(const f32x4*)(g + jj * 256 + lane * 4); u[jj] = u[jj] * rstd * gv; }
}
__device__ __forceinline__ void store_row_bf16(bf16* dst, int lane, const f32x4 (&u)[4]) {
#pragma unroll
    for (int jj = 0; jj < 4; ++jj) { u32x2 w; w.x = pk2(u[jj].x, u[jj].y); w.y = pk2(u[jj].z, u[jj].w); *(u32x2*)(dst + jj * 256 + lane * 4) = w; }
}
#define MFMA16(a, b, c) __builtin_amdgcn_mfma_f32_16x16x32_bf16(a, b, c, 0, 0, 0)
constexpr int RB_PITCH = 1032, RB_UH = 0, RB_UL = 16 * RB_PITCH * 2, RB_RED = 2 * RB_UL;
struct RowDots { bf16x8 bh[4], bl[4]; };
__device__ __forceinline__ void rowdots_init(RowDots& W, const float* wsrc, int ld, int w, int lane) {
    const int fr = lane & 15, fq = lane >> 4;
#pragma unroll
    for (int s_ = 0; s_ < 4; ++s_) { float v[8];
#pragma unroll
        for (int j = 0; j < 8; ++j) v[j] = wsrc[(size_t)(128 * w + 32 * s_ + 8 * fq + j) * ld + fr];
        unsigned hp[4], lp[4];
#pragma unroll
        for (int j = 0; j < 4; ++j) { hp[j] = pk2(v[2 * j], v[2 * j + 1]); lp[j] = pk2(v[2 * j] - bflo(hp[j]), v[2 * j + 1] - bfhi(hp[j])); }
        W.bh[s_] = __builtin_bit_cast(bf16x8, (u32x4){hp[0], hp[1], hp[2], hp[3]}); W.bl[s_] = __builtin_bit_cast(bf16x8, (u32x4){lp[0], lp[1], lp[2], lp[3]}); }
}
__device__ __forceinline__ void rowdots_put(LAS unsigned char* lds, int rs, int lane, const f32x4 (&u)[4]) {
#pragma unroll
    for (int jj = 0; jj < 4; ++jj) { const unsigned h0 = pk2(u[jj].x, u[jj].y), h1 = pk2(u[jj].z, u[jj].w);
        const unsigned l0 = pk2(u[jj].x - bflo(h0), u[jj].y - bfhi(h0)), l1 = pk2(u[jj].z - bflo(h1), u[jj].w - bfhi(h1));
        *(LAS u32x2*)(lds + RB_UH + (rs * RB_PITCH + jj * 256 + lane * 4) * 2) = (u32x2){h0, h1}; *(LAS u32x2*)(lds + RB_UL + (rs * RB_PITCH + jj * 256 + lane * 4) * 2) = (u32x2){l0, l1}; }
}
__device__ __forceinline__ void rowdots_mma(LAS unsigned char* lds, const RowDots& W, int w, int lane) {
    const int fr = lane & 15, fq = lane >> 4; f32x4 acc = (f32x4){0.f, 0.f, 0.f, 0.f};
#pragma unroll
    for (int s_ = 0; s_ < 4; ++s_) { const int off = (fr * RB_PITCH + 128 * w + 32 * s_ + 8 * fq) * 2;
        const bf16x8 ah = *(const LAS bf16x8*)(lds + RB_UH + off), al = *(const LAS bf16x8*)(lds + RB_UL + off);
        acc = MFMA16(ah, W.bh[s_], acc); acc = MFMA16(ah, W.bl[s_], acc); acc = MFMA16(al, W.bh[s_], acc); }
    *(LAS f32x4*)(lds + RB_RED + (w * 256 + lane * 4) * 4) = acc;
}
__device__ __forceinline__ float rowdots_get(const LAS unsigned char* lds, int row, int g) {
    const LAS float* red = (const LAS float*)(lds + RB_RED) + ((row >> 2) * 16 + g) * 4 + (row & 3); float s_ = 0.f;
#pragma unroll
    for (int w = 0; w < 8; ++w) s_ += red[w * 256];
    return s_;
}
__device__ __forceinline__ void phase_prep(Ctx& F) {
    bf16* WINT = (bf16*)(F.ws + WS_WINT); bf16* WOUTT = (bf16*)(F.ws + WS_WOUTT);
    LAS float* scr = (LAS float*)(F.lds + F.wave * 16384);
    const int gw = F.vcu * 8 + F.wave, NGW = F.G * 8;
    constexpr int I_IN = (D / 64) * (PC / 32), I_OUT = (D / 64) * (D / 32);
    for (int it = gw; it < I_IN + I_OUT; it += NGW) {
        if (it < I_IN) transpose_item<true>(F.w_in, D, PC, PCOLS, WINT, scr, it, F.lane);
        else transpose_item(F.w_out, D, D, D, WOUTT, scr, it - I_IN, F.lane);
    }
    f32x2* rope = (f32x2*)(F.ws + WS_ROPE);
    for (int idx = (F.vcu * 512 + F.tid); idx < NTOK * 64; idx += F.G * 512) {
        const int n = idx >> 6, i = idx & 63;
        const float inv = (float)exp(-(double)i * (9.210340371976184 / 64.0));
        const float angf = (float)n * inv;
        const double xd = (double)angf; const double kq = rint(xd * 0.6366197723675814);
        double r = fma(-kq, 1.5707963267948966, xd); r = fma(-kq, 6.123233995736766e-17, r);
        const double r2 = r * r;
        double sn = -1.0 / 1307674368000.0; sn = fma(sn, r2, 1.0 / 6227020800.0); sn = fma(sn, r2, -1.0 / 39916800.0); sn = fma(sn, r2, 1.0 / 362880.0); sn = fma(sn, r2, -1.0 / 5040.0); sn = fma(sn, r2, 1.0 / 120.0); sn = fma(sn, r2, -1.0 / 6.0); sn = fma(sn * r2, r, r);
        double cs = 1.0 / 20922789888000.0; cs = fma(cs, r2, -1.0 / 87178291200.0); cs = fma(cs, r2, 1.0 / 479001600.0); cs = fma(cs, r2, -1.0 / 3628800.0); cs = fma(cs, r2, 1.0 / 40320.0); cs = fma(cs, r2, -1.0 / 720.0); cs = fma(cs, r2, 1.0 / 24.0); cs = fma(cs, r2, -0.5); cs = fma(cs, r2, 1.0);
        const int q = ((int)kq) & 3;
        const double c = (q == 0) ? cs : (q == 1) ? -sn : (q == 2) ? -cs : sn;
        const double s = (q == 0) ? sn : (q == 1) ? cs : (q == 2) ? -sn : -cs;
        rope[idx] = (f32x2){(float)c, (float)s};
    }
    __syncthreads();
    bf16* U1 = (bf16*)(F.ws + WS_ACT1); float* GATES = (float*)(F.ws + WS_GATES);
    RowDots W; rowdots_init(W, F.w_in + PC, PCOLS, F.wave, F.lane);
    for (int bi = F.vcu; bi < R / 16; bi += F.G) {
        const int r0 = bi * 16;
        int rr[2]; bool ok[2]; f32x4 u[2][4];
#pragma unroll
        for (int t = 0; t < 2; ++t) { rr[t] = r0 + 2 * F.wave + t; const int b = rr[t] / PP, p = rr[t] - b * PP; ok[t] = p >= PADF;
            if (ok[t]) row_load((p < CHK) ? F.meta + (size_t)(p - PADF) * D : F.x + ((size_t)b * SEQ + (p - CHK)) * D, F.lane, u[t]);
            else {
#pragma unroll
                for (int jj = 0; jj < 4; ++jj) u[t][jj] = (f32x4){0.f, 0.f, 0.f, 0.f}; } }
#pragma unroll
        for (int t = 0; t < 2; ++t) {
            if (!ok[t]) {
                bf16* prow = (bf16*)(F.ws + WS_PROJ) + (size_t)rr[t] * PC;
#pragma unroll
                for (int jj = 0; jj < 8; ++jj) *(u32x4*)(prow + jj * 512 + F.lane * 8) = (u32x4){0u, 0u, 0u, 0u};
            } else { rms_apply(F.mix_g, F.lane, u[t]); store_row_bf16(U1 + (size_t)rr[t] * D, F.lane, u[t]); }
            rowdots_put(F.lds, 2 * F.wave + t, F.lane, u[t]);
        }
        __syncthreads();
        rowdots_mma(F.lds, W, F.wave, F.lane);
        __syncthreads();
        if (F.tid < 256) { const int row = F.tid >> 4, g = F.tid & 15, r = r0 + row; const int b = r / PP, p = r - b * PP;
            float gv = rowdots_get(F.lds, row, g) + F.b_gates[g]; if (g >= 8) gv = logsigmoidf_(gv);
            GATES[(size_t)r * 16 + g] = (p >= PADF) ? gv : ((g < 8) ? NEGF : 0.0f); }
    }
}

__device__ __forceinline__ void phase_rope_conv(Ctx& F) {
    const bf16* PROJ = (const bf16*)(F.ws + WS_PROJ); bf16* QKC = (bf16*)(F.ws + WS_ACT1);
    const int gw = F.vcu * 8 + F.wave, NGW = F.G * 8, lane = F.lane;
    const float qs = 0.08838834764831845f;
    float wv[2][5][8], bv[2][8];
#pragma unroll
    for (int jj = 0; jj < 2; ++jj) { const int ch0 = jj * 512 + lane * 8;
        { const f32x4 b0 = *(const f32x4*)(F.conv_b + ch0), b1 = *(const f32x4*)(F.conv_b + ch0 + 4); bv[jj][0] = b0.x; bv[jj][1] = b0.y; bv[jj][2] = b0.z; bv[jj][3] = b0.w; bv[jj][4] = b1.x; bv[jj][5] = b1.y; bv[jj][6] = b1.z; bv[jj][7] = b1.w; }
#pragma unroll
        for (int j = 0; j < 5; ++j) { const f32x4 w0 = *(const f32x4*)(F.conv_w + j * 1024 + ch0), w1 = *(const f32x4*)(F.conv_w + j * 1024 + ch0 + 4);
            wv[jj][j][0] = w0.x; wv[jj][j][1] = w0.y; wv[jj][j][2] = w0.z; wv[jj][j][3] = w0.w; wv[jj][j][4] = w1.x; wv[jj][j][5] = w1.y; wv[jj][j][6] = w1.z; wv[jj][j][7] = w1.w; } }
    for (int r = gw; r < R; r += NGW) {
        const int b = r / PP, p = r - b * PP;
        bf16* qrow = QKC + (size_t)r * D;
        if (p < PADF) {
#pragma unroll
            for (int jj = 0; jj < 2; ++jj) *(u32x4*)(qrow + jj * 512 + lane * 8) = (u32x4){0u, 0u, 0u, 0u};
            continue;
        }
        u32x4 xv[2][5];
#pragma unroll
        for (int jj = 0; jj < 2; ++jj)
#pragma unroll
            for (int j = 0; j < 5; ++j) { const int pj = p + j - 2; xv[jj][j] = (pj >= PADF && pj < PP) ? *(const u32x4*)(PROJ + (size_t)(r + j - 2) * PC + 2048 + jj * 512 + lane * 8) : (u32x4){0u, 0u, 0u, 0u}; }
#pragma unroll
        for (int jj = 0; jj < 2; ++jj) {
            float acc[8];
#pragma unroll
            for (int i = 0; i < 8; ++i) acc[i] = bv[jj][i];
#pragma unroll
            for (int j = 0; j < 5; ++j) { const u32x4 v = xv[jj][j];
                acc[0] += bflo(v.x) * wv[jj][j][0]; acc[1] += bfhi(v.x) * wv[jj][j][1]; acc[2] += bflo(v.y) * wv[jj][j][2]; acc[3] += bfhi(v.y) * wv[jj][j][3];
                acc[4] += bflo(v.z) * wv[jj][j][4]; acc[5] += bfhi(v.z) * wv[jj][j][5]; acc[6] += bflo(v.w) * wv[jj][j][6]; acc[7] += bfhi(v.w) * wv[jj][j][7]; }
            const float sc = (jj == 0) ? qs : 1.0f;
#pragma unroll
            for (int i = 0; i < 8; ++i) acc[i] = siluf_(acc[i]) * sc;
            *(u32x4*)(qrow + jj * 512 + lane * 8) = (u32x4){pk2(acc[0], acc[1]), pk2(acc[2], acc[3]), pk2(acc[4], acc[5]), pk2(acc[6], acc[7])};
        }
    }
}

__device__ __forceinline__ void zero_acc(f32x4 (&acc)[2][4]) {
#pragma unroll
    for (int mt = 0; mt < 2; ++mt)
#pragma unroll
        for (int nt = 0; nt < 4; ++nt) acc[mt][nt] = (f32x4){0.f, 0.f, 0.f, 0.f};
}
template <bool MAXOP, bool REV>
__device__ __forceinline__ void scan128(const LAS float* x, LAS float* out, int lane) {
    static_assert(!REV, "suffix scans are not used any more");
    const int i0 = 2 * lane, i1 = 2 * lane + 1;
    const float a0 = x[i0], a1r = x[i1]; const float a1 = MAXOP ? fmaxf(a0, a1r) : a0 + a1r;
    const float s = wave_scan_incl<MAXOP>(a1);
    const int idn = __builtin_bit_cast(int, MAXOP ? -3.0e38f : 0.0f);
    const float ex = __builtin_bit_cast(float, __builtin_amdgcn_update_dpp(idn, __builtin_bit_cast(int, s), 0x138, 0xF, 0xF, false));
    out[i0] = MAXOP ? fmaxf(ex, a0) : ex + a0; out[i1] = s;
}

typedef short s16x4 __attribute__((ext_vector_type(4)));
constexpr int NSEG = 4;
__device__ __forceinline__ int seg_begin(int s) { return s == 0 ? 0 : 1 + 16 * s; }
constexpr size_t SUMM_STRIDE = (size_t)(144 * 128 + 64);
constexpr size_t WS_SUMM = WS_STATE;
constexpr size_t WS_OUTD = WS_STATE + 16 * MiB;
static_assert(WS_OUTD + (size_t)2 * R * D * 2 <= WS_END && 64 * 3 * SUMM_STRIDE * 4 <= 16 * MiB, "mixer scratch map");
constexpr int VQ = VEC_OFF;
constexpr int V_LI = VQ, V_LF = VQ + 512, V_BC = VQ + 1024, V_GG = VQ + 1536, V_PM = VQ + 2048, V_E1 = VQ + 2560, V_WI = VQ + 3072, V_FL = VQ + 3584, V_WU = VQ + 4096,
              V_NV = VQ + 4608  , V_SC = VQ + 4864  ;

template <int KS, int NT> __device__ __forceinline__ void ld_rows(const LAS bf16* T, int rowbase, int fq, bf16x8 (&f)[NT]) {
#pragma unroll
    for (int t = 0; t < NT; ++t) f[t] = *(const LAS bf16x8*)(T + (rowbase + 16 * t) * TP + KS * 32 + 8 * fq);
}
template <int KS> __device__ __forceinline__ void tr_frag4(unsigned addr, bf16x8 (&f)[4]) {
    s16x4 r0, r1, r2, r3, r4, r5, r6, r7;
    asm volatile("ds_read_b64_tr_b16 %0, %8 offset:%9\n\tds_read_b64_tr_b16 %1, %8 offset:%10\n\tds_read_b64_tr_b16 %2, %8 offset:%11\n\tds_read_b64_tr_b16 %3, %8 offset:%12\n\t"
                 "ds_read_b64_tr_b16 %4, %8 offset:%13\n\tds_read_b64_tr_b16 %5, %8 offset:%14\n\tds_read_b64_tr_b16 %6, %8 offset:%15\n\tds_read_b64_tr_b16 %7, %8 offset:%16\n\ts_waitcnt lgkmcnt(0)"
                 : "=&v"(r0), "=&v"(r1), "=&v"(r2), "=&v"(r3), "=&v"(r4), "=&v"(r5), "=&v"(r6), "=&v"(r7)
                 : "v"(addr), "i"(KS * 8704), "i"(KS * 8704 + 1088), "i"(KS * 8704 + 32), "i"(KS * 8704 + 32 + 1088), "i"(KS * 8704 + 64), "i"(KS * 8704 + 64 + 1088), "i"(KS * 8704 + 96), "i"(KS * 8704 + 96 + 1088)
                 : "memory");
    f[0] = __builtin_shufflevector(r0, r1, 0, 1, 2, 3, 4, 5, 6, 7); f[1] = __builtin_shufflevector(r2, r3, 0, 1, 2, 3, 4, 5, 6, 7);
    f[2] = __builtin_shufflevector(r4, r5, 0, 1, 2, 3, 4, 5, 6, 7); f[3] = __builtin_shufflevector(r6, r7, 0, 1, 2, 3, 4, 5, 6, 7);
}
template <int KS> __device__ __forceinline__ void tr_frag2(unsigned addr, bf16x8 (&f)[2]) {
    s16x4 r0, r1, r2, r3;
    asm volatile("ds_read_b64_tr_b16 %0, %4 offset:%5\n\tds_read_b64_tr_b16 %1, %4 offset:%6\n\tds_read_b64_tr_b16 %2, %4 offset:%7\n\tds_read_b64_tr_b16 %3, %4 offset:%8\n\ts_waitcnt lgkmcnt(0)"
                 : "=&v"(r0), "=&v"(r1), "=&v"(r2), "=&v"(r3)
                 : "v"(addr), "i"(KS * 8704), "i"(KS * 8704 + 1088), "i"(KS * 8704 + 32), "i"(KS * 8704 + 32 + 1088)
                 : "memory");
    f[0] = __builtin_shufflevector(r0, r1, 0, 1, 2, 3, 4, 5, 6, 7); f[1] = __builtin_shufflevector(r2, r3, 0, 1, 2, 3, 4, 5, 6, 7);
}
__device__ __forceinline__ unsigned tr_lane_addr(const LAS bf16* T, int colbase, int lane) {
    const int g = lane >> 4, q = (lane & 15) >> 2, p = lane & 3;
    return (unsigned)(__UINTPTR_TYPE__)(T + (8 * g + q) * TP + colbase + 4 * p);
}

struct SeqUnit { int b, h, grp, dir, seg, combo; };
__device__ __forceinline__ SeqUnit seq_unit(int u) { SeqUnit q; q.seg = u & 3; q.combo = u >> 2; q.dir = q.combo & 1; q.grp = (q.combo >> 1) & 1; q.h = (q.combo >> 2) & 3; q.b = q.combo >> 4; return q; }
__device__ __forceinline__ int seq_chunk(const SeqUnit& q, int ci) { return q.dir ? NCH - 1 - ci : ci; }
__device__ __forceinline__ void tile_fetch(int tid, const bf16* src, size_t stride, int rev, u32x4 (&v)[4]) {
#pragma unroll
    for (int i = 0; i < 4; ++i) { const int q = tid + 512 * i, row = q >> 4, ch = q & 15, rs = rev ? 127 - row : row; v[i] = *(const u32x4*)(src + (size_t)rs * stride + ch * 8); }
}
__device__ __forceinline__ void tile_put(int tid, LAS bf16* T, const u32x4 (&v)[4]) {
#pragma unroll
    for (int i = 0; i < 4; ++i) { const int q = tid + 512 * i, row = q >> 4, ch = q & 15; *(LAS u32x4*)(T + row * TP + ch * 8) = v[i]; }
}
__device__ __forceinline__ void chunk_scans(LAS unsigned char* lds, int lane, bool nostab) {
    LAS float* LI = (LAS float*)(lds + V_LI); LAS float* LF = (LAS float*)(lds + V_LF); LAS float* BC = (LAS float*)(lds + V_BC); LAS float* GG = (LAS float*)(lds + V_GG); LAS float* PM = (LAS float*)(lds + V_PM);
    LAS float* E1 = (LAS float*)(lds + V_E1); LAS float* WI = (LAS float*)(lds + V_WI); LAS float* FL = (LAS float*)(lds + V_FL); LAS float* WU = (LAS float*)(lds + V_WU); LAS float* SC = (LAS float*)(lds + V_SC);
    scan128<false, false>(LF, BC, lane); LDS_WAIT();
    const int l0 = 2 * lane, l1 = 2 * lane + 1;
    const float bc0 = BC[l0], bc1 = BC[l1], li0 = LI[l0], li1 = LI[l1];
    GG[l0] = li0 - bc0; GG[l1] = li1 - bc1; LDS_WAIT();
    scan128<true, false>(GG, PM, lane); LDS_WAIT();
    const float blast = BC[127], m = SC[0];
    const float lu0 = blast - bc0 + li0, lu1 = blast - bc1 + li1;
    const float a = nostab ? 0.0f : wave_max(fmaxf(lu0, lu1));
    const float mnew = nostab ? 0.0f : fmaxf(blast + m, a);
    const float f = __expf(blast + m - mnew), g = __expf(a - mnew);
    const float mr0 = nostab ? 0.0f : fmaxf(bc0 + m, bc0 + PM[l0]), mr1 = nostab ? 0.0f : fmaxf(bc1 + m, bc1 + PM[l1]);
    E1[l0] = bc0 - mr0; E1[l1] = bc1 - mr1; WI[l0] = __expf(bc0 + m - mr0); WI[l1] = __expf(bc1 + m - mr1);
    FL[l0] = __expf(-mr0); FL[l1] = __expf(-mr1); WU[l0] = g * __expf(lu0 - a); WU[l1] = g * __expf(lu1 - a);
    if (lane == 0) { SC[1] = f; SC[2] = mnew; SC[3] += blast; }
}
__device__ __forceinline__ void scale_k(int tid, LAS bf16* TK, const LAS float* WU) {
#pragma unroll
    for (int i = 0; i < 4; ++i) { const int q = tid + 512 * i, row = q >> 4, ch = q & 15; LAS u32x4* p = (LAS u32x4*)(TK + row * TP + ch * 8); const u32x4 v = *p; const float wv = WU[row];
        *p = (u32x4){cvtpk(bflo(v.x) * wv, bfhi(v.x) * wv), cvtpk(bflo(v.y) * wv, bfhi(v.y) * wv), cvtpk(bflo(v.z) * wv, bfhi(v.z) * wv), cvtpk(bflo(v.w) * wv, bfhi(v.w) * wv)}; }
}
__device__ __forceinline__ void state_update(const LAS bf16* TV, const LAS bf16* TK, int w, int lane, float f, f32x4 (&C)[2][4], float (&nrow)[4]) {
    const int m0 = 32 * (w >> 1), n0 = 64 * (w & 1), fr = lane & 15;
#pragma unroll
    for (int mt = 0; mt < 2; ++mt)
#pragma unroll
        for (int nt = 0; nt < 4; ++nt) C[mt][nt] *= f;
    f32x4 nacc[4];
#pragma unroll
    for (int nt = 0; nt < 4; ++nt) nacc[nt] = (f32x4){nrow[nt] * f, 0.f, 0.f, 0.f};
    const unsigned aa = tr_lane_addr(TV, m0, lane), ab = tr_lane_addr(TK, n0, lane);
    bf16x8 ones; { const short o = (fr == 0) ? (short)0x3F80 : (short)0;
#pragma unroll
        for (int j = 0; j < 8; ++j) ones[j] = o; }
#define SU_STEP(KS) { bf16x8 a[2], b[4]; tr_frag2<KS>(aa, a); tr_frag4<KS>(ab, b); \
        _Pragma("unroll") for (int mt = 0; mt < 2; ++mt) _Pragma("unroll") for (int nt = 0; nt < 4; ++nt) C[mt][nt] = MFMA16(a[mt], b[nt], C[mt][nt]); \
        if (w < 2) { _Pragma("unroll") for (int nt = 0; nt < 4; ++nt) nacc[nt] = MFMA16(ones, b[nt], nacc[nt]); } }
    SU_STEP(0) SU_STEP(1) SU_STEP(2) SU_STEP(3)
#undef SU_STEP
#pragma unroll
    for (int nt = 0; nt < 4; ++nt) nrow[nt] = nacc[nt][0];
}
__device__ __forceinline__ const bf16* seq_src(const Ctx& F, const SeqUnit& q, int which  , size_t& stride) {
    const bf16* PROJ = (const bf16*)(F.ws + WS_PROJ); const bf16* QKC = (const bf16*)(F.ws + WS_ACT1);
    if (q.grp == 0) { stride = PC; return PROJ + which * 512 + q.h * 128; }
    if (which == 2) { stride = PC; return PROJ + 3072 + q.h * 128; }
    stride = D; return QKC + which * 512 + q.h * 128;
}
__device__ __forceinline__ void gates_fetch(const Ctx& F, const SeqUnit& q, int c, int tid, float lgam, float& li, float& lf) {
    if (q.grp == 0) { li = 0.0f; lf = lgam; return; }
    const float* GATES = (const float*)(F.ws + WS_GATES); const int row = q.dir ? 127 - tid : tid;
    const float* gp = GATES + ((size_t)q.b * PP + (size_t)c * CHK + row) * 16; li = gp[q.dir * 4 + q.h]; lf = gp[8 + q.dir * 4 + q.h];
}

constexpr int I_WD = (DFF / 64) * (D / 64);
constexpr int WD_SPLIT = 2800;
__device__ __forceinline__ void convert_wd(Ctx& F, int lo, int hi, int iw, int nw) {
    unsigned char* WdT = F.ws + WS_WD8; LAS float* scr = (LAS float*)(F.lds + F.wave * F8SCR);
    for (int it = lo + iw; it < hi; it += nw) { const int e = it / I_WD, item = it - e * I_WD;
        transpose_item_f8(F.w_down + (size_t)e * DFF * D, DFF, D, D, WdT + (size_t)e * D * DFF, scr, item, F.lane, WPRE_DN); }
}
__device__ __forceinline__ void phase_seg_summary(Ctx& F) {
    LAS bf16* TK = (LAS bf16*)(F.lds + T1_OFF); LAS bf16* TV = (LAS bf16*)(F.lds + T2_OFF);
    LAS float* SC = (LAS float*)(F.lds + V_SC); LAS float* LI = (LAS float*)(F.lds + V_LI); LAS float* LF = (LAS float*)(F.lds + V_LF); const LAS float* WU = (const LAS float*)(F.lds + V_WU);
    float* SUMM = (float*)(F.ws + WS_SUMM);
    const int w = F.wave;
    for (int u = F.vcu; u < 64 * NSEG; u += F.G) {
        const SeqUnit q = seq_unit(u);
        if (q.seg == NSEG - 1) { convert_wd(F, 0, WD_SPLIT, q.combo * 8 + F.wave, 64 * 8); continue; }
        int tid = F.tid; asm volatile("" : "+v"(tid));
        const int lane = tid & 63, fr = lane & 15, fq = lane >> 4;
        const bool nostab = (q.grp == 0);
        const float lgam = nostab ? logsigmoidf_(F.ret_logit[q.dir * NH + q.h]) : 0.0f;
        size_t sk, sv; const bf16* pk = seq_src(F, q, 1, sk); const bf16* pv = seq_src(F, q, 2, sv);
        f32x4 C[2][4]; float nrow[4] = {0.f, 0.f, 0.f, 0.f}; zero_acc(C);
        __syncthreads();
        if (tid == 0) { SC[0] = 0.f; SC[3] = 0.f; }
        const int ci0 = seg_begin(q.seg), ci1 = seg_begin(q.seg + 1);
        u32x4 rk[4], rv[4]; float gli = 0.f, glf = 0.f;
        {   const int c = seq_chunk(q, ci0); const size_t r0 = (size_t)q.b * PP + (size_t)c * CHK;
            tile_fetch(tid, pk + r0 * sk, sk, q.dir, rk); tile_fetch(tid, pv + r0 * sv, sv, q.dir, rv); if (tid < 128) gates_fetch(F, q, c, tid, lgam, gli, glf); }
#pragma unroll 1
        for (int ci = ci0; ci < ci1; ++ci) {
            tile_put(tid, TK, rk); tile_put(tid, TV, rv); if (tid < 128) { LI[tid] = gli; LF[tid] = glf; }
            __syncthreads();
            if (ci + 1 < ci1) { const int c = seq_chunk(q, ci + 1); const size_t r0 = (size_t)q.b * PP + (size_t)c * CHK;
                tile_fetch(tid, pk + r0 * sk, sk, q.dir, rk); tile_fetch(tid, pv + r0 * sv, sv, q.dir, rv); if (tid < 128) gates_fetch(F, q, c, tid, lgam, gli, glf); }
            if (w == 0) chunk_scans(F.lds, lane, nostab);
            __syncthreads();
            scale_k(tid, TK, WU);
            __syncthreads();
            const float f = SC[1];
            state_update(TV, TK, w, lane, f, C, nrow);
            __syncthreads();
            if (tid == 0) SC[0] = SC[2];
        }
        __syncthreads();
        float* dst = SUMM + ((size_t)q.combo * 3 + q.seg) * SUMM_STRIDE;
        const int m0 = 32 * (w >> 1), n0 = 64 * (w & 1);
#pragma unroll
        for (int mt = 0; mt < 2; ++mt)
#pragma unroll
            for (int nt = 0; nt < 4; ++nt)
#pragma unroll
                for (int rg = 0; rg < 4; ++rg) dst[(m0 + 16 * mt + 4 * fq + rg) * 128 + n0 + 16 * nt + fr] = C[mt][nt][rg];
        if (w < 2 && fq == 0) {
#pragma unroll
            for (int nt = 0; nt < 4; ++nt) dst[128 * 128 + n0 + 16 * nt + fr] = nrow[nt]; }
        if (tid == 0) { dst[144 * 128] = SC[0]; dst[144 * 128 + 1] = SC[3]; }
    }
}

__device__ __forceinline__ void phase_seq(Ctx& F) {
    LAS bf16* TQ = (LAS bf16*)(F.lds + T0_OFF); LAS bf16* TK = (LAS bf16*)(F.lds + T1_OFF); LAS bf16* TV = (LAS bf16*)(F.lds + T2_OFF); LAS bf16* TC = (LAS bf16*)(F.lds + T3_OFF);
    LAS float* SC = (LAS float*)(F.lds + V_SC); LAS float* LI = (LAS float*)(F.lds + V_LI); LAS float* LF = (LAS float*)(F.lds + V_LF);
    const LAS float* WU = (const LAS float*)(F.lds + V_WU); const LAS float* E1 = (const LAS float*)(F.lds + V_E1); const LAS float* GG = (const LAS float*)(F.lds + V_GG);
    const LAS float* WI = (const LAS float*)(F.lds + V_WI); const LAS float* FL = (const LAS float*)(F.lds + V_FL); LAS bf16* NV = (LAS bf16*)(F.lds + V_NV);
    const float* SUMM = (const float*)(F.ws + WS_SUMM); bf16* OUTD = (bf16*)(F.ws + WS_OUTD);
    const int w = F.wave, m0 = 32 * (w >> 1), n0 = 64 * (w & 1);
    if (w >= 4) __builtin_amdgcn_s_setprio(1);
    for (int u = F.vcu; u < 64 * NSEG; u += F.G) {
        const SeqUnit q = seq_unit(u);
        int tid_u = F.tid; asm volatile("" : "+v"(tid_u));
        const int tid = tid_u, lane = tid & 63, fr = lane & 15, fq = lane >> 4;
        const bool nostab = (q.grp == 0);
        const float lgam = nostab ? logsigmoidf_(F.ret_logit[q.dir * NH + q.h]) : 0.0f;
        size_t sq, sk, sv; const bf16* pq = seq_src(F, q, 0, sq); const bf16* pk = seq_src(F, q, 1, sk); const bf16* pv = seq_src(F, q, 2, sv);
        f32x4 C[2][4]; float nrow[4] = {0.f, 0.f, 0.f, 0.f}; zero_acc(C);
        float mst = 0.f;
        for (int s = 0; s < q.seg; ++s) {
            const float* src = SUMM + ((size_t)q.combo * 3 + s) * SUMM_STRIDE;
            const float ms = src[144 * 128], Bs = src[144 * 128 + 1];
            const float mo_ = nostab ? 0.0f : fmaxf(Bs + mst, ms); const float fa = __expf(Bs + mst - mo_), fb = __expf(ms - mo_); mst = mo_;
#pragma unroll
            for (int mt = 0; mt < 2; ++mt)
#pragma unroll
                for (int nt = 0; nt < 4; ++nt)
#pragma unroll
                    for (int rg = 0; rg < 4; ++rg) C[mt][nt][rg] = fa * C[mt][nt][rg] + fb * src[(m0 + 16 * mt + 4 * fq + rg) * 128 + n0 + 16 * nt + fr];
            if (w < 2 && fq == 0) {
#pragma unroll
                for (int nt = 0; nt < 4; ++nt) nrow[nt] = fa * nrow[nt] + fb * src[128 * 128 + n0 + 16 * nt + fr]; }
        }
        __syncthreads();
        if (tid == 0) { SC[0] = mst; SC[3] = 0.f; }
        const int ci0 = seg_begin(q.seg), ci1 = seg_begin(q.seg + 1);
        u32x4 rq[4], rk[4], rv[4]; float gli = 0.f, glf = 0.f;
        {   const int c = seq_chunk(q, ci0); const size_t r0 = (size_t)q.b * PP + (size_t)c * CHK;
            tile_fetch(tid, pq + r0 * sq, sq, q.dir, rq); tile_fetch(tid, pk + r0 * sk, sk, q.dir, rk); tile_fetch(tid, pv + r0 * sv, sv, q.dir, rv); if (tid < 128) gates_fetch(F, q, c, tid, lgam, gli, glf); }
#pragma unroll 1
        for (int ci = ci0; ci < ci1; ++ci) {
            const int c = seq_chunk(q, ci); const size_t r0 = (size_t)q.b * PP + (size_t)c * CHK;
            int tid = tid_u; asm volatile("" : "+v"(tid));
            const int lane = tid & 63, fr = lane & 15, fq = lane >> 4;
            tile_put(tid, TQ, rq); tile_put(tid, TK, rk); tile_put(tid, TV, rv); if (tid < 128) { LI[tid] = gli; LF[tid] = glf; }
#pragma unroll
            for (int mt = 0; mt < 2; ++mt)
#pragma unroll
                for (int nt = 0; nt < 4; ++nt) *(LAS u32x2*)(TC + (n0 + 16 * nt + fr) * TP + m0 + 16 * mt + 4 * fq) = (u32x2){cvtpk(C[mt][nt][0], C[mt][nt][1]), cvtpk(C[mt][nt][2], C[mt][nt][3])};
            if (w < 2 && fq == 0) {
#pragma unroll
                for (int nt = 0; nt < 4; ++nt) NV[n0 + 16 * nt + fr] = (bf16)f2bf(nrow[nt]); }
            __syncthreads();
            if (w == 0) chunk_scans(F.lds, lane, nostab);
            f32x4 accN[2][4], accD[4], accS[2][4]; zero_acc(accN); zero_acc(accS);
#pragma unroll
            for (int nt = 0; nt < 4; ++nt) accD[nt] = (f32x4){0.f, 0.f, 0.f, 0.f};
            {   const unsigned ac = tr_lane_addr(TC, m0, lane);
#define SX_STEP(KS) { bf16x8 a[2], bq[4]; ld_rows<KS, 4>(TQ, n0 + fr, fq, bq); tr_frag2<KS>(ac, a); \
                bf16x8 an = *(const LAS bf16x8*)(NV + KS * 32 + 8 * fq); if (fr != 0) { _Pragma("unroll") for (int j = 0; j < 8; ++j) an[j] = 0; } \
                _Pragma("unroll") for (int nt = 0; nt < 4; ++nt) { _Pragma("unroll") for (int mt = 0; mt < 2; ++mt) accN[mt][nt] = MFMA16(a[mt], bq[nt], accN[mt][nt]); accD[nt] = MFMA16(an, bq[nt], accD[nt]); } }
                SX_STEP(0) SX_STEP(1) SX_STEP(2) SX_STEP(3)
#undef SX_STEP
            }
#define SS_STEP(KS) { bf16x8 a[2], bq[4]; ld_rows<KS, 2>(TK, m0 + fr, fq, a); ld_rows<KS, 4>(TQ, n0 + fr, fq, bq); \
                _Pragma("unroll") for (int mt = 0; mt < 2; ++mt) { _Pragma("unroll") for (int nt = 0; nt < 4; ++nt) accS[mt][nt] = MFMA16(a[mt], bq[nt], accS[mt][nt]); } }
            SS_STEP(0) SS_STEP(1) SS_STEP(2) SS_STEP(3)
#undef SS_STEP
            __syncthreads();
#pragma unroll
            for (int nt = 0; nt < 4; ++nt) { const int l = n0 + 16 * nt + fr; const float wi = WI[l], e1 = E1[l]; accD[nt][0] *= wi;
#pragma unroll
                for (int mt = 0; mt < 2; ++mt) { accN[mt][nt] *= wi; const int mb = m0 + 16 * mt + 4 * fq; float pv_[4];
#pragma unroll
                    for (int rg = 0; rg < 4; ++rg) pv_[rg] = (mb + rg <= l) ? accS[mt][nt][rg] * __expf(e1 + GG[mb + rg]) : 0.0f;
                    *(LAS u32x2*)(TC + l * TP + mb) = (u32x2){cvtpk(pv_[0], pv_[1]), cvtpk(pv_[2], pv_[3])}; } }
            scale_k(tid, TK, WU);
            if (ci + 1 < ci1) { const int cn = seq_chunk(q, ci + 1); const size_t rn = (size_t)q.b * PP + (size_t)cn * CHK;
                tile_fetch(tid, pq + rn * sq, sq, q.dir, rq); tile_fetch(tid, pk + rn * sk, sk, q.dir, rk); tile_fetch(tid, pv + rn * sv, sv, q.dir, rv); if (tid < 128) gates_fetch(F, q, cn, tid, lgam, gli, glf); }
            __syncthreads();
            {   const unsigned av = tr_lane_addr(TV, m0, lane);
                bf16x8 ones; { const short o = (fr == 0) ? (short)0x3F80 : (short)0;
#pragma unroll
                    for (int j = 0; j < 8; ++j) ones[j] = o; }
#define PV_STEP(KS) { bf16x8 a[2], bp[4]; ld_rows<KS, 4>(TC, n0 + fr, fq, bp); tr_frag2<KS>(av, a); \
                _Pragma("unroll") for (int nt = 0; nt < 4; ++nt) { _Pragma("unroll") for (int mt = 0; mt < 2; ++mt) accN[mt][nt] = MFMA16(a[mt], bp[nt], accN[mt][nt]); accD[nt] = MFMA16(ones, bp[nt], accD[nt]); } }
                PV_STEP(0) PV_STEP(1) PV_STEP(2) PV_STEP(3)
#undef PV_STEP
            }
#pragma unroll
            for (int nt = 0; nt < 4; ++nt) { const int l = n0 + 16 * nt + fr;
                const float den = __shfl(accD[nt][0], fr); const float inv = nostab ? 1.0f : __builtin_amdgcn_rcpf(fmaxf(fabsf(den), FL[l]));
#pragma unroll
                for (int mt = 0; mt < 2; ++mt) { const f32x4 o = accN[mt][nt] * inv; *(LAS u32x2*)(TQ + l * TP + m0 + 16 * mt + 4 * fq) = (u32x2){cvtpk(o[0], o[1]), cvtpk(o[2], o[3])}; } }
            state_update(TV, TK, w, lane, SC[1], C, nrow);
            __syncthreads();
            {   bf16* dst = OUTD + ((size_t)q.dir * R + r0) * D + q.grp * 512 + q.h * 128;
#pragma unroll
                for (int i = 0; i < 4; ++i) { const int qq = tid + 512 * i, row = qq >> 4, ch = qq & 15, rs = q.dir ? 127 - row : row; *(u32x4*)(dst + (size_t)rs * D + ch * 8) = *(const LAS u32x4*)(TQ + row * TP + ch * 8); } }
            if (tid == 0) SC[0] = SC[2];
            __syncthreads();
        }
    }
    __builtin_amdgcn_s_setprio(0);
}

__device__ __forceinline__ void phase_combine(Ctx& F) {
    const bf16* PROJ = (const bf16*)(F.ws + WS_PROJ); const bf16* OUTD = (const bf16*)(F.ws + WS_OUTD); bf16* Y = (bf16*)(F.ws + WS_ACT2);
    const int gw = F.vcu * 8 + F.wave, NGW = F.G * 8, lane = F.lane;
    const int col = lane * 16, grp = col >> 9;
    const size_t goff = (grp == 0 ? 1536 + col : 3584 + (col - 512));
    u32x4 na[2], nc[2], ng[2];
    { const int p0 = gw - (gw / PP) * PP; if (gw < R && p0 >= PADF) {
#pragma unroll
        for (int hh = 0; hh < 2; ++hh) { na[hh] = *(const u32x4*)(OUTD + (size_t)gw * D + col + hh * 8); nc[hh] = *(const u32x4*)(OUTD + ((size_t)R + gw) * D + col + hh * 8); ng[hh] = *(const u32x4*)(PROJ + (size_t)gw * PC + goff + hh * 8); } } }
    for (int r = gw; r < R; r += NGW) {
        const int b = r / PP, p = r - b * PP; bf16* yrow = Y + (size_t)r * D + lane * 16;
        u32x4 ca[2], cc[2], cg[2];
#pragma unroll
        for (int hh = 0; hh < 2; ++hh) { ca[hh] = na[hh]; cc[hh] = nc[hh]; cg[hh] = ng[hh]; }
        { const int r2 = r + NGW; const int p2 = r2 - (r2 / PP) * PP; if (r2 < R && p2 >= PADF) {
#pragma unroll
            for (int hh = 0; hh < 2; ++hh) { na[hh] = *(const u32x4*)(OUTD + (size_t)r2 * D + col + hh * 8); nc[hh] = *(const u32x4*)(OUTD + ((size_t)R + r2) * D + col + hh * 8); ng[hh] = *(const u32x4*)(PROJ + (size_t)r2 * PC + goff + hh * 8); } } }
        if (p < PADF) { *(u32x4*)yrow = (u32x4){0u, 0u, 0u, 0u}; *(u32x4*)(yrow + 8) = (u32x4){0u, 0u, 0u, 0u}; continue; }
        float v[16], gt[16];
#pragma unroll
        for (int hh = 0; hh < 2; ++hh) { const u32x4 a = ca[hh], c = cc[hh], g = cg[hh];
            const unsigned aw[4] = {a.x, a.y, a.z, a.w}, cw[4] = {c.x, c.y, c.z, c.w}, gw_[4] = {g.x, g.y, g.z, g.w};
#pragma unroll
            for (int j = 0; j < 4; ++j) { v[hh * 8 + 2 * j] = bflo(aw[j]) + bflo(cw[j]); v[hh * 8 + 2 * j + 1] = bfhi(aw[j]) + bfhi(cw[j]); gt[hh * 8 + 2 * j] = bflo(gw_[j]); gt[hh * 8 + 2 * j + 1] = bfhi(gw_[j]); } }
        if (grp == 1) {
#pragma unroll
            for (int j = 0; j < 16; ++j) v[j] *= sigmoidf_(gt[j]); }
        float s = 0.f;
#pragma unroll
        for (int j = 0; j < 16; ++j) s += v[j];
        s += __shfl_xor(s, 1); s += __shfl_xor(s, 2); s += __shfl_xor(s, 4);
        const float mu = s * (1.0f / 128.0f); float qv = 0.f;
#pragma unroll
        for (int j = 0; j < 16; ++j) { v[j] -= mu; qv += v[j] * v[j]; }
        qv += __shfl_xor(qv, 1); qv += __shfl_xor(qv, 2); qv += __shfl_xor(qv, 4);
        const float rstd = rsqrtf(qv * (1.0f / 128.0f) + EPS);
        const float* gnp = (grp == 0 ? F.ret_gn + col : F.ml_gn + (col - 512)); float gn[16];
#pragma unroll
        for (int j4 = 0; j4 < 4; ++j4) { const f32x4 g4 = *(const f32x4*)(gnp + 4 * j4); gn[4 * j4] = g4.x; gn[4 * j4 + 1] = g4.y; gn[4 * j4 + 2] = g4.z; gn[4 * j4 + 3] = g4.w; }
        unsigned o[8];
#pragma unroll
        for (int j = 0; j < 8; ++j) { float y0 = v[2 * j] * rstd * gn[2 * j], y1 = v[2 * j + 1] * rstd * gn[2 * j + 1];
            if (grp == 0) { y0 *= siluf_(gt[2 * j]); y1 *= siluf_(gt[2 * j + 1]); }
            o[j] = pk2(y0, y1); }
        *(u32x4*)yrow = (u32x4){o[0], o[1], o[2], o[3]}; *(u32x4*)(yrow + 8) = (u32x4){o[4], o[5], o[6], o[7]};
    }
}

constexpr int SK_RED = 34816;
__device__ __forceinline__ f32x4 skinny16_ksplit(LAS unsigned char* lds, const bf16* btrow, int w, int lane) {
    const LAS bf16* A = (const LAS bf16*)lds; LAS float* RED = (LAS float*)(lds + SK_RED);
    const int fr = lane & 15, fq = lane >> 4;
    f32x4 acc = (f32x4){0.f, 0.f, 0.f, 0.f};
    bf16x8 bb[4];
#pragma unroll
    for (int j = 0; j < 4; ++j) bb[j] = *(const bf16x8*)(btrow + (4 * w + j) * 32 + 8 * fq);
#pragma unroll
    for (int j = 0; j < 4; ++j) { const bf16x8 a = *(const LAS bf16x8*)(A + fr * 1032 + (4 * w + j) * 32 + 8 * fq); acc = MFMA16(a, bb[j], acc); }
    *(LAS f32x4*)(RED + w * 256 + lane * 4) = acc;
    __syncthreads();
    if (w == 0) { acc = (f32x4){0.f, 0.f, 0.f, 0.f};
#pragma unroll
        for (int ww = 0; ww < 8; ++ww) acc += *(const LAS f32x4*)(RED + ww * 256 + lane * 4); }
    return acc;
}
__device__ __forceinline__ void proj_meta(Ctx& F) {
    const bf16* U1 = (const bf16*)(F.ws + WS_ACT1); const bf16* WINT = (const bf16*)(F.ws + WS_WINT); bf16* PROJ = (bf16*)(F.ws + WS_PROJ); const f32x2* rope = (const f32x2*)(F.ws + WS_ROPE);
    LAS bf16* AT = (LAS bf16*)F.lds;
    for (int it = F.vcu; it < PC / 16; it += F.G) {
        int tid = F.tid; asm volatile("" : "+v"(tid));
        const int lane = tid & 63, fr = lane & 15, fq = lane >> 4;
        __syncthreads();
        for (int i = tid; i < 16 * 128; i += 512) { const int r = i >> 7, ch = i & 127; *(LAS u32x4*)(AT + r * 1032 + ch * 8) = *(const u32x4*)(U1 + (size_t)(PADF + r) * D + ch * 8); }
        __syncthreads();
        const int t = it * 16 + fr;
        const f32x4 acc = skinny16_ksplit(F.lds, WINT + (size_t)t * D, F.wave, lane);
        if (F.wave == 0) {
#pragma unroll
            for (int rg = 0; rg < 4; ++rg) {
                const int n = 4 * fq + rg; float val = acc[rg]; int col = t;
                const float other = __shfl_xor(val, 4);
                if (t < 1024) {
                    const int tc = t & 127, dd = 4 * (tc >> 3) + (tc & 3); const f32x2 cs = rope[n * 64 + dd]; const float sc = (t < 512) ? 0.08838834764831845f : 1.0f;
                    if ((tc & 4) == 0) { val = (val * cs.x - other * cs.y) * sc; col = (t & ~127) + dd; } else { val = (val * cs.x + other * cs.y) * sc; col = (t & ~127) + 64 + dd; }
                }
                const bf16 hv = (bf16)f2bf(val);
#pragma unroll
                for (int b = 0; b < NB; ++b) PROJ[((size_t)b * PP + PADF + n) * PC + col] = hv;
            }
        }
    }
}
__device__ __forceinline__ void out_meta(Ctx& F) {
    const bf16* Y = (const bf16*)(F.ws + WS_ACT2); const bf16* WOUTT = (const bf16*)(F.ws + WS_WOUTT); float* H1M = (float*)(F.ws + WS_H1META);
    LAS bf16* AT = (LAS bf16*)F.lds;
    for (int it = F.vcu; it < NB * (D / 16); it += F.G) {
        int tid = F.tid; asm volatile("" : "+v"(tid));
        const int lane = tid & 63, fr = lane & 15, fq = lane >> 4;
        const int b = it >> 6, cg_ = it & 63;
        __syncthreads();
        for (int i = tid; i < 16 * 128; i += 512) { const int r = i >> 7, ch = i & 127; *(LAS u32x4*)(AT + r * 1032 + ch * 8) = *(const u32x4*)(Y + ((size_t)b * PP + PADF + r) * D + ch * 8); }
        __syncthreads();
        const int col = cg_ * 16 + fr;
        const f32x4 acc = skinny16_ksplit(F.lds, WOUTT + (size_t)col * D, F.wave, lane);
        if (F.wave == 0) {
#pragma unroll
            for (int rg = 0; rg < 4; ++rg) { const int n = 4 * fq + rg; H1M[(size_t)(b * NMETA + n) * D + col] = F.meta[(size_t)n * D + col] + acc[rg]; } }
    }
}

__device__ __forceinline__ void phase_router(Ctx& F) {
    const int gw = F.vcu * 8 + F.wave, NGW = F.G * 8;
    {
        unsigned char* WgT = F.ws + WS_WEXP; unsigned char* WuT = F.ws + WS_WEXP + WEXP_ONE;
        LAS float* scr = (LAS float*)(F.lds + F.wave * F8SCR);
        constexpr int I_ONE = (D / 64) * (DFF / 64);
        for (int it = gw; it < 2 * NE * I_ONE; it += NGW) {
            const int mat = it / (NE * I_ONE), rem = it - mat * (NE * I_ONE), e = rem / I_ONE, item = rem - e * I_ONE;
            if (mat == 0) transpose_item_f8(F.w_gate + (size_t)e * D * DFF, D, DFF, DFF, WgT + (size_t)e * DFF * D, scr, item, F.lane, WPRE_UP);
            else transpose_item_f8(F.w_up + (size_t)e * D * DFF, D, DFF, DFF, WuT + (size_t)e * DFF * D, scr, item, F.lane, WPRE_UP);
        }
    }
    __syncthreads();
    unsigned char* U2 = F.ws + WS_ACT1; float* AFF = (float*)(F.ws + WS_AFF); const float* H1M = (const float*)(F.ws + WS_H1META);
    RowDots W; rowdots_init(W, F.w_router, NE, F.wave, F.lane);
    for (int bi = F.vcu; bi < R / 16; bi += F.G) {
        const int r0 = bi * 16;
        int rr[2]; bool ok[2]; f32x4 u[2][4];
#pragma unroll
        for (int t = 0; t < 2; ++t) { rr[t] = r0 + 2 * F.wave + t; const int b = rr[t] / PP, p = rr[t] - b * PP; ok[t] = p >= PADF;
            if (ok[t]) { if (p < CHK) row_load(H1M + (size_t)(b * NMETA + p - PADF) * D, F.lane, u[t]); else { const size_t xo = ((size_t)b * SEQ + (p - CHK)) * D; row_load_h1(F.x + xo, (const bf16*)(F.ws + WS_DELTA) + xo, F.lane, u[t]); } }
            else {
#pragma unroll
                for (int jj = 0; jj < 4; ++jj) u[t][jj] = (f32x4){0.f, 0.f, 0.f, 0.f}; } }
#pragma unroll
        for (int t = 0; t < 2; ++t) { if (ok[t]) { rms_apply(F.ffn_g, F.lane, u[t]); unsigned char* urow = U2 + (size_t)rr[t] * D;
#pragma unroll
                for (int jj = 0; jj < 4; ++jj) *(unsigned*)(urow + jj * 256 + F.lane * 4) = pk4_fp8(u[t][jj].x, u[t][jj].y, u[t][jj].z, u[t][jj].w); }
            rowdots_put(F.lds, 2 * F.wave + t, F.lane, u[t]); }
        __syncthreads();
        rowdots_mma(F.lds, W, F.wave, F.lane);
        __syncthreads();
        if (F.tid < 256) { const int row = F.tid >> 4, g = F.tid & 15, r = r0 + row; const int b = r / PP, p = r - b * PP;
            const float lg = rowdots_get(F.lds, row, g);
            float mx = lg; mx = fmaxf(mx, __shfl_xor(mx, 1)); mx = fmaxf(mx, __shfl_xor(mx, 2)); mx = fmaxf(mx, __shfl_xor(mx, 4)); mx = fmaxf(mx, __shfl_xor(mx, 8));
            const float ev = expf(lg - mx); float sm = ev; sm += __shfl_xor(sm, 1); sm += __shfl_xor(sm, 2); sm += __shfl_xor(sm, 4); sm += __shfl_xor(sm, 8);
            if (p >= PADF) AFF[((size_t)b * NE + g) * NTOK + (p - PADF)] = ev / sm; }
    }
}

__device__ __forceinline__ void phase_topk(Ctx& F) {
    const float* AFF = (const float*)(F.ws + WS_AFF); int* IDX = (int*)(F.ws + WS_IDX); float* GV = (float*)(F.ws + WS_GV); int* SLOT = (int*)(F.ws + WS_SLOT); unsigned* ROWOFF = (unsigned*)(F.ws + WS_SCAL);
    LAS unsigned* keys = (LAS unsigned*)F.lds; LAS unsigned* hist = keys + 8448; LAS unsigned* misc = hist + 256; LAS unsigned* wtot = misc + 16;
    const int tid = F.tid, lane = F.lane, w = F.wave;
    if (F.vcu >= NB * NE) { convert_wd(F, WD_SPLIT, NE * I_WD, (F.vcu - NB * NE) * 8 + F.wave, (F.G - NB * NE) * 8); return; }
    for (int u = F.vcu; u < NB * NE; u += F.G) {
        const int b = u >> 4, e = u & 15; const float* a = AFF + (size_t)u * NTOK;
        __syncthreads();
        for (int i = tid; i < NTOK; i += 512) keys[i] = __builtin_bit_cast(unsigned, a[i]);
        unsigned prefix = 0u, need = CAP;
        for (int pass = 0; pass < 4; ++pass) {
            const int shift = 24 - 8 * pass;
            if (tid < 256) hist[tid] = 0u;
            __syncthreads();
            for (int i = tid; i < NTOK; i += 512) { const unsigned k = keys[i]; if (pass == 0 || (k >> (shift + 8)) == (prefix >> (shift + 8))) atomicAdd((unsigned*)&hist[(k >> shift) & 255u], 1u); }
            __syncthreads();
            if (w == 0) {
                const int bb = 255 - 4 * lane; const unsigned c0 = hist[bb], c1 = hist[bb - 1], c2 = hist[bb - 2], c3 = hist[bb - 3]; const unsigned tot = c0 + c1 + c2 + c3;
                const float incl_f = wave_scan_incl<false>((float)tot); const unsigned incl = (unsigned)incl_f, excl = incl - tot;
                const bool here = excl < need && need <= incl;
                if (here) { unsigned cum = excl; int sel = bb;
                    if (cum + c0 >= need) sel = bb; else { cum += c0; if (cum + c1 >= need) sel = bb - 1; else { cum += c1; if (cum + c2 >= need) sel = bb - 2; else { cum += c2; sel = bb - 3; } } }
                    misc[0] = prefix | ((unsigned)sel << shift); misc[1] = need - cum; }
            }
            __syncthreads();
            prefix = misc[0]; need = misc[1];
            __syncthreads();
        }
        const int i0 = tid * 17, i1 = (i0 + 17 < NTOK) ? i0 + 17 : NTOK;
        unsigned cg_ = 0u, ce = 0u;
        for (int i = i0; i < i1; ++i) { const unsigned k = keys[i]; cg_ += (k > prefix) ? 1u : 0u; ce += (k == prefix) ? 1u : 0u; }
        unsigned sg = cg_, se = ce;
#pragma unroll
        for (int o = 1; o < 64; o <<= 1) { const unsigned tg = __shfl_up(sg, o), te = __shfl_up(se, o); if (lane >= o) { sg += tg; se += te; } }
        if (lane == 63) { wtot[w] = sg; wtot[8 + w] = se; }
        __syncthreads();
        unsigned og = 0u, oe = 0u;
        for (int j = 0; j < w; ++j) { og += wtot[j]; oe += wtot[8 + j]; }
        unsigned gb = og + sg - cg_, eb = oe + se - ce;
        for (int i = i0; i < i1; ++i) { const unsigned k = keys[i]; int slot = -1;
            if (k > prefix) { slot = (int)(gb + (eb < need ? eb : need)); ++gb; }
            else if (k == prefix) { if (eb < need) slot = (int)(gb + eb); ++eb; }
            SLOT[((size_t)b * NTOK + i) * NE + e] = slot;
            if (slot >= 0) { IDX[(size_t)u * CAP + slot] = i; GV[(size_t)u * CAP + slot] = __builtin_bit_cast(float, k);
                const int j = b * CAP + slot; if (j < 4096) ROWOFF[e * 4096 + j] = (unsigned)(b * PP + PADF + i) * (unsigned)D; } }
    }
}

constexpr size_t WS_HIDT = WS_UN;
constexpr int XT_PITCH = D + 16, HT_PITCH = DFF + 16;
__device__ __forceinline__ void ffn_thin_up(Ctx& F) {
    const unsigned char* U2 = F.ws + WS_ACT1; const int* IDX = (const int*)(F.ws + WS_IDX);
    const unsigned char* WgT = F.ws + WS_WEXP; const unsigned char* WuT = F.ws + WS_WEXP + WEXP_ONE; unsigned char* HIDT = F.ws + WS_HIDT;
    LAS unsigned char* XT = F.lds;
    const int w = F.wave;
    for (int it = F.vcu; it < NE * 22; it += F.G) {
        int tid = F.tid; asm volatile("" : "+v"(tid));
        const int lane = tid & 63, fr = lane & 15, fq = lane >> 4;
        const int e = it / 22, ft = it % 22;
        __syncthreads();
        if (tid < 8 * 64) { const int r = tid >> 6, ch = tid & 63; const int j = 4096 + r, b = j / CAP, slot = j - b * CAP; const int n = IDX[(b * NE + e) * CAP + slot];
            *(LAS u32x4*)(XT + r * XT_PITCH + ch * 16) = *(const u32x4*)(U2 + ((size_t)b * PP + PADF + n) * D + ch * 16); }
        __syncthreads();
        const int f = ft * 128 + w * 16 + fr;
        const unsigned char* wg = WgT + ((size_t)e * DFF + f) * D + 8 * fq; const unsigned char* wu = WuT + ((size_t)e * DFF + f) * D + 8 * fq;
        f32x4 ag = (f32x4){0.f, 0.f, 0.f, 0.f}, au = ag;
#pragma unroll 1
        for (int k8 = 0; k8 < 32; k8 += 16) {
            long bg[16], bu[16];
#pragma unroll
            for (int j = 0; j < 16; ++j) { bg[j] = *(const long*)(wg + (k8 + j) * 32); bu[j] = *(const long*)(wu + (k8 + j) * 32); }
#pragma unroll
            for (int j = 0; j < 16; ++j) { long a = *(const LAS long*)(XT + (fr & 7) * XT_PITCH + (k8 + j) * 32 + 8 * fq); if (fr >= 8) a = 0;
                ag = __builtin_amdgcn_mfma_f32_16x16x32_fp8_fp8(a, bg[j], ag, 0, 0, 0); au = __builtin_amdgcn_mfma_f32_16x16x32_fp8_fp8(a, bu[j], au, 0, 0, 0); }
        }
        if (fq < 2) {
            float hv[4];
#pragma unroll
            for (int rg = 0; rg < 4; ++rg) hv[rg] = fminf(fmaxf(siluf_(ag[rg] * (1.0f / WPRE_UP)) * (au[rg] * (1.0f / WPRE_UP)), -448.0f), 448.0f);
            const unsigned pk = pk4_fp8(hv[0], hv[1], hv[2], hv[3]);
#pragma unroll
            for (int rg = 0; rg < 4; ++rg) HIDT[((size_t)e * 8 + 4 * fq + rg) * DFF + f] = (unsigned char)(pk >> (8 * rg)); }
    }
}
__device__ __forceinline__ void ffn_thin_down(Ctx& F) {
    const unsigned char* WdT = F.ws + WS_WD8; const unsigned char* HIDT = F.ws + WS_HIDT; bf16* YE = (bf16*)(F.ws + WS_YE);
    LAS unsigned char* HT = F.lds;
    const int w = F.wave;
    for (int it = F.vcu; it < NE * 8; it += F.G) {
        int tid = F.tid; asm volatile("" : "+v"(tid));
        const int lane = tid & 63, fr = lane & 15, fq = lane >> 4;
        const int e = it >> 3, dt = it & 7;
        __syncthreads();
        for (int i = tid; i < 8 * 176; i += 512) { const int r = i / 176, ch = i - r * 176; *(LAS u32x4*)(HT + r * HT_PITCH + ch * 16) = *(const u32x4*)(HIDT + ((size_t)e * 8 + r) * DFF + ch * 16); }
        __syncthreads();
        const int d = dt * 128 + w * 16 + fr;
        const unsigned char* wd = WdT + ((size_t)e * D + d) * DFF + 8 * fq;
        f32x4 ay = (f32x4){0.f, 0.f, 0.f, 0.f};
#pragma unroll 1
        for (int k8 = 0; k8 < 88; k8 += 22) {
            long bd[22];
#pragma unroll
            for (int j = 0; j < 22; ++j) bd[j] = *(const long*)(wd + (k8 + j) * 32);
#pragma unroll
            for (int j = 0; j < 22; ++j) { long a = *(const LAS long*)(HT + (fr & 7) * HT_PITCH + (k8 + j) * 32 + 8 * fq); if (fr >= 8) a = 0;
                ay = __builtin_amdgcn_mfma_f32_16x16x32_fp8_fp8(a, bd[j], ay, 0, 0, 0); }
        }
        if (fq < 2) {
#pragma unroll
            for (int rg = 0; rg < 4; ++rg) YE[((size_t)e * EROWSP + 4096 + 4 * fq + rg) * D + d] = (bf16)f2bf(ay[rg] * (1.0f / WPRE_DN)); }
    }
}

__device__ __forceinline__ void phase_final(Ctx& F) {
    const int* SLOT = (const int*)(F.ws + WS_SLOT); const float* GV = (const float*)(F.ws + WS_GV); const bf16* YE = (const bf16*)(F.ws + WS_YE);
    const int gw = F.vcu * 8 + F.wave, NGW = F.G * 8, lane = F.lane;
    f32x4 nv[4]; int nslot = -1;
    const bf16* DELTA = (const bf16*)(F.ws + WS_DELTA);
    if (gw < NB * SEQ) { row_load_h1(F.x + (size_t)gw * D, DELTA + (size_t)gw * D, lane, nv); const int b0 = gw / SEQ, n0_ = gw - b0 * SEQ + NMETA; nslot = (lane < 16) ? SLOT[((size_t)b0 * NTOK + n0_) * NE + lane] : -1; }
    for (int t = gw; t < NB * SEQ; t += NGW) {
        const int b = t / SEQ;
        float* row = F.out + (size_t)t * D;
        f32x4 v[4];
#pragma unroll
        for (int jj = 0; jj < 4; ++jj) v[jj] = nv[jj];
        const int myslot = nslot;
        { const int t2 = t + NGW; if (t2 < NB * SEQ) { row_load_h1(F.x + (size_t)t2 * D, DELTA + (size_t)t2 * D, lane, nv); const int b2 = t2 / SEQ, n2 = t2 - b2 * SEQ + NMETA; nslot = (lane < 16) ? SLOT[((size_t)b2 * NTOK + n2) * NE + lane] : -1; } }
        unsigned em = (unsigned)(__ballot(myslot >= 0) & 0xffffull);
        while (em) {
            const int ea = __builtin_ctz(em); em &= em - 1u; const bool two = em != 0u; const int eb = two ? __builtin_ctz(em) : ea; if (two) em &= em - 1u;
            const int sa = __shfl(myslot, ea), sb = __shfl(myslot, eb);
            const float ga = GV[((size_t)b * NE + ea) * CAP + sa], gb = two ? GV[((size_t)b * NE + eb) * CAP + sb] : 0.0f;
            const bf16* ya = YE + ((size_t)ea * EROWSP + (size_t)b * CAP + sa) * D; const bf16* yb = YE + ((size_t)eb * EROWSP + (size_t)b * CAP + sb) * D;
            u32x2 wa[4], wb[4];
#pragma unroll
            for (int jj = 0; jj < 4; ++jj) { wa[jj] = *(const u32x2*)(ya + jj * 256 + lane * 4); wb[jj] = *(const u32x2*)(yb + jj * 256 + lane * 4); }
#pragma unroll
            for (int jj = 0; jj < 4; ++jj) {
                v[jj].x += ga * bflo(wa[jj].x) + gb * bflo(wb[jj].x); v[jj].y += ga * bfhi(wa[jj].x) + gb * bfhi(wb[jj].x);
                v[jj].z += ga * bflo(wa[jj].y) + gb * bflo(wb[jj].y); v[jj].w += ga * bfhi(wa[jj].y) + gb * bfhi(wb[jj].y); }
        }
        float ss = 0.f;
#pragma unroll
        for (int jj = 0; jj < 4; ++jj) ss += v[jj].x * v[jj].x + v[jj].y * v[jj].y + v[jj].z * v[jj].z + v[jj].w * v[jj].w;
        const float rstd = rsqrtf(wave_sum(ss) * (1.0f / D) + EPS);
#pragma unroll
        for (int jj = 0; jj < 4; ++jj) { const f32x4 gv = *(const f32x4*)(F.fin_g + jj * 256 + lane * 4); *(f32x4*)(row + jj * 256 + lane * 4) = v[jj] * rstd * gv; }
    }
}

constexpr int N_PHASES = 12;
struct Args { const float* in[17]; float* out; unsigned char* ws; };
#define XB_TMO      128
#define XB_XCNT(j)  (256  + 64 * (j))
#define XB_XSUB(j)  (1280 + 64 * (j))
#define XB_XGEN(j)  (2304 + 64 * (j))
#define XB_TOP      3328
#define XB_TOPGEN   3392
#define XCD_BAR_WORDS 3456
#define XB_SPIN_CAP (1u << 22)
__device__ __forceinline__ unsigned xb_ld(unsigned* p)              { return __hip_atomic_load(p, __ATOMIC_RELAXED, __HIP_MEMORY_SCOPE_AGENT); }
__device__ __forceinline__ unsigned xb_add(unsigned* p, unsigned v) { return __hip_atomic_fetch_add(p, v, __ATOMIC_RELAXED, __HIP_MEMORY_SCOPE_AGENT); }
__device__ __forceinline__ unsigned xb_xcc_id() { return (unsigned)__builtin_amdgcn_s_getreg((3 << 11) | 20) & 0xFu; }
#define XB_SPIN(cond, bar) do { unsigned _sp = 0; while (cond) { __builtin_amdgcn_s_sleep(1); \
    if ((++_sp & 255u) == 0u) { if (xb_ld(&(bar)[XB_TMO])) break; if (_sp > XB_SPIN_CAP) { atomicAdd(&(bar)[XB_TMO], 1u); break; } } } } while (0)
struct XcdBarrier { unsigned* bar; unsigned x; volatile LAS unsigned* st; };
__device__ __forceinline__ XcdBarrier xcd_barrier_post(unsigned* bar, volatile LAS unsigned* st) {
    XcdBarrier b; b.bar = bar; b.x = xb_xcc_id(); b.st = st;
    if (threadIdx.x == 0) (void)xb_add(&bar[XB_XCNT(b.x)], 1u);
    return b;
}
__device__ __forceinline__ void xcd_barrier_complete(unsigned* bar, unsigned x, unsigned& nloc, unsigned& nx) {
    const unsigned G = gridDim.x * gridDim.y * gridDim.z;
    unsigned sum, cnt, mine, sp = 0u;
    for (;;) {
        sum = 0u; cnt = 0u; mine = 0u;
#pragma unroll
        for (unsigned j = 0; j < 16; ++j) { const unsigned c = xb_ld(&bar[XB_XCNT(j)]); sum += c; cnt += (c > 0u) ? 1u : 0u; mine = (j == x) ? c : mine; }
        if (sum == G) break;
        __builtin_amdgcn_s_sleep(1);
        if ((++sp & 255u) == 0u) { if (xb_ld(&bar[XB_TMO])) break; if (sp > XB_SPIN_CAP) { atomicAdd(&bar[XB_TMO], 1u); break; } }
    }
    nloc = mine > 0u ? mine : 1u; nx = cnt > 0u ? cnt : 1u;
}
__device__ __forceinline__ void xcd_barrier(const XcdBarrier& b) {
    asm volatile("s_waitcnt vmcnt(0)" ::: "memory");
    __syncthreads();
    if (threadIdx.x == 0) {
        unsigned* bar = b.bar;
        __builtin_amdgcn_s_waitcnt(0);
        unsigned nloc = b.st[0], nx = b.st[1];
        if (nloc == 0u) { xcd_barrier_complete(bar, b.x, nloc, nx); b.st[0] = nloc; b.st[1] = nx; }
        const unsigned old = xb_add(&bar[XB_XSUB(b.x)], 1u);
        const unsigned gen = old / nloc;
        if (old + 1u == (gen + 1u) * nloc) {
            __builtin_amdgcn_fence(__ATOMIC_RELEASE, "agent");
            asm volatile("s_waitcnt vmcnt(0)" ::: "memory");
            const unsigned og = xb_add(&bar[XB_TOP], 1u);
            const unsigned tg = og / nx;
            if (og + 1u == (tg + 1u) * nx) xb_add(&bar[XB_TOPGEN], 1u);
            else XB_SPIN(xb_ld(&bar[XB_TOPGEN]) == tg, bar);
            __builtin_amdgcn_fence(__ATOMIC_ACQUIRE, "agent");
            xb_add(&bar[XB_XGEN(b.x)], 1u);
            asm volatile("s_waitcnt vmcnt(0)" ::: "memory");
        } else {
            XB_SPIN(xb_ld(&bar[XB_XGEN(b.x)]) == gen, bar);
            __builtin_amdgcn_fence(__ATOMIC_ACQUIRE, "agent");
            asm volatile("s_waitcnt vmcnt(0)" ::: "memory");
        }
    }
    __syncthreads();
}
constexpr int MISC_OFF = LDS_BYTES - 16;

typedef const __attribute__((address_space(4))) Args* ArgsP;
__device__ __forceinline__ void make_ctx(Ctx& F, unsigned char* lds_raw) {
    ArgsP A = (ArgsP)__builtin_amdgcn_kernarg_segment_ptr(); asm volatile("" : "+s"(A));
    F.lds = (LAS unsigned char*)lds_raw;
    { int t = threadIdx.x; asm volatile("" : "+v"(t)); F.tid = t; } F.lane = F.tid & 63; F.wave = __builtin_amdgcn_readfirstlane(F.tid >> 6);
    F.G = gridDim.x; { const int bx = blockIdx.x; F.vcu = (F.G % 8 == 0) ? (bx % 8) * (F.G / 8) + bx / 8 : bx; }
    F.x = A->in[0]; F.meta = A->in[1]; F.mix_g = A->in[2]; F.w_in = A->in[3]; F.b_gates = A->in[4]; F.conv_w = A->in[5]; F.conv_b = A->in[6];
    F.ret_logit = A->in[7]; F.ret_gn = A->in[8]; F.ml_gn = A->in[9]; F.w_out = A->in[10]; F.ffn_g = A->in[11]; F.w_router = A->in[12];
    F.w_gate = A->in[13]; F.w_up = A->in[14]; F.w_down = A->in[15]; F.fin_g = A->in[16];
    F.out = A->out; F.ws = A->ws;
}
template <int LO, int HI> __global__ void __launch_bounds__(512, 2) mk_fwd(Args args) {
    extern __shared__ __attribute__((aligned(16))) unsigned char lds_raw[];
#if MK_SPLIT
#define GRID_BAR() do {} while (0)
#elif MK_BARRIER == 0
    cg::grid_group grid = cg::this_grid();
#define GRID_BAR() grid.sync()
#else
    XcdBarrier xbar;
    {   volatile LAS unsigned* st = (volatile LAS unsigned*)((LAS unsigned char*)lds_raw + MISC_OFF);
        if (threadIdx.x < 4) st[threadIdx.x] = 0u;
        __syncthreads();
        ArgsP A0 = (ArgsP)__builtin_amdgcn_kernarg_segment_ptr();
        xbar = xcd_barrier_post((unsigned*)A0->ws, st); }
#define GRID_BAR() xcd_barrier(xbar)
#endif
#define IN(k) (LO <= (k) && (k) < HI)
#define SEAM(k) do { if (IN(k) && IN((k) + 1)) GRID_BAR(); } while (0)
#define CTX() Ctx F; make_ctx(F, lds_raw)

    if (IN(0)) { CTX(); phase_prep(F); } SEAM(0);
    if (IN(1)) {
        CTX();
        pg8::DenseOrder S{(const bf16*)(F.ws + WS_ACT1), (const bf16*)(F.ws + WS_WINT), D, D, NB * SEQ / 256, PC / 256, (NB * SEQ / 256) * (PC / 256), F.G, (int)blockIdx.x};
        pg8::EpiProj E{(bf16*)(F.ws + WS_PROJ), (const f32x2*)(F.ws + WS_ROPE)};
        pg8::gemm_phase(F.lds, D, S, E);
        proj_meta(F);
    } SEAM(1);
    if (IN(2)) { CTX(); phase_rope_conv(F); } SEAM(2);
    if (IN(3)) { CTX(); phase_seg_summary(F); } SEAM(3);
    if (IN(4)) { CTX(); phase_seq(F); } SEAM(4);
    if (IN(5)) { CTX(); phase_combine(F); } SEAM(5);
    if (IN(6)) {
        CTX();
        pg8::DenseOrder S{(const bf16*)(F.ws + WS_ACT2), (const bf16*)(F.ws + WS_WOUTT), D, D, NB * SEQ / 256, D / 256, (NB * SEQ / 256) * (D / 256), F.G, (int)blockIdx.x};
        pg8::EpiDelta E{(bf16*)(F.ws + WS_DELTA)};
        pg8::gemm_phase(F.lds, D, S, E);
        out_meta(F);
    } SEAM(6);
    if (IN(7)) { CTX(); phase_router(F); } SEAM(7);
    if (IN(8)) { CTX(); phase_topk(F); } SEAM(8);
    if (IN(9)) {
        CTX();
        pg8::FfnUpOrder S{F.ws + WS_ACT1, (const unsigned*)(F.ws + WS_SCAL), F.ws + WS_WEXP, F.ws + WS_WEXP + WEXP_ONE, D / 2, D / 2, NE * 22 * 16, F.G, F.vcu};
        pg8::EpiSwiglu E{F.ws + WS_HID};
        pg8::gemm_phase(F.lds, D / 2, S, E);
        ffn_thin_up(F);
    } SEAM(9);
    if (IN(10)) {
        CTX();
        pg8::FfnDownOrder S{F.ws + WS_HID, F.ws + WS_WD8, DFF / 2, DFF / 2, NE * 4 * 16, F.G, F.vcu};
        pg8::EpiStoreBf16 E{(bf16*)(F.ws + WS_YE), D, (size_t)EROWSP * D};
        pg8::gemm_phase(F.lds, DFF / 2, S, E);
        ffn_thin_down(F);
    } SEAM(10);
    if (IN(11)) { CTX(); phase_final(F); }
#undef IN
#undef SEAM
#undef CTX
}

template <int PH> static void launch_split(int grid, hipStream_t stream, const Args& a) {
    if constexpr (PH < N_PHASES) {
        static bool attr = false;
        if (!attr) { (void)hipFuncSetAttribute((const void*)mk_fwd<PH, PH + 1>, hipFuncAttributeMaxDynamicSharedMemorySize, LDS_BYTES); attr = true; }
        hipLaunchKernelGGL((mk_fwd<PH, PH + 1>), dim3(grid), dim3(512), LDS_BYTES, stream, a);
        if ((PROBE_MASK >> PH) & 1) hipLaunchKernelGGL((mk_fwd<PH, PH + 1>), dim3(grid), dim3(512), LDS_BYTES, stream, a);
        launch_split<PH + 1>(grid, stream, a);
    }
}
extern "C" void kernel_launch(void* const* d_in, const int* in_sizes, int n_in, void* d_out, int out_size, void* d_ws, size_t ws_size, hipStream_t stream) {
    static int grid = 0;
    if (grid == 0) {
        if (n_in != 17 || out_size != NB * SEQ * D || ws_size < WS_END) { fprintf(stderr, "kernel_launch: unexpected shapes (n_in %d out %d ws %zu need %zu)\n", n_in, out_size, ws_size, (size_t)WS_END); grid = -1; return; }
        int dev = 0, cus = 0;
        if (hipGetDevice(&dev) != hipSuccess || hipDeviceGetAttribute(&cus, hipDeviceAttributeMultiprocessorCount, dev) != hipSuccess) { grid = -1; return; }
#if !MK_SPLIT
        int per_cu = 0;
        if (hipFuncSetAttribute((const void*)mk_fwd<0, N_PHASES>, hipFuncAttributeMaxDynamicSharedMemorySize, LDS_BYTES) != hipSuccess) { fprintf(stderr, "kernel_launch: hipFuncSetAttribute failed\n"); grid = -1; return; }
        if (hipOccupancyMaxActiveBlocksPerMultiprocessor(&per_cu, (const void*)mk_fwd<0, N_PHASES>, 512, LDS_BYTES) != hipSuccess || per_cu < 1) { fprintf(stderr, "kernel_launch: occupancy query says %d\n", per_cu); }
#endif
        (void)hipGetLastError();
        grid = cus;
    }
    if (grid < 0) return;
    Args a{};
    for (int i = 0; i < 17; ++i) a.in[i] = (const float*)d_in[i];
    a.out = (float*)d_out; a.ws = (unsigned char*)d_ws;
#if MK_SPLIT
    launch_split<0>(grid, stream, a);
#else
#if MK_BARRIER == 0
    void* kargs[] = {&a};
    hipError_t e = hipLaunchCooperativeKernel((const void*)mk_fwd<0, N_PHASES>, dim3(grid), dim3(512), kargs, LDS_BYTES, stream);
    if (e != hipSuccess) fprintf(stderr, "cooperative launch failed: %s (grid %d)\n", hipGetErrorString(e), grid);
#else
    if (hipMemsetAsync(d_ws, 0, 16384, stream) != hipSuccess) { fprintf(stderr, "kernel_launch: memset of barrier words failed\n"); return; }
    hipLaunchKernelGGL((mk_fwd<0, N_PHASES>), dim3(grid), dim3(512), LDS_BYTES, stream, a);
#endif
#endif
}
```

```cpp
#include <hip/hip_runtime.h>
#include <hip/hip_cooperative_groups.h>
#include <cstdio>
#include <cstdint>
namespace cg = cooperative_groups;

#ifndef MK_SPLIT
#define MK_SPLIT 0
#endif
#ifndef PROBE_MASK
#define PROBE_MASK 0
#endif
#ifndef MK_BARRIER
#define MK_BARRIER 1
#endif

#define GAS __attribute__((address_space(1)))
#define LAS __attribute__((address_space(3)))
typedef unsigned short bf16;
typedef short bf16x8 __attribute__((ext_vector_type(8)));
typedef float f32x4 __attribute__((ext_vector_type(4)));
typedef float f32x2 __attribute__((ext_vector_type(2)));
typedef unsigned u32x4 __attribute__((ext_vector_type(4)));
typedef unsigned u32x2 __attribute__((ext_vector_type(2)));
typedef int i32x8 __attribute__((ext_vector_type(8)));
typedef int i32x4 __attribute__((ext_vector_type(4)));

constexpr int NB = 4, SEQ = 8192, D = 1024, NMETA = 16, CHK = 128, PADF = 112;
constexpr int NTOK = NMETA + SEQ;
constexpr int PP = NTOK + PADF;
constexpr int NCH = PP / CHK;
constexpr int R = NB * PP;
constexpr int PCOLS = 4112, PC = 4096;
constexpr int NE = 16, CAP = 1026, DFF = 2816, EROWS = NB * CAP, EROWSP = 4352;
constexpr int NH = 4;
constexpr float EPS = 1e-6f, NEGF = -1e30f;
constexpr int WSC_UP = 0x7A7A7A7A, WSC_DN = 0x79797979;
constexpr float WPRE_UP = 32.0f, WPRE_DN = 64.0f;

constexpr size_t MiB = 1u << 20;
constexpr size_t WS_ROPE = 1 * MiB, WS_GATES = 6 * MiB, WS_AFF = 9 * MiB, WS_IDX = 12 * MiB, WS_GV = 13 * MiB, WS_SLOT = 14 * MiB;
constexpr size_t WS_H1META = 17 * MiB, WS_UN = 18 * MiB, WS_SCAL = 21 * MiB, WS_WINT = 22 * MiB, WS_WOUTT = 30 * MiB;
constexpr size_t WS_ACT1 = 32 * MiB;
constexpr size_t WS_ACT2 = 97 * MiB;
constexpr size_t WS_PROJ = 162 * MiB;
constexpr size_t WS_STATE = 422 * MiB;
constexpr size_t WS_YE = 97 * MiB;
constexpr size_t WS_WEXP = 233 * MiB;
constexpr size_t WS_HID = 365 * MiB;
constexpr size_t WS_WD8 = 568 * MiB;
constexpr size_t WS_DELTA = 612 * MiB;
constexpr size_t WS_END = 684 * MiB;
constexpr size_t WEXP_ONE = (size_t)NE * DFF * D;
static_assert(WS_PROJ + (size_t)R * PC * 2 <= WS_STATE && WS_STATE + (size_t)64 * NCH * 16384 * 4 <= WS_END, "mixer map");
static_assert(WS_YE + (size_t)NE * EROWSP * D * 2 <= WS_WEXP && WS_WEXP + 2 * WEXP_ONE <= WS_HID && WS_WD8 + WEXP_ONE <= WS_DELTA && WS_DELTA + (size_t)NB * SEQ * D * 2 <= WS_END && WS_HID + (size_t)NE * 4096 * DFF <= WS_END, "ffn map");

constexpr int LDS_BYTES = 155648;
constexpr int TP = 136;
constexpr int T0_OFF = 0, T1_OFF = 34816, T2_OFF = 69632, T3_OFF = 104448, VEC_OFF = 139264;

__device__ __forceinline__ unsigned f2bf(float f) { unsigned u = __builtin_bit_cast(unsigned, f); return (u + 0x7fffu + ((u >> 16) & 1u)) >> 16; }
__device__ __forceinline__ unsigned pk2(float lo, float hi) { unsigned r; asm("v_cvt_pk_bf16_f32 %0, %1, %2" : "=v"(r) : "v"(lo), "v"(hi)); return r; }
__device__ __forceinline__ unsigned cvtpk(float lo, float hi) { unsigned r; asm("v_cvt_pk_bf16_f32 %0, %1, %2" : "=v"(r) : "v"(lo), "v"(hi)); return r; }
__device__ __forceinline__ unsigned pk4_fp8(float a, float b, float c, float d) { int p = __builtin_amdgcn_cvt_pk_fp8_f32(a, b, 0, false); p = __builtin_amdgcn_cvt_pk_fp8_f32(c, d, p, true); return (unsigned)p; }
__device__ __forceinline__ float bf2f(unsigned b) { return __builtin_bit_cast(float, b << 16); }
__device__ __forceinline__ float bflo(unsigned w) { return __builtin_bit_cast(float, w << 16); }
__device__ __forceinline__ float bfhi(unsigned w) { return __builtin_bit_cast(float, w & 0xffff0000u); }
template <bool MAXOP>
__device__ __forceinline__ float wave_scan_incl(float v) {
    const int idn = __builtin_bit_cast(int, MAXOP ? -3.0e38f : 0.0f);
#define DPP_STEP(ctrl, rmask) { const float t = __builtin_bit_cast(float, __builtin_amdgcn_update_dpp(idn, __builtin_bit_cast(int, v), ctrl, rmask, 0xF, false)); v = MAXOP ? fmaxf(v, t) : v + t; }
    DPP_STEP(0x111, 0xF) DPP_STEP(0x112, 0xF) DPP_STEP(0x114, 0xF) DPP_STEP(0x118, 0xF) DPP_STEP(0x142, 0xA) DPP_STEP(0x143, 0xC)
#undef DPP_STEP
    return v;
}
__device__ __forceinline__ float wave_sum(float v) { v = wave_scan_incl<false>(v); return __builtin_bit_cast(float, __builtin_amdgcn_readlane(__builtin_bit_cast(int, v), 63)); }
__device__ __forceinline__ float wave_max(float v) { v = wave_scan_incl<true>(v); return __builtin_bit_cast(float, __builtin_amdgcn_readlane(__builtin_bit_cast(int, v), 63)); }
__device__ __forceinline__ float sigmoidf_(float x) { return __builtin_amdgcn_rcpf(1.0f + __expf(-x)); }
__device__ __forceinline__ float siluf_(float x) { return x * __builtin_amdgcn_rcpf(1.0f + __expf(-x)); }
__device__ __forceinline__ float logsigmoidf_(float x) { return fminf(x, 0.0f) - log1pf(__expf(-fabsf(x))); }
#define LDS_WAIT() asm volatile("s_waitcnt lgkmcnt(0)" ::: "memory")

namespace pg8 {
constexpr int BM = 256, BK = 64, HALF = 128, HTB = HALF * BK * 2, STAGE_BYTES = 8 * HTB;
__device__ __forceinline__ int lds_byte(int r, int c) { const int st = (r >> 4) * 2 + (c >> 5), rr = r & 15, cc = c & 31, ob = rr * 64 + cc * 2; return st * 1024 + (ob ^ (((ob >> 9) & 1) << 5)); }
__device__ __forceinline__ void stage_rc(int b, int& Rr, int& C) { const int st = b / 1024, sb = b % 1024, swz = sb ^ (((sb >> 9) & 1) << 5); Rr = (st >> 1) * 16 + swz / 64; C = (st & 1) * 32 + (swz % 64) / 2; }
__device__ __forceinline__ int perm32(int rho) { const int n = rho >> 4, i = rho & 15; return 8 * (i >> 2) + 4 * n + (i & 3); }
__device__ __forceinline__ unsigned cvt_pk_bf16(float lo, float hi) { unsigned r; asm volatile("v_cvt_pk_bf16_f32 %0, %1, %2" : "=v"(r) : "v"(lo), "v"(hi)); return r; }

struct Unit { int pm, pn, e, row0; };
struct UAddr { const char* a0; const char* a1; const char* b0; const char* b1; };

template <class Epi, class Sched>
__device__ __forceinline__ void gemm_phase(LAS unsigned char* lds, const int K, const Sched& S, const Epi& E) {
    int tid_ = threadIdx.x; asm volatile("" : "+v"(tid_));
    const int tid = tid_, wid = __builtin_amdgcn_readfirstlane(tid >> 6), lane = tid & 63, wr = wid >> 2, wc = wid & 3, fr = lane & 15, fq = lane >> 4;
    const int nt = K / BK;
    unsigned voffB[2], voffA0 = 0, voffA1 = 0, colb = 0;
    int sR0, sC0;
    {   int sR1, sC1; stage_rc(tid * 16, sR0, sC0); stage_rc(tid * 16 + 8192, sR1, sC1);
        const int Rb0 = Epi::PERM ? ((sR0 & ~31) + perm32(sR0 & 31)) : sR0, Rb1 = Epi::PERM ? ((sR1 & ~31) + perm32(sR1 & 31)) : sR1;
        voffB[0] = (unsigned)(Rb0 * S.ldb + sC0) * 2u; voffB[1] = (unsigned)(Rb1 * S.ldb + sC1) * 2u;
        if constexpr (!Sched::GATHER) { voffA0 = (unsigned)(sR0 * S.lda + sC0) * 2u; voffA1 = (unsigned)(sR1 * S.lda + sC1) * 2u; } else colb = (unsigned)sC0 * 2u; }
    LAS unsigned* const tab = (LAS unsigned*)(lds + STAGE_BYTES);
    const LAS unsigned* const tabp = tab + sR0;
    const size_t kstep = (size_t)(BK * 2);
    const unsigned ldsw = (unsigned)wid * 1024u;
    constexpr bool FP8 = Sched::FP8;
    const int aoff = FP8 ? lds_byte(wr * 64 + fr, fq * 16) : lds_byte(wr * 64 + fr, fq * 8), boff = FP8 ? lds_byte(wc * 32 + fr, fq * 16) : lds_byte(wc * 32 + fr, fq * 8);
    int wsc_v = S.wscale, one_v = 0x7F7F7F7F; asm volatile("" : "+v"(wsc_v), "+v"(one_v));
#define PG8_SA(b, h) (((b) * 2 + (h)) * HTB)
#define PG8_SB(b, h) ((4 + (b) * 2 + (h)) * HTB)
#define PG8_STAGE(bufoff, gbase, v0, v1) do { \
        __builtin_amdgcn_global_load_lds((const unsigned*)((const char*)(gbase) + (v0)), (LAS unsigned*)(lds + (bufoff) + ldsw), 16, 0, 0); \
        __builtin_amdgcn_global_load_lds((const unsigned*)((const char*)(gbase) + (v1)), (LAS unsigned*)(lds + (bufoff) + ldsw + 8192), 16, 0, 0); } while (0)
#define PG8_STAGE_A(bufoff, gbase, slot, h) do { if constexpr (Sched::GATHER) { const unsigned _r0 = tabp[(slot) * 256 + (h) * 128] + colb, _r1 = tabp[(slot) * 256 + (h) * 128 + 64] + colb; PG8_STAGE(bufoff, gbase, _r0, _r1); } \
        else PG8_STAGE(bufoff, gbase, voffA0, voffA1); } while (0)
#define PG8_LD32(p) __builtin_shufflevector(*(const LAS i32x4*)(p), *(const LAS i32x4*)((p) + 16), 0, 1, 2, 3, 4, 5, 6, 7)
#define PG8_LDA(dst, b, h) do { if constexpr (FP8) { _Pragma("unroll") for (int m = 0; m < 4; ++m) dst##8[m] = PG8_LD32(lds + PG8_SA(b, h) + aoff + m * 2048); } \
        else { _Pragma("unroll") for (int m = 0; m < 4; ++m) _Pragma("unroll") for (int k = 0; k < 2; ++k) dst[m][k] = *(const LAS bf16x8*)(lds + PG8_SA(b, h) + aoff + m * 2048 + k * 1024); } } while (0)
#define PG8_LDB(dst, b, h) do { if constexpr (FP8) { _Pragma("unroll") for (int n = 0; n < 2; ++n) dst##8[n] = PG8_LD32(lds + PG8_SB(b, h) + boff + n * 2048); } \
        else { _Pragma("unroll") for (int n = 0; n < 2; ++n) _Pragma("unroll") for (int k = 0; k < 2; ++k) dst[n][k] = *(const LAS bf16x8*)(lds + PG8_SB(b, h) + boff + n * 2048 + k * 1024); } } while (0)
#define PG8_MMA_FULL(ai, bj, At, Bt) do { __builtin_amdgcn_s_setprio(1); \
        if constexpr (FP8) { _Pragma("unroll") for (int m = 0; m < 4; ++m) _Pragma("unroll") for (int n = 0; n < 2; ++n) \
            asm volatile("v_mfma_scale_f32_16x16x128_f8f6f4 %0, %1, %2, %0, %3, %4 op_sel_hi:[0,0,0]" : "+v"(acc[ai][bj][m][n]) : "v"(Bt##8[n]), "v"(At##8[m]), "v"(wsc_v), "v"(one_v)); } \
        else { _Pragma("unroll") for (int m = 0; m < 4; ++m) _Pragma("unroll") for (int n = 0; n < 2; ++n) _Pragma("unroll") for (int k = 0; k < 2; ++k) \
            acc[ai][bj][m][n] = __builtin_amdgcn_mfma_f32_16x16x32_bf16(Bt[n][k], At[m][k], acc[ai][bj][m][n], 0, 0, 0); } \
        __builtin_amdgcn_s_setprio(0); } while (0)
#define PG8_MMA_THIN(ai, bj, At, Bt) do { if (!FP8 && (ai) == 0 && wr == 0) { _Pragma("unroll") for (int n = 0; n < 2; ++n) _Pragma("unroll") for (int k = 0; k < 2; ++k) \
        acc[0][bj][0][n] = __builtin_amdgcn_mfma_f32_16x16x32_bf16(Bt[n][k], At[0][k], acc[0][bj][0][n], 0, 0, 0); } } while (0)
#define PG8_WAIT_V(n) asm volatile("s_waitcnt vmcnt(" #n ")" ::: "memory")
#define PG8_WAIT_L(n) asm volatile("s_waitcnt lgkmcnt(" #n ")" ::: "memory")
#define PG8_BAR __builtin_amdgcn_s_barrier()
#define PG8_SCHED __builtin_amdgcn_sched_barrier(0)
    Unit cur, nxt; int ui = 0;
    if (!S.next(0, cur)) return;
    f32x4 acc[2][2][4][2];
#pragma unroll
    for (int a = 0; a < 2; ++a)
#pragma unroll
        for (int b = 0; b < 2; ++b)
#pragma unroll
            for (int m = 0; m < 4; ++m)
#pragma unroll
                for (int n = 0; n < 2; ++n) acc[a][b][m][n] = (f32x4){0.f, 0.f, 0.f, 0.f};
    bf16x8 At[4][2], B0[2][2], B1[2][2]; i32x8 At8[4], B08[2], B18[2];
    UAddr cu, nx;
    S.addr(cur, cu);
    if constexpr (Sched::GATHER) {
        if (tid < 256) __builtin_amdgcn_global_load_lds((const unsigned*)(S.rowoff_ptr(cur) + tid), (LAS unsigned*)(tab + wid * 64), 4, 0, 0);
        asm volatile("s_waitcnt vmcnt(0)" ::: "memory"); __syncthreads(); }
    PG8_STAGE(PG8_SB(0, 0), cu.b0, voffB[0], voffB[1]); PG8_STAGE(PG8_SB(0, 1), cu.b1, voffB[0], voffB[1]); PG8_STAGE_A(PG8_SA(0, 0), cu.a0, 0, 0); PG8_STAGE_A(PG8_SA(0, 1), cu.a1, 0, 1);
    if (wr == 1) PG8_BAR;
    PG8_WAIT_V(2); PG8_BAR;
    PG8_STAGE(PG8_SB(1, 0), cu.b0 + kstep, voffB[0], voffB[1]); PG8_STAGE_A(PG8_SA(1, 0), cu.a0 + kstep, 0, 0); PG8_STAGE(PG8_SB(1, 1), cu.b1 + kstep, voffB[0], voffB[1]);
    PG8_WAIT_V(6); PG8_BAR;
    for (;;) {
        const bool has_next = S.next(ui + 1, nxt);
        const bool thin = Sched::HAS_THIN && S.thin(cur);
        const int cs = ui & 1, ns = has_next ? (cs ^ 1) : cs;
        if (has_next) { S.addr(nxt, nx); if constexpr (Sched::GATHER) { if (tid < 256) __builtin_amdgcn_global_load_lds((const unsigned*)(S.rowoff_ptr(nxt) + tid), (LAS unsigned*)(tab + (cs ^ 1) * 256 + wid * 64), 4, 0, 0); } } else nx = cu;
#define PG8_KLOOP(MMA) \
        for (int t = 0; t < nt; t += 2) { \
            const bool last = (t == nt - 2); \
            const char* a1h1 = cu.a1 + (size_t)(t + 1) * kstep; \
            const char* a2h0 = last ? nx.a0 : cu.a0 + (size_t)(t + 2) * kstep; const char* a2h1 = last ? nx.a1 : cu.a1 + (size_t)(t + 2) * kstep; \
            const char* b2h0 = last ? nx.b0 : cu.b0 + (size_t)(t + 2) * kstep; const char* b2h1 = last ? nx.b1 : cu.b1 + (size_t)(t + 2) * kstep; \
            const int s2 = last ? ns : cs; \
              \
            PG8_LDB(B0, 0, 0); PG8_LDB(B1, 0, 1); PG8_SCHED; PG8_LDA(At, 0, 0); PG8_STAGE_A(PG8_SA(1, 1), a1h1, cs, 1); \
            PG8_WAIT_V(8); PG8_WAIT_L(0); PG8_BAR; MMA(0, 0, At, B0); MMA(0, 1, At, B1); PG8_BAR; PG8_SCHED; \
              \
            PG8_LDA(At, 0, 1); PG8_STAGE(PG8_SB(0, 0), b2h0, voffB[0], voffB[1]); PG8_STAGE(PG8_SB(0, 1), b2h1, voffB[0], voffB[1]); PG8_STAGE_A(PG8_SA(0, 0), a2h0, s2, 0); \
            PG8_WAIT_V(8); PG8_WAIT_L(0); PG8_BAR; MMA(1, 0, At, B0); MMA(1, 1, At, B1); PG8_BAR; PG8_SCHED; \
              \
            PG8_LDB(B0, 1, 0); PG8_LDB(B1, 1, 1); PG8_SCHED; PG8_LDA(At, 1, 0); PG8_STAGE_A(PG8_SA(0, 1), a2h1, s2, 1); \
            PG8_WAIT_V(8); PG8_WAIT_L(0); PG8_BAR; MMA(0, 0, At, B0); MMA(0, 1, At, B1); PG8_BAR; PG8_SCHED; \
              \
            PG8_LDA(At, 1, 1); PG8_STAGE(PG8_SB(1, 0), b2h0 + kstep, voffB[0], voffB[1]); PG8_STAGE(PG8_SB(1, 1), b2h1 + kstep, voffB[0], voffB[1]); PG8_STAGE_A(PG8_SA(1, 0), a2h0 + kstep, s2, 0); \
            PG8_WAIT_V(8); PG8_WAIT_L(0); PG8_BAR; MMA(1, 0, At, B0); MMA(1, 1, At, B1); PG8_BAR; PG8_SCHED; \
        }
        if (Sched::HAS_THIN && thin) { PG8_KLOOP(PG8_MMA_THIN) } else { PG8_KLOOP(PG8_MMA_FULL) }
#undef PG8_KLOOP
        if (wr == 0) PG8_BAR;
        if constexpr (FP8) asm volatile("s_nop 15\n\ts_nop 15" ::: "memory");
        { int fr_e = fr, fq_e = fq; asm volatile("" : "+v"(fr_e), "+v"(fq_e));
          E(acc, cur, wr, wc, fr_e, fq_e); }
        if (!has_next) break;
#pragma unroll
        for (int a = 0; a < 2; ++a)
#pragma unroll
            for (int b = 0; b < 2; ++b)
#pragma unroll
                for (int m = 0; m < 4; ++m)
#pragma unroll
                    for (int n = 0; n < 2; ++n) acc[a][b][m][n] = (f32x4){0.f, 0.f, 0.f, 0.f};
        cur = nxt; cu = nx; ++ui;
        if (wr == 1) PG8_BAR;
    }
    PG8_WAIT_V(0);
    PG8_BAR;
#undef PG8_SA
#undef PG8_SB
#undef PG8_STAGE
#undef PG8_STAGE_A
#undef PG8_LDA
#undef PG8_LDB
#undef PG8_MMA_THIN
#undef PG8_LD32
#undef PG8_MMA_FULL
#undef PG8_WAIT_V
#undef PG8_WAIT_L
#undef PG8_BAR
#undef PG8_SCHED
}

struct DenseOrder {
    static constexpr bool GATHER = false, HAS_THIN = false, FP8 = false; static constexpr int wscale = 0;
    __device__ __forceinline__ bool thin(const Unit&) const { return false; }
    const bf16* A; const bf16* Bt; int lda, ldb; int nM, nN, nwg, G, c;
    __device__ __forceinline__ const unsigned* rowoff_ptr(const Unit&) const { return nullptr; }
    __device__ __forceinline__ bool next(int i, Unit& u) const {
        const long L = (long)i * G + c; if (L >= nwg) return false;
        int wgid = (int)L; { const int q = nwg / 8, r = nwg % 8, xcd = wgid % 8, off = wgid / 8; wgid = (xcd < r ? xcd * (q + 1) : r * (q + 1) + (xcd - r) * q) + off; }
        const int nig = 8 * nN, gid = wgid / nig, fm = gid * 8, gsz = (nM - fm) < 8 ? (nM - fm) : 8;
        u.pm = fm + ((wgid % nig) % gsz); u.pn = (wgid % nig) / gsz; u.e = 0; u.row0 = (u.pm >> 5) * PP + CHK + 256 * (u.pm & 31); return true;
    }
    __device__ __forceinline__ void addr(const Unit& u, UAddr& g) const {
        g.a0 = (const char*)(A + (size_t)u.row0 * lda); g.a1 = g.a0 + (size_t)128 * lda * 2;
        g.b0 = (const char*)(Bt + (size_t)u.pn * 256 * ldb); g.b1 = g.b0 + (size_t)128 * ldb * 2;
    }
};
struct FfnUpOrder {
    static constexpr bool GATHER = true, HAS_THIN = false, FP8 = true; static constexpr int wscale = WSC_UP;
    __device__ __forceinline__ bool thin(const Unit&) const { return false; }
    const unsigned char* U2; const unsigned* ROWOFF; const unsigned char* WgT; const unsigned char* WuT; int lda, ldb; int nunits, G, c;
    __device__ __forceinline__ bool next(int i, Unit& u) const {
        const int L = i * G + c; if (L >= nunits) return false;
        const int e = L / (22 * 16), rem = L - e * (22 * 16); u.e = e;
        if (rem < 320) { const int blk = rem >> 5, idx = rem & 31, h = blk / 5, pq = blk - 5 * h; u.pn = 4 * pq + (idx >> 3); u.pm = 8 * h + (idx & 7); }
        else { const int r = rem - 320, h = r >> 4, idx = r & 15; u.pn = 20 + (idx >> 3); u.pm = 8 * h + (idx & 7); }
        u.row0 = u.pm * 256; return true;
    }
    __device__ __forceinline__ const unsigned* rowoff_ptr(const Unit& u) const { return ROWOFF + u.e * 4096 + u.pm * 256; }
    __device__ __forceinline__ void addr(const Unit& u, UAddr& g) const {
        g.a0 = (const char*)U2; g.a1 = g.a0;
        g.b0 = (const char*)(WgT + ((size_t)u.e * DFF + (size_t)u.pn * 128) * D); g.b1 = (const char*)(WuT + ((size_t)u.e * DFF + (size_t)u.pn * 128) * D);
    }
};
struct FfnDownOrder {
    static constexpr bool GATHER = false, HAS_THIN = false, FP8 = true; static constexpr int wscale = WSC_DN;
    __device__ __forceinline__ bool thin(const Unit&) const { return false; }
    const unsigned char* HID; const unsigned char* WdT; int lda, ldb; int nunits, G, c;
    __device__ __forceinline__ const unsigned* rowoff_ptr(const Unit&) const { return nullptr; }
    __device__ __forceinline__ bool next(int i, Unit& u) const {
        const int L = i * G + c; if (L >= nunits) return false;
        u.e = L >> 6; const int rem = L & 63; u.pn = rem >> 4; u.pm = rem & 15; u.row0 = u.pm * 256; return true;
    }
    __device__ __forceinline__ void addr(const Unit& u, UAddr& g) const {
        g.a0 = (const char*)(HID + ((size_t)u.e * 4096 + (size_t)u.pm * 256) * DFF); g.a1 = g.a0 + (size_t)128 * DFF;
        g.b0 = (const char*)(WdT + ((size_t)u.e * D + (size_t)u.pn * 256) * DFF); g.b1 = g.b0 + (size_t)128 * DFF;
    }
};

struct EpiStoreBf16 {
    static constexpr bool PERM = true;
    bf16* O; int ldc; size_t estride;
    __device__ __forceinline__ void operator()(const f32x4 (&acc)[2][2][4][2], const Unit& u, int wr, int wc, int fr, int fq) const {
        bf16* base = O + (size_t)u.e * estride + (size_t)(u.pm * 256 + wr * 64 + fr) * ldc + u.pn * 256 + wc * 32 + 8 * fq;
#pragma unroll
        for (int ai = 0; ai < 2; ++ai)
#pragma unroll
            for (int m = 0; m < 4; ++m) { bf16* rowp = base + (size_t)(ai * 128 + m * 16) * ldc;
#pragma unroll
                for (int bj = 0; bj < 2; ++bj) { const f32x4 v0 = acc[ai][bj][m][0], v1 = acc[ai][bj][m][1];
                    u32x4 w; w.x = cvt_pk_bf16(v0[0], v0[1]); w.y = cvt_pk_bf16(v0[2], v0[3]); w.z = cvt_pk_bf16(v1[0], v1[1]); w.w = cvt_pk_bf16(v1[2], v1[3]);
                    *(u32x4*)(rowp + bj * 128) = w; } }
    }
};
struct EpiProj {
    static constexpr bool PERM = true;
    bf16* O; const f32x2* rope;
    __device__ __forceinline__ void operator()(const f32x4 (&acc)[2][2][4][2], const Unit& u, int wr, int wc, int fr, int fq) const {
        const int row0 = u.row0 + wr * 64 + fr;
        if (u.pn >= 4) {
            bf16* base = O + (size_t)row0 * PC + u.pn * 256 + wc * 32 + 8 * fq;
#pragma unroll
            for (int ai = 0; ai < 2; ++ai)
#pragma unroll
                for (int m = 0; m < 4; ++m) { bf16* rowp = base + (size_t)(ai * 128 + m * 16) * PC;
#pragma unroll
                    for (int bj = 0; bj < 2; ++bj) { const f32x4 v0 = acc[ai][bj][m][0], v1 = acc[ai][bj][m][1];
                        u32x4 w; w.x = cvt_pk_bf16(v0[0], v0[1]); w.y = cvt_pk_bf16(v0[2], v0[3]); w.z = cvt_pk_bf16(v1[0], v1[1]); w.w = cvt_pk_bf16(v1[2], v1[3]);
                        *(u32x4*)(rowp + bj * 128) = w; } }
        } else {
            const float sc = (u.pn < 2) ? 0.08838834764831845f : 1.0f; const int d0 = 16 * wc + 4 * fq;
#pragma unroll
            for (int ai = 0; ai < 2; ++ai)
#pragma unroll
                for (int m = 0; m < 4; ++m) { const int row = row0 + ai * 128 + m * 16; const int b = row / PP, p = row - b * PP; const int n = p - PADF;
                    const f32x2* tb = rope + (size_t)n * 64 + d0; const f32x2 t0 = tb[0], t1 = tb[1], t2 = tb[2], t3 = tb[3];
                    bf16* rowp = O + (size_t)row * PC + u.pn * 256 + d0;
#pragma unroll
                    for (int bj = 0; bj < 2; ++bj) { const f32x4 x1 = acc[ai][bj][m][0], x2 = acc[ai][bj][m][1];
                        u32x2 o1, o2;
                        o1.x = cvt_pk_bf16((x1[0] * t0.x - x2[0] * t0.y) * sc, (x1[1] * t1.x - x2[1] * t1.y) * sc); o1.y = cvt_pk_bf16((x1[2] * t2.x - x2[2] * t2.y) * sc, (x1[3] * t3.x - x2[3] * t3.y) * sc);
                        o2.x = cvt_pk_bf16((x2[0] * t0.x + x1[0] * t0.y) * sc, (x2[1] * t1.x + x1[1] * t1.y) * sc); o2.y = cvt_pk_bf16((x2[2] * t2.x + x1[2] * t2.y) * sc, (x2[3] * t3.x + x1[3] * t3.y) * sc);
                        *(u32x2*)(rowp + bj * 128) = o1; *(u32x2*)(rowp + bj * 128 + 64) = o2; } }
        }
    }
};
struct EpiSwiglu {
    static constexpr bool PERM = true;
    unsigned char* HID;
    __device__ __forceinline__ void operator()(const f32x4 (&acc)[2][2][4][2], const Unit& u, int wr, int wc, int fr, int fq) const {
        unsigned char* base = HID + ((size_t)u.e * 4096 + (size_t)(u.pm * 256 + wr * 64 + fr)) * DFF + u.pn * 128 + wc * 32 + 8 * fq;
#pragma unroll
        for (int ai = 0; ai < 2; ++ai)
#pragma unroll
            for (int m = 0; m < 4; ++m) { unsigned char* rowp = base + (size_t)(ai * 128 + m * 16) * DFF;
                float h[8];
#pragma unroll
                for (int n = 0; n < 2; ++n)
#pragma unroll
                    for (int j = 0; j < 4; ++j) { const float g = acc[ai][0][m][n][j], up = acc[ai][1][m][n][j]; h[n * 4 + j] = fminf(fmaxf(siluf_(g) * up, -448.0f), 448.0f); }
                *(u32x2*)rowp = (u32x2){pk4_fp8(h[0], h[1], h[2], h[3]), pk4_fp8(h[4], h[5], h[6], h[7])}; }
    }
};
struct EpiDelta {
    static constexpr bool PERM = true;
    bf16* O;
    __device__ __forceinline__ void operator()(const f32x4 (&acc)[2][2][4][2], const Unit& u, int wr, int wc, int fr, int fq) const {
        const int tok0 = (u.pm >> 5) * SEQ + 256 * (u.pm & 31) + wr * 64 + fr;
        bf16* base = O + (size_t)tok0 * D + u.pn * 256 + wc * 32 + 8 * fq;
#pragma unroll
        for (int ai = 0; ai < 2; ++ai)
#pragma unroll
            for (int m = 0; m < 4; ++m) { bf16* rowp = base + (size_t)(ai * 128 + m * 16) * D;
#pragma unroll
                for (int bj = 0; bj < 2; ++bj) { const f32x4 v0 = acc[ai][bj][m][0], v1 = acc[ai][bj][m][1];
                    u32x4 w; w.x = cvt_pk_bf16(v0[0], v0[1]); w.y = cvt_pk_bf16(v0[2], v0[3]); w.z = cvt_pk_bf16(v1[0], v1[1]); w.w = cvt_pk_bf16(v1[2], v1[3]);
                    *(u32x4*)(rowp + bj * 128) = w; } }
    }
};
}

struct Ctx {
    LAS unsigned char* lds; int tid, lane, wave, vcu, G;
    const float *x, *meta, *mix_g, *w_in, *b_gates, *conv_w, *conv_b, *ret_logit, *ret_gn, *ml_gn, *w_out, *ffn_g, *w_router, *w_gate, *w_up, *w_down, *fin_g;
    float* out; unsigned char* ws;
};

__device__ __forceinline__ int rope_row(int c) { if (c >= 1024) return c; const int d = c & 127, dd = d & 63; return (c & ~127) | (8 * (dd >> 2) + (d >> 6) * 4 + (dd & 3)); }
template <bool PAIRPERM = false>
__device__ __forceinline__ void transpose_item(const float* W, int K, int N, int ldw, bf16* WT, LAS float* scr, int item, int lane) {
    const int nblk = N / 32, kb = item / nblk, nb = item % nblk, k0 = 64 * kb, n0 = 32 * nb;
#pragma unroll 8
    for (int i = 0; i < 32; ++i) { const int kk = 2 * i + (lane >> 5); scr[kk * 33 + (lane & 31)] = W[(size_t)(k0 + kk) * ldw + n0 + (lane & 31)]; }
    LDS_WAIT(); asm volatile("" ::: "memory");
    const int c = lane & 7;
#pragma unroll
    for (int j = 0; j < 4; ++j) { const int n = (lane >> 3) + 8 * j; const LAS float* s = scr + (8 * c) * 33 + n;
        u32x4 o; o.x = pk2(s[0 * 33], s[1 * 33]); o.y = pk2(s[2 * 33], s[3 * 33]); o.z = pk2(s[4 * 33], s[5 * 33]); o.w = pk2(s[6 * 33], s[7 * 33]);
        *(u32x4*)(WT + (size_t)(PAIRPERM ? rope_row(n0 + n) : (n0 + n)) * K + k0 + 8 * c) = o; }
    LDS_WAIT(); asm volatile("" ::: "memory");
}
constexpr int F8SCR = 0;
__device__ __forceinline__ void transpose_item_f8(const float* W, int K, int N, int ldw, unsigned char* WT, LAS float*  , int item, int lane, float pre) {
    const int nblk = N / 64, kb = item / nblk, nb = item % nblk, k0 = 64 * kb + 16 * (lane >> 4), n0 = 64 * nb + 4 * (lane & 15);
    const float* src = W + (size_t)k0 * ldw + n0;
    f32x4 v[16];
#pragma unroll
    for (int i = 0; i < 16; ++i) v[i] = *(const f32x4*)(src + (size_t)i * ldw) * pre;
#pragma unroll
    for (int j = 0; j < 4; ++j) {
        u32x4 o;
        o.x = pk4_fp8(v[0][j], v[1][j], v[2][j], v[3][j]); o.y = pk4_fp8(v[4][j], v[5][j], v[6][j], v[7][j]); o.z = pk4_fp8(v[8][j], v[9][j], v[10][j], v[11][j]); o.w = pk4_fp8(v[12][j], v[13][j], v[14][j], v[15][j]);
        *(u32x4*)(WT + (size_t)(n0 + j) * K + k0) = o; }
}
__device__ __forceinline__ void row_load(const float* row, int lane, f32x4 (&u)[4]) {
#pragma unroll
    for (int jj = 0; jj < 4; ++jj) u[jj] = *(const f32x4*)(row + jj * 256 + lane * 4);
}
__device__ __forceinline__ void row_load_h1(const float* xrow, const bf16* drow, int lane, f32x4 (&u)[4]) {
    u32x2 dv[4];
#pragma unroll
    for (int jj = 0; jj < 4; ++jj) { u[jj] = *(const f32x4*)(xrow + jj * 256 + lane * 4); dv[jj] = *(const u32x2*)(drow + jj * 256 + lane * 4); }
#pragma unroll
    for (int jj = 0; jj < 4; ++jj) { u[jj].x += bflo(dv[jj].x); u[jj].y += bfhi(dv[jj].x); u[jj].z += bflo(dv[jj].y); u[jj].w += bfhi(dv[jj].y); }
}
__device__ __forceinline__ void rms_apply(const float* g, int lane, f32x4 (&u)[4]) {
    float s = 0.f;
#pragma unroll
    for (int jj = 0; jj < 4; ++jj) s += u[jj].x * u[jj].x + u[jj].y * u[jj].y + u[jj].z * u[jj].z + u[jj].w * u[jj].w;
    const float rstd = rsqrtf(wave_sum(s) * (1.0f / D) + EPS);
#pragma unroll
    for (int jj = 0; jj < 4; ++jj) { const f32x4 gv = *(const f32x4*)(g + jj * 256 + lane * 4); u[jj] = u[jj] * rstd * gv; }
}
__device__ __forceinline__ void store_row_bf16(bf16* dst, int lane, const f32x4 (&u)[4]) {
#pragma unroll
    for (int jj = 0; jj < 4; ++jj) { u32x2 w; w.x = pk2(u[jj].x, u[jj].y); w.y = pk2(u[jj].z, u[jj].w); *(u32x2*)(dst + jj * 256 + lane * 4) = w; }
}
#define MFMA16(a, b, c) __builtin_amdgcn_mfma_f32_16x16x32_bf16(a, b, c, 0, 0, 0)
constexpr int RB_PITCH = 1032, RB_UH = 0, RB_UL = 16 * RB_PITCH * 2, RB_RED = 2 * RB_UL;
struct RowDots { bf16x8 bh[4], bl[4]; };
__device__ __forceinline__ void rowdots_init(RowDots& W, const float* wsrc, int ld, int w, int lane) {
    const int fr = lane & 15, fq = lane >> 4;
#pragma unroll
    for (int s_ = 0; s_ < 4; ++s_) { float v[8];
#pragma unroll
        for (int j = 0; j < 8; ++j) v[j] = wsrc[(size_t)(128 * w + 32 * s_ + 8 * fq + j) * ld + fr];
        unsigned hp[4], lp[4];
#pragma unroll
        for (int j = 0; j < 4; ++j) { hp[j] = pk2(v[2 * j], v[2 * j + 1]); lp[j] = pk2(v[2 * j] - bflo(hp[j]), v[2 * j + 1] - bfhi(hp[j])); }
        W.bh[s_] = __builtin_bit_cast(bf16x8, (u32x4){hp[0], hp[1], hp[2], hp[3]}); W.bl[s_] = __builtin_bit_cast(bf16x8, (u32x4){lp[0], lp[1], lp[2], lp[3]}); }
}
__device__ __forceinline__ void rowdots_put(LAS unsigned char* lds, int rs, int lane, const f32x4 (&u)[4]) {
#pragma unroll
    for (int jj = 0; jj < 4; ++jj) { const unsigned h0 = pk2(u[jj].x, u[jj].y), h1 = pk2(u[jj].z, u[jj].w);
        const unsigned l0 = pk2(u[jj].x - bflo(h0), u[jj].y - bfhi(h0)), l1 = pk2(u[jj].z - bflo(h1), u[jj].w - bfhi(h1));
        *(LAS u32x2*)(lds + RB_UH + (rs * RB_PITCH + jj * 256 + lane * 4) * 2) = (u32x2){h0, h1}; *(LAS u32x2*)(lds + RB_UL + (rs * RB_PITCH + jj * 256 + lane * 4) * 2) = (u32x2){l0, l1}; }
}
__device__ __forceinline__ void rowdots_mma(LAS unsigned char* lds, const RowDots& W, int w, int lane) {
    const int fr = lane & 15, fq = lane >> 4; f32x4 acc = (f32x4){0.f, 0.f, 0.f, 0.f};
#pragma unroll
    for (int s_ = 0; s_ < 4; ++s_) { const int off = (fr * RB_PITCH + 128 * w + 32 * s_ + 8 * fq) * 2;
        const bf16x8 ah = *(const LAS bf16x8*)(lds + RB_UH + off), al = *(const LAS bf16x8*)(lds + RB_UL + off);
        acc = MFMA16(ah, W.bh[s_], acc); acc = MFMA16(ah, W.bl[s_], acc); acc = MFMA16(al, W.bh[s_], acc); }
    *(LAS f32x4*)(lds + RB_RED + (w * 256 + lane * 4) * 4) = acc;
}
__device__ __forceinline__ float rowdots_get(const LAS unsigned char* lds, int row, int g) {
    const LAS float* red = (const LAS float*)(lds + RB_RED) + ((row >> 2) * 16 + g) * 4 + (row & 3); float s_ = 0.f;
#pragma unroll
    for (int w = 0; w < 8; ++w) s_ += red[w * 256];
    return s_;
}
__device__ __forceinline__ void phase_prep(Ctx& F) {
    bf16* WINT = (bf16*)(F.ws + WS_WINT); bf16* WOUTT = (bf16*)(F.ws + WS_WOUTT);
    LAS float* scr = (LAS float*)(F.lds + F.wave * 16384);
    const int gw = F.vcu * 8 + F.wave, NGW = F.G * 8;
    constexpr int I_IN = (D / 64) * (PC / 32), I_OUT = (D / 64) * (D / 32);
    for (int it = gw; it < I_IN + I_OUT; it += NGW) {
        if (it < I_IN) transpose_item<true>(F.w_in, D, PC, PCOLS, WINT, scr, it, F.lane);
        else transpose_item(F.w_out, D, D, D, WOUTT, scr, it - I_IN, F.lane);
    }
    f32x2* rope = (f32x2*)(F.ws + WS_ROPE);
    for (int idx = (F.vcu * 512 + F.tid); idx < NTOK * 64; idx += F.G * 512) {
        const int n = idx >> 6, i = idx & 63;
        const float inv = (float)exp(-(double)i * (9.210340371976184 / 64.0));
        const float angf = (float)n * inv;
        const double xd = (double)angf; const double kq = rint(xd * 0.6366197723675814);
        double r = fma(-kq, 1.5707963267948966, xd); r = fma(-kq, 6.123233995736766e-17, r);
        const double r2 = r * r;
        double sn = -1.0 / 1307674368000.0; sn = fma(sn, r2, 1.0 / 6227020800.0); sn = fma(sn, r2, -1.0 / 39916800.0); sn = fma(sn, r2, 1.0 / 362880.0); sn = fma(sn, r2, -1.0 / 5040.0); sn = fma(sn, r2, 1.0 / 120.0); sn = fma(sn, r2, -1.0 / 6.0); sn = fma(sn * r2, r, r);
        double cs = 1.0 / 20922789888000.0; cs = fma(cs, r2, -1.0 / 87178291200.0); cs = fma(cs, r2, 1.0 / 479001600.0); cs = fma(cs, r2, -1.0 / 3628800.0); cs = fma(cs, r2, 1.0 / 40320.0); cs = fma(cs, r2, -1.0 / 720.0); cs = fma(cs, r2, 1.0 / 24.0); cs = fma(cs, r2, -0.5); cs = fma(cs, r2, 1.0);
        const int q = ((int)kq) & 3;
        const double c = (q == 0) ? cs : (q == 1) ? -sn : (q == 2) ? -cs : sn;
        const double s = (q == 0) ? sn : (q == 1) ? cs : (q == 2) ? -sn : -cs;
        rope[idx] = (f32x2){(float)c, (float)s};
    }
    __syncthreads();
    bf16* U1 = (bf16*)(F.ws + WS_ACT1); float* GATES = (float*)(F.ws + WS_GATES);
    RowDots W; rowdots_init(W, F.w_in + PC, PCOLS, F.wave, F.lane);
    for (int bi = F.vcu; bi < R / 16; bi += F.G) {
        const int r0 = bi * 16;
        int rr[2]; bool ok[2]; f32x4 u[2][4];
#pragma unroll
        for (int t = 0; t < 2; ++t) { rr[t] = r0 + 2 * F.wave + t; const int b = rr[t] / PP, p = rr[t] - b * PP; ok[t] = p >= PADF;
            if (ok[t]) row_load((p < CHK) ? F.meta + (size_t)(p - PADF) * D : F.x + ((size_t)b * SEQ + (p - CHK)) * D, F.lane, u[t]);
            else {
#pragma unroll
                for (int jj = 0; jj < 4; ++jj) u[t][jj] = (f32x4){0.f, 0.f, 0.f, 0.f}; } }
#pragma unroll
        for (int t = 0; t < 2; ++t) {
            if (!ok[t]) {
                bf16* prow = (bf16*)(F.ws + WS_PROJ) + (size_t)rr[t] * PC;
#pragma unroll
                for (int jj = 0; jj < 8; ++jj) *(u32x4*)(prow + jj * 512 + F.lane * 8) = (u32x4){0u, 0u, 0u, 0u};
            } else { rms_apply(F.mix_g, F.lane, u[t]); store_row_bf16(U1 + (size_t)rr[t] * D, F.lane, u[t]); }
            rowdots_put(F.lds, 2 * F.wave + t, F.lane, u[t]);
        }
        __syncthreads();
        rowdots_mma(F.lds, W, F.wave, F.lane);
        __syncthreads();
        if (F.tid < 256) { const int row = F.tid >> 4, g = F.tid & 15, r = r0 + row; const int b = r / PP, p = r - b * PP;
            float gv = rowdots_get(F.lds, row, g) + F.b_gates[g]; if (g >= 8) gv = logsigmoidf_(gv);
            GATES[(size_t)r * 16 + g] = (p >= PADF) ? gv : ((g < 8) ? NEGF : 0.0f); }
    }
}

__device__ __forceinline__ void phase_rope_conv(Ctx& F) {
    const bf16* PROJ = (const bf16*)(F.ws + WS_PROJ); bf16* QKC = (bf16*)(F.ws + WS_ACT1);
    const int gw = F.vcu * 8 + F.wave, NGW = F.G * 8, lane = F.lane;
    const float qs = 0.08838834764831845f;
    float wv[2][5][8], bv[2][8];
#pragma unroll
    for (int jj = 0; jj < 2; ++jj) { const int ch0 = jj * 512 + lane * 8;
        { const f32x4 b0 = *(const f32x4*)(F.conv_b + ch0), b1 = *(const f32x4*)(F.conv_b + ch0 + 4); bv[jj][0] = b0.x; bv[jj][1] = b0.y; bv[jj][2] = b0.z; bv[jj][3] = b0.w; bv[jj][4] = b1.x; bv[jj][5] = b1.y; bv[jj][6] = b1.z; bv[jj][7] = b1.w; }
#pragma unroll
        for (int j = 0; j < 5; ++j) { const f32x4 w0 = *(const f32x4*)(F.conv_w + j * 1024 + ch0), w1 = *(const f32x4*)(F.conv_w + j * 1024 + ch0 + 4);
            wv[jj][j][0] = w0.x; wv[jj][j][1] = w0.y; wv[jj][j][2] = w0.z; wv[jj][j][3] = w0.w; wv[jj][j][4] = w1.x; wv[jj][j][5] = w1.y; wv[jj][j][6] = w1.z; wv[jj][j][7] = w1.w; } }
    for (int r = gw; r < R; r += NGW) {
        const int b = r / PP, p = r - b * PP;
        bf16* qrow = QKC + (size_t)r * D;
        if (p < PADF) {
#pragma unroll
            for (int jj = 0; jj < 2; ++jj) *(u32x4*)(qrow + jj * 512 + lane * 8) = (u32x4){0u, 0u, 0u, 0u};
            continue;
        }
        u32x4 xv[2][5];
#pragma unroll
        for (int jj = 0; jj < 2; ++jj)
#pragma unroll
            for (int j = 0; j < 5; ++j) { const int pj = p + j - 2; xv[jj][j] = (pj >= PADF && pj < PP) ? *(const u32x4*)(PROJ + (size_t)(r + j - 2) * PC + 2048 + jj * 512 + lane * 8) : (u32x4){0u, 0u, 0u, 0u}; }
#pragma unroll
        for (int jj = 0; jj < 2; ++jj) {
            float acc[8];
#pragma unroll
            for (int i = 0; i < 8; ++i) acc[i] = bv[jj][i];
#pragma unroll
            for (int j = 0; j < 5; ++j) { const u32x4 v = xv[jj][j];
                acc[0] += bflo(v.x) * wv[jj][j][0]; acc[1] += bfhi(v.x) * wv[jj][j][1]; acc[2] += bflo(v.y) * wv[jj][j][2]; acc[3] += bfhi(v.y) * wv[jj][j][3];
                acc[4] += bflo(v.z) * wv[jj][j][4]; acc[5] += bfhi(v.z) * wv[jj][j][5]; acc[6] += bflo(v.w) * wv[jj][j][6]; acc[7] += bfhi(v.w) * wv[jj][j][7]; }
            const float sc = (jj == 0) ? qs : 1.0f;
#pragma unroll
            for (int i = 0; i < 8; ++i) acc[i] = siluf_(acc[i]) * sc;
            *(u32x4*)(qrow + jj * 512 + lane * 8) = (u32x4){pk2(acc[0], acc[1]), pk2(acc[2], acc[3]), pk2(acc[4], acc[5]), pk2(acc[6], acc[7])};
        }
    }
}

__device__ __forceinline__ void zero_acc(f32x4 (&acc)[2][4]) {
#pragma unroll
    for (int mt = 0; mt < 2; ++mt)
#pragma unroll
        for (int nt = 0; nt < 4; ++nt) acc[mt][nt] = (f32x4){0.f, 0.f, 0.f, 0.f};
}
template <bool MAXOP, bool REV>
__device__ __forceinline__ void scan128(const LAS float* x, LAS float* out, int lane) {
    static_assert(!REV, "suffix scans are not used any more");
    const int i0 = 2 * lane, i1 = 2 * lane + 1;
    const float a0 = x[i0], a1r = x[i1]; const float a1 = MAXOP ? fmaxf(a0, a1r) : a0 + a1r;
    const float s = wave_scan_incl<MAXOP>(a1);
    const int idn = __builtin_bit_cast(int, MAXOP ? -3.0e38f : 0.0f);
    const float ex = __builtin_bit_cast(float, __builtin_amdgcn_update_dpp(idn, __builtin_bit_cast(int, s), 0x138, 0xF, 0xF, false));
    out[i0] = MAXOP ? fmaxf(ex, a0) : ex + a0; out[i1] = s;
}

typedef short s16x4 __attribute__((ext_vector_type(4)));
constexpr int NSEG = 4;
__device__ __forceinline__ int seg_begin(int s) { return s == 0 ? 0 : 1 + 16 * s; }
constexpr size_t SUMM_STRIDE = (size_t)(144 * 128 + 64);
constexpr size_t WS_SUMM = WS_STATE;
constexpr size_t WS_OUTD = WS_STATE + 16 * MiB;
static_assert(WS_OUTD + (size_t)2 * R * D * 2 <= WS_END && 64 * 3 * SUMM_STRIDE * 4 <= 16 * MiB, "mixer scratch map");
constexpr int VQ = VEC_OFF;
constexpr int V_LI = VQ, V_LF = VQ + 512, V_BC = VQ + 1024, V_GG = VQ + 1536, V_PM = VQ + 2048, V_E1 = VQ + 2560, V_WI = VQ + 3072, V_FL = VQ + 3584, V_WU = VQ + 4096,
              V_NV = VQ + 4608  , V_SC = VQ + 4864  ;

template <int KS, int NT> __device__ __forceinline__ void ld_rows(const LAS bf16* T, int rowbase, int fq, bf16x8 (&f)[NT]) {
#pragma unroll
    for (int t = 0; t < NT; ++t) f[t] = *(const LAS bf16x8*)(T + (rowbase + 16 * t) * TP + KS * 32 + 8 * fq);
}
template <int KS> __device__ __forceinline__ void tr_frag4(unsigned addr, bf16x8 (&f)[4]) {
    s16x4 r0, r1, r2, r3, r4, r5, r6, r7;
    asm volatile("ds_read_b64_tr_b16 %0, %8 offset:%9\n\tds_read_b64_tr_b16 %1, %8 offset:%10\n\tds_read_b64_tr_b16 %2, %8 offset:%11\n\tds_read_b64_tr_b16 %3, %8 offset:%12\n\t"
                 "ds_read_b64_tr_b16 %4, %8 offset:%13\n\tds_read_b64_tr_b16 %5, %8 offset:%14\n\tds_read_b64_tr_b16 %6, %8 offset:%15\n\tds_read_b64_tr_b16 %7, %8 offset:%16\n\ts_waitcnt lgkmcnt(0)"
                 : "=&v"(r0), "=&v"(r1), "=&v"(r2), "=&v"(r3), "=&v"(r4), "=&v"(r5), "=&v"(r6), "=&v"(r7)
                 : "v"(addr), "i"(KS * 8704), "i"(KS * 8704 + 1088), "i"(KS * 8704 + 32), "i"(KS * 8704 + 32 + 1088), "i"(KS * 8704 + 64), "i"(KS * 8704 + 64 + 1088), "i"(KS * 8704 + 96), "i"(KS * 8704 + 96 + 1088)
                 : "memory");
    f[0] = __builtin_shufflevector(r0, r1, 0, 1, 2, 3, 4, 5, 6, 7); f[1] = __builtin_shufflevector(r2, r3, 0, 1, 2, 3, 4, 5, 6, 7);
    f[2] = __builtin_shufflevector(r4, r5, 0, 1, 2, 3, 4, 5, 6, 7); f[3] = __builtin_shufflevector(r6, r7, 0, 1, 2, 3, 4, 5, 6, 7);
}
template <int KS> __device__ __forceinline__ void tr_frag2(unsigned addr, bf16x8 (&f)[2]) {
    s16x4 r0, r1, r2, r3;
    asm volatile("ds_read_b64_tr_b16 %0, %4 offset:%5\n\tds_read_b64_tr_b16 %1, %4 offset:%6\n\tds_read_b64_tr_b16 %2, %4 offset:%7\n\tds_read_b64_tr_b16 %3, %4 offset:%8\n\ts_waitcnt lgkmcnt(0)"
                 : "=&v"(r0), "=&v"(r1), "=&v"(r2), "=&v"(r3)
                 : "v"(addr), "i"(KS * 8704), "i"(KS * 8704 + 1088), "i"(KS * 8704 + 32), "i"(KS * 8704 + 32 + 1088)
                 : "memory");
    f[0] = __builtin_shufflevector(r0, r1, 0, 1, 2, 3, 4, 5, 6, 7); f[1] = __builtin_shufflevector(r2, r3, 0, 1, 2, 3, 4, 5, 6, 7);
}
__device__ __forceinline__ unsigned tr_lane_addr(const LAS bf16* T, int colbase, int lane) {
    const int g = lane >> 4, q = (lane & 15) >> 2, p = lane & 3;
    return (unsigned)(__UINTPTR_TYPE__)(T + (8 * g + q) * TP + colbase + 4 * p);
}

struct SeqUnit { int b, h, grp, dir, seg, combo; };
__device__ __forceinline__ SeqUnit seq_unit(int u) { SeqUnit q; q.seg = u & 3; q.combo = u >> 2; q.dir = q.combo & 1; q.grp = (q.combo >> 1) & 1; q.h = (q.combo >> 2) & 3; q.b = q.combo >> 4; return q; }
__device__ __forceinline__ int seq_chunk(const SeqUnit& q, int ci) { return q.dir ? NCH - 1 - ci : ci; }
__device__ __forceinline__ void tile_fetch(int tid, const bf16* src, size_t stride, int rev, u32x4 (&v)[4]) {
#pragma unroll
    for (int i = 0; i < 4; ++i) { const int q = tid + 512 * i, row = q >> 4, ch = q & 15, rs = rev ? 127 - row : row; v[i] = *(const u32x4*)(src + (size_t)rs * stride + ch * 8); }
}
__device__ __forceinline__ void tile_put(int tid, LAS bf16* T, const u32x4 (&v)[4]) {
#pragma unroll
    for (int i = 0; i < 4; ++i) { const int q = tid + 512 * i, row = q >> 4, ch = q & 15; *(LAS u32x4*)(T + row * TP + ch * 8) = v[i]; }
}
__device__ __forceinline__ void chunk_scans(LAS unsigned char* lds, int lane, bool nostab) {
    LAS float* LI = (LAS float*)(lds + V_LI); LAS float* LF = (LAS float*)(lds + V_LF); LAS float* BC = (LAS float*)(lds + V_BC); LAS float* GG = (LAS float*)(lds + V_GG); LAS float* PM = (LAS float*)(lds + V_PM);
    LAS float* E1 = (LAS float*)(lds + V_E1); LAS float* WI = (LAS float*)(lds + V_WI); LAS float* FL = (LAS float*)(lds + V_FL); LAS float* WU = (LAS float*)(lds + V_WU); LAS float* SC = (LAS float*)(lds + V_SC);
    scan128<false, false>(LF, BC, lane); LDS_WAIT();
    const int l0 = 2 * lane, l1 = 2 * lane + 1;
    const float bc0 = BC[l0], bc1 = BC[l1], li0 = LI[l0], li1 = LI[l1];
    GG[l0] = li0 - bc0; GG[l1] = li1 - bc1; LDS_WAIT();
    scan128<true, false>(GG, PM, lane); LDS_WAIT();
    const float blast = BC[127], m = SC[0];
    const float lu0 = blast - bc0 + li0, lu1 = blast - bc1 + li1;
    const float a = nostab ? 0.0f : wave_max(fmaxf(lu0, lu1));
    const float mnew = nostab ? 0.0f : fmaxf(blast + m, a);
    const float f = __expf(blast + m - mnew), g = __expf(a - mnew);
    const float mr0 = nostab ? 0.0f : fmaxf(bc0 + m, bc0 + PM[l0]), mr1 = nostab ? 0.0f : fmaxf(bc1 + m, bc1 + PM[l1]);
    E1[l0] = bc0 - mr0; E1[l1] = bc1 - mr1; WI[l0] = __expf(bc0 + m - mr0); WI[l1] = __expf(bc1 + m - mr1);
    FL[l0] = __expf(-mr0); FL[l1] = __expf(-mr1); WU[l0] = g * __expf(lu0 - a); WU[l1] = g * __expf(lu1 - a);
    if (lane == 0) { SC[1] = f; SC[2] = mnew; SC[3] += blast; }
}
__device__ __forceinline__ void scale_k(int tid, LAS bf16* TK, const LAS float* WU) {
#pragma unroll
    for (int i = 0; i < 4; ++i) { const int q = tid + 512 * i, row = q >> 4, ch = q & 15; LAS u32x4* p = (LAS u32x4*)(TK + row * TP + ch * 8); const u32x4 v = *p; const float wv = WU[row];
        *p = (u32x4){cvtpk(bflo(v.x) * wv, bfhi(v.x) * wv), cvtpk(bflo(v.y) * wv, bfhi(v.y) * wv), cvtpk(bflo(v.z) * wv, bfhi(v.z) * wv), cvtpk(bflo(v.w) * wv, bfhi(v.w) * wv)}; }
}
__device__ __forceinline__ void state_update(const LAS bf16* TV, const LAS bf16* TK, int w, int lane, float f, f32x4 (&C)[2][4], float (&nrow)[4]) {
    const int m0 = 32 * (w >> 1), n0 = 64 * (w & 1), fr = lane & 15;
#pragma unroll
    for (int mt = 0; mt < 2; ++mt)
#pragma unroll
        for (int nt = 0; nt < 4; ++nt) C[mt][nt] *= f;
    f32x4 nacc[4];
#pragma unroll
    for (int nt = 0; nt < 4; ++nt) nacc[nt] = (f32x4){nrow[nt] * f, 0.f, 0.f, 0.f};
    const unsigned aa = tr_lane_addr(TV, m0, lane), ab = tr_lane_addr(TK, n0, lane);
    bf16x8 ones; { const short o = (fr == 0) ? (short)0x3F80 : (short)0;
#pragma unroll
        for (int j = 0; j < 8; ++j) ones[j] = o; }
#define SU_STEP(KS) { bf16x8 a[2], b[4]; tr_frag2<KS>(aa, a); tr_frag4<KS>(ab, b); \
        _Pragma("unroll") for (int mt = 0; mt < 2; ++mt) _Pragma("unroll") for (int nt = 0; nt < 4; ++nt) C[mt][nt] = MFMA16(a[mt], b[nt], C[mt][nt]); \
        if (w < 2) { _Pragma("unroll") for (int nt = 0; nt < 4; ++nt) nacc[nt] = MFMA16(ones, b[nt], nacc[nt]); } }
    SU_STEP(0) SU_STEP(1) SU_STEP(2) SU_STEP(3)
#undef SU_STEP
#pragma unroll
    for (int nt = 0; nt < 4; ++nt) nrow[nt] = nacc[nt][0];
}
__device__ __forceinline__ const bf16* seq_src(const Ctx& F, const SeqUnit& q, int which  , size_t& stride) {
    const bf16* PROJ = (const bf16*)(F.ws + WS_PROJ); const bf16* QKC = (const bf16*)(F.ws + WS_ACT1);
    if (q.grp == 0) { stride = PC; return PROJ + which * 512 + q.h * 128; }
    if (which == 2) { stride = PC; return PROJ + 3072 + q.h * 128; }
    stride = D; return QKC + which * 512 + q.h * 128;
}
__device__ __forceinline__ void gates_fetch(const Ctx& F, const SeqUnit& q, int c, int tid, float lgam, float& li, float& lf) {
    if (q.grp == 0) { li = 0.0f; lf = lgam; return; }
    const float* GATES = (const float*)(F.ws + WS_GATES); const int row = q.dir ? 127 - tid : tid;
    const float* gp = GATES + ((size_t)q.b * PP + (size_t)c * CHK + row) * 16; li = gp[q.dir * 4 + q.h]; lf = gp[8 + q.dir * 4 + q.h];
}

constexpr int I_WD = (DFF / 64) * (D / 64);
constexpr int WD_SPLIT = 2800;
__device__ __forceinline__ void convert_wd(Ctx& F, int lo, int hi, int iw, int nw) {
    unsigned char* WdT = F.ws + WS_WD8; LAS float* scr = (LAS float*)(F.lds + F.wave * F8SCR);
    for (int it = lo + iw; it < hi; it += nw) { const int e = it / I_WD, item = it - e * I_WD;
        transpose_item_f8(F.w_down + (size_t)e * DFF * D, DFF, D, D, WdT + (size_t)e * D * DFF, scr, item, F.lane, WPRE_DN); }
}
__device__ __forceinline__ void phase_seg_summary(Ctx& F) {
    LAS bf16* TK = (LAS bf16*)(F.lds + T1_OFF); LAS bf16* TV = (LAS bf16*)(F.lds + T2_OFF);
    LAS float* SC = (LAS float*)(F.lds + V_SC); LAS float* LI = (LAS float*)(F.lds + V_LI); LAS float* LF = (LAS float*)(F.lds + V_LF); const LAS float* WU = (const LAS float*)(F.lds + V_WU);
    float* SUMM = (float*)(F.ws + WS_SUMM);
    const int w = F.wave;
    for (int u = F.vcu; u < 64 * NSEG; u += F.G) {
        const SeqUnit q = seq_unit(u);
        if (q.seg == NSEG - 1) { convert_wd(F, 0, WD_SPLIT, q.combo * 8 + F.wave, 64 * 8); continue; }
        int tid = F.tid; asm volatile("" : "+v"(tid));
        const int lane = tid & 63, fr = lane & 15, fq = lane >> 4;
        const bool nostab = (q.grp == 0);
        const float lgam = nostab ? logsigmoidf_(F.ret_logit[q.dir * NH + q.h]) : 0.0f;
        size_t sk, sv; const bf16* pk = seq_src(F, q, 1, sk); const bf16* pv = seq_src(F, q, 2, sv);
        f32x4 C[2][4]; float nrow[4] = {0.f, 0.f, 0.f, 0.f}; zero_acc(C);
        __syncthreads();
        if (tid == 0) { SC[0] = 0.f; SC[3] = 0.f; }
        const int ci0 = seg_begin(q.seg), ci1 = seg_begin(q.seg + 1);
        u32x4 rk[4], rv[4]; float gli = 0.f, glf = 0.f;
        {   const int c = seq_chunk(q, ci0); const size_t r0 = (size_t)q.b * PP + (size_t)c * CHK;
            tile_fetch(tid, pk + r0 * sk, sk, q.dir, rk); tile_fetch(tid, pv + r0 * sv, sv, q.dir, rv); if (tid < 128) gates_fetch(F, q, c, tid, lgam, gli, glf); }
#pragma unroll 1
        for (int ci = ci0; ci < ci1; ++ci) {
            tile_put(tid, TK, rk); tile_put(tid, TV, rv); if (tid < 128) { LI[tid] = gli; LF[tid] = glf; }
            __syncthreads();
            if (ci + 1 < ci1) { const int c = seq_chunk(q, ci + 1); const size_t r0 = (size_t)q.b * PP + (size_t)c * CHK;
                tile_fetch(tid, pk + r0 * sk, sk, q.dir, rk); tile_fetch(tid, pv + r0 * sv, sv, q.dir, rv); if (tid < 128) gates_fetch(F, q, c, tid, lgam, gli, glf); }
            if (w == 0) chunk_scans(F.lds, lane, nostab);
            __syncthreads();
            scale_k(tid, TK, WU);
            __syncthreads();
            const float f = SC[1];
            state_update(TV, TK, w, lane, f, C, nrow);
            __syncthreads();
            if (tid == 0) SC[0] = SC[2];
        }
        __syncthreads();
        float* dst = SUMM + ((size_t)q.combo * 3 + q.seg) * SUMM_STRIDE;
        const int m0 = 32 * (w >> 1), n0 = 64 * (w & 1);
#pragma unroll
        for (int mt = 0; mt < 2; ++mt)
#pragma unroll
            for (int nt = 0; nt < 4; ++nt)
#pragma unroll
                for (int rg = 0; rg < 4; ++rg) dst[(m0 + 16 * mt + 4 * fq + rg) * 128 + n0 + 16 * nt + fr] = C[mt][nt][rg];
        if (w < 2 && fq == 0) {
#pragma unroll
            for (int nt = 0; nt < 4; ++nt) dst[128 * 128 + n0 + 16 * nt + fr] = nrow[nt]; }
        if (tid == 0) { dst[144 * 128] = SC[0]; dst[144 * 128 + 1] = SC[3]; }
    }
}

__device__ __forceinline__ void phase_seq(Ctx& F) {
    LAS bf16* TQ = (LAS bf16*)(F.lds + T0_OFF); LAS bf16* TK = (LAS bf16*)(F.lds + T1_OFF); LAS bf16* TV = (LAS bf16*)(F.lds + T2_OFF); LAS bf16* TC = (LAS bf16*)(F.lds + T3_OFF);
    LAS float* SC = (LAS float*)(F.lds + V_SC); LAS float* LI = (LAS float*)(F.lds + V_LI); LAS float* LF = (LAS float*)(F.lds + V_LF);
    const LAS float* WU = (const LAS float*)(F.lds + V_WU); const LAS float* E1 = (const LAS float*)(F.lds + V_E1); const LAS float* GG = (const LAS float*)(F.lds + V_GG);
    const LAS float* WI = (const LAS float*)(F.lds + V_WI); const LAS float* FL = (const LAS float*)(F.lds + V_FL); LAS bf16* NV = (LAS bf16*)(F.lds + V_NV);
    const float* SUMM = (const float*)(F.ws + WS_SUMM); bf16* OUTD = (bf16*)(F.ws + WS_OUTD);
    const int w = F.wave, m0 = 32 * (w >> 1), n0 = 64 * (w & 1);
    for (int u = F.vcu; u < 64 * NSEG; u += F.G) {
        const SeqUnit q = seq_unit(u);
        int tid_u = F.tid; asm volatile("" : "+v"(tid_u));
        const int tid = tid_u, lane = tid & 63, fr = lane & 15, fq = lane >> 4;
        const bool nostab = (q.grp == 0);
        const float lgam = nostab ? logsigmoidf_(F.ret_logit[q.dir * NH + q.h]) : 0.0f;
        size_t sq, sk, sv; const bf16* pq = seq_src(F, q, 0, sq); const bf16* pk = seq_src(F, q, 1, sk); const bf16* pv = seq_src(F, q, 2, sv);
        f32x4 C[2][4]; float nrow[4] = {0.f, 0.f, 0.f, 0.f}; zero_acc(C);
        float mst = 0.f;
        for (int s = 0; s < q.seg; ++s) {
            const float* src = SUMM + ((size_t)q.combo * 3 + s) * SUMM_STRIDE;
            const float ms = src[144 * 128], Bs = src[144 * 128 + 1];
            const float mo_ = nostab ? 0.0f : fmaxf(Bs + mst, ms); const float fa = __expf(Bs + mst - mo_), fb = __expf(ms - mo_); mst = mo_;
#pragma unroll
            for (int mt = 0; mt < 2; ++mt)
#pragma unroll
                for (int nt = 0; nt < 4; ++nt)
#pragma unroll
                    for (int rg = 0; rg < 4; ++rg) C[mt][nt][rg] = fa * C[mt][nt][rg] + fb * src[(m0 + 16 * mt + 4 * fq + rg) * 128 + n0 + 16 * nt + fr];
            if (w < 2 && fq == 0) {
#pragma unroll
                for (int nt = 0; nt < 4; ++nt) nrow[nt] = fa * nrow[nt] + fb * src[128 * 128 + n0 + 16 * nt + fr]; }
        }
        __syncthreads();
        if (tid == 0) { SC[0] = mst; SC[3] = 0.f; }
        const int ci0 = seg_begin(q.seg), ci1 = seg_begin(q.seg + 1);
        u32x4 rq[4], rk[4], rv[4]; float gli = 0.f, glf = 0.f;
        {   const int c = seq_chunk(q, ci0); const size_t r0 = (size_t)q.b * PP + (size_t)c * CHK;
            tile_fetch(tid, pq + r0 * sq, sq, q.dir, rq); tile_fetch(tid, pk + r0 * sk, sk, q.dir, rk); tile_fetch(tid, pv + r0 * sv, sv, q.dir, rv); if (tid < 128) gates_fetch(F, q, c, tid, lgam, gli, glf); }
#pragma unroll 1
        for (int ci = ci0; ci < ci1; ++ci) {
            const int c = seq_chunk(q, ci); const size_t r0 = (size_t)q.b * PP + (size_t)c * CHK;
            int tid = tid_u; asm volatile("" : "+v"(tid));
            const int lane = tid & 63, fr = lane & 15, fq = lane >> 4;
            tile_put(tid, TQ, rq); tile_put(tid, TK, rk); tile_put(tid, TV, rv); if (tid < 128) { LI[tid] = gli; LF[tid] = glf; }
#pragma unroll
            for (int mt = 0; mt < 2; ++mt)
#pragma unroll
                for (int nt = 0; nt < 4; ++nt) *(LAS u32x2*)(TC + (n0 + 16 * nt + fr) * TP + m0 + 16 * mt + 4 * fq) = (u32x2){cvtpk(C[mt][nt][0], C[mt][nt][1]), cvtpk(C[mt][nt][2], C[mt][nt][3])};
            if (w < 2 && fq == 0) {
#pragma unroll
                for (int nt = 0; nt < 4; ++nt) NV[n0 + 16 * nt + fr] = (bf16)f2bf(nrow[nt]); }
            __syncthreads();
            if (w == 0) chunk_scans(F.lds, lane, nostab);
            f32x4 accN[2][4], accD[4], accS[2][4]; zero_acc(accN); zero_acc(accS);
#pragma unroll
            for (int nt = 0; nt < 4; ++nt) accD[nt] = (f32x4){0.f, 0.f, 0.f, 0.f};
            {   const unsigned ac = tr_lane_addr(TC, m0, lane);
#define SX_STEP(KS) { bf16x8 a[2], bq[4]; ld_rows<KS, 4>(TQ, n0 + fr, fq, bq); tr_frag2<KS>(ac, a); \
                bf16x8 an = *(const LAS bf16x8*)(NV + KS * 32 + 8 * fq); if (fr != 0) { _Pragma("unroll") for (int j = 0; j < 8; ++j) an[j] = 0; } \
                _Pragma("unroll") for (int nt = 0; nt < 4; ++nt) { _Pragma("unroll") for (int mt = 0; mt < 2; ++mt) accN[mt][nt] = MFMA16(a[mt], bq[nt], accN[mt][nt]); accD[nt] = MFMA16(an, bq[nt], accD[nt]); } }
                SX_STEP(0) SX_STEP(1) SX_STEP(2) SX_STEP(3)
#undef SX_STEP
            }
#define SS_STEP(KS) { bf16x8 a[2], bq[4]; ld_rows<KS, 2>(TK, m0 + fr, fq, a); ld_rows<KS, 4>(TQ, n0 + fr, fq, bq); \
                _Pragma("unroll") for (int mt = 0; mt < 2; ++mt) { _Pragma("unroll") for (int nt = 0; nt < 4; ++nt) accS[mt][nt] = MFMA16(a[mt], bq[nt], accS[mt][nt]); } }
            SS_STEP(0) SS_STEP(1) SS_STEP(2) SS_STEP(3)
#undef SS_STEP
            __syncthreads();
#pragma unroll
            for (int nt = 0; nt < 4; ++nt) { const int l = n0 + 16 * nt + fr; const float wi = WI[l], e1 = E1[l]; accD[nt][0] *= wi;
#pragma unroll
                for (int mt = 0; mt < 2; ++mt) { accN[mt][nt] *= wi; const int mb = m0 + 16 * mt + 4 * fq; float pv_[4];
#pragma unroll
                    for (int rg = 0; rg < 4; ++rg) pv_[rg] = (mb + rg <= l) ? accS[mt][nt][rg] * __expf(e1 + GG[mb + rg]) : 0.0f;
                    *(LAS u32x2*)(TC + l * TP + mb) = (u32x2){cvtpk(pv_[0], pv_[1]), cvtpk(pv_[2], pv_[3])}; } }
            scale_k(tid, TK, WU);
            if (ci + 1 < ci1) { const int cn = seq_chunk(q, ci + 1); const size_t rn = (size_t)q.b * PP + (size_t)cn * CHK;
                tile_fetch(tid, pq + rn * sq, sq, q.dir, rq); tile_fetch(tid, pk + rn * sk, sk, q.dir, rk); tile_fetch(tid, pv + rn * sv, sv, q.dir, rv); if (tid < 128) gates_fetch(F, q, cn, tid, lgam, gli, glf); }
            __syncthreads();
            {   const unsigned av = tr_lane_addr(TV, m0, lane);
                bf16x8 ones; { const short o = (fr == 0) ? (short)0x3F80 : (short)0;
#pragma unroll
                    for (int j = 0; j < 8; ++j) ones[j] = o; }
#define PV_STEP(KS) { bf16x8 a[2], bp[4]; ld_rows<KS, 4>(TC, n0 + fr, fq, bp); tr_frag2<KS>(av, a); \
                _Pragma("unroll") for (int nt = 0; nt < 4; ++nt) { _Pragma("unroll") for (int mt = 0; mt < 2; ++mt) accN[mt][nt] = MFMA16(a[mt], bp[nt], accN[mt][nt]); accD[nt] = MFMA16(ones, bp[nt], accD[nt]); } }
                PV_STEP(0) PV_STEP(1) PV_STEP(2) PV_STEP(3)
#undef PV_STEP
            }
#pragma unroll
            for (int nt = 0; nt < 4; ++nt) { const int l = n0 + 16 * nt + fr;
                const float den = __shfl(accD[nt][0], fr); const float inv = nostab ? 1.0f : __builtin_amdgcn_rcpf(fmaxf(fabsf(den), FL[l]));
#pragma unroll
                for (int mt = 0; mt < 2; ++mt) { const f32x4 o = accN[mt][nt] * inv; *(LAS u32x2*)(TQ + l * TP + m0 + 16 * mt + 4 * fq) = (u32x2){cvtpk(o[0], o[1]), cvtpk(o[2], o[3])}; } }
            state_update(TV, TK, w, lane, SC[1], C, nrow);
            __syncthreads();
            {   bf16* dst = OUTD + ((size_t)q.dir * R + r0) * D + q.grp * 512 + q.h * 128;
#pragma unroll
                for (int i = 0; i < 4; ++i) { const int qq = tid + 512 * i, row = qq >> 4, ch = qq & 15, rs = q.dir ? 127 - row : row; *(u32x4*)(dst + (size_t)rs * D + ch * 8) = *(const LAS u32x4*)(TQ + row * TP + ch * 8); } }
            if (tid == 0) SC[0] = SC[2];
            __syncthreads();
        }
    }
}

__device__ __forceinline__ void phase_combine(Ctx& F) {
    const bf16* PROJ = (const bf16*)(F.ws + WS_PROJ); const bf16* OUTD = (const bf16*)(F.ws + WS_OUTD); bf16* Y = (bf16*)(F.ws + WS_ACT2);
    const int gw = F.vcu * 8 + F.wave, NGW = F.G * 8, lane = F.lane;
    const int col = lane * 16, grp = col >> 9;
    const size_t goff = (grp == 0 ? 1536 + col : 3584 + (col - 512));
    u32x4 na[2], nc[2], ng[2];
    { const int p0 = gw - (gw / PP) * PP; if (gw < R && p0 >= PADF) {
#pragma unroll
        for (int hh = 0; hh < 2; ++hh) { na[hh] = *(const u32x4*)(OUTD + (size_t)gw * D + col + hh * 8); nc[hh] = *(const u32x4*)(OUTD + ((size_t)R + gw) * D + col + hh * 8); ng[hh] = *(const u32x4*)(PROJ + (size_t)gw * PC + goff + hh * 8); } } }
    for (int r = gw; r < R; r += NGW) {
        const int b = r / PP, p = r - b * PP; bf16* yrow = Y + (size_t)r * D + lane * 16;
        u32x4 ca[2], cc[2], cg[2];
#pragma unroll
        for (int hh = 0; hh < 2; ++hh) { ca[hh] = na[hh]; cc[hh] = nc[hh]; cg[hh] = ng[hh]; }
        { const int r2 = r + NGW; const int p2 = r2 - (r2 / PP) * PP; if (r2 < R && p2 >= PADF) {
#pragma unroll
            for (int hh = 0; hh < 2; ++hh) { na[hh] = *(const u32x4*)(OUTD + (size_t)r2 * D + col + hh * 8); nc[hh] = *(const u32x4*)(OUTD + ((size_t)R + r2) * D + col + hh * 8); ng[hh] = *(const u32x4*)(PROJ + (size_t)r2 * PC + goff + hh * 8); } } }
        if (p < PADF) { *(u32x4*)yrow = (u32x4){0u, 0u, 0u, 0u}; *(u32x4*)(yrow + 8) = (u32x4){0u, 0u, 0u, 0u}; continue; }
        float v[16], gt[16];
#pragma unroll
        for (int hh = 0; hh < 2; ++hh) { const u32x4 a = ca[hh], c = cc[hh], g = cg[hh];
            const unsigned aw[4] = {a.x, a.y, a.z, a.w}, cw[4] = {c.x, c.y, c.z, c.w}, gw_[4] = {g.x, g.y, g.z, g.w};
#pragma unroll
            for (int j = 0; j < 4; ++j) { v[hh * 8 + 2 * j] = bflo(aw[j]) + bflo(cw[j]); v[hh * 8 + 2 * j + 1] = bfhi(aw[j]) + bfhi(cw[j]); gt[hh * 8 + 2 * j] = bflo(gw_[j]); gt[hh * 8 + 2 * j + 1] = bfhi(gw_[j]); } }
        if (grp == 1) {
#pragma unroll
            for (int j = 0; j < 16; ++j) v[j] *= sigmoidf_(gt[j]); }
        float s = 0.f;
#pragma unroll
        for (int j = 0; j < 16; ++j) s += v[j];
        s += __shfl_xor(s, 1); s += __shfl_xor(s, 2); s += __shfl_xor(s, 4);
        const float mu = s * (1.0f / 128.0f); float qv = 0.f;
#pragma unroll
        for (int j = 0; j < 16; ++j) { v[j] -= mu; qv += v[j] * v[j]; }
        qv += __shfl_xor(qv, 1); qv += __shfl_xor(qv, 2); qv += __shfl_xor(qv, 4);
        const float rstd = rsqrtf(qv * (1.0f / 128.0f) + EPS);
        const float* gnp = (grp == 0 ? F.ret_gn + col : F.ml_gn + (col - 512)); float gn[16];
#pragma unroll
        for (int j4 = 0; j4 < 4; ++j4) { const f32x4 g4 = *(const f32x4*)(gnp + 4 * j4); gn[4 * j4] = g4.x; gn[4 * j4 + 1] = g4.y; gn[4 * j4 + 2] = g4.z; gn[4 * j4 + 3] = g4.w; }
        unsigned o[8];
#pragma unroll
        for (int j = 0; j < 8; ++j) { float y0 = v[2 * j] * rstd * gn[2 * j], y1 = v[2 * j + 1] * rstd * gn[2 * j + 1];
            if (grp == 0) { y0 *= siluf_(gt[2 * j]); y1 *= siluf_(gt[2 * j + 1]); }
            o[j] = pk2(y0, y1); }
        *(u32x4*)yrow = (u32x4){o[0], o[1], o[2], o[3]}; *(u32x4*)(yrow + 8) = (u32x4){o[4], o[5], o[6], o[7]};
    }
}

constexpr int SK_RED = 34816;
__device__ __forceinline__ f32x4 skinny16_ksplit(LAS unsigned char* lds, const bf16* btrow, int w, int lane) {
    const LAS bf16* A = (const LAS bf16*)lds; LAS float* RED = (LAS float*)(lds + SK_RED);
    const int fr = lane & 15, fq = lane >> 4;
    f32x4 acc = (f32x4){0.f, 0.f, 0.f, 0.f};
    bf16x8 bb[4];
#pragma unroll
    for (int j = 0; j < 4; ++j) bb[j] = *(const bf16x8*)(btrow + (4 * w + j) * 32 + 8 * fq);
#pragma unroll
    for (int j = 0; j < 4; ++j) { const bf16x8 a = *(const LAS bf16x8*)(A + fr * 1032 + (4 * w + j) * 32 + 8 * fq); acc = MFMA16(a, bb[j], acc); }
    *(LAS f32x4*)(RED + w * 256 + lane * 4) = acc;
    __syncthreads();
    if (w == 0) { acc = (f32x4){0.f, 0.f, 0.f, 0.f};
#pragma unroll
        for (int ww = 0; ww < 8; ++ww) acc += *(const LAS f32x4*)(RED + ww * 256 + lane * 4); }
    return acc;
}
__device__ __forceinline__ void proj_meta(Ctx& F) {
    const bf16* U1 = (const bf16*)(F.ws + WS_ACT1); const bf16* WINT = (const bf16*)(F.ws + WS_WINT); bf16* PROJ = (bf16*)(F.ws + WS_PROJ); const f32x2* rope = (const f32x2*)(F.ws + WS_ROPE);
    LAS bf16* AT = (LAS bf16*)F.lds;
    for (int it = F.vcu; it < PC / 16; it += F.G) {
        int tid = F.tid; asm volatile("" : "+v"(tid));
        const int lane = tid & 63, fr = lane & 15, fq = lane >> 4;
        __syncthreads();
        for (int i = tid; i < 16 * 128; i += 512) { const int r = i >> 7, ch = i & 127; *(LAS u32x4*)(AT + r * 1032 + ch * 8) = *(const u32x4*)(U1 + (size_t)(PADF + r) * D + ch * 8); }
        __syncthreads();
        const int t = it * 16 + fr;
        const f32x4 acc = skinny16_ksplit(F.lds, WINT + (size_t)t * D, F.wave, lane);
        if (F.wave == 0) {
#pragma unroll
            for (int rg = 0; rg < 4; ++rg) {
                const int n = 4 * fq + rg; float val = acc[rg]; int col = t;
                const float other = __shfl_xor(val, 4);
                if (t < 1024) {
                    const int tc = t & 127, dd = 4 * (tc >> 3) + (tc & 3); const f32x2 cs = rope[n * 64 + dd]; const float sc = (t < 512) ? 0.08838834764831845f : 1.0f;
                    if ((tc & 4) == 0) { val = (val * cs.x - other * cs.y) * sc; col = (t & ~127) + dd; } else { val = (val * cs.x + other * cs.y) * sc; col = (t & ~127) + 64 + dd; }
                }
                const bf16 hv = (bf16)f2bf(val);
#pragma unroll
                for (int b = 0; b < NB; ++b) PROJ[((size_t)b * PP + PADF + n) * PC + col] = hv;
            }
        }
    }
}
__device__ __forceinline__ void out_meta(Ctx& F) {
    const bf16* Y = (const bf16*)(F.ws + WS_ACT2); const bf16* WOUTT = (const bf16*)(F.ws + WS_WOUTT); float* H1M = (float*)(F.ws + WS_H1META);
    LAS bf16* AT = (LAS bf16*)F.lds;
    for (int it = F.vcu; it < NB * (D / 16); it += F.G) {
        int tid = F.tid; asm volatile("" : "+v"(tid));
        const int lane = tid & 63, fr = lane & 15, fq = lane >> 4;
        const int b = it >> 6, cg_ = it & 63;
        __syncthreads();
        for (int i = tid; i < 16 * 128; i += 512) { const int r = i >> 7, ch = i & 127; *(LAS u32x4*)(AT + r * 1032 + ch * 8) = *(const u32x4*)(Y + ((size_t)b * PP + PADF + r) * D + ch * 8); }
        __syncthreads();
        const int col = cg_ * 16 + fr;
        const f32x4 acc = skinny16_ksplit(F.lds, WOUTT + (size_t)col * D, F.wave, lane);
        if (F.wave == 0) {
#pragma unroll
            for (int rg = 0; rg < 4; ++rg) { const int n = 4 * fq + rg; H1M[(size_t)(b * NMETA + n) * D + col] = F.meta[(size_t)n * D + col] + acc[rg]; } }
    }
}

__device__ __forceinline__ void phase_router(Ctx& F) {
    const int gw = F.vcu * 8 + F.wave, NGW = F.G * 8;
    {
        unsigned char* WgT = F.ws + WS_WEXP; unsigned char* WuT = F.ws + WS_WEXP + WEXP_ONE;
        LAS float* scr = (LAS float*)(F.lds + F.wave * F8SCR);
        constexpr int I_ONE = (D / 64) * (DFF / 64);
        for (int it = gw; it < 2 * NE * I_ONE; it += NGW) {
            const int mat = it / (NE * I_ONE), rem = it - mat * (NE * I_ONE), e = rem / I_ONE, item = rem - e * I_ONE;
            if (mat == 0) transpose_item_f8(F.w_gate + (size_t)e * D * DFF, D, DFF, DFF, WgT + (size_t)e * DFF * D, scr, item, F.lane, WPRE_UP);
            else transpose_item_f8(F.w_up + (size_t)e * D * DFF, D, DFF, DFF, WuT + (size_t)e * DFF * D, scr, item, F.lane, WPRE_UP);
        }
    }
    __syncthreads();
    unsigned char* U2 = F.ws + WS_ACT1; float* AFF = (float*)(F.ws + WS_AFF); const float* H1M = (const float*)(F.ws + WS_H1META);
    RowDots W; rowdots_init(W, F.w_router, NE, F.wave, F.lane);
    for (int bi = F.vcu; bi < R / 16; bi += F.G) {
        const int r0 = bi * 16;
        int rr[2]; bool ok[2]; f32x4 u[2][4];
#pragma unroll
        for (int t = 0; t < 2; ++t) { rr[t] = r0 + 2 * F.wave + t; const int b = rr[t] / PP, p = rr[t] - b * PP; ok[t] = p >= PADF;
            if (ok[t]) { if (p < CHK) row_load(H1M + (size_t)(b * NMETA + p - PADF) * D, F.lane, u[t]); else { const size_t xo = ((size_t)b * SEQ + (p - CHK)) * D; row_load_h1(F.x + xo, (const bf16*)(F.ws + WS_DELTA) + xo, F.lane, u[t]); } }
            else {
#pragma unroll
                for (int jj = 0; jj < 4; ++jj) u[t][jj] = (f32x4){0.f, 0.f, 0.f, 0.f}; } }
#pragma unroll
        for (int t = 0; t < 2; ++t) { if (ok[t]) { rms_apply(F.ffn_g, F.lane, u[t]); unsigned char* urow = U2 + (size_t)rr[t] * D;
#pragma unroll
                for (int jj = 0; jj < 4; ++jj) *(unsigned*)(urow + jj * 256 + F.lane * 4) = pk4_fp8(u[t][jj].x, u[t][jj].y, u[t][jj].z, u[t][jj].w); }
            rowdots_put(F.lds, 2 * F.wave + t, F.lane, u[t]); }
        __syncthreads();
        rowdots_mma(F.lds, W, F.wave, F.lane);
        __syncthreads();
        if (F.tid < 256) { const int row = F.tid >> 4, g = F.tid & 15, r = r0 + row; const int b = r / PP, p = r - b * PP;
            const float lg = rowdots_get(F.lds, row, g);
            float mx = lg; mx = fmaxf(mx, __shfl_xor(mx, 1)); mx = fmaxf(mx, __shfl_xor(mx, 2)); mx = fmaxf(mx, __shfl_xor(mx, 4)); mx = fmaxf(mx, __shfl_xor(mx, 8));
            const float ev = expf(lg - mx); float sm = ev; sm += __shfl_xor(sm, 1); sm += __shfl_xor(sm, 2); sm += __shfl_xor(sm, 4); sm += __shfl_xor(sm, 8);
            if (p >= PADF) AFF[((size_t)b * NE + g) * NTOK + (p - PADF)] = ev / sm; }
    }
}

__device__ __forceinline__ void phase_topk(Ctx& F) {
    const float* AFF = (const float*)(F.ws + WS_AFF); int* IDX = (int*)(F.ws + WS_IDX); float* GV = (float*)(F.ws + WS_GV); int* SLOT = (int*)(F.ws + WS_SLOT); unsigned* ROWOFF = (unsigned*)(F.ws + WS_SCAL);
    LAS unsigned* keys = (LAS unsigned*)F.lds; LAS unsigned* hist = keys + 8448; LAS unsigned* misc = hist + 256; LAS unsigned* wtot = misc + 16;
    const int tid = F.tid, lane = F.lane, w = F.wave;
    if (F.vcu >= NB * NE) { convert_wd(F, WD_SPLIT, NE * I_WD, (F.vcu - NB * NE) * 8 + F.wave, (F.G - NB * NE) * 8); return; }
    for (int u = F.vcu; u < NB * NE; u += F.G) {
        const int b = u >> 4, e = u & 15; const float* a = AFF + (size_t)u * NTOK;
        __syncthreads();
        for (int i = tid; i < NTOK; i += 512) keys[i] = __builtin_bit_cast(unsigned, a[i]);
        unsigned prefix = 0u, need = CAP;
        for (int pass = 0; pass < 4; ++pass) {
            const int shift = 24 - 8 * pass;
            if (tid < 256) hist[tid] = 0u;
            __syncthreads();
            for (int i = tid; i < NTOK; i += 512) { const unsigned k = keys[i]; if (pass == 0 || (k >> (shift + 8)) == (prefix >> (shift + 8))) atomicAdd((unsigned*)&hist[(k >> shift) & 255u], 1u); }
            __syncthreads();
            if (w == 0) {
                const int bb = 255 - 4 * lane; const unsigned c0 = hist[bb], c1 = hist[bb - 1], c2 = hist[bb - 2], c3 = hist[bb - 3]; const unsigned tot = c0 + c1 + c2 + c3;
                const float incl_f = wave_scan_incl<false>((float)tot); const unsigned incl = (unsigned)incl_f, excl = incl - tot;
                const bool here = excl < need && need <= incl;
                if (here) { unsigned cum = excl; int sel = bb;
                    if (cum + c0 >= need) sel = bb; else { cum += c0; if (cum + c1 >= need) sel = bb - 1; else { cum += c1; if (cum + c2 >= need) sel = bb - 2; else { cum += c2; sel = bb - 3; } } }
                    misc[0] = prefix | ((unsigned)sel << shift); misc[1] = need - cum; }
            }
            __syncthreads();
            prefix = misc[0]; need = misc[1];
            __syncthreads();
        }
        const int i0 = tid * 17, i1 = (i0 + 17 < NTOK) ? i0 + 17 : NTOK;
        unsigned cg_ = 0u, ce = 0u;
        for (int i = i0; i < i1; ++i) { const unsigned k = keys[i]; cg_ += (k > prefix) ? 1u : 0u; ce += (k == prefix) ? 1u : 0u; }
        unsigned sg = cg_, se = ce;
#pragma unroll
        for (int o = 1; o < 64; o <<= 1) { const unsigned tg = __shfl_up(sg, o), te = __shfl_up(se, o); if (lane >= o) { sg += tg; se += te; } }
        if (lane == 63) { wtot[w] = sg; wtot[8 + w] = se; }
        __syncthreads();
        unsigned og = 0u, oe = 0u;
        for (int j = 0; j < w; ++j) { og += wtot[j]; oe += wtot[8 + j]; }
        unsigned gb = og + sg - cg_, eb = oe + se - ce;
        for (int i = i0; i < i1; ++i) { const unsigned k = keys[i]; int slot = -1;
            if (k > prefix) { slot = (int)(gb + (eb < need ? eb : need)); ++gb; }
            else if (k == prefix) { if (eb < need) slot = (int)(gb + eb); ++eb; }
            SLOT[((size_t)b * NTOK + i) * NE + e] = slot;
            if (slot >= 0) { IDX[(size_t)u * CAP + slot] = i; GV[(size_t)u * CAP + slot] = __builtin_bit_cast(float, k);
                const int j = b * CAP + slot; if (j < 4096) ROWOFF[e * 4096 + j] = (unsigned)(b * PP + PADF + i) * (unsigned)D; } }
    }
}

constexpr size_t WS_HIDT = WS_UN;
constexpr int XT_PITCH = D + 16, HT_PITCH = DFF + 16;
__device__ __forceinline__ void ffn_thin_up(Ctx& F) {
    const unsigned char* U2 = F.ws + WS_ACT1; const int* IDX = (const int*)(F.ws + WS_IDX);
    const unsigned char* WgT = F.ws + WS_WEXP; const unsigned char* WuT = F.ws + WS_WEXP + WEXP_ONE; unsigned char* HIDT = F.ws + WS_HIDT;
    LAS unsigned char* XT = F.lds;
    const int w = F.wave;
    for (int it = F.vcu; it < NE * 22; it += F.G) {
        int tid = F.tid; asm volatile("" : "+v"(tid));
        const int lane = tid & 63, fr = lane & 15, fq = lane >> 4;
        const int e = it / 22, ft = it % 22;
        __syncthreads();
        if (tid < 8 * 64) { const int r = tid >> 6, ch = tid & 63; const int j = 4096 + r, b = j / CAP, slot = j - b * CAP; const int n = IDX[(b * NE + e) * CAP + slot];
            *(LAS u32x4*)(XT + r * XT_PITCH + ch * 16) = *(const u32x4*)(U2 + ((size_t)b * PP + PADF + n) * D + ch * 16); }
        __syncthreads();
        const int f = ft * 128 + w * 16 + fr;
        const unsigned char* wg = WgT + ((size_t)e * DFF + f) * D + 8 * fq; const unsigned char* wu = WuT + ((size_t)e * DFF + f) * D + 8 * fq;
        f32x4 ag = (f32x4){0.f, 0.f, 0.f, 0.f}, au = ag;
#pragma unroll 1
        for (int k8 = 0; k8 < 32; k8 += 16) {
            long bg[16], bu[16];
#pragma unroll
            for (int j = 0; j < 16; ++j) { bg[j] = *(const long*)(wg + (k8 + j) * 32); bu[j] = *(const long*)(wu + (k8 + j) * 32); }
#pragma unroll
            for (int j = 0; j < 16; ++j) { long a = *(const LAS long*)(XT + (fr & 7) * XT_PITCH + (k8 + j) * 32 + 8 * fq); if (fr >= 8) a = 0;
                ag = __builtin_amdgcn_mfma_f32_16x16x32_fp8_fp8(a, bg[j], ag, 0, 0, 0); au = __builtin_amdgcn_mfma_f32_16x16x32_fp8_fp8(a, bu[j], au, 0, 0, 0); }
        }
        if (fq < 2) {
            float hv[4];
#pragma unroll
            for (int rg = 0; rg < 4; ++rg) hv[rg] = fminf(fmaxf(siluf_(ag[rg] * (1.0f / WPRE_UP)) * (au[rg] * (1.0f / WPRE_UP)), -448.0f), 448.0f);
            const unsigned pk = pk4_fp8(hv[0], hv[1], hv[2], hv[3]);
#pragma unroll
            for (int rg = 0; rg < 4; ++rg) HIDT[((size_t)e * 8 + 4 * fq + rg) * DFF + f] = (unsigned char)(pk >> (8 * rg)); }
    }
}
__device__ __forceinline__ void ffn_thin_down(Ctx& F) {
    const unsigned char* WdT = F.ws + WS_WD8; const unsigned char* HIDT = F.ws + WS_HIDT; bf16* YE = (bf16*)(F.ws + WS_YE);
    LAS unsigned char* HT = F.lds;
    const int w = F.wave;
    for (int it = F.vcu; it < NE * 8; it += F.G) {
        int tid = F.tid; asm volatile("" : "+v"(tid));
        const int lane = tid & 63, fr = lane & 15, fq = lane >> 4;
        const int e = it >> 3, dt = it & 7;
        __syncthreads();
        for (int i = tid; i < 8 * 176; i += 512) { const int r = i / 176, ch = i - r * 176; *(LAS u32x4*)(HT + r * HT_PITCH + ch * 16) = *(const u32x4*)(HIDT + ((size_t)e * 8 + r) * DFF + ch * 16); }
        __syncthreads();
        const int d = dt * 128 + w * 16 + fr;
        const unsigned char* wd = WdT + ((size_t)e * D + d) * DFF + 8 * fq;
        f32x4 ay = (f32x4){0.f, 0.f, 0.f, 0.f};
#pragma unroll 1
        for (int k8 = 0; k8 < 88; k8 += 22) {
            long bd[22];
#pragma unroll
            for (int j = 0; j < 22; ++j) bd[j] = *(const long*)(wd + (k8 + j) * 32);
#pragma unroll
            for (int j = 0; j < 22; ++j) { long a = *(const LAS long*)(HT + (fr & 7) * HT_PITCH + (k8 + j) * 32 + 8 * fq); if (fr >= 8) a = 0;
                ay = __builtin_amdgcn_mfma_f32_16x16x32_fp8_fp8(a, bd[j], ay, 0, 0, 0); }
        }
        if (fq < 2) {
#pragma unroll
            for (int rg = 0; rg < 4; ++rg) YE[((size_t)e * EROWSP + 4096 + 4 * fq + rg) * D + d] = (bf16)f2bf(ay[rg] * (1.0f / WPRE_DN)); }
    }
}

struct FinTok { f32x4 h[4]; int slot; };
struct FinY { u32x2 ya[4], yb[4]; float ga, gb; unsigned rest; };
__device__ __forceinline__ void phase_final(Ctx& F) {
    const int* SLOT = (const int*)(F.ws + WS_SLOT); const float* GV = (const float*)(F.ws + WS_GV); const bf16* YE = (const bf16*)(F.ws + WS_YE);
    const int gw = F.vcu * 8 + F.wave, NGW = F.G * 8, lane = F.lane;
    const bf16* DELTA = (const bf16*)(F.ws + WS_DELTA);
    constexpr int NT = NB * SEQ;
#define FIN_STAGE1(t_, K) do { const int _t = (t_); (K).slot = -1; if (_t < NT) { row_load_h1(F.x + (size_t)_t * D, DELTA + (size_t)_t * D, lane, (K).h); \
        const int _b = _t / SEQ, _n = _t - _b * SEQ + NMETA; (K).slot = (lane < 16) ? SLOT[((size_t)_b * NTOK + _n) * NE + lane] : -1; } } while (0)
#define FIN_STAGE2(t_, K, Y) do { const int _t = (t_); unsigned _em = (unsigned)(__ballot((K).slot >= 0) & 0xffffull); (Y).ga = 0.0f; (Y).gb = 0.0f; \
        _Pragma("unroll") for (int jj = 0; jj < 4; ++jj) { (Y).ya[jj] = (u32x2){0u, 0u}; (Y).yb[jj] = (u32x2){0u, 0u}; } \
        if (_em) { const int _b = _t / SEQ; const int _ea = __builtin_ctz(_em); _em &= _em - 1u; const bool _two = _em != 0u; const int _eb = _two ? __builtin_ctz(_em) : _ea; if (_two) _em &= _em - 1u; \
            const int _sa = __shfl((K).slot, _ea), _sb = __shfl((K).slot, _eb); \
            (Y).ga = GV[((size_t)_b * NE + _ea) * CAP + _sa]; (Y).gb = _two ? GV[((size_t)_b * NE + _eb) * CAP + _sb] : 0.0f; \
            const bf16* _ya = YE + ((size_t)_ea * EROWSP + (size_t)_b * CAP + _sa) * D; const bf16* _yb = YE + ((size_t)_eb * EROWSP + (size_t)_b * CAP + _sb) * D; \
            _Pragma("unroll") for (int jj = 0; jj < 4; ++jj) { (Y).ya[jj] = *(const u32x2*)(_ya + jj * 256 + lane * 4); (Y).yb[jj] = *(const u32x2*)(_yb + jj * 256 + lane * 4); } } \
        (Y).rest = _em; } while (0)
    FinTok k0, k1, k2; FinY y0, y1;
    FIN_STAGE1(gw, k0); FIN_STAGE1(gw + NGW, k1);
    FIN_STAGE2(gw, k0, y0);
    for (int t = gw; t < NT; t += NGW) {
        FIN_STAGE2(t + NGW, k1, y1);
        FIN_STAGE1(t + 2 * NGW, k2);
        const int b = t / SEQ;
        float* row = F.out + (size_t)t * D;
        f32x4 v[4];
#pragma unroll
        for (int jj = 0; jj < 4; ++jj) {
            v[jj].x = k0.h[jj].x + y0.ga * bflo(y0.ya[jj].x) + y0.gb * bflo(y0.yb[jj].x); v[jj].y = k0.h[jj].y + y0.ga * bfhi(y0.ya[jj].x) + y0.gb * bfhi(y0.yb[jj].x);
            v[jj].z = k0.h[jj].z + y0.ga * bflo(y0.ya[jj].y) + y0.gb * bflo(y0.yb[jj].y); v[jj].w = k0.h[jj].w + y0.ga * bfhi(y0.ya[jj].y) + y0.gb * bfhi(y0.yb[jj].y); }
        const int myslot = k0.slot;
        unsigned em = y0.rest;
        while (em) {
            const int ea = __builtin_ctz(em); em &= em - 1u; const bool two = em != 0u; const int eb = two ? __builtin_ctz(em) : ea; if (two) em &= em - 1u;
            const int sa = __shfl(myslot, ea), sb = __shfl(myslot, eb);
            const float ga = GV[((size_t)b * NE + ea) * CAP + sa], gb = two ? GV[((size_t)b * NE + eb) * CAP + sb] : 0.0f;
            const bf16* ya = YE + ((size_t)ea * EROWSP + (size_t)b * CAP + sa) * D; const bf16* yb = YE + ((size_t)eb * EROWSP + (size_t)b * CAP + sb) * D;
            u32x2 wa[4], wb[4];
#pragma unroll
            for (int jj = 0; jj < 4; ++jj) { wa[jj] = *(const u32x2*)(ya + jj * 256 + lane * 4); wb[jj] = *(const u32x2*)(yb + jj * 256 + lane * 4); }
#pragma unroll
            for (int jj = 0; jj < 4; ++jj) {
                v[jj].x += ga * bflo(wa[jj].x) + gb * bflo(wb[jj].x); v[jj].y += ga * bfhi(wa[jj].x) + gb * bfhi(wb[jj].x);
                v[jj].z += ga * bflo(wa[jj].y) + gb * bflo(wb[jj].y); v[jj].w += ga * bfhi(wa[jj].y) + gb * bfhi(wb[jj].y); }
        }
        float ss = 0.f;
#pragma unroll
        for (int jj = 0; jj < 4; ++jj) ss += v[jj].x * v[jj].x + v[jj].y * v[jj].y + v[jj].z * v[jj].z + v[jj].w * v[jj].w;
        const float rstd = rsqrtf(wave_sum(ss) * (1.0f / D) + EPS);
#pragma unroll
        for (int jj = 0; jj < 4; ++jj) { const f32x4 gv = *(const f32x4*)(F.fin_g + jj * 256 + lane * 4); *(f32x4*)(row + jj * 256 + lane * 4) = v[jj] * rstd * gv; }
        k0 = k1; k1 = k2; y0 = y1;
    }
#undef FIN_STAGE1
#undef FIN_STAGE2
}

constexpr int N_PHASES = 12;
struct Args { const float* in[17]; float* out; unsigned char* ws; };
#define XB_TMO      128
#define XB_XCNT(j)  (256  + 64 * (j))
#define XB_XSUB(j)  (1280 + 64 * (j))
#define XB_XGEN(j)  (2304 + 64 * (j))
#define XB_TOP      3328
#define XB_TOPGEN   3392
#define XCD_BAR_WORDS 3456
#define XB_SPIN_CAP (1u << 22)
__device__ __forceinline__ unsigned xb_ld(unsigned* p)              { return __hip_atomic_load(p, __ATOMIC_RELAXED, __HIP_MEMORY_SCOPE_AGENT); }
__device__ __forceinline__ unsigned xb_add(unsigned* p, unsigned v) { return __hip_atomic_fetch_add(p, v, __ATOMIC_RELAXED, __HIP_MEMORY_SCOPE_AGENT); }
__device__ __forceinline__ unsigned xb_xcc_id() { return (unsigned)__builtin_amdgcn_s_getreg((3 << 11) | 20) & 0xFu; }
#define XB_SPIN(cond, bar) do { unsigned _sp = 0; while (cond) { __builtin_amdgcn_s_sleep(1); \
    if ((++_sp & 255u) == 0u) { if (xb_ld(&(bar)[XB_TMO])) break; if (_sp > XB_SPIN_CAP) { atomicAdd(&(bar)[XB_TMO], 1u); break; } } } } while (0)
struct XcdBarrier { unsigned* bar; unsigned x; volatile LAS unsigned* st; };
__device__ __forceinline__ XcdBarrier xcd_barrier_post(unsigned* bar, volatile LAS unsigned* st) {
    XcdBarrier b; b.bar = bar; b.x = xb_xcc_id(); b.st = st;
    if (threadIdx.x == 0) (void)xb_add(&bar[XB_XCNT(b.x)], 1u);
    return b;
}
__device__ __forceinline__ void xcd_barrier_complete(unsigned* bar, unsigned x, unsigned& nloc, unsigned& nx) {
    const unsigned G = gridDim.x * gridDim.y * gridDim.z;
    unsigned sum, cnt, mine, sp = 0u;
    for (;;) {
        sum = 0u; cnt = 0u; mine = 0u;
#pragma unroll
        for (unsigned j = 0; j < 16; ++j) { const unsigned c = xb_ld(&bar[XB_XCNT(j)]); sum += c; cnt += (c > 0u) ? 1u : 0u; mine = (j == x) ? c : mine; }
        if (sum == G) break;
        __builtin_amdgcn_s_sleep(1);
        if ((++sp & 255u) == 0u) { if (xb_ld(&bar[XB_TMO])) break; if (sp > XB_SPIN_CAP) { atomicAdd(&bar[XB_TMO], 1u); break; } }
    }
    nloc = mine > 0u ? mine : 1u; nx = cnt > 0u ? cnt : 1u;
}
__device__ __forceinline__ void xcd_barrier(const XcdBarrier& b) {
    asm volatile("s_waitcnt vmcnt(0)" ::: "memory");
    __syncthreads();
    if (threadIdx.x == 0) {
        unsigned* bar = b.bar;
        __builtin_amdgcn_s_waitcnt(0);
        unsigned nloc = b.st[0], nx = b.st[1];
        if (nloc == 0u) { xcd_barrier_complete(bar, b.x, nloc, nx); b.st[0] = nloc; b.st[1] = nx; }
        const unsigned old = xb_add(&bar[XB_XSUB(b.x)], 1u);
        const unsigned gen = old / nloc;
        if (old + 1u == (gen + 1u) * nloc) {
            __builtin_amdgcn_fence(__ATOMIC_RELEASE, "agent");
            asm volatile("s_waitcnt vmcnt(0)" ::: "memory");
            const unsigned og = xb_add(&bar[XB_TOP], 1u);
            const unsigned tg = og / nx;
            if (og + 1u == (tg + 1u) * nx) xb_add(&bar[XB_TOPGEN], 1u);
            else XB_SPIN(xb_ld(&bar[XB_TOPGEN]) == tg, bar);
            __builtin_amdgcn_fence(__ATOMIC_ACQUIRE, "agent");
            xb_add(&bar[XB_XGEN(b.x)], 1u);
            asm volatile("s_waitcnt vmcnt(0)" ::: "memory");
        } else {
            XB_SPIN(xb_ld(&bar[XB_XGEN(b.x)]) == gen, bar);
            __builtin_amdgcn_fence(__ATOMIC_ACQUIRE, "agent");
            asm volatile("s_waitcnt vmcnt(0)" ::: "memory");
        }
    }
    __syncthreads();
}
constexpr int MISC_OFF = LDS_BYTES - 16;

typedef const __attribute__((address_space(4))) Args* ArgsP;
__device__ __forceinline__ void make_ctx(Ctx& F, unsigned char* lds_raw) {
    ArgsP A = (ArgsP)__builtin_amdgcn_kernarg_segment_ptr(); asm volatile("" : "+s"(A));
    F.lds = (LAS unsigned char*)lds_raw;
    { int t = threadIdx.x; asm volatile("" : "+v"(t)); F.tid = t; } F.lane = F.tid & 63; F.wave = __builtin_amdgcn_readfirstlane(F.tid >> 6);
    F.G = gridDim.x; { const int bx = blockIdx.x; F.vcu = (F.G % 8 == 0) ? (bx % 8) * (F.G / 8) + bx / 8 : bx; }
    F.x = A->in[0]; F.meta = A->in[1]; F.mix_g = A->in[2]; F.w_in = A->in[3]; F.b_gates = A->in[4]; F.conv_w = A->in[5]; F.conv_b = A->in[6];
    F.ret_logit = A->in[7]; F.ret_gn = A->in[8]; F.ml_gn = A->in[9]; F.w_out = A->in[10]; F.ffn_g = A->in[11]; F.w_router = A->in[12];
    F.w_gate = A->in[13]; F.w_up = A->in[14]; F.w_down = A->in[15]; F.fin_g = A->in[16];
    F.out = A->out; F.ws = A->ws;
}
template <int LO, int HI> __global__ void __launch_bounds__(512, 2) mk_fwd(Args args) {
    extern __shared__ __attribute__((aligned(16))) unsigned char lds_raw[];
#if MK_SPLIT
#define GRID_BAR() do {} while (0)
#elif MK_BARRIER == 0
    cg::grid_group grid = cg::this_grid();
#define GRID_BAR() grid.sync()
#else
    XcdBarrier xbar;
    {   volatile LAS unsigned* st = (volatile LAS unsigned*)((LAS unsigned char*)lds_raw + MISC_OFF);
        if (threadIdx.x < 4) st[threadIdx.x] = 0u;
        __syncthreads();
        ArgsP A0 = (ArgsP)__builtin_amdgcn_kernarg_segment_ptr();
        xbar = xcd_barrier_post((unsigned*)A0->ws, st); }
#define GRID_BAR() xcd_barrier(xbar)
#endif
#define IN(k) (LO <= (k) && (k) < HI)
#define SEAM(k) do { if (IN(k) && IN((k) + 1)) GRID_BAR(); } while (0)
#define CTX() Ctx F; make_ctx(F, lds_raw)

    if (IN(0)) { CTX(); phase_prep(F); } SEAM(0);
    if (IN(1)) {
        CTX();
        pg8::DenseOrder S{(const bf16*)(F.ws + WS_ACT1), (const bf16*)(F.ws + WS_WINT), D, D, NB * SEQ / 256, PC / 256, (NB * SEQ / 256) * (PC / 256), F.G, (int)blockIdx.x};
        pg8::EpiProj E{(bf16*)(F.ws + WS_PROJ), (const f32x2*)(F.ws + WS_ROPE)};
        pg8::gemm_phase(F.lds, D, S, E);
        proj_meta(F);
    } SEAM(1);
    if (IN(2)) { CTX(); phase_rope_conv(F); } SEAM(2);
    if (IN(3)) { CTX(); phase_seg_summary(F); } SEAM(3);
    if (IN(4)) { CTX(); phase_seq(F); } SEAM(4);
    if (IN(5)) { CTX(); phase_combine(F); } SEAM(5);
    if (IN(6)) {
        CTX();
        pg8::DenseOrder S{(const bf16*)(F.ws + WS_ACT2), (const bf16*)(F.ws + WS_WOUTT), D, D, NB * SEQ / 256, D / 256, (NB * SEQ / 256) * (D / 256), F.G, (int)blockIdx.x};
        pg8::EpiDelta E{(bf16*)(F.ws + WS_DELTA)};
        pg8::gemm_phase(F.lds, D, S, E);
        out_meta(F);
    } SEAM(6);
    if (IN(7)) { CTX(); phase_router(F); } SEAM(7);
    if (IN(8)) { CTX(); phase_topk(F); } SEAM(8);
    if (IN(9)) {
        CTX();
        pg8::FfnUpOrder S{F.ws + WS_ACT1, (const unsigned*)(F.ws + WS_SCAL), F.ws + WS_WEXP, F.ws + WS_WEXP + WEXP_ONE, D / 2, D / 2, NE * 22 * 16, F.G, F.vcu};
        pg8::EpiSwiglu E{F.ws + WS_HID};
        pg8::gemm_phase(F.lds, D / 2, S, E);
        ffn_thin_up(F);
    } SEAM(9);
    if (IN(10)) {
        CTX();
        pg8::FfnDownOrder S{F.ws + WS_HID, F.ws + WS_WD8, DFF / 2, DFF / 2, NE * 4 * 16, F.G, F.vcu};
        pg8::EpiStoreBf16 E{(bf16*)(F.ws + WS_YE), D, (size_t)EROWSP * D};
        pg8::gemm_phase(F.lds, DFF / 2, S, E);
        ffn_thin_down(F);
    } SEAM(10);
    if (IN(11)) { CTX(); phase_final(F); }
#undef IN
#undef SEAM
#undef CTX
}

template <int PH> static void launch_split(int grid, hipStream_t stream, const Args& a) {
    if constexpr (PH < N_PHASES) {
        static bool attr = false;
        if (!attr) { (void)hipFuncSetAttribute((const void*)mk_fwd<PH, PH + 1>, hipFuncAttributeMaxDynamicSharedMemorySize, LDS_BYTES); attr = true; }
        hipLaunchKernelGGL((mk_fwd<PH, PH + 1>), dim3(grid), dim3(512), LDS_BYTES, stream, a);
        if ((PROBE_MASK >> PH) & 1) hipLaunchKernelGGL((mk_fwd<PH, PH + 1>), dim3(grid), dim3(512), LDS_BYTES, stream, a);
        launch_split<PH + 1>(grid, stream, a);
    }
}
extern "C" void kernel_launch(void* const* d_in, const int* in_sizes, int n_in, void* d_out, int out_size, void* d_ws, size_t ws_size, hipStream_t stream) {
    static int grid = 0;
    if (grid == 0) {
        if (n_in != 17 || out_size != NB * SEQ * D || ws_size < WS_END) { fprintf(stderr, "kernel_launch: unexpected shapes (n_in %d out %d ws %zu need %zu)\n", n_in, out_size, ws_size, (size_t)WS_END); grid = -1; return; }
        int dev = 0, cus = 0;
        if (hipGetDevice(&dev) != hipSuccess || hipDeviceGetAttribute(&cus, hipDeviceAttributeMultiprocessorCount, dev) != hipSuccess) { grid = -1; return; }
#if !MK_SPLIT
        int per_cu = 0;
        if (hipFuncSetAttribute((const void*)mk_fwd<0, N_PHASES>, hipFuncAttributeMaxDynamicSharedMemorySize, LDS_BYTES) != hipSuccess) { fprintf(stderr, "kernel_launch: hipFuncSetAttribute failed\n"); grid = -1; return; }
        if (hipOccupancyMaxActiveBlocksPerMultiprocessor(&per_cu, (const void*)mk_fwd<0, N_PHASES>, 512, LDS_BYTES) != hipSuccess || per_cu < 1) { fprintf(stderr, "kernel_launch: occupancy query says %d\n", per_cu); }
#endif
        (void)hipGetLastError();
        grid = cus;
    }
    if (grid < 0) return;
    Args a{};
    for (int i = 0; i < 17; ++i) a.in[i] = (const float*)d_in[i];
    a.out = (float*)d_out; a.ws = (unsigned char*)d_ws;
#if MK_SPLIT
    launch_split<0>(grid, stream, a);
#else
#if MK_BARRIER == 0
    void* kargs[] = {&a};
    hipError_t e = hipLaunchCooperativeKernel((const void*)mk_fwd<0, N_PHASES>, dim3(grid), dim3(512), kargs, LDS_BYTES, stream);
    if (e != hipSuccess) fprintf(stderr, "cooperative launch failed: %s (grid %d)\n", hipGetErrorString(e), grid);
#else
    if (hipMemsetAsync(d_ws, 0, 16384, stream) != hipSuccess) { fprintf(stderr, "kernel_launch: memset of barrier words failed\n"); return; }
    hipLaunchKernelGGL((mk_fwd<0, N_PHASES>), dim3(grid), dim3(512), LDS_BYTES, stream, a);
#endif
#endif
}
```

```cpp
#include <hip/hip_runtime.h>
#include <hip/hip_cooperative_groups.h>
#include <cstdio>
#include <cstdint>
namespace cg = cooperative_groups;

#ifndef MK_SPLIT
#define MK_SPLIT 0
#endif
#ifndef PROBE_MASK
#define PROBE_MASK 0
#endif
#ifndef MK_BARRIER
#define MK_BARRIER 1
#endif

#define GAS __attribute__((address_space(1)))
#define LAS __attribute__((address_space(3)))
typedef unsigned short bf16;
typedef short bf16x8 __attribute__((ext_vector_type(8)));
typedef float f32x4 __attribute__((ext_vector_type(4)));
typedef float f32x2 __attribute__((ext_vector_type(2)));
typedef unsigned u32x4 __attribute__((ext_vector_type(4)));
typedef unsigned u32x2 __attribute__((ext_vector_type(2)));
typedef int i32x8 __attribute__((ext_vector_type(8)));
typedef int i32x4 __attribute__((ext_vector_type(4)));

constexpr int NB = 4, SEQ = 8192, D = 1024, NMETA = 16, CHK = 128, PADF = 112;
constexpr int NTOK = NMETA + SEQ;
constexpr int PP = NTOK + PADF;
constexpr int NCH = PP / CHK;
constexpr int R = NB * PP;
constexpr int PCOLS = 4112, PC = 4096;
constexpr int NE = 16, CAP = 1026, DFF = 2816, EROWS = NB * CAP, EROWSP = 4352;
constexpr int NH = 4;
constexpr float EPS = 1e-6f, NEGF = -1e30f;
constexpr int WSC_UP = 0x7A7A7A7A, WSC_DN = 0x79797979;
constexpr float WPRE_UP = 32.0f, WPRE_DN = 64.0f;

constexpr size_t MiB = 1u << 20;
constexpr size_t WS_ROPE = 1 * MiB, WS_GATES = 6 * MiB, WS_AFF = 9 * MiB, WS_IDX = 12 * MiB, WS_GV = 13 * MiB, WS_SLOT = 14 * MiB;
constexpr size_t WS_H1META = 17 * MiB, WS_UN = 18 * MiB, WS_SCAL = 21 * MiB, WS_WINT = 22 * MiB, WS_WOUTT = 30 * MiB;
constexpr size_t WS_ACT1 = 32 * MiB;
constexpr size_t WS_ACT2 = 97 * MiB;
constexpr size_t WS_PROJ = 162 * MiB;
constexpr size_t WS_STATE = 422 * MiB;
constexpr size_t WS_YE = 97 * MiB;
constexpr size_t WS_WEXP = 233 * MiB;
constexpr size_t WS_HID = 365 * MiB;
constexpr size_t WS_WD8 = 568 * MiB;
constexpr size_t WS_DELTA = 612 * MiB;
constexpr size_t WS_END = 684 * MiB;
constexpr size_t WEXP_ONE = (size_t)NE * DFF * D;
static_assert(WS_PROJ + (size_t)R * PC * 2 <= WS_STATE && WS_STATE + (size_t)64 * NCH * 16384 * 4 <= WS_END, "mixer map");
static_assert(WS_YE + (size_t)NE * EROWSP * D * 2 <= WS_WEXP && WS_WEXP + 2 * WEXP_ONE <= WS_HID && WS_WD8 + WEXP_ONE <= WS_DELTA && WS_DELTA + (size_t)NB * SEQ * D * 2 <= WS_END && WS_HID + (size_t)NE * 4096 * DFF <= WS_END, "ffn map");

constexpr int LDS_BYTES = 155648;
constexpr int TP = 136;
constexpr int T0_OFF = 0, T1_OFF = 34816, T2_OFF = 69632, T3_OFF = 104448, VEC_OFF = 139264;

__device__ __forceinline__ unsigned f2bf(float f) { unsigned u = __builtin_bit_cast(unsigned, f); return (u + 0x7fffu + ((u >> 16) & 1u)) >> 16; }
__device__ __forceinline__ unsigned pk2(float lo, float hi) { unsigned r; asm("v_cvt_pk_bf16_f32 %0, %1, %2" : "=v"(r) : "v"(lo), "v"(hi)); return r; }
__device__ __forceinline__ unsigned cvtpk(float lo, float hi) { unsigned r; asm("v_cvt_pk_bf16_f32 %0, %1, %2" : "=v"(r) : "v"(lo), "v"(hi)); return r; }
__device__ __forceinline__ unsigned pk4_fp8(float a, float b, float c, float d) { int p = __builtin_amdgcn_cvt_pk_fp8_f32(a, b, 0, false); p = __builtin_amdgcn_cvt_pk_fp8_f32(c, d, p, true); return (unsigned)p; }
__device__ __forceinline__ float bf2f(unsigned b) { return __builtin_bit_cast(float, b << 16); }
__device__ __forceinline__ float bflo(unsigned w) { return __builtin_bit_cast(float, w << 16); }
__device__ __forceinline__ float bfhi(unsigned w) { return __builtin_bit_cast(float, w & 0xffff0000u); }
template <bool MAXOP>
__device__ __forceinline__ float wave_scan_incl(float v) {
    const int idn = __builtin_bit_cast(int, MAXOP ? -3.0e38f : 0.0f);
#define DPP_STEP(ctrl, rmask) { const float t = __builtin_bit_cast(float, __builtin_amdgcn_update_dpp(idn, __builtin_bit_cast(int, v), ctrl, rmask, 0xF, false)); v = MAXOP ? fmaxf(v, t) : v + t; }
    DPP_STEP(0x111, 0xF) DPP_STEP(0x112, 0xF) DPP_STEP(0x114, 0xF) DPP_STEP(0x118, 0xF) DPP_STEP(0x142, 0xA) DPP_STEP(0x143, 0xC)
#undef DPP_STEP
    return v;
}
__device__ __forceinline__ float wave_sum(float v) { v = wave_scan_incl<false>(v); return __builtin_bit_cast(float, __builtin_amdgcn_readlane(__builtin_bit_cast(int, v), 63)); }
__device__ __forceinline__ float wave_max(float v) { v = wave_scan_incl<true>(v); return __builtin_bit_cast(float, __builtin_amdgcn_readlane(__builtin_bit_cast(int, v), 63)); }
__device__ __forceinline__ float sigmoidf_(float x) { return __builtin_amdgcn_rcpf(1.0f + __expf(-x)); }
__device__ __forceinline__ float siluf_(float x) { return x * __builtin_amdgcn_rcpf(1.0f + __expf(-x)); }
__device__ __forceinline__ float logsigmoidf_(float x) { return fminf(x, 0.0f) - log1pf(__expf(-fabsf(x))); }
#define LDS_WAIT() asm volatile("s_waitcnt lgkmcnt(0)" ::: "memory")

namespace pg8 {
constexpr int BM = 256, BK = 64, HALF = 128, HTB = HALF * BK * 2, STAGE_BYTES = 8 * HTB;
__device__ __forceinline__ int lds_byte(int r, int c) { const int st = (r >> 4) * 2 + (c >> 5), rr = r & 15, cc = c & 31, ob = rr * 64 + cc * 2; return st * 1024 + (ob ^ (((ob >> 9) & 1) << 5)); }
__device__ __forceinline__ void stage_rc(int b, int& Rr, int& C) { const int st = b / 1024, sb = b % 1024, swz = sb ^ (((sb >> 9) & 1) << 5); Rr = (st >> 1) * 16 + swz / 64; C = (st & 1) * 32 + (swz % 64) / 2; }
__device__ __forceinline__ int perm32(int rho) { const int n = rho >> 4, i = rho & 15; return 8 * (i >> 2) + 4 * n + (i & 3); }
__device__ __forceinline__ unsigned cvt_pk_bf16(float lo, float hi) { unsigned r; asm volatile("v_cvt_pk_bf16_f32 %0, %1, %2" : "=v"(r) : "v"(lo), "v"(hi)); return r; }

struct Unit { int pm, pn, e, row0; };
struct UAddr { const char* a0; const char* a1; const char* b0; const char* b1; };

template <class Epi, class Sched>
__device__ __forceinline__ void gemm_phase(LAS unsigned char* lds, const int K, const Sched& S, const Epi& E) {
    int tid_ = threadIdx.x; asm volatile("" : "+v"(tid_));
    const int tid = tid_, wid = __builtin_amdgcn_readfirstlane(tid >> 6), lane = tid & 63, wr = wid >> 2, wc = wid & 3, fr = lane & 15, fq = lane >> 4;
    const int nt = K / BK;
    unsigned voffB[2], voffA0 = 0, voffA1 = 0, colb = 0;
    int sR0, sC0;
    {   int sR1, sC1; stage_rc(tid * 16, sR0, sC0); stage_rc(tid * 16 + 8192, sR1, sC1);
        const int Rb0 = Epi::PERM ? ((sR0 & ~31) + perm32(sR0 & 31)) : sR0, Rb1 = Epi::PERM ? ((sR1 & ~31) + perm32(sR1 & 31)) : sR1;
        voffB[0] = (unsigned)(Rb0 * S.ldb + sC0) * 2u; voffB[1] = (unsigned)(Rb1 * S.ldb + sC1) * 2u;
        if constexpr (!Sched::GATHER) { voffA0 = (unsigned)(sR0 * S.lda + sC0) * 2u; voffA1 = (unsigned)(sR1 * S.lda + sC1) * 2u; } else colb = (unsigned)sC0 * 2u; }
    LAS unsigned* const tab = (LAS unsigned*)(lds + STAGE_BYTES);
    const LAS unsigned* const tabp = tab + sR0;
    const size_t kstep = (size_t)(BK * 2);
    const unsigned ldsw = (unsigned)wid * 1024u;
    constexpr bool FP8 = Sched::FP8;
    const int aoff = FP8 ? lds_byte(wr * 64 + fr, fq * 16) : lds_byte(wr * 64 + fr, fq * 8), boff = FP8 ? lds_byte(wc * 32 + fr, fq * 16) : lds_byte(wc * 32 + fr, fq * 8);
    int wsc_v = S.wscale, one_v = 0x7F7F7F7F; asm volatile("" : "+v"(wsc_v), "+v"(one_v));
#define PG8_SA(b, h) (((b) * 2 + (h)) * HTB)
#define PG8_SB(b, h) ((4 + (b) * 2 + (h)) * HTB)
#define PG8_STAGE(bufoff, gbase, v0, v1) do { \
        __builtin_amdgcn_global_load_lds((const unsigned*)((const char*)(gbase) + (v0)), (LAS unsigned*)(lds + (bufoff) + ldsw), 16, 0, 0); \
        __builtin_amdgcn_global_load_lds((const unsigned*)((const char*)(gbase) + (v1)), (LAS unsigned*)(lds + (bufoff) + ldsw + 8192), 16, 0, 0); } while (0)
#define PG8_STAGE_A(bufoff, gbase, slot, h) do { if constexpr (Sched::GATHER) { const unsigned _r0 = tabp[(slot) * 256 + (h) * 128] + colb, _r1 = tabp[(slot) * 256 + (h) * 128 + 64] + colb; PG8_STAGE(bufoff, gbase, _r0, _r1); } \
        else PG8_STAGE(bufoff, gbase, voffA0, voffA1); } while (0)
#define PG8_LD32(p) __builtin_shufflevector(*(const LAS i32x4*)(p), *(const LAS i32x4*)((p) + 16), 0, 1, 2, 3, 4, 5, 6, 7)
#define PG8_LDA(dst, b, h) do { if constexpr (FP8) { _Pragma("unroll") for (int m = 0; m < 4; ++m) dst##8[m] = PG8_LD32(lds + PG8_SA(b, h) + aoff + m * 2048); } \
        else { _Pragma("unroll") for (int m = 0; m < 4; ++m) _Pragma("unroll") for (int k = 0; k < 2; ++k) dst[m][k] = *(const LAS bf16x8*)(lds + PG8_SA(b, h) + aoff + m * 2048 + k * 1024); } } while (0)
#define PG8_LDB(dst, b, h) do { if constexpr (FP8) { _Pragma("unroll") for (int n = 0; n < 2; ++n) dst##8[n] = PG8_LD32(lds + PG8_SB(b, h) + boff + n * 2048); } \
        else { _Pragma("unroll") for (int n = 0; n < 2; ++n) _Pragma("unroll") for (int k = 0; k < 2; ++k) dst[n][k] = *(const LAS bf16x8*)(lds + PG8_SB(b, h) + boff + n * 2048 + k * 1024); } } while (0)
#define PG8_MMA_FULL(ai, bj, At, Bt) do { __builtin_amdgcn_s_setprio(1); \
        if constexpr (FP8) { _Pragma("unroll") for (int m = 0; m < 4; ++m) _Pragma("unroll") for (int n = 0; n < 2; ++n) \
            asm volatile("v_mfma_scale_f32_16x16x128_f8f6f4 %0, %1, %2, %0, %3, %4 op_sel_hi:[0,0,0]" : "+v"(acc[ai][bj][m][n]) : "v"(Bt##8[n]), "v"(At##8[m]), "v"(wsc_v), "v"(one_v)); } \
        else { _Pragma("unroll") for (int m = 0; m < 4; ++m) _Pragma("unroll") for (int n = 0; n < 2; ++n) _Pragma("unroll") for (int k = 0; k < 2; ++k) \
            acc[ai][bj][m][n] = __builtin_amdgcn_mfma_f32_16x16x32_bf16(Bt[n][k], At[m][k], acc[ai][bj][m][n], 0, 0, 0); } \
        __builtin_amdgcn_s_setprio(0); } while (0)
#define PG8_MMA_THIN(ai, bj, At, Bt) do { if (!FP8 && (ai) == 0 && wr == 0) { _Pragma("unroll") for (int n = 0; n < 2; ++n) _Pragma("unroll") for (int k = 0; k < 2; ++k) \
        acc[0][bj][0][n] = __builtin_amdgcn_mfma_f32_16x16x32_bf16(Bt[n][k], At[0][k], acc[0][bj][0][n], 0, 0, 0); } } while (0)
#define PG8_WAIT_V(n) asm volatile("s_waitcnt vmcnt(" #n ")" ::: "memory")
#define PG8_WAIT_L(n) asm volatile("s_waitcnt lgkmcnt(" #n ")" ::: "memory")
#define PG8_BAR __builtin_amdgcn_s_barrier()
#define PG8_SCHED __builtin_amdgcn_sched_barrier(0)
    Unit cur, nxt; int ui = 0;
    if (!S.next(0, cur)) return;
    f32x4 acc[2][2][4][2];
#pragma unroll
    for (int a = 0; a < 2; ++a)
#pragma unroll
        for (int b = 0; b < 2; ++b)
#pragma unroll
            for (int m = 0; m < 4; ++m)
#pragma unroll
                for (int n = 0; n < 2; ++n) acc[a][b][m][n] = (f32x4){0.f, 0.f, 0.f, 0.f};
    bf16x8 At[4][2], B0[2][2], B1[2][2]; i32x8 At8[4], B08[2], B18[2];
    UAddr cu, nx;
    S.addr(cur, cu);
    if constexpr (Sched::GATHER) {
        if (tid < 256) __builtin_amdgcn_global_load_lds((const unsigned*)(S.rowoff_ptr(cur) + tid), (LAS unsigned*)(tab + wid * 64), 4, 0, 0);
        asm volatile("s_waitcnt vmcnt(0)" ::: "memory"); __syncthreads(); }
    PG8_STAGE(PG8_SB(0, 0), cu.b0, voffB[0], voffB[1]); PG8_STAGE(PG8_SB(0, 1), cu.b1, voffB[0], voffB[1]); PG8_STAGE_A(PG8_SA(0, 0), cu.a0, 0, 0); PG8_STAGE_A(PG8_SA(0, 1), cu.a1, 0, 1);
    if (wr == 1) PG8_BAR;
    PG8_WAIT_V(2); PG8_BAR;
    PG8_STAGE(PG8_SB(1, 0), cu.b0 + kstep, voffB[0], voffB[1]); PG8_STAGE_A(PG8_SA(1, 0), cu.a0 + kstep, 0, 0); PG8_STAGE(PG8_SB(1, 1), cu.b1 + kstep, voffB[0], voffB[1]);
    PG8_WAIT_V(6); PG8_BAR;
    for (;;) {
        const bool has_next = S.next(ui + 1, nxt);
        const bool thin = Sched::HAS_THIN && S.thin(cur);
        const int cs = ui & 1, ns = has_next ? (cs ^ 1) : cs;
        if (has_next) { S.addr(nxt, nx); if constexpr (Sched::GATHER) { if (tid < 256) __builtin_amdgcn_global_load_lds((const unsigned*)(S.rowoff_ptr(nxt) + tid), (LAS unsigned*)(tab + (cs ^ 1) * 256 + wid * 64), 4, 0, 0); } } else nx = cu;
#define PG8_KLOOP(MMA) \
        for (int t = 0; t < nt; t += 2) { \
            const bool last = (t == nt - 2); \
            const char* a1h1 = cu.a1 + (size_t)(t + 1) * kstep; \
            const char* a2h0 = last ? nx.a0 : cu.a0 + (size_t)(t + 2) * kstep; const char* a2h1 = last ? nx.a1 : cu.a1 + (size_t)(t + 2) * kstep; \
            const char* b2h0 = last ? nx.b0 : cu.b0 + (size_t)(t + 2) * kstep; const char* b2h1 = last ? nx.b1 : cu.b1 + (size_t)(t + 2) * kstep; \
            const int s2 = last ? ns : cs; \
              \
            PG8_LDB(B0, 0, 0); PG8_LDB(B1, 0, 1); PG8_SCHED; PG8_LDA(At, 0, 0); PG8_STAGE_A(PG8_SA(1, 1), a1h1, cs, 1); \
            PG8_WAIT_V(8); PG8_WAIT_L(0); PG8_BAR; MMA(0, 0, At, B0); MMA(0, 1, At, B1); PG8_BAR; PG8_SCHED; \
              \
            PG8_LDA(At, 0, 1); PG8_STAGE(PG8_SB(0, 0), b2h0, voffB[0], voffB[1]); PG8_STAGE(PG8_SB(0, 1), b2h1, voffB[0], voffB[1]); PG8_STAGE_A(PG8_SA(0, 0), a2h0, s2, 0); \
            PG8_WAIT_V(8); PG8_WAIT_L(0); PG8_BAR; MMA(1, 0, At, B0); MMA(1, 1, At, B1); PG8_BAR; PG8_SCHED; \
              \
            PG8_LDB(B0, 1, 0); PG8_LDB(B1, 1, 1); PG8_SCHED; PG8_LDA(At, 1, 0); PG8_STAGE_A(PG8_SA(0, 1), a2h1, s2, 1); \
            PG8_WAIT_V(8); PG8_WAIT_L(0); PG8_BAR; MMA(0, 0, At, B0); MMA(0, 1, At, B1); PG8_BAR; PG8_SCHED; \
              \
            PG8_LDA(At, 1, 1); PG8_STAGE(PG8_SB(1, 0), b2h0 + kstep, voffB[0], voffB[1]); PG8_STAGE(PG8_SB(1, 1), b2h1 + kstep, voffB[0], voffB[1]); PG8_STAGE_A(PG8_SA(1, 0), a2h0 + kstep, s2, 0); \
            PG8_WAIT_V(8); PG8_WAIT_L(0); PG8_BAR; MMA(1, 0, At, B0); MMA(1, 1, At, B1); PG8_BAR; PG8_SCHED; \
        }
        if (Sched::HAS_THIN && thin) { PG8_KLOOP(PG8_MMA_THIN) } else { PG8_KLOOP(PG8_MMA_FULL) }
#undef PG8_KLOOP
        if (wr == 0) PG8_BAR;
        if constexpr (FP8) asm volatile("s_nop 15\n\ts_nop 15" ::: "memory");
        { int fr_e = fr, fq_e = fq; asm volatile("" : "+v"(fr_e), "+v"(fq_e));
          E(acc, cur, wr, wc, fr_e, fq_e); }
        if (!has_next) break;
#pragma unroll
        for (int a = 0; a < 2; ++a)
#pragma unroll
            for (int b = 0; b < 2; ++b)
#pragma unroll
                for (int m = 0; m < 4; ++m)
#pragma unroll
                    for (int n = 0; n < 2; ++n) acc[a][b][m][n] = (f32x4){0.f, 0.f, 0.f, 0.f};
        cur = nxt; cu = nx; ++ui;
        if (wr == 1) PG8_BAR;
    }
    PG8_WAIT_V(0);
    PG8_BAR;
#undef PG8_SA
#undef PG8_SB
#undef PG8_STAGE
#undef PG8_STAGE_A
#undef PG8_LDA
#undef PG8_LDB
#undef PG8_MMA_THIN
#undef PG8_LD32
#undef PG8_MMA_FULL
#undef PG8_WAIT_V
#undef PG8_WAIT_L
#undef PG8_BAR
#undef PG8_SCHED
}

struct DenseOrder {
    static constexpr bool GATHER = false, HAS_THIN = false, FP8 = false; static constexpr int wscale = 0;
    __device__ __forceinline__ bool thin(const Unit&) const { return false; }
    const bf16* A; const bf16* Bt; int lda, ldb; int nM, nN, nwg, G, c;
    __device__ __forceinline__ const unsigned* rowoff_ptr(const Unit&) const { return nullptr; }
    __device__ __forceinline__ bool next(int i, Unit& u) const {
        const long L = (long)i * G + c; if (L >= nwg) return false;
        int wgid = (int)L; { const int q = nwg / 8, r = nwg % 8, xcd = wgid % 8, off = wgid / 8; wgid = (xcd < r ? xcd * (q + 1) : r * (q + 1) + (xcd - r) * q) + off; }
        const int nig = 8 * nN, gid = wgid / nig, fm = gid * 8, gsz = (nM - fm) < 8 ? (nM - fm) : 8;
        u.pm = fm + ((wgid % nig) % gsz); u.pn = (wgid % nig) / gsz; u.e = 0; u.row0 = (u.pm >> 5) * PP + CHK + 256 * (u.pm & 31); return true;
    }
    __device__ __forceinline__ void addr(const Unit& u, UAddr& g) const {
        g.a0 = (const char*)(A + (size_t)u.row0 * lda); g.a1 = g.a0 + (size_t)128 * lda * 2;
        g.b0 = (const char*)(Bt + (size_t)u.pn * 256 * ldb); g.b1 = g.b0 + (size_t)128 * ldb * 2;
    }
};
struct FfnUpOrder {
    static constexpr bool GATHER = true, HAS_THIN = false, FP8 = true; static constexpr int wscale = WSC_UP;
    __device__ __forceinline__ bool thin(const Unit&) const { return false; }
    const unsigned char* U2; const unsigned* ROWOFF; const unsigned char* WgT; const unsigned char* WuT; int lda, ldb; int nunits, G, c;
    __device__ __forceinline__ bool next(int i, Unit& u) const {
        const int L = i * G + c; if (L >= nunits) return false;
        const int e = L / (22 * 16), rem = L - e * (22 * 16); u.e = e;
        if (rem < 320) { const int blk = rem >> 5, idx = rem & 31, h = blk / 5, pq = blk - 5 * h; u.pn = 4 * pq + (idx >> 3); u.pm = 8 * h + (idx & 7); }
        else { const int r = rem - 320, h = r >> 4, idx = r & 15; u.pn = 20 + (idx >> 3); u.pm = 8 * h + (idx & 7); }
        u.row0 = u.pm * 256; return true;
    }
    __device__ __forceinline__ const unsigned* rowoff_ptr(const Unit& u) const { return ROWOFF + u.e * 4096 + u.pm * 256; }
    __device__ __forceinline__ void addr(const Unit& u, UAddr& g) const {
        g.a0 = (const char*)U2; g.a1 = g.a0;
        g.b0 = (const char*)(WgT + ((size_t)u.e * DFF + (size_t)u.pn * 128) * D); g.b1 = (const char*)(WuT + ((size_t)u.e * DFF + (size_t)u.pn * 128) * D);
    }
};
struct FfnDownOrder {
    static constexpr bool GATHER = false, HAS_THIN = false, FP8 = true; static constexpr int wscale = WSC_DN;
    __device__ __forceinline__ bool thin(const Unit&) const { return false; }
    const unsigned char* HID; const unsigned char* WdT; int lda, ldb; int nunits, G, c;
    __device__ __forceinline__ const unsigned* rowoff_ptr(const Unit&) const { return nullptr; }
    __device__ __forceinline__ bool next(int i, Unit& u) const {
        const int L = i * G + c; if (L >= nunits) return false;
        u.e = L >> 6; const int rem = L & 63; u.pn = rem >> 4; u.pm = rem & 15; u.row0 = u.pm * 256; return true;
    }
    __device__ __forceinline__ void addr(const Unit& u, UAddr& g) const {
        g.a0 = (const char*)(HID + ((size_t)u.e * 4096 + (size_t)u.pm * 256) * DFF); g.a1 = g.a0 + (size_t)128 * DFF;
        g.b0 = (const char*)(WdT + ((size_t)u.e * D + (size_t)u.pn * 256) * DFF); g.b1 = g.b0 + (size_t)128 * DFF;
    }
};

struct EpiStoreBf16 {
    static constexpr bool PERM = true;
    bf16* O; int ldc; size_t estride;
    __device__ __forceinline__ void operator()(const f32x4 (&acc)[2][2][4][2], const Unit& u, int wr, int wc, int fr, int fq) const {
        bf16* base = O + (size_t)u.e * estride + (size_t)(u.pm * 256 + wr * 64 + fr) * ldc + u.pn * 256 + wc * 32 + 8 * fq;
#pragma unroll
        for (int ai = 0; ai < 2; ++ai)
#pragma unroll
            for (int m = 0; m < 4; ++m) { bf16* rowp = base + (size_t)(ai * 128 + m * 16) * ldc;
#pragma unroll
                for (int bj = 0; bj < 2; ++bj) { const f32x4 v0 = acc[ai][bj][m][0], v1 = acc[ai][bj][m][1];
                    u32x4 w; w.x = cvt_pk_bf16(v0[0], v0[1]); w.y = cvt_pk_bf16(v0[2], v0[3]); w.z = cvt_pk_bf16(v1[0], v1[1]); w.w = cvt_pk_bf16(v1[2], v1[3]);
                    *(u32x4*)(rowp + bj * 128) = w; } }
    }
};
struct EpiProj {
    static constexpr bool PERM = true;
    bf16* O; const f32x2* rope;
    __device__ __forceinline__ void operator()(const f32x4 (&acc)[2][2][4][2], const Unit& u, int wr, int wc, int fr, int fq) const {
        const int row0 = u.row0 + wr * 64 + fr;
        if (u.pn >= 4) {
            bf16* base = O + (size_t)row0 * PC + u.pn * 256 + wc * 32 + 8 * fq;
#pragma unroll
            for (int ai = 0; ai < 2; ++ai)
#pragma unroll
                for (int m = 0; m < 4; ++m) { bf16* rowp = base + (size_t)(ai * 128 + m * 16) * PC;
#pragma unroll
                    for (int bj = 0; bj < 2; ++bj) { const f32x4 v0 = acc[ai][bj][m][0], v1 = acc[ai][bj][m][1];
                        u32x4 w; w.x = cvt_pk_bf16(v0[0], v0[1]); w.y = cvt_pk_bf16(v0[2], v0[3]); w.z = cvt_pk_bf16(v1[0], v1[1]); w.w = cvt_pk_bf16(v1[2], v1[3]);
                        *(u32x4*)(rowp + bj * 128) = w; } }
        } else {
            const float sc = (u.pn < 2) ? 0.08838834764831845f : 1.0f; const int d0 = 16 * wc + 4 * fq;
#pragma unroll
            for (int ai = 0; ai < 2; ++ai)
#pragma unroll
                for (int m = 0; m < 4; ++m) { const int row = row0 + ai * 128 + m * 16; const int b = row / PP, p = row - b * PP; const int n = p - PADF;
                    const f32x2* tb = rope + (size_t)n * 64 + d0; const f32x2 t0 = tb[0], t1 = tb[1], t2 = tb[2], t3 = tb[3];
                    bf16* rowp = O + (size_t)row * PC + u.pn * 256 + d0;
#pragma unroll
                    for (int bj = 0; bj < 2; ++bj) { const f32x4 x1 = acc[ai][bj][m][0], x2 = acc[ai][bj][m][1];
                        u32x2 o1, o2;
                        o1.x = cvt_pk_bf16((x1[0] * t0.x - x2[0] * t0.y) * sc, (x1[1] * t1.x - x2[1] * t1.y) * sc); o1.y = cvt_pk_bf16((x1[2] * t2.x - x2[2] * t2.y) * sc, (x1[3] * t3.x - x2[3] * t3.y) * sc);
                        o2.x = cvt_pk_bf16((x2[0] * t0.x + x1[0] * t0.y) * sc, (x2[1] * t1.x + x1[1] * t1.y) * sc); o2.y = cvt_pk_bf16((x2[2] * t2.x + x1[2] * t2.y) * sc, (x2[3] * t3.x + x1[3] * t3.y) * sc);
                        *(u32x2*)(rowp + bj * 128) = o1; *(u32x2*)(rowp + bj * 128 + 64) = o2; } }
        }
    }
};
struct EpiSwiglu {
    static constexpr bool PERM = true;
    unsigned char* HID;
    __device__ __forceinline__ void operator()(const f32x4 (&acc)[2][2][4][2], const Unit& u, int wr, int wc, int fr, int fq) const {
        unsigned char* base = HID + ((size_t)u.e * 4096 + (size_t)(u.pm * 256 + wr * 64 + fr)) * DFF + u.pn * 128 + wc * 32 + 8 * fq;
#pragma unroll
        for (int ai = 0; ai < 2; ++ai)
#pragma unroll
            for (int m = 0; m < 4; ++m) { unsigned char* rowp = base + (size_t)(ai * 128 + m * 16) * DFF;
                float h[8];
#pragma unroll
                for (int n = 0; n < 2; ++n)
#pragma unroll
                    for (int j = 0; j < 4; ++j) { const float g = acc[ai][0][m][n][j], up = acc[ai][1][m][n][j]; h[n * 4 + j] = fminf(fmaxf(siluf_(g) * up, -448.0f), 448.0f); }
                *(u32x2*)rowp = (u32x2){pk4_fp8(h[0], h[1], h[2], h[3]), pk4_fp8(h[4], h[5], h[6], h[7])}; }
    }
};
struct EpiDelta {
    static constexpr bool PERM = true;
    bf16* O; const float* X;
    __device__ __forceinline__ void operator()(const f32x4 (&acc)[2][2][4][2], const Unit& u, int wr, int wc, int fr, int fq) const {
        const int tok0 = (u.pm >> 5) * SEQ + 256 * (u.pm & 31) + wr * 64 + fr;
        const size_t off0 = (size_t)tok0 * D + u.pn * 256 + wc * 32 + 8 * fq;
#pragma unroll
        for (int ai = 0; ai < 2; ++ai) {
            f32x4 xv[4][2][2];
#pragma unroll
            for (int m = 0; m < 4; ++m)
#pragma unroll
                for (int bj = 0; bj < 2; ++bj) { const float* xp = X + off0 + (size_t)(ai * 128 + m * 16) * D + bj * 128; xv[m][bj][0] = *(const f32x4*)xp; xv[m][bj][1] = *(const f32x4*)(xp + 4); }
#pragma unroll
            for (int m = 0; m < 4; ++m) { bf16* rowp = O + off0 + (size_t)(ai * 128 + m * 16) * D;
#pragma unroll
                for (int bj = 0; bj < 2; ++bj) { const f32x4 v0 = acc[ai][bj][m][0] + xv[m][bj][0], v1 = acc[ai][bj][m][1] + xv[m][bj][1];
                    u32x4 w; w.x = cvt_pk_bf16(v0[0], v0[1]); w.y = cvt_pk_bf16(v0[2], v0[3]); w.z = cvt_pk_bf16(v1[0], v1[1]); w.w = cvt_pk_bf16(v1[2], v1[3]);
                    *(u32x4*)(rowp + bj * 128) = w; } }
        }
    }
};
}

struct Ctx {
    LAS unsigned char* lds; int tid, lane, wave, vcu, G;
    const float *x, *meta, *mix_g, *w_in, *b_gates, *conv_w, *conv_b, *ret_logit, *ret_gn, *ml_gn, *w_out, *ffn_g, *w_router, *w_gate, *w_up, *w_down, *fin_g;
    float* out; unsigned char* ws;
};

__device__ __forceinline__ int rope_row(int c) { if (c >= 1024) return c; const int d = c & 127, dd = d & 63; return (c & ~127) | (8 * (dd >> 2) + (d >> 6) * 4 + (dd & 3)); }
template <bool PAIRPERM = false>
__device__ __forceinline__ void transpose_item(const float* W, int K, int N, int ldw, bf16* WT, LAS float* scr, int item, int lane) {
    const int nblk = N / 32, kb = item / nblk, nb = item % nblk, k0 = 64 * kb, n0 = 32 * nb;
#pragma unroll 8
    for (int i = 0; i < 32; ++i) { const int kk = 2 * i + (lane >> 5); scr[kk * 33 + (lane & 31)] = W[(size_t)(k0 + kk) * ldw + n0 + (lane & 31)]; }
    LDS_WAIT(); asm volatile("" ::: "memory");
    const int c = lane & 7;
#pragma unroll
    for (int j = 0; j < 4; ++j) { const int n = (lane >> 3) + 8 * j; const LAS float* s = scr + (8 * c) * 33 + n;
        u32x4 o; o.x = pk2(s[0 * 33], s[1 * 33]); o.y = pk2(s[2 * 33], s[3 * 33]); o.z = pk2(s[4 * 33], s[5 * 33]); o.w = pk2(s[6 * 33], s[7 * 33]);
        *(u32x4*)(WT + (size_t)(PAIRPERM ? rope_row(n0 + n) : (n0 + n)) * K + k0 + 8 * c) = o; }
    LDS_WAIT(); asm volatile("" ::: "memory");
}
constexpr int F8SCR = 0;
__device__ __forceinline__ void transpose_item_f8(const float* W, int K, int N, int ldw, unsigned char* WT, LAS float*  , int item, int lane, float pre) {
    const int nblk = N / 64, kb = item / nblk, nb = item % nblk, k0 = 64 * kb + 16 * (lane >> 4), n0 = 64 * nb + 4 * (lane & 15);
    const float* src = W + (size_t)k0 * ldw + n0;
    f32x4 v[16];
#pragma unroll
    for (int i = 0; i < 16; ++i) v[i] = *(const f32x4*)(src + (size_t)i * ldw) * pre;
#pragma unroll
    for (int j = 0; j < 4; ++j) {
        u32x4 o;
        o.x = pk4_fp8(v[0][j], v[1][j], v[2][j], v[3][j]); o.y = pk4_fp8(v[4][j], v[5][j], v[6][j], v[7][j]); o.z = pk4_fp8(v[8][j], v[9][j], v[10][j], v[11][j]); o.w = pk4_fp8(v[12][j], v[13][j], v[14][j], v[15][j]);
        *(u32x4*)(WT + (size_t)(n0 + j) * K + k0) = o; }
}
__device__ __forceinline__ void row_load(const float* row, int lane, f32x4 (&u)[4]) {
#pragma unroll
    for (int jj = 0; jj < 4; ++jj) u[jj] = *(const f32x4*)(row + jj * 256 + lane * 4);
}
__device__ __forceinline__ void row_load_bf(const bf16* row, int lane, f32x4 (&u)[4]) {
    u32x2 dv[4];
#pragma unroll
    for (int jj = 0; jj < 4; ++jj) dv[jj] = *(const u32x2*)(row + jj * 256 + lane * 4);
#pragma unroll
    for (int jj = 0; jj < 4; ++jj) u[jj] = (f32x4){bflo(dv[jj].x), bfhi(dv[jj].x), bflo(dv[jj].y), bfhi(dv[jj].y)};
}
__device__ __forceinline__ void rms_apply(const float* g, int lane, f32x4 (&u)[4]) {
    float s = 0.f;
#pragma unroll
    for (int jj = 0; jj < 4; ++jj) s += u[jj].x * u[jj].x + u[jj].y * u[jj].y + u[jj].z * u[jj].z + u[jj].w * u[jj].w;
    const float rstd = rsqrtf(wave_sum(s) * (1.0f / D) + EPS);
#pragma unroll
    for (int jj = 0; jj < 4; ++jj) { const f32x4 gv = *(const f32x4*)(g + jj * 256 + lane * 4); u[jj] = u[jj] * rstd * gv; }
}
__device__ __forceinline__ void store_row_bf16(bf16* dst, int lane, const f32x4 (&u)[4]) {
#pragma unroll
    for (int jj = 0; jj < 4; ++jj) { u32x2 w; w.x = pk2(u[jj].x, u[jj].y); w.y = pk2(u[jj].z, u[jj].w); *(u32x2*)(dst + jj * 256 + lane * 4) = w; }
}
#define MFMA16(a, b, c) __builtin_amdgcn_mfma_f32_16x16x32_bf16(a, b, c, 0, 0, 0)
constexpr int RB_PITCH = 1032, RB_UH = 0, RB_UL = 16 * RB_PITCH * 2, RB_RED = 2 * RB_UL;
struct RowDots { bf16x8 bh[4], bl[4]; };
__device__ __forceinline__ void rowdots_init(RowDots& W, const float* wsrc, int ld, int w, int lane) {
    const int fr = lane & 15, fq = lane >> 4;
#pragma unroll
    for (int s_ = 0; s_ < 4; ++s_) { float v[8];
#pragma unroll
        for (int j = 0; j < 8; ++j) v[j] = wsrc[(size_t)(128 * w + 32 * s_ + 8 * fq + j) * ld + fr];
        unsigned hp[4], lp[4];
#pragma unroll
        for (int j = 0; j < 4; ++j) { hp[j] = pk2(v[2 * j], v[2 * j + 1]); lp[j] = pk2(v[2 * j] - bflo(hp[j]), v[2 * j + 1] - bfhi(hp[j])); }
        W.bh[s_] = __builtin_bit_cast(bf16x8, (u32x4){hp[0], hp[1], hp[2], hp[3]}); W.bl[s_] = __builtin_bit_cast(bf16x8, (u32x4){lp[0], lp[1], lp[2], lp[3]}); }
}
__device__ __forceinline__ void rowdots_put(LAS unsigned char* lds, int rs, int lane, const f32x4 (&u)[4]) {
#pragma unroll
    for (int jj = 0; jj < 4; ++jj) { const unsigned h0 = pk2(u[jj].x, u[jj].y), h1 = pk2(u[jj].z, u[jj].w);
        const unsigned l0 = pk2(u[jj].x - bflo(h0), u[jj].y - bfhi(h0)), l1 = pk2(u[jj].z - bflo(h1), u[jj].w - bfhi(h1));
        *(LAS u32x2*)(lds + RB_UH + (rs * RB_PITCH + jj * 256 + lane * 4) * 2) = (u32x2){h0, h1}; *(LAS u32x2*)(lds + RB_UL + (rs * RB_PITCH + jj * 256 + lane * 4) * 2) = (u32x2){l0, l1}; }
}
__device__ __forceinline__ void rowdots_mma(LAS unsigned char* lds, const RowDots& W, int w, int lane) {
    const int fr = lane & 15, fq = lane >> 4; f32x4 acc = (f32x4){0.f, 0.f, 0.f, 0.f};
#pragma unroll
    for (int s_ = 0; s_ < 4; ++s_) { const int off = (fr * RB_PITCH + 128 * w + 32 * s_ + 8 * fq) * 2;
        const bf16x8 ah = *(const LAS bf16x8*)(lds + RB_UH + off), al = *(const LAS bf16x8*)(lds + RB_UL + off);
        acc = MFMA16(ah, W.bh[s_], acc); acc = MFMA16(ah, W.bl[s_], acc); acc = MFMA16(al, W.bh[s_], acc); }
    *(LAS f32x4*)(lds + RB_RED + (w * 256 + lane * 4) * 4) = acc;
}
__device__ __forceinline__ float rowdots_get(const LAS unsigned char* lds, int row, int g) {
    const LAS float* red = (const LAS float*)(lds + RB_RED) + ((row >> 2) * 16 + g) * 4 + (row & 3); float s_ = 0.f;
#pragma unroll
    for (int w = 0; w < 8; ++w) s_ += red[w * 256];
    return s_;
}
__device__ __forceinline__ void phase_prep(Ctx& F) {
    bf16* WINT = (bf16*)(F.ws + WS_WINT); bf16* WOUTT = (bf16*)(F.ws + WS_WOUTT);
    LAS float* scr = (LAS float*)(F.lds + F.wave * 16384);
    const int gw = F.vcu * 8 + F.wave, NGW = F.G * 8;
    constexpr int I_IN = (D / 64) * (PC / 32), I_OUT = (D / 64) * (D / 32);
    for (int it = gw; it < I_IN + I_OUT; it += NGW) {
        if (it < I_IN) transpose_item<true>(F.w_in, D, PC, PCOLS, WINT, scr, it, F.lane);
        else transpose_item(F.w_out, D, D, D, WOUTT, scr, it - I_IN, F.lane);
    }
    f32x2* rope = (f32x2*)(F.ws + WS_ROPE);
    for (int idx = (F.vcu * 512 + F.tid); idx < NTOK * 64; idx += F.G * 512) {
        const int n = idx >> 6, i = idx & 63;
        const float inv = (float)exp(-(double)i * (9.210340371976184 / 64.0));
        const float angf = (float)n * inv;
        const double xd = (double)angf; const double kq = rint(xd * 0.6366197723675814);
        double r = fma(-kq, 1.5707963267948966, xd); r = fma(-kq, 6.123233995736766e-17, r);
        const double r2 = r * r;
        double sn = -1.0 / 1307674368000.0; sn = fma(sn, r2, 1.0 / 6227020800.0); sn = fma(sn, r2, -1.0 / 39916800.0); sn = fma(sn, r2, 1.0 / 362880.0); sn = fma(sn, r2, -1.0 / 5040.0); sn = fma(sn, r2, 1.0 / 120.0); sn = fma(sn, r2, -1.0 / 6.0); sn = fma(sn * r2, r, r);
        double cs = 1.0 / 20922789888000.0; cs = fma(cs, r2, -1.0 / 87178291200.0); cs = fma(cs, r2, 1.0 / 479001600.0); cs = fma(cs, r2, -1.0 / 3628800.0); cs = fma(cs, r2, 1.0 / 40320.0); cs = fma(cs, r2, -1.0 / 720.0); cs = fma(cs, r2, 1.0 / 24.0); cs = fma(cs, r2, -0.5); cs = fma(cs, r2, 1.0);
        const int q = ((int)kq) & 3;
        const double c = (q == 0) ? cs : (q == 1) ? -sn : (q == 2) ? -cs : sn;
        const double s = (q == 0) ? sn : (q == 1) ? cs : (q == 2) ? -sn : -cs;
        rope[idx] = (f32x2){(float)c, (float)s};
    }
    __syncthreads();
    bf16* U1 = (bf16*)(F.ws + WS_ACT1); float* GATES = (float*)(F.ws + WS_GATES);
    RowDots W; rowdots_init(W, F.w_in + PC, PCOLS, F.wave, F.lane);
    for (int bi = F.vcu; bi < R / 16; bi += F.G) {
        const int r0 = bi * 16;
        int rr[2]; bool ok[2]; f32x4 u[2][4];
#pragma unroll
        for (int t = 0; t < 2; ++t) { rr[t] = r0 + 2 * F.wave + t; const int b = rr[t] / PP, p = rr[t] - b * PP; ok[t] = p >= PADF;
            if (ok[t]) row_load((p < CHK) ? F.meta + (size_t)(p - PADF) * D : F.x + ((size_t)b * SEQ + (p - CHK)) * D, F.lane, u[t]);
            else {
#pragma unroll
                for (int jj = 0; jj < 4; ++jj) u[t][jj] = (f32x4){0.f, 0.f, 0.f, 0.f}; } }
#pragma unroll
        for (int t = 0; t < 2; ++t) {
            if (!ok[t]) {
                bf16* prow = (bf16*)(F.ws + WS_PROJ) + (size_t)rr[t] * PC;
#pragma unroll
                for (int jj = 0; jj < 8; ++jj) *(u32x4*)(prow + jj * 512 + F.lane * 8) = (u32x4){0u, 0u, 0u, 0u};
            } else { rms_apply(F.mix_g, F.lane, u[t]); store_row_bf16(U1 + (size_t)rr[t] * D, F.lane, u[t]); }
            rowdots_put(F.lds, 2 * F.wave + t, F.lane, u[t]);
        }
        __syncthreads();
        rowdots_mma(F.lds, W, F.wave, F.lane);
        __syncthreads();
        if (F.tid < 256) { const int row = F.tid >> 4, g = F.tid & 15, r = r0 + row; const int b = r / PP, p = r - b * PP;
            float gv = rowdots_get(F.lds, row, g) + F.b_gates[g]; if (g >= 8) gv = logsigmoidf_(gv);
            GATES[(size_t)r * 16 + g] = (p >= PADF) ? gv : ((g < 8) ? NEGF : 0.0f); }
    }
}

__device__ __forceinline__ void phase_rope_conv(Ctx& F) {
    const bf16* PROJ = (const bf16*)(F.ws + WS_PROJ); bf16* QKC = (bf16*)(F.ws + WS_ACT1);
    const int gw = F.vcu * 8 + F.wave, NGW = F.G * 8, lane = F.lane;
    const float qs = 0.08838834764831845f;
    float wv[2][5][8], bv[2][8];
#pragma unroll
    for (int jj = 0; jj < 2; ++jj) { const int ch0 = jj * 512 + lane * 8;
        { const f32x4 b0 = *(const f32x4*)(F.conv_b + ch0), b1 = *(const f32x4*)(F.conv_b + ch0 + 4); bv[jj][0] = b0.x; bv[jj][1] = b0.y; bv[jj][2] = b0.z; bv[jj][3] = b0.w; bv[jj][4] = b1.x; bv[jj][5] = b1.y; bv[jj][6] = b1.z; bv[jj][7] = b1.w; }
#pragma unroll
        for (int j = 0; j < 5; ++j) { const f32x4 w0 = *(const f32x4*)(F.conv_w + j * 1024 + ch0), w1 = *(const f32x4*)(F.conv_w + j * 1024 + ch0 + 4);
            wv[jj][j][0] = w0.x; wv[jj][j][1] = w0.y; wv[jj][j][2] = w0.z; wv[jj][j][3] = w0.w; wv[jj][j][4] = w1.x; wv[jj][j][5] = w1.y; wv[jj][j][6] = w1.z; wv[jj][j][7] = w1.w; } }
    for (int r = gw; r < R; r += NGW) {
        const int b = r / PP, p = r - b * PP;
        bf16* qrow = QKC + (size_t)r * D;
        if (p < PADF) {
#pragma unroll
            for (int jj = 0; jj < 2; ++jj) *(u32x4*)(qrow + jj * 512 + lane * 8) = (u32x4){0u, 0u, 0u, 0u};
            continue;
        }
        u32x4 xv[2][5];
#pragma unroll
        for (int jj = 0; jj < 2; ++jj)
#pragma unroll
            for (int j = 0; j < 5; ++j) { const int pj = p + j - 2; xv[jj][j] = (pj >= PADF && pj < PP) ? *(const u32x4*)(PROJ + (size_t)(r + j - 2) * PC + 2048 + jj * 512 + lane * 8) : (u32x4){0u, 0u, 0u, 0u}; }
#pragma unroll
        for (int jj = 0; jj < 2; ++jj) {
            float acc[8];
#pragma unroll
            for (int i = 0; i < 8; ++i) acc[i] = bv[jj][i];
#pragma unroll
            for (int j = 0; j < 5; ++j) { const u32x4 v = xv[jj][j];
                acc[0] += bflo(v.x) * wv[jj][j][0]; acc[1] += bfhi(v.x) * wv[jj][j][1]; acc[2] += bflo(v.y) * wv[jj][j][2]; acc[3] += bfhi(v.y) * wv[jj][j][3];
                acc[4] += bflo(v.z) * wv[jj][j][4]; acc[5] += bfhi(v.z) * wv[jj][j][5]; acc[6] += bflo(v.w) * wv[jj][j][6]; acc[7] += bfhi(v.w) * wv[jj][j][7]; }
            const float sc = (jj == 0) ? qs : 1.0f;
#pragma unroll
            for (int i = 0; i < 8; ++i) acc[i] = siluf_(acc[i]) * sc;
            *(u32x4*)(qrow + jj * 512 + lane * 8) = (u32x4){pk2(acc[0], acc[1]), pk2(acc[2], acc[3]), pk2(acc[4], acc[5]), pk2(acc[6], acc[7])};
        }
    }
}

__device__ __forceinline__ void zero_acc(f32x4 (&acc)[2][4]) {
#pragma unroll
    for (int mt = 0; mt < 2; ++mt)
#pragma unroll
        for (int nt = 0; nt < 4; ++nt) acc[mt][nt] = (f32x4){0.f, 0.f, 0.f, 0.f};
}
template <bool MAXOP, bool REV>
__device__ __forceinline__ void scan128(const LAS float* x, LAS float* out, int lane) {
    static_assert(!REV, "suffix scans are not used any more");
    const int i0 = 2 * lane, i1 = 2 * lane + 1;
    const float a0 = x[i0], a1r = x[i1]; const float a1 = MAXOP ? fmaxf(a0, a1r) : a0 + a1r;
    const float s = wave_scan_incl<MAXOP>(a1);
    const int idn = __builtin_bit_cast(int, MAXOP ? -3.0e38f : 0.0f);
    const float ex = __builtin_bit_cast(float, __builtin_amdgcn_update_dpp(idn, __builtin_bit_cast(int, s), 0x138, 0xF, 0xF, false));
    out[i0] = MAXOP ? fmaxf(ex, a0) : ex + a0; out[i1] = s;
}

typedef short s16x4 __attribute__((ext_vector_type(4)));
constexpr int NSEG = 4;
__device__ __forceinline__ int seg_begin(int s) { return s == 0 ? 0 : 1 + 16 * s; }
constexpr size_t SUMM_STRIDE = (size_t)(144 * 128 + 64);
constexpr size_t WS_SUMM = WS_STATE;
constexpr size_t WS_OUTD = WS_STATE + 16 * MiB;
static_assert(WS_OUTD + (size_t)2 * R * D * 2 <= WS_END && 64 * 3 * SUMM_STRIDE * 4 <= 16 * MiB, "mixer scratch map");
constexpr int VQ = VEC_OFF;
constexpr int V_LI = VQ, V_LF = VQ + 512, V_BC = VQ + 1024, V_GG = VQ + 1536, V_PM = VQ + 2048, V_E1 = VQ + 2560, V_WI = VQ + 3072, V_FL = VQ + 3584, V_WU = VQ + 4096,
              V_NV = VQ + 4608  , V_SC = VQ + 4864  ;

template <int KS, int NT> __device__ __forceinline__ void ld_rows(const LAS bf16* T, int rowbase, int fq, bf16x8 (&f)[NT]) {
#pragma unroll
    for (int t = 0; t < NT; ++t) f[t] = *(const LAS bf16x8*)(T + (rowbase + 16 * t) * TP + KS * 32 + 8 * fq);
}
template <int KS> __device__ __forceinline__ void tr_frag4(unsigned addr, bf16x8 (&f)[4]) {
    s16x4 r0, r1, r2, r3, r4, r5, r6, r7;
    asm volatile("ds_read_b64_tr_b16 %0, %8 offset:%9\n\tds_read_b64_tr_b16 %1, %8 offset:%10\n\tds_read_b64_tr_b16 %2, %8 offset:%11\n\tds_read_b64_tr_b16 %3, %8 offset:%12\n\t"
                 "ds_read_b64_tr_b16 %4, %8 offset:%13\n\tds_read_b64_tr_b16 %5, %8 offset:%14\n\tds_read_b64_tr_b16 %6, %8 offset:%15\n\tds_read_b64_tr_b16 %7, %8 offset:%16\n\ts_waitcnt lgkmcnt(0)"
                 : "=&v"(r0), "=&v"(r1), "=&v"(r2), "=&v"(r3), "=&v"(r4), "=&v"(r5), "=&v"(r6), "=&v"(r7)
                 : "v"(addr), "i"(KS * 8704), "i"(KS * 8704 + 1088), "i"(KS * 8704 + 32), "i"(KS * 8704 + 32 + 1088), "i"(KS * 8704 + 64), "i"(KS * 8704 + 64 + 1088), "i"(KS * 8704 + 96), "i"(KS * 8704 + 96 + 1088)
                 : "memory");
    f[0] = __builtin_shufflevector(r0, r1, 0, 1, 2, 3, 4, 5, 6, 7); f[1] = __builtin_shufflevector(r2, r3, 0, 1, 2, 3, 4, 5, 6, 7);
    f[2] = __builtin_shufflevector(r4, r5, 0, 1, 2, 3, 4, 5, 6, 7); f[3] = __builtin_shufflevector(r6, r7, 0, 1, 2, 3, 4, 5, 6, 7);
}
template <int KS> __device__ __forceinline__ void tr_frag2(unsigned addr, bf16x8 (&f)[2]) {
    s16x4 r0, r1, r2, r3;
    asm volatile("ds_read_b64_tr_b16 %0, %4 offset:%5\n\tds_read_b64_tr_b16 %1, %4 offset:%6\n\tds_read_b64_tr_b16 %2, %4 offset:%7\n\tds_read_b64_tr_b16 %3, %4 offset:%8\n\ts_waitcnt lgkmcnt(0)"
                 : "=&v"(r0), "=&v"(r1), "=&v"(r2), "=&v"(r3)
                 : "v"(addr), "i"(KS * 8704), "i"(KS * 8704 + 1088), "i"(KS * 8704 + 32), "i"(KS * 8704 + 32 + 1088)
                 : "memory");
    f[0] = __builtin_shufflevector(r0, r1, 0, 1, 2, 3, 4, 5, 6, 7); f[1] = __builtin_shufflevector(r2, r3, 0, 1, 2, 3, 4, 5, 6, 7);
}
__device__ __forceinline__ unsigned tr_lane_addr(const LAS bf16* T, int colbase, int lane) {
    const int g = lane >> 4, q = (lane & 15) >> 2, p = lane & 3;
    return (unsigned)(__UINTPTR_TYPE__)(T + (8 * g + q) * TP + colbase + 4 * p);
}

struct SeqUnit { int b, h, grp, dir, seg, combo; };
__device__ __forceinline__ SeqUnit seq_unit(int u) { SeqUnit q; q.seg = u & 3; q.combo = u >> 2; q.dir = q.combo & 1; q.grp = (q.combo >> 1) & 1; q.h = (q.combo >> 2) & 3; q.b = q.combo >> 4; return q; }
__device__ __forceinline__ int seq_chunk(const SeqUnit& q, int ci) { return q.dir ? NCH - 1 - ci : ci; }
__device__ __forceinline__ void tile_fetch(int tid, const bf16* src, size_t stride, int rev, u32x4 (&v)[4]) {
#pragma unroll
    for (int i = 0; i < 4; ++i) { const int q = tid + 512 * i, row = q >> 4, ch = q & 15, rs = rev ? 127 - row : row; v[i] = *(const u32x4*)(src + (size_t)rs * stride + ch * 8); }
}
__device__ __forceinline__ void tile_put(int tid, LAS bf16* T, const u32x4 (&v)[4]) {
#pragma unroll
    for (int i = 0; i < 4; ++i) { const int q = tid + 512 * i, row = q >> 4, ch = q & 15; *(LAS u32x4*)(T + row * TP + ch * 8) = v[i]; }
}
__device__ __forceinline__ void chunk_scans(LAS unsigned char* lds, int lane, bool nostab) {
    LAS float* LI = (LAS float*)(lds + V_LI); LAS float* LF = (LAS float*)(lds + V_LF); LAS float* BC = (LAS float*)(lds + V_BC); LAS float* GG = (LAS float*)(lds + V_GG); LAS float* PM = (LAS float*)(lds + V_PM);
    LAS float* E1 = (LAS float*)(lds + V_E1); LAS float* WI = (LAS float*)(lds + V_WI); LAS float* FL = (LAS float*)(lds + V_FL); LAS float* WU = (LAS float*)(lds + V_WU); LAS float* SC = (LAS float*)(lds + V_SC);
    scan128<false, false>(LF, BC, lane); LDS_WAIT();
    const int l0 = 2 * lane, l1 = 2 * lane + 1;
    const float bc0 = BC[l0], bc1 = BC[l1], li0 = LI[l0], li1 = LI[l1];
    GG[l0] = li0 - bc0; GG[l1] = li1 - bc1; LDS_WAIT();
    scan128<true, false>(GG, PM, lane); LDS_WAIT();
    const float blast = BC[127], m = SC[0];
    const float lu0 = blast - bc0 + li0, lu1 = blast - bc1 + li1;
    const float a = nostab ? 0.0f : wave_max(fmaxf(lu0, lu1));
    const float mnew = nostab ? 0.0f : fmaxf(blast + m, a);
    const float f = __expf(blast + m - mnew), g = __expf(a - mnew);
    const float mr0 = nostab ? 0.0f : fmaxf(bc0 + m, bc0 + PM[l0]), mr1 = nostab ? 0.0f : fmaxf(bc1 + m, bc1 + PM[l1]);
    E1[l0] = bc0 - mr0; E1[l1] = bc1 - mr1; WI[l0] = __expf(bc0 + m - mr0); WI[l1] = __expf(bc1 + m - mr1);
    FL[l0] = __expf(-mr0); FL[l1] = __expf(-mr1); WU[l0] = g * __expf(lu0 - a); WU[l1] = g * __expf(lu1 - a);
    if (lane == 0) { SC[1] = f; SC[2] = mnew; SC[3] += blast; }
}
__device__ __forceinline__ void scale_k(int tid, LAS bf16* TK, const LAS float* WU) {
#pragma unroll
    for (int i = 0; i < 4; ++i) { const int q = tid + 512 * i, row = q >> 4, ch = q & 15; LAS u32x4* p = (LAS u32x4*)(TK + row * TP + ch * 8); const u32x4 v = *p; const float wv = WU[row];
        *p = (u32x4){cvtpk(bflo(v.x) * wv, bfhi(v.x) * wv), cvtpk(bflo(v.y) * wv, bfhi(v.y) * wv), cvtpk(bflo(v.z) * wv, bfhi(v.z) * wv), cvtpk(bflo(v.w) * wv, bfhi(v.w) * wv)}; }
}
__device__ __forceinline__ void state_update(const LAS bf16* TV, const LAS bf16* TK, int w, int lane, float f, f32x4 (&C)[2][4], float (&nrow)[4]) {
    const int m0 = 32 * (w >> 1), n0 = 64 * (w & 1), fr = lane & 15;
#pragma unroll
    for (int mt = 0; mt < 2; ++mt)
#pragma unroll
        for (int nt = 0; nt < 4; ++nt) C[mt][nt] *= f;
    f32x4 nacc[4];
#pragma unroll
    for (int nt = 0; nt < 4; ++nt) nacc[nt] = (f32x4){nrow[nt] * f, 0.f, 0.f, 0.f};
    const unsigned aa = tr_lane_addr(TV, m0, lane), ab = tr_lane_addr(TK, n0, lane);
    bf16x8 ones; { const short o = (fr == 0) ? (short)0x3F80 : (short)0;
#pragma unroll
        for (int j = 0; j < 8; ++j) ones[j] = o; }
#define SU_STEP(KS) { bf16x8 a[2], b[4]; tr_frag2<KS>(aa, a); tr_frag4<KS>(ab, b); \
        _Pragma("unroll") for (int mt = 0; mt < 2; ++mt) _Pragma("unroll") for (int nt = 0; nt < 4; ++nt) C[mt][nt] = MFMA16(a[mt], b[nt], C[mt][nt]); \
        if (w < 2) { _Pragma("unroll") for (int nt = 0; nt < 4; ++nt) nacc[nt] = MFMA16(ones, b[nt], nacc[nt]); } }
    SU_STEP(0) SU_STEP(1) SU_STEP(2) SU_STEP(3)
#undef SU_STEP
#pragma unroll
    for (int nt = 0; nt < 4; ++nt) nrow[nt] = nacc[nt][0];
}
__device__ __forceinline__ const bf16* seq_src(const Ctx& F, const SeqUnit& q, int which  , size_t& stride) {
    const bf16* PROJ = (const bf16*)(F.ws + WS_PROJ); const bf16* QKC = (const bf16*)(F.ws + WS_ACT1);
    if (q.grp == 0) { stride = PC; return PROJ + which * 512 + q.h * 128; }
    if (which == 2) { stride = PC; return PROJ + 3072 + q.h * 128; }
    stride = D; return QKC + which * 512 + q.h * 128;
}
__device__ __forceinline__ void gates_fetch(const Ctx& F, const SeqUnit& q, int c, int tid, float lgam, float& li, float& lf) {
    if (q.grp == 0) { li = 0.0f; lf = lgam; return; }
    const float* GATES = (const float*)(F.ws + WS_GATES); const int row = q.dir ? 127 - tid : tid;
    const float* gp = GATES + ((size_t)q.b * PP + (size_t)c * CHK + row) * 16; li = gp[q.dir * 4 + q.h]; lf = gp[8 + q.dir * 4 + q.h];
}

constexpr int I_WD = (DFF / 64) * (D / 64);
constexpr int WD_SPLIT = 2800;
__device__ __forceinline__ void convert_wd(Ctx& F, int lo, int hi, int iw, int nw) {
    unsigned char* WdT = F.ws + WS_WD8; LAS float* scr = (LAS float*)(F.lds + F.wave * F8SCR);
    for (int it = lo + iw; it < hi; it += nw) { const int e = it / I_WD, item = it - e * I_WD;
        transpose_item_f8(F.w_down + (size_t)e * DFF * D, DFF, D, D, WdT + (size_t)e * D * DFF, scr, item, F.lane, WPRE_DN); }
}
__device__ __forceinline__ void phase_seg_summary(Ctx& F) {
    LAS bf16* TK = (LAS bf16*)(F.lds + T1_OFF); LAS bf16* TV = (LAS bf16*)(F.lds + T2_OFF);
    LAS float* SC = (LAS float*)(F.lds + V_SC); LAS float* LI = (LAS float*)(F.lds + V_LI); LAS float* LF = (LAS float*)(F.lds + V_LF); const LAS float* WU = (const LAS float*)(F.lds + V_WU);
    float* SUMM = (float*)(F.ws + WS_SUMM);
    const int w = F.wave;
    for (int u = F.vcu; u < 64 * NSEG; u += F.G) {
        const SeqUnit q = seq_unit(u);
        if (q.seg == NSEG - 1) { convert_wd(F, 0, WD_SPLIT, q.combo * 8 + F.wave, 64 * 8); continue; }
        int tid = F.tid; asm volatile("" : "+v"(tid));
        const int lane = tid & 63, fr = lane & 15, fq = lane >> 4;
        const bool nostab = (q.grp == 0);
        const float lgam = nostab ? logsigmoidf_(F.ret_logit[q.dir * NH + q.h]) : 0.0f;
        size_t sk, sv; const bf16* pk = seq_src(F, q, 1, sk); const bf16* pv = seq_src(F, q, 2, sv);
        f32x4 C[2][4]; float nrow[4] = {0.f, 0.f, 0.f, 0.f}; zero_acc(C);
        __syncthreads();
        if (tid == 0) { SC[0] = 0.f; SC[3] = 0.f; }
        const int ci0 = seg_begin(q.seg), ci1 = seg_begin(q.seg + 1);
        u32x4 rk[4], rv[4]; float gli = 0.f, glf = 0.f;
        {   const int c = seq_chunk(q, ci0); const size_t r0 = (size_t)q.b * PP + (size_t)c * CHK;
            tile_fetch(tid, pk + r0 * sk, sk, q.dir, rk); tile_fetch(tid, pv + r0 * sv, sv, q.dir, rv); if (tid < 128) gates_fetch(F, q, c, tid, lgam, gli, glf); }
#pragma unroll 1
        for (int ci = ci0; ci < ci1; ++ci) {
            tile_put(tid, TK, rk); tile_put(tid, TV, rv); if (tid < 128) { LI[tid] = gli; LF[tid] = glf; }
            __syncthreads();
            if (ci + 1 < ci1) { const int c = seq_chunk(q, ci + 1); const size_t r0 = (size_t)q.b * PP + (size_t)c * CHK;
                tile_fetch(tid, pk + r0 * sk, sk, q.dir, rk); tile_fetch(tid, pv + r0 * sv, sv, q.dir, rv); if (tid < 128) gates_fetch(F, q, c, tid, lgam, gli, glf); }
            if (w == 0) chunk_scans(F.lds, lane, nostab);
            __syncthreads();
            scale_k(tid, TK, WU);
            __syncthreads();
            const float f = SC[1];
            state_update(TV, TK, w, lane, f, C, nrow);
            __syncthreads();
            if (tid == 0) SC[0] = SC[2];
        }
        __syncthreads();
        float* dst = SUMM + ((size_t)q.combo * 3 + q.seg) * SUMM_STRIDE;
        const int m0 = 32 * (w >> 1), n0 = 64 * (w & 1);
#pragma unroll
        for (int mt = 0; mt < 2; ++mt)
#pragma unroll
            for (int nt = 0; nt < 4; ++nt)
#pragma unroll
                for (int rg = 0; rg < 4; ++rg) dst[(m0 + 16 * mt + 4 * fq + rg) * 128 + n0 + 16 * nt + fr] = C[mt][nt][rg];
        if (w < 2 && fq == 0) {
#pragma unroll
            for (int nt = 0; nt < 4; ++nt) dst[128 * 128 + n0 + 16 * nt + fr] = nrow[nt]; }
        if (tid == 0) { dst[144 * 128] = SC[0]; dst[144 * 128 + 1] = SC[3]; }
    }
}

__device__ __forceinline__ void phase_seq(Ctx& F) {
    LAS bf16* TQ = (LAS bf16*)(F.lds + T0_OFF); LAS bf16* TK = (LAS bf16*)(F.lds + T1_OFF); LAS bf16* TV = (LAS bf16*)(F.lds + T2_OFF); LAS bf16* TC = (LAS bf16*)(F.lds + T3_OFF);
    LAS float* SC = (LAS float*)(F.lds + V_SC); LAS float* LI = (LAS float*)(F.lds + V_LI); LAS float* LF = (LAS float*)(F.lds + V_LF);
    const LAS float* WU = (const LAS float*)(F.lds + V_WU); const LAS float* E1 = (const LAS float*)(F.lds + V_E1); const LAS float* GG = (const LAS float*)(F.lds + V_GG);
    const LAS float* WI = (const LAS float*)(F.lds + V_WI); const LAS float* FL = (const LAS float*)(F.lds + V_FL); LAS bf16* NV = (LAS bf16*)(F.lds + V_NV);
    const float* SUMM = (const float*)(F.ws + WS_SUMM); bf16* OUTD = (bf16*)(F.ws + WS_OUTD);
    const int w = F.wave, m0 = 32 * (w >> 1), n0 = 64 * (w & 1);
    for (int u = F.vcu; u < 64 * NSEG; u += F.G) {
        const SeqUnit q = seq_unit(u);
        int tid_u = F.tid; asm volatile("" : "+v"(tid_u));
        const int tid = tid_u, lane = tid & 63, fr = lane & 15, fq = lane >> 4;
        const bool nostab = (q.grp == 0);
        const float lgam = nostab ? logsigmoidf_(F.ret_logit[q.dir * NH + q.h]) : 0.0f;
        size_t sq, sk, sv; const bf16* pq = seq_src(F, q, 0, sq); const bf16* pk = seq_src(F, q, 1, sk); const bf16* pv = seq_src(F, q, 2, sv);
        f32x4 C[2][4]; float nrow[4] = {0.f, 0.f, 0.f, 0.f}; zero_acc(C);
        float mst = 0.f;
        for (int s = 0; s < q.seg; ++s) {
            const float* src = SUMM + ((size_t)q.combo * 3 + s) * SUMM_STRIDE;
            const float ms = src[144 * 128], Bs = src[144 * 128 + 1];
            const float mo_ = nostab ? 0.0f : fmaxf(Bs + mst, ms); const float fa = __expf(Bs + mst - mo_), fb = __expf(ms - mo_); mst = mo_;
#pragma unroll
            for (int mt = 0; mt < 2; ++mt)
#pragma unroll
                for (int nt = 0; nt < 4; ++nt)
#pragma unroll
                    for (int rg = 0; rg < 4; ++rg) C[mt][nt][rg] = fa * C[mt][nt][rg] + fb * src[(m0 + 16 * mt + 4 * fq + rg) * 128 + n0 + 16 * nt + fr];
            if (w < 2 && fq == 0) {
#pragma unroll
                for (int nt = 0; nt < 4; ++nt) nrow[nt] = fa * nrow[nt] + fb * src[128 * 128 + n0 + 16 * nt + fr]; }
        }
        __syncthreads();
        if (tid == 0) { SC[0] = mst; SC[3] = 0.f; }
        const int ci0 = seg_begin(q.seg), ci1 = seg_begin(q.seg + 1);
        u32x4 rq[4], rk[4], rv[4]; float gli = 0.f, glf = 0.f;
        {   const int c = seq_chunk(q, ci0); const size_t r0 = (size_t)q.b * PP + (size_t)c * CHK;
            tile_fetch(tid, pq + r0 * sq, sq, q.dir, rq); tile_fetch(tid, pk + r0 * sk, sk, q.dir, rk); tile_fetch(tid, pv + r0 * sv, sv, q.dir, rv); if (tid < 128) gates_fetch(F, q, c, tid, lgam, gli, glf); }
#pragma unroll 1
        for (int ci = ci0; ci < ci1; ++ci) {
            const int c = seq_chunk(q, ci); const size_t r0 = (size_t)q.b * PP + (size_t)c * CHK;
            int tid = tid_u; asm volatile("" : "+v"(tid));
            const int lane = tid & 63, fr = lane & 15, fq = lane >> 4;
            tile_put(tid, TQ, rq); tile_put(tid, TK, rk); tile_put(tid, TV, rv); if (tid < 128) { LI[tid] = gli; LF[tid] = glf; }
#pragma unroll
            for (int mt = 0; mt < 2; ++mt)
#pragma unroll
                for (int nt = 0; nt < 4; ++nt) *(LAS u32x2*)(TC + (n0 + 16 * nt + fr) * TP + m0 + 16 * mt + 4 * fq) = (u32x2){cvtpk(C[mt][nt][0], C[mt][nt][1]), cvtpk(C[mt][nt][2], C[mt][nt][3])};
            if (w < 2 && fq == 0) {
#pragma unroll
                for (int nt = 0; nt < 4; ++nt) NV[n0 + 16 * nt + fr] = (bf16)f2bf(nrow[nt]); }
            __syncthreads();
            if (w == 0) chunk_scans(F.lds, lane, nostab);
            f32x4 accN[2][4], accD[4], accS[2][4]; zero_acc(accN); zero_acc(accS);
#pragma unroll
            for (int nt = 0; nt < 4; ++nt) accD[nt] = (f32x4){0.f, 0.f, 0.f, 0.f};
            {   const unsigned ac = tr_lane_addr(TC, m0, lane);
#define SX_STEP(KS) { bf16x8 a[2], bq[4]; ld_rows<KS, 4>(TQ, n0 + fr, fq, bq); tr_frag2<KS>(ac, a); \
                bf16x8 an = *(const LAS bf16x8*)(NV + KS * 32 + 8 * fq); if (fr != 0) { _Pragma("unroll") for (int j = 0; j < 8; ++j) an[j] = 0; } \
                _Pragma("unroll") for (int nt = 0; nt < 4; ++nt) { _Pragma("unroll") for (int mt = 0; mt < 2; ++mt) accN[mt][nt] = MFMA16(a[mt], bq[nt], accN[mt][nt]); accD[nt] = MFMA16(an, bq[nt], accD[nt]); } }
                SX_STEP(0) SX_STEP(1) SX_STEP(2) SX_STEP(3)
#undef SX_STEP
            }
#define SS_STEP(KS) { bf16x8 a[2], bq[4]; ld_rows<KS, 2>(TK, m0 + fr, fq, a); ld_rows<KS, 4>(TQ, n0 + fr, fq, bq); \
                _Pragma("unroll") for (int mt = 0; mt < 2; ++mt) { _Pragma("unroll") for (int nt = 0; nt < 4; ++nt) accS[mt][nt] = MFMA16(a[mt], bq[nt], accS[mt][nt]); } }
            SS_STEP(0) SS_STEP(1) SS_STEP(2) SS_STEP(3)
#undef SS_STEP
            __syncthreads();
#pragma unroll
            for (int nt = 0; nt < 4; ++nt) { const int l = n0 + 16 * nt + fr; const float wi = WI[l], e1 = E1[l]; accD[nt][0] *= wi;
#pragma unroll
                for (int mt = 0; mt < 2; ++mt) { accN[mt][nt] *= wi; const int mb = m0 + 16 * mt + 4 * fq; float pv_[4];
#pragma unroll
                    for (int rg = 0; rg < 4; ++rg) pv_[rg] = (mb + rg <= l) ? accS[mt][nt][rg] * __expf(e1 + GG[mb + rg]) : 0.0f;
                    *(LAS u32x2*)(TC + l * TP + mb) = (u32x2){cvtpk(pv_[0], pv_[1]), cvtpk(pv_[2], pv_[3])}; } }
            scale_k(tid, TK, WU);
            if (ci + 1 < ci1) { const int cn = seq_chunk(q, ci + 1); const size_t rn = (size_t)q.b * PP + (size_t)cn * CHK;
                tile_fetch(tid, pq + rn * sq, sq, q.dir, rq); tile_fetch(tid, pk + rn * sk, sk, q.dir, rk); tile_fetch(tid, pv + rn * sv, sv, q.dir, rv); if (tid < 128) gates_fetch(F, q, cn, tid, lgam, gli, glf); }
            __syncthreads();
            {   const unsigned av = tr_lane_addr(TV, m0, lane);
                bf16x8 ones; { const short o = (fr == 0) ? (short)0x3F80 : (short)0;
#pragma unroll
                    for (int j = 0; j < 8; ++j) ones[j] = o; }
#define PV_STEP(KS) { bf16x8 a[2], bp[4]; ld_rows<KS, 4>(TC, n0 + fr, fq, bp); tr_frag2<KS>(av, a); \
                _Pragma("unroll") for (int nt = 0; nt < 4; ++nt) { _Pragma("unroll") for (int mt = 0; mt < 2; ++mt) accN[mt][nt] = MFMA16(a[mt], bp[nt], accN[mt][nt]); accD[nt] = MFMA16(ones, bp[nt], accD[nt]); } }
                PV_STEP(0) PV_STEP(1) PV_STEP(2) PV_STEP(3)
#undef PV_STEP
            }
#pragma unroll
            for (int nt = 0; nt < 4; ++nt) { const int l = n0 + 16 * nt + fr;
                const float den = __shfl(accD[nt][0], fr); const float inv = nostab ? 1.0f : __builtin_amdgcn_rcpf(fmaxf(fabsf(den), FL[l]));
#pragma unroll
                for (int mt = 0; mt < 2; ++mt) { const f32x4 o = accN[mt][nt] * inv; *(LAS u32x2*)(TQ + l * TP + m0 + 16 * mt + 4 * fq) = (u32x2){cvtpk(o[0], o[1]), cvtpk(o[2], o[3])}; } }
            state_update(TV, TK, w, lane, SC[1], C, nrow);
            __syncthreads();
            {   bf16* dst = OUTD + ((size_t)q.dir * R + r0) * D + q.grp * 512 + q.h * 128;
#pragma unroll
                for (int i = 0; i < 4; ++i) { const int qq = tid + 512 * i, row = qq >> 4, ch = qq & 15, rs = q.dir ? 127 - row : row; *(u32x4*)(dst + (size_t)rs * D + ch * 8) = *(const LAS u32x4*)(TQ + row * TP + ch * 8); } }
            if (tid == 0) SC[0] = SC[2];
            __syncthreads();
        }
    }
}

__device__ __forceinline__ void phase_combine(Ctx& F) {
    const bf16* PROJ = (const bf16*)(F.ws + WS_PROJ); const bf16* OUTD = (const bf16*)(F.ws + WS_OUTD); bf16* Y = (bf16*)(F.ws + WS_ACT2);
    const int gw = F.vcu * 8 + F.wave, NGW = F.G * 8, lane = F.lane;
    const int col = lane * 16, grp = col >> 9;
    const size_t goff = (grp == 0 ? 1536 + col : 3584 + (col - 512));
    u32x4 na[2], nc[2], ng[2];
    { const int p0 = gw - (gw / PP) * PP; if (gw < R && p0 >= PADF) {
#pragma unroll
        for (int hh = 0; hh < 2; ++hh) { na[hh] = *(const u32x4*)(OUTD + (size_t)gw * D + col + hh * 8); nc[hh] = *(const u32x4*)(OUTD + ((size_t)R + gw) * D + col + hh * 8); ng[hh] = *(const u32x4*)(PROJ + (size_t)gw * PC + goff + hh * 8); } } }
    for (int r = gw; r < R; r += NGW) {
        const int b = r / PP, p = r - b * PP; bf16* yrow = Y + (size_t)r * D + lane * 16;
        u32x4 ca[2], cc[2], cg[2];
#pragma unroll
        for (int hh = 0; hh < 2; ++hh) { ca[hh] = na[hh]; cc[hh] = nc[hh]; cg[hh] = ng[hh]; }
        { const int r2 = r + NGW; const int p2 = r2 - (r2 / PP) * PP; if (r2 < R && p2 >= PADF) {
#pragma unroll
            for (int hh = 0; hh < 2; ++hh) { na[hh] = *(const u32x4*)(OUTD + (size_t)r2 * D + col + hh * 8); nc[hh] = *(const u32x4*)(OUTD + ((size_t)R + r2) * D + col + hh * 8); ng[hh] = *(const u32x4*)(PROJ + (size_t)r2 * PC + goff + hh * 8); } } }
        if (p < PADF) { *(u32x4*)yrow = (u32x4){0u, 0u, 0u, 0u}; *(u32x4*)(yrow + 8) = (u32x4){0u, 0u, 0u, 0u}; continue; }
        float v[16], gt[16];
#pragma unroll
        for (int hh = 0; hh < 2; ++hh) { const u32x4 a = ca[hh], c = cc[hh], g = cg[hh];
            const unsigned aw[4] = {a.x, a.y, a.z, a.w}, cw[4] = {c.x, c.y, c.z, c.w}, gw_[4] = {g.x, g.y, g.z, g.w};
#pragma unroll
            for (int j = 0; j < 4; ++j) { v[hh * 8 + 2 * j] = bflo(aw[j]) + bflo(cw[j]); v[hh * 8 + 2 * j + 1] = bfhi(aw[j]) + bfhi(cw[j]); gt[hh * 8 + 2 * j] = bflo(gw_[j]); gt[hh * 8 + 2 * j + 1] = bfhi(gw_[j]); } }
        if (grp == 1) {
#pragma unroll
            for (int j = 0; j < 16; ++j) v[j] *= sigmoidf_(gt[j]); }
        float s = 0.f;
#pragma unroll
        for (int j = 0; j < 16; ++j) s += v[j];
        s += __shfl_xor(s, 1); s += __shfl_xor(s, 2); s += __shfl_xor(s, 4);
        const float mu = s * (1.0f / 128.0f); float qv = 0.f;
#pragma unroll
        for (int j = 0; j < 16; ++j) { v[j] -= mu; qv += v[j] * v[j]; }
        qv += __shfl_xor(qv, 1); qv += __shfl_xor(qv, 2); qv += __shfl_xor(qv, 4);
        const float rstd = rsqrtf(qv * (1.0f / 128.0f) + EPS);
        const float* gnp = (grp == 0 ? F.ret_gn + col : F.ml_gn + (col - 512)); float gn[16];
#pragma unroll
        for (int j4 = 0; j4 < 4; ++j4) { const f32x4 g4 = *(const f32x4*)(gnp + 4 * j4); gn[4 * j4] = g4.x; gn[4 * j4 + 1] = g4.y; gn[4 * j4 + 2] = g4.z; gn[4 * j4 + 3] = g4.w; }
        unsigned o[8];
#pragma unroll
        for (int j = 0; j < 8; ++j) { float y0 = v[2 * j] * rstd * gn[2 * j], y1 = v[2 * j + 1] * rstd * gn[2 * j + 1];
            if (grp == 0) { y0 *= siluf_(gt[2 * j]); y1 *= siluf_(gt[2 * j + 1]); }
            o[j] = pk2(y0, y1); }
        *(u32x4*)yrow = (u32x4){o[0], o[1], o[2], o[3]}; *(u32x4*)(yrow + 8) = (u32x4){o[4], o[5], o[6], o[7]};
    }
}

constexpr int SK_RED = 34816;
__device__ __forceinline__ f32x4 skinny16_ksplit(LAS unsigned char* lds, const bf16* btrow, int w, int lane) {
    const LAS bf16* A = (const LAS bf16*)lds; LAS float* RED = (LAS float*)(lds + SK_RED);
    const int fr = lane & 15, fq = lane >> 4;
    f32x4 acc = (f32x4){0.f, 0.f, 0.f, 0.f};
    bf16x8 bb[4];
#pragma unroll
    for (int j = 0; j < 4; ++j) bb[j] = *(const bf16x8*)(btrow + (4 * w + j) * 32 + 8 * fq);
#pragma unroll
    for (int j = 0; j < 4; ++j) { const bf16x8 a = *(const LAS bf16x8*)(A + fr * 1032 + (4 * w + j) * 32 + 8 * fq); acc = MFMA16(a, bb[j], acc); }
    *(LAS f32x4*)(RED + w * 256 + lane * 4) = acc;
    __syncthreads();
    if (w == 0) { acc = (f32x4){0.f, 0.f, 0.f, 0.f};
#pragma unroll
        for (int ww = 0; ww < 8; ++ww) acc += *(const LAS f32x4*)(RED + ww * 256 + lane * 4); }
    return acc;
}
__device__ __forceinline__ void proj_meta(Ctx& F) {
    const bf16* U1 = (const bf16*)(F.ws + WS_ACT1); const bf16* WINT = (const bf16*)(F.ws + WS_WINT); bf16* PROJ = (bf16*)(F.ws + WS_PROJ); const f32x2* rope = (const f32x2*)(F.ws + WS_ROPE);
    LAS bf16* AT = (LAS bf16*)F.lds;
    for (int it = F.vcu; it < PC / 16; it += F.G) {
        int tid = F.tid; asm volatile("" : "+v"(tid));
        const int lane = tid & 63, fr = lane & 15, fq = lane >> 4;
        __syncthreads();
        for (int i = tid; i < 16 * 128; i += 512) { const int r = i >> 7, ch = i & 127; *(LAS u32x4*)(AT + r * 1032 + ch * 8) = *(const u32x4*)(U1 + (size_t)(PADF + r) * D + ch * 8); }
        __syncthreads();
        const int t = it * 16 + fr;
        const f32x4 acc = skinny16_ksplit(F.lds, WINT + (size_t)t * D, F.wave, lane);
        if (F.wave == 0) {
#pragma unroll
            for (int rg = 0; rg < 4; ++rg) {
                const int n = 4 * fq + rg; float val = acc[rg]; int col = t;
                const float other = __shfl_xor(val, 4);
                if (t < 1024) {
                    const int tc = t & 127, dd = 4 * (tc >> 3) + (tc & 3); const f32x2 cs = rope[n * 64 + dd]; const float sc = (t < 512) ? 0.08838834764831845f : 1.0f;
                    if ((tc & 4) == 0) { val = (val * cs.x - other * cs.y) * sc; col = (t & ~127) + dd; } else { val = (val * cs.x + other * cs.y) * sc; col = (t & ~127) + 64 + dd; }
                }
                const bf16 hv = (bf16)f2bf(val);
#pragma unroll
                for (int b = 0; b < NB; ++b) PROJ[((size_t)b * PP + PADF + n) * PC + col] = hv;
            }
        }
    }
}
__device__ __forceinline__ void out_meta(Ctx& F) {
    const bf16* Y = (const bf16*)(F.ws + WS_ACT2); const bf16* WOUTT = (const bf16*)(F.ws + WS_WOUTT); float* H1M = (float*)(F.ws + WS_H1META);
    LAS bf16* AT = (LAS bf16*)F.lds;
    for (int it = F.vcu; it < NB * (D / 16); it += F.G) {
        int tid = F.tid; asm volatile("" : "+v"(tid));
        const int lane = tid & 63, fr = lane & 15, fq = lane >> 4;
        const int b = it >> 6, cg_ = it & 63;
        __syncthreads();
        for (int i = tid; i < 16 * 128; i += 512) { const int r = i >> 7, ch = i & 127; *(LAS u32x4*)(AT + r * 1032 + ch * 8) = *(const u32x4*)(Y + ((size_t)b * PP + PADF + r) * D + ch * 8); }
        __syncthreads();
        const int col = cg_ * 16 + fr;
        const f32x4 acc = skinny16_ksplit(F.lds, WOUTT + (size_t)col * D, F.wave, lane);
        if (F.wave == 0) {
#pragma unroll
            for (int rg = 0; rg < 4; ++rg) { const int n = 4 * fq + rg; H1M[(size_t)(b * NMETA + n) * D + col] = F.meta[(size_t)n * D + col] + acc[rg]; } }
    }
}

__device__ __forceinline__ void phase_router(Ctx& F) {
    const int gw = F.vcu * 8 + F.wave, NGW = F.G * 8;
    {
        unsigned char* WgT = F.ws + WS_WEXP; unsigned char* WuT = F.ws + WS_WEXP + WEXP_ONE;
        LAS float* scr = (LAS float*)(F.lds + F.wave * F8SCR);
        constexpr int I_ONE = (D / 64) * (DFF / 64);
        for (int it = gw; it < 2 * NE * I_ONE; it += NGW) {
            const int mat = it / (NE * I_ONE), rem = it - mat * (NE * I_ONE), e = rem / I_ONE, item = rem - e * I_ONE;
            if (mat == 0) transpose_item_f8(F.w_gate + (size_t)e * D * DFF, D, DFF, DFF, WgT + (size_t)e * DFF * D, scr, item, F.lane, WPRE_UP);
            else transpose_item_f8(F.w_up + (size_t)e * D * DFF, D, DFF, DFF, WuT + (size_t)e * DFF * D, scr, item, F.lane, WPRE_UP);
        }
    }
    __syncthreads();
    unsigned char* U2 = F.ws + WS_ACT1; float* AFF = (float*)(F.ws + WS_AFF); const float* H1M = (const float*)(F.ws + WS_H1META);
    RowDots W; rowdots_init(W, F.w_router, NE, F.wave, F.lane);
    for (int bi = F.vcu; bi < R / 16; bi += F.G) {
        const int r0 = bi * 16;
        int rr[2]; bool ok[2]; f32x4 u[2][4];
#pragma unroll
        for (int t = 0; t < 2; ++t) { rr[t] = r0 + 2 * F.wave + t; const int b = rr[t] / PP, p = rr[t] - b * PP; ok[t] = p >= PADF;
            if (ok[t]) { if (p < CHK) row_load(H1M + (size_t)(b * NMETA + p - PADF) * D, F.lane, u[t]); else { const size_t xo = ((size_t)b * SEQ + (p - CHK)) * D; row_load_bf((const bf16*)(F.ws + WS_DELTA) + xo, F.lane, u[t]); } }
            else {
#pragma unroll
                for (int jj = 0; jj < 4; ++jj) u[t][jj] = (f32x4){0.f, 0.f, 0.f, 0.f}; } }
#pragma unroll
        for (int t = 0; t < 2; ++t) { if (ok[t]) { rms_apply(F.ffn_g, F.lane, u[t]); unsigned char* urow = U2 + (size_t)rr[t] * D;
#pragma unroll
                for (int jj = 0; jj < 4; ++jj) *(unsigned*)(urow + jj * 256 + F.lane * 4) = pk4_fp8(u[t][jj].x, u[t][jj].y, u[t][jj].z, u[t][jj].w); }
            rowdots_put(F.lds, 2 * F.wave + t, F.lane, u[t]); }
        __syncthreads();
        rowdots_mma(F.lds, W, F.wave, F.lane);
        __syncthreads();
        if (F.tid < 256) { const int row = F.tid >> 4, g = F.tid & 15, r = r0 + row; const int b = r / PP, p = r - b * PP;
            const float lg = rowdots_get(F.lds, row, g);
            float mx = lg; mx = fmaxf(mx, __shfl_xor(mx, 1)); mx = fmaxf(mx, __shfl_xor(mx, 2)); mx = fmaxf(mx, __shfl_xor(mx, 4)); mx = fmaxf(mx, __shfl_xor(mx, 8));
            const float ev = expf(lg - mx); float sm = ev; sm += __shfl_xor(sm, 1); sm += __shfl_xor(sm, 2); sm += __shfl_xor(sm, 4); sm += __shfl_xor(sm, 8);
            if (p >= PADF) AFF[((size_t)b * NE + g) * NTOK + (p - PADF)] = ev / sm; }
    }
}

__device__ __forceinline__ void phase_topk(Ctx& F) {
    const float* AFF = (const float*)(F.ws + WS_AFF); int* IDX = (int*)(F.ws + WS_IDX); float* GV = (float*)(F.ws + WS_GV); int* SLOT = (int*)(F.ws + WS_SLOT); unsigned* ROWOFF = (unsigned*)(F.ws + WS_SCAL);
    LAS unsigned* keys = (LAS unsigned*)F.lds; LAS unsigned* hist = keys + 8448; LAS unsigned* misc = hist + 256; LAS unsigned* wtot = misc + 16;
    const int tid = F.tid, lane = F.lane, w = F.wave;
    if (F.vcu >= NB * NE) { convert_wd(F, WD_SPLIT, NE * I_WD, (F.vcu - NB * NE) * 8 + F.wave, (F.G - NB * NE) * 8); return; }
    for (int u = F.vcu; u < NB * NE; u += F.G) {
        const int b = u >> 4, e = u & 15; const float* a = AFF + (size_t)u * NTOK;
        __syncthreads();
        for (int i = tid; i < NTOK; i += 512) keys[i] = __builtin_bit_cast(unsigned, a[i]);
        unsigned prefix = 0u, need = CAP;
        for (int pass = 0; pass < 4; ++pass) {
            const int shift = 24 - 8 * pass;
            if (tid < 256) hist[tid] = 0u;
            __syncthreads();
            for (int i = tid; i < NTOK; i += 512) { const unsigned k = keys[i]; if (pass == 0 || (k >> (shift + 8)) == (prefix >> (shift + 8))) atomicAdd((unsigned*)&hist[(k >> shift) & 255u], 1u); }
            __syncthreads();
            if (w == 0) {
                const int bb = 255 - 4 * lane; const unsigned c0 = hist[bb], c1 = hist[bb - 1], c2 = hist[bb - 2], c3 = hist[bb - 3]; const unsigned tot = c0 + c1 + c2 + c3;
                const float incl_f = wave_scan_incl<false>((float)tot); const unsigned incl = (unsigned)incl_f, excl = incl - tot;
                const bool here = excl < need && need <= incl;
                if (here) { unsigned cum = excl; int sel = bb;
                    if (cum + c0 >= need) sel = bb; else { cum += c0; if (cum + c1 >= need) sel = bb - 1; else { cum += c1; if (cum + c2 >= need) sel = bb - 2; else { cum += c2; sel = bb - 3; } } }
                    misc[0] = prefix | ((unsigned)sel << shift); misc[1] = need - cum; }
            }
            __syncthreads();
            prefix = misc[0]; need = misc[1];
            __syncthreads();
        }
        const int i0 = tid * 17, i1 = (i0 + 17 < NTOK) ? i0 + 17 : NTOK;
        unsigned cg_ = 0u, ce = 0u;
        for (int i = i0; i < i1; ++i) { const unsigned k = keys[i]; cg_ += (k > prefix) ? 1u : 0u; ce += (k == prefix) ? 1u : 0u; }
        unsigned sg = cg_, se = ce;
#pragma unroll
        for (int o = 1; o < 64; o <<= 1) { const unsigned tg = __shfl_up(sg, o), te = __shfl_up(se, o); if (lane >= o) { sg += tg; se += te; } }
        if (lane == 63) { wtot[w] = sg; wtot[8 + w] = se; }
        __syncthreads();
        unsigned og = 0u, oe = 0u;
        for (int j = 0; j < w; ++j) { og += wtot[j]; oe += wtot[8 + j]; }
        unsigned gb = og + sg - cg_, eb = oe + se - ce;
        for (int i = i0; i < i1; ++i) { const unsigned k = keys[i]; int slot = -1;
            if (k > prefix) { slot = (int)(gb + (eb < need ? eb : need)); ++gb; }
            else if (k == prefix) { if (eb < need) slot = (int)(gb + eb); ++eb; }
            SLOT[((size_t)b * NTOK + i) * NE + e] = slot;
            if (slot >= 0) { IDX[(size_t)u * CAP + slot] = i; GV[(size_t)u * CAP + slot] = __builtin_bit_cast(float, k);
                const int j = b * CAP + slot; if (j < 4096) ROWOFF[e * 4096 + j] = (unsigned)(b * PP + PADF + i) * (unsigned)D; } }
    }
}

constexpr size_t WS_HIDT = WS_UN;
constexpr int XT_PITCH = D + 16, HT_PITCH = DFF + 16;
__device__ __forceinline__ void ffn_thin_up(Ctx& F) {
    const unsigned char* U2 = F.ws + WS_ACT1; const int* IDX = (const int*)(F.ws + WS_IDX);
    const unsigned char* WgT = F.ws + WS_WEXP; const unsigned char* WuT = F.ws + WS_WEXP + WEXP_ONE; unsigned char* HIDT = F.ws + WS_HIDT;
    LAS unsigned char* XT = F.lds;
    const int w = F.wave;
    for (int it = F.vcu; it < NE * 22; it += F.G) {
        int tid = F.tid; asm volatile("" : "+v"(tid));
        const int lane = tid & 63, fr = lane & 15, fq = lane >> 4;
        const int e = it / 22, ft = it % 22;
        __syncthreads();
        if (tid < 8 * 64) { const int r = tid >> 6, ch = tid & 63; const int j = 4096 + r, b = j / CAP, slot = j - b * CAP; const int n = IDX[(b * NE + e) * CAP + slot];
            *(LAS u32x4*)(XT + r * XT_PITCH + ch * 16) = *(const u32x4*)(U2 + ((size_t)b * PP + PADF + n) * D + ch * 16); }
        __syncthreads();
        const int f = ft * 128 + w * 16 + fr;
        const unsigned char* wg = WgT + ((size_t)e * DFF + f) * D + 8 * fq; const unsigned char* wu = WuT + ((size_t)e * DFF + f) * D + 8 * fq;
        f32x4 ag = (f32x4){0.f, 0.f, 0.f, 0.f}, au = ag;
#pragma unroll 1
        for (int k8 = 0; k8 < 32; k8 += 16) {
            long bg[16], bu[16];
#pragma unroll
            for (int j = 0; j < 16; ++j) { bg[j] = *(const long*)(wg + (k8 + j) * 32); bu[j] = *(const long*)(wu + (k8 + j) * 32); }
#pragma unroll
            for (int j = 0; j < 16; ++j) { long a = *(const LAS long*)(XT + (fr & 7) * XT_PITCH + (k8 + j) * 32 + 8 * fq); if (fr >= 8) a = 0;
                ag = __builtin_amdgcn_mfma_f32_16x16x32_fp8_fp8(a, bg[j], ag, 0, 0, 0); au = __builtin_amdgcn_mfma_f32_16x16x32_fp8_fp8(a, bu[j], au, 0, 0, 0); }
        }
        if (fq < 2) {
            float hv[4];
#pragma unroll
            for (int rg = 0; rg < 4; ++rg) hv[rg] = fminf(fmaxf(siluf_(ag[rg] * (1.0f / WPRE_UP)) * (au[rg] * (1.0f / WPRE_UP)), -448.0f), 448.0f);
            const unsigned pk = pk4_fp8(hv[0], hv[1], hv[2], hv[3]);
#pragma unroll
            for (int rg = 0; rg < 4; ++rg) HIDT[((size_t)e * 8 + 4 * fq + rg) * DFF + f] = (unsigned char)(pk >> (8 * rg)); }
    }
}
__device__ __forceinline__ void ffn_thin_down(Ctx& F) {
    const unsigned char* WdT = F.ws + WS_WD8; const unsigned char* HIDT = F.ws + WS_HIDT; bf16* YE = (bf16*)(F.ws + WS_YE);
    LAS unsigned char* HT = F.lds;
    const int w = F.wave;
    for (int it = F.vcu; it < NE * 8; it += F.G) {
        int tid = F.tid; asm volatile("" : "+v"(tid));
        const int lane = tid & 63, fr = lane & 15, fq = lane >> 4;
        const int e = it >> 3, dt = it & 7;
        __syncthreads();
        for (int i = tid; i < 8 * 176; i += 512) { const int r = i / 176, ch = i - r * 176; *(LAS u32x4*)(HT + r * HT_PITCH + ch * 16) = *(const u32x4*)(HIDT + ((size_t)e * 8 + r) * DFF + ch * 16); }
        __syncthreads();
        const int d = dt * 128 + w * 16 + fr;
        const unsigned char* wd = WdT + ((size_t)e * D + d) * DFF + 8 * fq;
        f32x4 ay = (f32x4){0.f, 0.f, 0.f, 0.f};
#pragma unroll 1
        for (int k8 = 0; k8 < 88; k8 += 22) {
            long bd[22];
#pragma unroll
            for (int j = 0; j < 22; ++j) bd[j] = *(const long*)(wd + (k8 + j) * 32);
#pragma unroll
            for (int j = 0; j < 22; ++j) { long a = *(const LAS long*)(HT + (fr & 7) * HT_PITCH + (k8 + j) * 32 + 8 * fq); if (fr >= 8) a = 0;
                ay = __builtin_amdgcn_mfma_f32_16x16x32_fp8_fp8(a, bd[j], ay, 0, 0, 0); }
        }
        if (fq < 2) {
#pragma unroll
            for (int rg = 0; rg < 4; ++rg) YE[((size_t)e * EROWSP + 4096 + 4 * fq + rg) * D + d] = (bf16)f2bf(ay[rg] * (1.0f / WPRE_DN)); }
    }
}

struct FinTok { f32x4 h[4]; int slot; };
struct FinY { u32x2 ya[4], yb[4]; float ga, gb; unsigned rest; };
__device__ __forceinline__ void phase_final(Ctx& F) {
    const int* SLOT = (const int*)(F.ws + WS_SLOT); const float* GV = (const float*)(F.ws + WS_GV); const bf16* YE = (const bf16*)(F.ws + WS_YE);
    const int gw = F.vcu * 8 + F.wave, NGW = F.G * 8, lane = F.lane;
    const bf16* DELTA = (const bf16*)(F.ws + WS_DELTA);
    constexpr int NT = NB * SEQ;
#define FIN_STAGE1(t_, K) do { const int _t = (t_); (K).slot = -1; if (_t < NT) { row_load_bf(DELTA + (size_t)_t * D, lane, (K).h); \
        const int _b = _t / SEQ, _n = _t - _b * SEQ + NMETA; (K).slot = (lane < 16) ? SLOT[((size_t)_b * NTOK + _n) * NE + lane] : -1; } } while (0)
#define FIN_STAGE2(t_, K, Y) do { const int _t = (t_); unsigned _em = (unsigned)(__ballot((K).slot >= 0) & 0xffffull); (Y).ga = 0.0f; (Y).gb = 0.0f; \
        _Pragma("unroll") for (int jj = 0; jj < 4; ++jj) { (Y).ya[jj] = (u32x2){0u, 0u}; (Y).yb[jj] = (u32x2){0u, 0u}; } \
        if (_em) { const int _b = _t / SEQ; const int _ea = __builtin_ctz(_em); _em &= _em - 1u; const bool _two = _em != 0u; const int _eb = _two ? __builtin_ctz(_em) : _ea; if (_two) _em &= _em - 1u; \
            const int _sa = __shfl((K).slot, _ea), _sb = __shfl((K).slot, _eb); \
            (Y).ga = GV[((size_t)_b * NE + _ea) * CAP + _sa]; (Y).gb = _two ? GV[((size_t)_b * NE + _eb) * CAP + _sb] : 0.0f; \
            const bf16* _ya = YE + ((size_t)_ea * EROWSP + (size_t)_b * CAP + _sa) * D; const bf16* _yb = YE + ((size_t)_eb * EROWSP + (size_t)_b * CAP + _sb) * D; \
            _Pragma("unroll") for (int jj = 0; jj < 4; ++jj) { (Y).ya[jj] = *(const u32x2*)(_ya + jj * 256 + lane * 4); (Y).yb[jj] = *(const u32x2*)(_yb + jj * 256 + lane * 4); } } \
        (Y).rest = _em; } while (0)
    FinTok k0, k1, k2; FinY y0, y1;
    FIN_STAGE1(gw, k0); FIN_STAGE1(gw + NGW, k1);
    FIN_STAGE2(gw, k0, y0);
    for (int t = gw; t < NT; t += NGW) {
        FIN_STAGE2(t + NGW, k1, y1);
        FIN_STAGE1(t + 2 * NGW, k2);
        const int b = t / SEQ;
        float* row = F.out + (size_t)t * D;
        f32x4 v[4];
#pragma unroll
        for (int jj = 0; jj < 4; ++jj) {
            v[jj].x = k0.h[jj].x + y0.ga * bflo(y0.ya[jj].x) + y0.gb * bflo(y0.yb[jj].x); v[jj].y = k0.h[jj].y + y0.ga * bfhi(y0.ya[jj].x) + y0.gb * bfhi(y0.yb[jj].x);
            v[jj].z = k0.h[jj].z + y0.ga * bflo(y0.ya[jj].y) + y0.gb * bflo(y0.yb[jj].y); v[jj].w = k0.h[jj].w + y0.ga * bfhi(y0.ya[jj].y) + y0.gb * bfhi(y0.yb[jj].y); }
        const int myslot = k0.slot;
        unsigned em = y0.rest;
        while (em) {
            const int ea = __builtin_ctz(em); em &= em - 1u; const bool two = em != 0u; const int eb = two ? __builtin_ctz(em) : ea; if (two) em &= em - 1u;
            const int sa = __shfl(myslot, ea), sb = __shfl(myslot, eb);
            const float ga = GV[((size_t)b * NE + ea) * CAP + sa], gb = two ? GV[((size_t)b * NE + eb) * CAP + sb] : 0.0f;
            const bf16* ya = YE + ((size_t)ea * EROWSP + (size_t)b * CAP + sa) * D; const bf16* yb = YE + ((size_t)eb * EROWSP + (size_t)b * CAP + sb) * D;
            u32x2 wa[4], wb[4];
#pragma unroll
            for (int jj = 0; jj < 4; ++jj) { wa[jj] = *(const u32x2*)(ya + jj * 256 + lane * 4); wb[jj] = *(const u32x2*)(yb + jj * 256 + lane * 4); }
#pragma unroll
            for (int jj = 0; jj < 4; ++jj) {
                v[jj].x += ga * bflo(wa[jj].x) + gb * bflo(wb[jj].x); v[jj].y += ga * bfhi(wa[jj].x) + gb * bfhi(wb[jj].x);
                v[jj].z += ga * bflo(wa[jj].y) + gb * bflo(wb[jj].y); v[jj].w += ga * bfhi(wa[jj].y) + gb * bfhi(wb[jj].y); }
        }
        float ss = 0.f;
#pragma unroll
        for (int jj = 0; jj < 4; ++jj) ss += v[jj].x * v[jj].x + v[jj].y * v[jj].y + v[jj].z * v[jj].z + v[jj].w * v[jj].w;
        const float rstd = rsqrtf(wave_sum(ss) * (1.0f / D) + EPS);
#pragma unroll
        for (int jj = 0; jj < 4; ++jj) { const f32x4 gv = *(const f32x4*)(F.fin_g + jj * 256 + lane * 4); *(f32x4*)(row + jj * 256 + lane * 4) = v[jj] * rstd * gv; }
        k0 = k1; k1 = k2; y0 = y1;
    }
#undef FIN_STAGE1
#undef FIN_STAGE2
}

constexpr int N_PHASES = 12;
struct Args { const float* in[17]; float* out; unsigned char* ws; };
#define XB_TMO      128
#define XB_XCNT(j)  (256  + 64 * (j))
#define XB_XSUB(j)  (1280 + 64 * (j))
#define XB_XGEN(j)  (2304 + 64 * (j))
#define XB_TOP      3328
#define XB_TOPGEN   3392
#define XCD_BAR_WORDS 3456
#define XB_SPIN_CAP (1u << 22)
__device__ __forceinline__ unsigned xb_ld(unsigned* p)              { return __hip_atomic_load(p, __ATOMIC_RELAXED, __HIP_MEMORY_SCOPE_AGENT); }
__device__ __forceinline__ unsigned xb_add(unsigned* p, unsigned v) { return __hip_atomic_fetch_add(p, v, __ATOMIC_RELAXED, __HIP_MEMORY_SCOPE_AGENT); }
__device__ __forceinline__ unsigned xb_xcc_id() { return (unsigned)__builtin_amdgcn_s_getreg((3 << 11) | 20) & 0xFu; }
#define XB_SPIN(cond, bar) do { unsigned _sp = 0; while (cond) { __builtin_amdgcn_s_sleep(1); \
    if ((++_sp & 255u) == 0u) { if (xb_ld(&(bar)[XB_TMO])) break; if (_sp > XB_SPIN_CAP) { atomicAdd(&(bar)[XB_TMO], 1u); break; } } } } while (0)
struct XcdBarrier { unsigned* bar; unsigned x; volatile LAS unsigned* st; };
__device__ __forceinline__ XcdBarrier xcd_barrier_post(unsigned* bar, volatile LAS unsigned* st) {
    XcdBarrier b; b.bar = bar; b.x = xb_xcc_id(); b.st = st;
    if (threadIdx.x == 0) (void)xb_add(&bar[XB_XCNT(b.x)], 1u);
    return b;
}
__device__ __forceinline__ void xcd_barrier_complete(unsigned* bar, unsigned x, unsigned& nloc, unsigned& nx) {
    const unsigned G = gridDim.x * gridDim.y * gridDim.z;
    unsigned sum, cnt, mine, sp = 0u;
    for (;;) {
        sum = 0u; cnt = 0u; mine = 0u;
#pragma unroll
        for (unsigned j = 0; j < 16; ++j) { const unsigned c = xb_ld(&bar[XB_XCNT(j)]); sum += c; cnt += (c > 0u) ? 1u : 0u; mine = (j == x) ? c : mine; }
        if (sum == G) break;
        __builtin_amdgcn_s_sleep(1);
        if ((++sp & 255u) == 0u) { if (xb_ld(&bar[XB_TMO])) break; if (sp > XB_SPIN_CAP) { atomicAdd(&bar[XB_TMO], 1u); break; } }
    }
    nloc = mine > 0u ? mine : 1u; nx = cnt > 0u ? cnt : 1u;
}
__device__ __forceinline__ void xcd_barrier(const XcdBarrier& b) {
    asm volatile("s_waitcnt vmcnt(0)" ::: "memory");
    __syncthreads();
    if (threadIdx.x == 0) {
        unsigned* bar = b.bar;
        __builtin_amdgcn_s_waitcnt(0);
        unsigned nloc = b.st[0], nx = b.st[1];
        if (nloc == 0u) { xcd_barrier_complete(bar, b.x, nloc, nx); b.st[0] = nloc; b.st[1] = nx; }
        const unsigned old = xb_add(&bar[XB_XSUB(b.x)], 1u);
        const unsigned gen = old / nloc;
        if (old + 1u == (gen + 1u) * nloc) {
            __builtin_amdgcn_fence(__ATOMIC_RELEASE, "agent");
            asm volatile("s_waitcnt vmcnt(0)" ::: "memory");
            const unsigned og = xb_add(&bar[XB_TOP], 1u);
            const unsigned tg = og / nx;
            if (og + 1u == (tg + 1u) * nx) xb_add(&bar[XB_TOPGEN], 1u);
            else XB_SPIN(xb_ld(&bar[XB_TOPGEN]) == tg, bar);
            __builtin_amdgcn_fence(__ATOMIC_ACQUIRE, "agent");
            xb_add(&bar[XB_XGEN(b.x)], 1u);
            asm volatile("s_waitcnt vmcnt(0)" ::: "memory");
        } else {
            XB_SPIN(xb_ld(&bar[XB_XGEN(b.x)]) == gen, bar);
            __builtin_amdgcn_fence(__ATOMIC_ACQUIRE, "agent");
            asm volatile("s_waitcnt vmcnt(0)" ::: "memory");
        }
    }
    __syncthreads();
}
constexpr int MISC_OFF = LDS_BYTES - 16;

typedef const __attribute__((address_space(4))) Args* ArgsP;
__device__ __forceinline__ void make_ctx(Ctx& F, unsigned char* lds_raw) {
    ArgsP A = (ArgsP)__builtin_amdgcn_kernarg_segment_ptr(); asm volatile("" : "+s"(A));
    F.lds = (LAS unsigned char*)lds_raw;
    { int t = threadIdx.x; asm volatile("" : "+v"(t)); F.tid = t; } F.lane = F.tid & 63; F.wave = __builtin_amdgcn_readfirstlane(F.tid >> 6);
    F.G = gridDim.x; { const int bx = blockIdx.x; F.vcu = (F.G % 8 == 0) ? (bx % 8) * (F.G / 8) + bx / 8 : bx; }
    F.x = A->in[0]; F.meta = A->in[1]; F.mix_g = A->in[2]; F.w_in = A->in[3]; F.b_gates = A->in[4]; F.conv_w = A->in[5]; F.conv_b = A->in[6];
    F.ret_logit = A->in[7]; F.ret_gn = A->in[8]; F.ml_gn = A->in[9]; F.w_out = A->in[10]; F.ffn_g = A->in[11]; F.w_router = A->in[12];
    F.w_gate = A->in[13]; F.w_up = A->in[14]; F.w_down = A->in[15]; F.fin_g = A->in[16];
    F.out = A->out; F.ws = A->ws;
}
template <int LO, int HI> __global__ void __launch_bounds__(512, 2) mk_fwd(Args args) {
    extern __shared__ __attribute__((aligned(16))) unsigned char lds_raw[];
#if MK_SPLIT
#define GRID_BAR() do {} while (0)
#elif MK_BARRIER == 0
    cg::grid_group grid = cg::this_grid();
#define GRID_BAR() grid.sync()
#else
    XcdBarrier xbar;
    {   volatile LAS unsigned* st = (volatile LAS unsigned*)((LAS unsigned char*)lds_raw + MISC_OFF);
        if (threadIdx.x < 4) st[threadIdx.x] = 0u;
        __syncthreads();
        ArgsP A0 = (ArgsP)__builtin_amdgcn_kernarg_segment_ptr();
        xbar = xcd_barrier_post((unsigned*)A0->ws, st); }
#define GRID_BAR() xcd_barrier(xbar)
#endif
#define IN(k) (LO <= (k) && (k) < HI)
#define SEAM(k) do { if (IN(k) && IN((k) + 1)) GRID_BAR(); } while (0)
#define CTX() Ctx F; make_ctx(F, lds_raw)

    if (IN(0)) { CTX(); phase_prep(F); } SEAM(0);
    if (IN(1)) {
        CTX();
        pg8::DenseOrder S{(const bf16*)(F.ws + WS_ACT1), (const bf16*)(F.ws + WS_WINT), D, D, NB * SEQ / 256, PC / 256, (NB * SEQ / 256) * (PC / 256), F.G, (int)blockIdx.x};
        pg8::EpiProj E{(bf16*)(F.ws + WS_PROJ), (const f32x2*)(F.ws + WS_ROPE)};
        pg8::gemm_phase(F.lds, D, S, E);
        proj_meta(F);
    } SEAM(1);
    if (IN(2)) { CTX(); phase_rope_conv(F); } SEAM(2);
    if (IN(3)) { CTX(); phase_seg_summary(F); } SEAM(3);
    if (IN(4)) { CTX(); phase_seq(F); } SEAM(4);
    if (IN(5)) { CTX(); phase_combine(F); } SEAM(5);
    if (IN(6)) {
        CTX();
        pg8::DenseOrder S{(const bf16*)(F.ws + WS_ACT2), (const bf16*)(F.ws + WS_WOUTT), D, D, NB * SEQ / 256, D / 256, (NB * SEQ / 256) * (D / 256), F.G, (int)blockIdx.x};
        pg8::EpiDelta E{(bf16*)(F.ws + WS_DELTA), F.x};
        pg8::gemm_phase(F.lds, D, S, E);
        out_meta(F);
    } SEAM(6);
    if (IN(7)) { CTX(); phase_router(F); } SEAM(7);
    if (IN(8)) { CTX(); phase_topk(F); } SEAM(8);
    if (IN(9)) {
        CTX();
        pg8::FfnUpOrder S{F.ws + WS_ACT1, (const unsigned*)(F.ws + WS_SCAL), F.ws + WS_WEXP, F.ws + WS_WEXP + WEXP_ONE, D / 2, D / 2, NE * 22 * 16, F.G, F.vcu};
        pg8::EpiSwiglu E{F.ws + WS_HID};
        pg8::gemm_phase(F.lds, D / 2, S, E);
        ffn_thin_up(F);
    } SEAM(9);
    if (IN(10)) {
        CTX();
        pg8::FfnDownOrder S{F.ws + WS_HID, F.ws + WS_WD8, DFF / 2, DFF / 2, NE * 4 * 16, F.G, F.vcu};
        pg8::EpiStoreBf16 E{(bf16*)(F.ws + WS_YE), D, (size_t)EROWSP * D};
        pg8::gemm_phase(F.lds, DFF / 2, S, E);
        ffn_thin_down(F);
    } SEAM(10);
    if (IN(11)) { CTX(); phase_final(F); }
#undef IN
#undef SEAM
#undef CTX
}

template <int PH> static void launch_split(int grid, hipStream_t stream, const Args& a) {
    if constexpr (PH < N_PHASES) {
        static bool attr = false;
        if (!attr) { (void)hipFuncSetAttribute((const void*)mk_fwd<PH, PH + 1>, hipFuncAttributeMaxDynamicSharedMemorySize, LDS_BYTES); attr = true; }
        hipLaunchKernelGGL((mk_fwd<PH, PH + 1>), dim3(grid), dim3(512), LDS_BYTES, stream, a);
        if ((PROBE_MASK >> PH) & 1) hipLaunchKernelGGL((mk_fwd<PH, PH + 1>), dim3(grid), dim3(512), LDS_BYTES, stream, a);
        launch_split<PH + 1>(grid, stream, a);
    }
}
extern "C" void kernel_launch(void* const* d_in, const int* in_sizes, int n_in, void* d_out, int out_size, void* d_ws, size_t ws_size, hipStream_t stream) {
    static int grid = 0;
    if (grid == 0) {
        if (n_in != 17 || out_size != NB * SEQ * D || ws_size < WS_END) { fprintf(stderr, "kernel_launch: unexpected shapes (n_in %d out %d ws %zu need %zu)\n", n_in, out_size, ws_size, (size_t)WS_END); grid = -1; return; }
        int dev = 0, cus = 0;
        if (hipGetDevice(&dev) != hipSuccess || hipDeviceGetAttribute(&cus, hipDeviceAttributeMultiprocessorCount, dev) != hipSuccess) { grid = -1; return; }
#if !MK_SPLIT
        int per_cu = 0;
        if (hipFuncSetAttribute((const void*)mk_fwd<0, N_PHASES>, hipFuncAttributeMaxDynamicSharedMemorySize, LDS_BYTES) != hipSuccess) { fprintf(stderr, "kernel_launch: hipFuncSetAttribute failed\n"); grid = -1; return; }
        if (hipOccupancyMaxActiveBlocksPerMultiprocessor(&per_cu, (const void*)mk_fwd<0, N_PHASES>, 512, LDS_BYTES) != hipSuccess || per_cu < 1) { fprintf(stderr, "kernel_launch: occupancy query says %d\n", per_cu); }
#endif
        (void)hipGetLastError();
        grid = cus;
    }
    if (grid < 0) return;
    Args a{};
    for (int i = 0; i < 17; ++i) a.in[i] = (const float*)d_in[i];
    a.out = (float*)d_out; a.ws = (unsigned char*)d_ws;
#if MK_SPLIT
    launch_split<0>(grid, stream, a);
#else
#if MK_BARRIER == 0
    void* kargs[] = {&a};
    hipError_t e = hipLaunchCooperativeKernel((const void*)mk_fwd<0, N_PHASES>, dim3(grid), dim3(512), kargs, LDS_BYTES, stream);
    if (e != hipSuccess) fprintf(stderr, "cooperative launch failed: %s (grid %d)\n", hipGetErrorString(e), grid);
#else
    if (hipMemsetAsync(d_ws, 0, 16384, stream) != hipSuccess) { fprintf(stderr, "kernel_launch: memset of barrier words failed\n"); return; }
    hipLaunchKernelGGL((mk_fwd<0, N_PHASES>), dim3(grid), dim3(512), LDS_BYTES, stream, a);
#endif
#endif
}
```

```cpp
#include <hip/hip_runtime.h>
#include <hip/hip_cooperative_groups.h>
#include <cstdio>
#include <cstdint>
namespace cg = cooperative_groups;

#ifndef MK_SPLIT
#define MK_SPLIT 0
#endif
#ifndef PROBE_MASK
#define PROBE_MASK 0
#endif
#ifndef MK_BARRIER
#define MK_BARRIER 1
#endif

#define GAS __attribute__((address_space(1)))
#define LAS __attribute__((address_space(3)))
typedef unsigned short bf16;
typedef short bf16x8 __attribute__((ext_vector_type(8)));
typedef float f32x4 __attribute__((ext_vector_type(4)));
typedef float f32x2 __attribute__((ext_vector_type(2)));
typedef unsigned u32x4 __attribute__((ext_vector_type(4)));
typedef unsigned u32x2 __attribute__((ext_vector_type(2)));
typedef int i32x8 __attribute__((ext_vector_type(8)));
typedef int i32x4 __attribute__((ext_vector_type(4)));

constexpr int NB = 4, SEQ = 8192, D = 1024, NMETA = 16, CHK = 128, PADF = 112;
constexpr int NTOK = NMETA + SEQ;
constexpr int PP = NTOK + PADF;
constexpr int NCH = PP / CHK;
constexpr int R = NB * PP;
constexpr int PCOLS = 4112, PC = 4096;
constexpr int NE = 16, CAP = 1026, DFF = 2816, EROWS = NB * CAP, EROWSP = 4352;
constexpr int NH = 4;
constexpr float EPS = 1e-6f, NEGF = -1e30f;
constexpr int WSC_UP = 0x7A7A7A7A, WSC_DN = 0x79797979;
constexpr float WPRE_UP = 32.0f, WPRE_DN = 64.0f;

constexpr size_t MiB = 1u << 20;
constexpr size_t WS_ROPE = 1 * MiB, WS_GATES = 6 * MiB, WS_AFF = 9 * MiB, WS_IDX = 12 * MiB, WS_GV = 13 * MiB, WS_SLOT = 14 * MiB;
constexpr size_t WS_H1META = 17 * MiB, WS_UN = 18 * MiB, WS_SCAL = 21 * MiB, WS_WINT = 22 * MiB, WS_WOUTT = 30 * MiB;
constexpr size_t WS_ACT1 = 32 * MiB;
constexpr size_t WS_ACT2 = 97 * MiB;
constexpr size_t WS_PROJ = 162 * MiB;
constexpr size_t WS_STATE = 422 * MiB;
constexpr size_t WS_YE = 97 * MiB;
constexpr size_t WS_WEXP = 233 * MiB;
constexpr size_t WS_HID = 365 * MiB;
constexpr size_t WS_WD8 = 568 * MiB;
constexpr size_t WS_DELTA = 612 * MiB;
constexpr size_t WS_END = 684 * MiB;
constexpr size_t WEXP_ONE = (size_t)NE * DFF * D;
static_assert(WS_PROJ + (size_t)R * PC * 2 <= WS_STATE && WS_STATE + (size_t)64 * NCH * 16384 * 4 <= WS_END, "mixer map");
static_assert(WS_YE + (size_t)NE * EROWSP * D * 2 <= WS_WEXP && WS_WEXP + 2 * WEXP_ONE <= WS_HID && WS_WD8 + WEXP_ONE <= WS_DELTA && WS_DELTA + (size_t)NB * SEQ * D * 2 <= WS_END && WS_HID + (size_t)NE * 4096 * DFF <= WS_END, "ffn map");

constexpr int LDS_BYTES = 155648;
constexpr int TP = 136;
constexpr int T0_OFF = 0, T1_OFF = 34816, T2_OFF = 69632, T3_OFF = 104448, VEC_OFF = 139264;

__device__ __forceinline__ unsigned f2bf(float f) { unsigned u = __builtin_bit_cast(unsigned, f); return (u + 0x7fffu + ((u >> 16) & 1u)) >> 16; }
__device__ __forceinline__ unsigned pk2(float lo, float hi) { unsigned r; asm("v_cvt_pk_bf16_f32 %0, %1, %2" : "=v"(r) : "v"(lo), "v"(hi)); return r; }
__device__ __forceinline__ unsigned cvtpk(float lo, float hi) { unsigned r; asm("v_cvt_pk_bf16_f32 %0, %1, %2" : "=v"(r) : "v"(lo), "v"(hi)); return r; }
__device__ __forceinline__ unsigned pk4_fp8(float a, float b, float c, float d) { int p = __builtin_amdgcn_cvt_pk_fp8_f32(a, b, 0, false); p = __builtin_amdgcn_cvt_pk_fp8_f32(c, d, p, true); return (unsigned)p; }
__device__ __forceinline__ float bf2f(unsigned b) { return __builtin_bit_cast(float, b << 16); }
__device__ __forceinline__ float bflo(unsigned w) { return __builtin_bit_cast(float, w << 16); }
__device__ __forceinline__ float bfhi(unsigned w) { return __builtin_bit_cast(float, w & 0xffff0000u); }
template <bool MAXOP>
__device__ __forceinline__ float wave_scan_incl(float v) {
    const int idn = __builtin_bit_cast(int, MAXOP ? -3.0e38f : 0.0f);
#define DPP_STEP(ctrl, rmask) { const float t = __builtin_bit_cast(float, __builtin_amdgcn_update_dpp(idn, __builtin_bit_cast(int, v), ctrl, rmask, 0xF, false)); v = MAXOP ? fmaxf(v, t) : v + t; }
    DPP_STEP(0x111, 0xF) DPP_STEP(0x112, 0xF) DPP_STEP(0x114, 0xF) DPP_STEP(0x118, 0xF) DPP_STEP(0x142, 0xA) DPP_STEP(0x143, 0xC)
#undef DPP_STEP
    return v;
}
__device__ __forceinline__ float wave_sum(float v) { v = wave_scan_incl<false>(v); return __builtin_bit_cast(float, __builtin_amdgcn_readlane(__builtin_bit_cast(int, v), 63)); }
__device__ __forceinline__ float wave_max(float v) { v = wave_scan_incl<true>(v); return __builtin_bit_cast(float, __builtin_amdgcn_readlane(__builtin_bit_cast(int, v), 63)); }
__device__ __forceinline__ float sigmoidf_(float x) { return __builtin_amdgcn_rcpf(1.0f + __expf(-x)); }
__device__ __forceinline__ float siluf_(float x) { return x * __builtin_amdgcn_rcpf(1.0f + __expf(-x)); }
__device__ __forceinline__ float logsigmoidf_(float x) { return fminf(x, 0.0f) - log1pf(__expf(-fabsf(x))); }
#define LDS_WAIT() asm volatile("s_waitcnt lgkmcnt(0)" ::: "memory")

namespace pg8 {
constexpr int BM = 256, BK = 64, HALF = 128, HTB = HALF * BK * 2, STAGE_BYTES = 8 * HTB;
__device__ __forceinline__ int lds_byte(int r, int c) { const int st = (r >> 4) * 2 + (c >> 5), rr = r & 15, cc = c & 31, ob = rr * 64 + cc * 2; return st * 1024 + (ob ^ (((ob >> 9) & 1) << 5)); }
__device__ __forceinline__ void stage_rc(int b, int& Rr, int& C) { const int st = b / 1024, sb = b % 1024, swz = sb ^ (((sb >> 9) & 1) << 5); Rr = (st >> 1) * 16 + swz / 64; C = (st & 1) * 32 + (swz % 64) / 2; }
__device__ __forceinline__ int perm32(int rho) { const int n = rho >> 4, i = rho & 15; return 8 * (i >> 2) + 4 * n + (i & 3); }
__device__ __forceinline__ unsigned cvt_pk_bf16(float lo, float hi) { unsigned r; asm volatile("v_cvt_pk_bf16_f32 %0, %1, %2" : "=v"(r) : "v"(lo), "v"(hi)); return r; }

struct Unit { int pm, pn, e, row0; };
struct UAddr { const char* a0; const char* a1; const char* b0; const char* b1; };

template <class Epi, class Sched>
__device__ __forceinline__ void gemm_phase(LAS unsigned char* lds, const int K, const Sched& S, const Epi& E) {
    int tid_ = threadIdx.x; asm volatile("" : "+v"(tid_));
    const int tid = tid_, wid = __builtin_amdgcn_readfirstlane(tid >> 6), lane = tid & 63, wr = wid >> 2, wc = wid & 3, fr = lane & 15, fq = lane >> 4;
    const int nt = K / BK;
    unsigned voffB[2], voffA0 = 0, voffA1 = 0, colb = 0;
    int sR0, sC0;
    {   int sR1, sC1; stage_rc(tid * 16, sR0, sC0); stage_rc(tid * 16 + 8192, sR1, sC1);
        const int Rb0 = Epi::PERM ? ((sR0 & ~31) + perm32(sR0 & 31)) : sR0, Rb1 = Epi::PERM ? ((sR1 & ~31) + perm32(sR1 & 31)) : sR1;
        voffB[0] = (unsigned)(Rb0 * S.ldb + sC0) * 2u; voffB[1] = (unsigned)(Rb1 * S.ldb + sC1) * 2u;
        if constexpr (!Sched::GATHER) { voffA0 = (unsigned)(sR0 * S.lda + sC0) * 2u; voffA1 = (unsigned)(sR1 * S.lda + sC1) * 2u; } else colb = (unsigned)sC0 * 2u; }
    LAS unsigned* const tab = (LAS unsigned*)(lds + STAGE_BYTES);
    const LAS unsigned* const tabp = tab + sR0;
    const size_t kstep = (size_t)(BK * 2);
    const unsigned ldsw = (unsigned)wid * 1024u;
    constexpr bool FP8 = Sched::FP8;
    const int aoff = FP8 ? lds_byte(wr * 64 + fr, fq * 16) : lds_byte(wr * 64 + fr, fq * 8), boff = FP8 ? lds_byte(wc * 32 + fr, fq * 16) : lds_byte(wc * 32 + fr, fq * 8);
    int wsc_v = S.wscale, one_v = 0x7F7F7F7F; asm volatile("" : "+v"(wsc_v), "+v"(one_v));
#define PG8_SA(b, h) (((b) * 2 + (h)) * HTB)
#define PG8_SB(b, h) ((4 + (b) * 2 + (h)) * HTB)
#define PG8_STAGE(bufoff, gbase, v0, v1) do { \
        __builtin_amdgcn_global_load_lds((const unsigned*)((const char*)(gbase) + (v0)), (LAS unsigned*)(lds + (bufoff) + ldsw), 16, 0, 0); \
        __builtin_amdgcn_global_load_lds((const unsigned*)((const char*)(gbase) + (v1)), (LAS unsigned*)(lds + (bufoff) + ldsw + 8192), 16, 0, 0); } while (0)
#define PG8_STAGE_A(bufoff, gbase, slot, h) do { if constexpr (Sched::GATHER) { const unsigned _r0 = tabp[(slot) * 256 + (h) * 128] + colb, _r1 = tabp[(slot) * 256 + (h) * 128 + 64] + colb; PG8_STAGE(bufoff, gbase, _r0, _r1); } \
        else PG8_STAGE(bufoff, gbase, voffA0, voffA1); } while (0)
#define PG8_LD32(p) __builtin_shufflevector(*(const LAS i32x4*)(p), *(const LAS i32x4*)((p) + 16), 0, 1, 2, 3, 4, 5, 6, 7)
#define PG8_LDA(dst, b, h) do { if constexpr (FP8) { _Pragma("unroll") for (int m = 0; m < 4; ++m) dst##8[m] = PG8_LD32(lds + PG8_SA(b, h) + aoff + m * 2048); } \
        else { _Pragma("unroll") for (int m = 0; m < 4; ++m) _Pragma("unroll") for (int k = 0; k < 2; ++k) dst[m][k] = *(const LAS bf16x8*)(lds + PG8_SA(b, h) + aoff + m * 2048 + k * 1024); } } while (0)
#define PG8_LDB(dst, b, h) do { if constexpr (FP8) { _Pragma("unroll") for (int n = 0; n < 2; ++n) dst##8[n] = PG8_LD32(lds + PG8_SB(b, h) + boff + n * 2048); } \
        else { _Pragma("unroll") for (int n = 0; n < 2; ++n) _Pragma("unroll") for (int k = 0; k < 2; ++k) dst[n][k] = *(const LAS bf16x8*)(lds + PG8_SB(b, h) + boff + n * 2048 + k * 1024); } } while (0)
#define PG8_MMA_FULL(ai, bj, At, Bt) do { __builtin_amdgcn_s_setprio(1); \
        if constexpr (FP8) { _Pragma("unroll") for (int m = 0; m < 4; ++m) _Pragma("unroll") for (int n = 0; n < 2; ++n) \
            asm volatile("v_mfma_scale_f32_16x16x128_f8f6f4 %0, %1, %2, %0, %3, %4 op_sel_hi:[0,0,0]" : "+v"(acc[ai][bj][m][n]) : "v"(Bt##8[n]), "v"(At##8[m]), "v"(wsc_v), "v"(one_v)); } \
        else { _Pragma("unroll") for (int m = 0; m < 4; ++m) _Pragma("unroll") for (int n = 0; n < 2; ++n) _Pragma("unroll") for (int k = 0; k < 2; ++k) \
            acc[ai][bj][m][n] = __builtin_amdgcn_mfma_f32_16x16x32_bf16(Bt[n][k], At[m][k], acc[ai][bj][m][n], 0, 0, 0); } \
        __builtin_amdgcn_s_setprio(0); } while (0)
#define PG8_MMA_THIN(ai, bj, At, Bt) do { if (!FP8 && (ai) == 0 && wr == 0) { _Pragma("unroll") for (int n = 0; n < 2; ++n) _Pragma("unroll") for (int k = 0; k < 2; ++k) \
        acc[0][bj][0][n] = __builtin_amdgcn_mfma_f32_16x16x32_bf16(Bt[n][k], At[0][k], acc[0][bj][0][n], 0, 0, 0); } } while (0)
#define PG8_WAIT_V(n) asm volatile("s_waitcnt vmcnt(" #n ")" ::: "memory")
#define PG8_WAIT_L(n) asm volatile("s_waitcnt lgkmcnt(" #n ")" ::: "memory")
#define PG8_BAR __builtin_amdgcn_s_barrier()
#define PG8_SCHED __builtin_amdgcn_sched_barrier(0)
    Unit cur, nxt; int ui = 0;
    if (!S.next(0, cur)) return;
    f32x4 acc[2][2][4][2];
#pragma unroll
    for (int a = 0; a < 2; ++a)
#pragma unroll
        for (int b = 0; b < 2; ++b)
#pragma unroll
            for (int m = 0; m < 4; ++m)
#pragma unroll
                for (int n = 0; n < 2; ++n) acc[a][b][m][n] = (f32x4){0.f, 0.f, 0.f, 0.f};
    bf16x8 At[4][2], B0[2][2], B1[2][2]; i32x8 At8[4], B08[2], B18[2];
    UAddr cu, nx;
    S.addr(cur, cu);
    if constexpr (Sched::GATHER) {
        if (tid < 256) __builtin_amdgcn_global_load_lds((const unsigned*)(S.rowoff_ptr(cur) + tid), (LAS unsigned*)(tab + wid * 64), 4, 0, 0);
        asm volatile("s_waitcnt vmcnt(0)" ::: "memory"); __syncthreads(); }
    PG8_STAGE(PG8_SB(0, 0), cu.b0, voffB[0], voffB[1]); PG8_STAGE(PG8_SB(0, 1), cu.b1, voffB[0], voffB[1]); PG8_STAGE_A(PG8_SA(0, 0), cu.a0, 0, 0); PG8_STAGE_A(PG8_SA(0, 1), cu.a1, 0, 1);
    if (wr == 1) PG8_BAR;
    PG8_WAIT_V(2); PG8_BAR;
    PG8_STAGE(PG8_SB(1, 0), cu.b0 + kstep, voffB[0], voffB[1]); PG8_STAGE_A(PG8_SA(1, 0), cu.a0 + kstep, 0, 0); PG8_STAGE(PG8_SB(1, 1), cu.b1 + kstep, voffB[0], voffB[1]);
    PG8_WAIT_V(6); PG8_BAR;
    for (;;) {
        const bool has_next = S.next(ui + 1, nxt);
        const bool thin = Sched::HAS_THIN && S.thin(cur);
        const int cs = ui & 1, ns = has_next ? (cs ^ 1) : cs;
        if (has_next) { S.addr(nxt, nx); if constexpr (Sched::GATHER) { if (tid < 256) __builtin_amdgcn_global_load_lds((const unsigned*)(S.rowoff_ptr(nxt) + tid), (LAS unsigned*)(tab + (cs ^ 1) * 256 + wid * 64), 4, 0, 0); } } else nx = cu;
#define PG8_KLOOP(MMA) \
        for (int t = 0; t < nt; t += 2) { \
            const bool last = (t == nt - 2); \
            const char* a1h1 = cu.a1 + (size_t)(t + 1) * kstep; \
            const char* a2h0 = last ? nx.a0 : cu.a0 + (size_t)(t + 2) * kstep; const char* a2h1 = last ? nx.a1 : cu.a1 + (size_t)(t + 2) * kstep; \
            const char* b2h0 = last ? nx.b0 : cu.b0 + (size_t)(t + 2) * kstep; const char* b2h1 = last ? nx.b1 : cu.b1 + (size_t)(t + 2) * kstep; \
            const int s2 = last ? ns : cs; \
              \
            PG8_LDB(B0, 0, 0); PG8_LDB(B1, 0, 1); PG8_SCHED; PG8_LDA(At, 0, 0); PG8_STAGE_A(PG8_SA(1, 1), a1h1, cs, 1); \
            PG8_WAIT_V(8); PG8_WAIT_L(0); PG8_BAR; MMA(0, 0, At, B0); MMA(0, 1, At, B1); PG8_BAR; PG8_SCHED; \
              \
            PG8_LDA(At, 0, 1); PG8_STAGE(PG8_SB(0, 0), b2h0, voffB[0], voffB[1]); PG8_STAGE(PG8_SB(0, 1), b2h1, voffB[0], voffB[1]); PG8_STAGE_A(PG8_SA(0, 0), a2h0, s2, 0); \
            PG8_WAIT_V(8); PG8_WAIT_L(0); PG8_BAR; MMA(1, 0, At, B0); MMA(1, 1, At, B1); PG8_BAR; PG8_SCHED; \
              \
            PG8_LDB(B0, 1, 0); PG8_LDB(B1, 1, 1); PG8_SCHED; PG8_LDA(At, 1, 0); PG8_STAGE_A(PG8_SA(0, 1), a2h1, s2, 1); \
            PG8_WAIT_V(8); PG8_WAIT_L(0); PG8_BAR; MMA(0, 0, At, B0); MMA(0, 1, At, B1); PG8_BAR; PG8_SCHED; \
              \
            PG8_LDA(At, 1, 1); PG8_STAGE(PG8_SB(1, 0), b2h0 + kstep, voffB[0], voffB[1]); PG8_STAGE(PG8_SB(1, 1), b2h1 + kstep, voffB[0], voffB[1]); PG8_STAGE_A(PG8_SA(1, 0), a2h0 + kstep, s2, 0); \
            PG8_WAIT_V(8); PG8_WAIT_L(0); PG8_BAR; MMA(1, 0, At, B0); MMA(1, 1, At, B1); PG8_BAR; PG8_SCHED; \
        }
        if (Sched::HAS_THIN && thin) { PG8_KLOOP(PG8_MMA_THIN) } else { PG8_KLOOP(PG8_MMA_FULL) }
#undef PG8_KLOOP
        if (wr == 0) PG8_BAR;
        if constexpr (FP8) asm volatile("s_nop 15\n\ts_nop 15" ::: "memory");
        { int fr_e = fr, fq_e = fq; asm volatile("" : "+v"(fr_e), "+v"(fq_e));
          E(acc, cur, wr, wc, fr_e, fq_e); }
        if (!has_next) break;
#pragma unroll
        for (int a = 0; a < 2; ++a)
#pragma unroll
            for (int b = 0; b < 2; ++b)
#pragma unroll
                for (int m = 0; m < 4; ++m)
#pragma unroll
                    for (int n = 0; n < 2; ++n) acc[a][b][m][n] = (f32x4){0.f, 0.f, 0.f, 0.f};
        cur = nxt; cu = nx; ++ui;
        if (wr == 1) PG8_BAR;
    }
    PG8_WAIT_V(0);
    PG8_BAR;
#undef PG8_SA
#undef PG8_SB
#undef PG8_STAGE
#undef PG8_STAGE_A
#undef PG8_LDA
#undef PG8_LDB
#undef PG8_MMA_THIN
#undef PG8_LD32
#undef PG8_MMA_FULL
#undef PG8_WAIT_V
#undef PG8_WAIT_L
#undef PG8_BAR
#undef PG8_SCHED
}

struct DenseOrder {
    static constexpr bool GATHER = false, HAS_THIN = false, FP8 = false; static constexpr int wscale = 0;
    __device__ __forceinline__ bool thin(const Unit&) const { return false; }
    const bf16* A; const bf16* Bt; int lda, ldb; int nM, nN, nwg, G, c;
    __device__ __forceinline__ const unsigned* rowoff_ptr(const Unit&) const { return nullptr; }
    __device__ __forceinline__ bool next(int i, Unit& u) const {
        const long L = (long)i * G + c; if (L >= nwg) return false;
        int wgid = (int)L; { const int q = nwg / 8, r = nwg % 8, xcd = wgid % 8, off = wgid / 8; wgid = (xcd < r ? xcd * (q + 1) : r * (q + 1) + (xcd - r) * q) + off; }
        const int nig = 8 * nN, gid = wgid / nig, fm = gid * 8, gsz = (nM - fm) < 8 ? (nM - fm) : 8;
        u.pm = fm + ((wgid % nig) % gsz); u.pn = (wgid % nig) / gsz; u.e = 0; u.row0 = (u.pm >> 5) * PP + CHK + 256 * (u.pm & 31); return true;
    }
    __device__ __forceinline__ void addr(const Unit& u, UAddr& g) const {
        g.a0 = (const char*)(A + (size_t)u.row0 * lda); g.a1 = g.a0 + (size_t)128 * lda * 2;
        g.b0 = (const char*)(Bt + (size_t)u.pn * 256 * ldb); g.b1 = g.b0 + (size_t)128 * ldb * 2;
    }
};
struct FfnUpOrder {
    static constexpr bool GATHER = true, HAS_THIN = false, FP8 = true; static constexpr int wscale = WSC_UP;
    __device__ __forceinline__ bool thin(const Unit&) const { return false; }
    const unsigned char* U2; const unsigned* ROWOFF; const unsigned char* WgT; const unsigned char* WuT; int lda, ldb; int nunits, G, c;
    __device__ __forceinline__ bool next(int i, Unit& u) const {
        const int L = i * G + c; if (L >= nunits) return false;
        const int e = L / (22 * 16), rem = L - e * (22 * 16); u.e = e;
        if (rem < 320) { const int blk = rem >> 5, idx = rem & 31, h = blk / 5, pq = blk - 5 * h; u.pn = 4 * pq + (idx >> 3); u.pm = 8 * h + (idx & 7); }
        else { const int r = rem - 320, h = r >> 4, idx = r & 15; u.pn = 20 + (idx >> 3); u.pm = 8 * h + (idx & 7); }
        u.row0 = u.pm * 256; return true;
    }
    __device__ __forceinline__ const unsigned* rowoff_ptr(const Unit& u) const { return ROWOFF + u.e * 4096 + u.pm * 256; }
    __device__ __forceinline__ void addr(const Unit& u, UAddr& g) const {
        g.a0 = (const char*)U2; g.a1 = g.a0;
        g.b0 = (const char*)(WgT + ((size_t)u.e * DFF + (size_t)u.pn * 128) * D); g.b1 = (const char*)(WuT + ((size_t)u.e * DFF + (size_t)u.pn * 128) * D);
    }
};
struct FfnDownOrder {
    static constexpr bool GATHER = false, HAS_THIN = false, FP8 = true; static constexpr int wscale = WSC_DN;
    __device__ __forceinline__ bool thin(const Unit&) const { return false; }
    const unsigned char* HID; const unsigned char* WdT; int lda, ldb; int nunits, G, c;
    __device__ __forceinline__ const unsigned* rowoff_ptr(const Unit&) const { return nullptr; }
    __device__ __forceinline__ bool next(int i, Unit& u) const {
        const int L = i * G + c; if (L >= nunits) return false;
        u.e = L >> 6; const int rem = L & 63; u.pn = rem >> 4; u.pm = rem & 15; u.row0 = u.pm * 256; return true;
    }
    __device__ __forceinline__ void addr(const Unit& u, UAddr& g) const {
        g.a0 = (const char*)(HID + ((size_t)u.e * 4096 + (size_t)u.pm * 256) * DFF); g.a1 = g.a0 + (size_t)128 * DFF;
        g.b0 = (const char*)(WdT + ((size_t)u.e * D + (size_t)u.pn * 256) * DFF); g.b1 = g.b0 + (size_t)128 * DFF;
    }
};

struct EpiStoreBf16 {
    static constexpr bool PERM = true;
    bf16* O; int ldc; size_t estride;
    __device__ __forceinline__ void operator()(const f32x4 (&acc)[2][2][4][2], const Unit& u, int wr, int wc, int fr, int fq) const {
        bf16* base = O + (size_t)u.e * estride + (size_t)(u.pm * 256 + wr * 64 + fr) * ldc + u.pn * 256 + wc * 32 + 8 * fq;
#pragma unroll
        for (int ai = 0; ai < 2; ++ai)
#pragma unroll
            for (int m = 0; m < 4; ++m) { bf16* rowp = base + (size_t)(ai * 128 + m * 16) * ldc;
#pragma unroll
                for (int bj = 0; bj < 2; ++bj) { const f32x4 v0 = acc[ai][bj][m][0], v1 = acc[ai][bj][m][1];
                    u32x4 w; w.x = cvt_pk_bf16(v0[0], v0[1]); w.y = cvt_pk_bf16(v0[2], v0[3]); w.z = cvt_pk_bf16(v1[0], v1[1]); w.w = cvt_pk_bf16(v1[2], v1[3]);
                    *(u32x4*)(rowp + bj * 128) = w; } }
    }
};
struct EpiProj {
    static constexpr bool PERM = true;
    bf16* O; const f32x2* rope;
    __device__ __forceinline__ void operator()(const f32x4 (&acc)[2][2][4][2], const Unit& u, int wr, int wc, int fr, int fq) const {
        const int row0 = u.row0 + wr * 64 + fr;
        if (u.pn >= 4) {
            bf16* base = O + (size_t)row0 * PC + u.pn * 256 + wc * 32 + 8 * fq;
#pragma unroll
            for (int ai = 0; ai < 2; ++ai)
#pragma unroll
                for (int m = 0; m < 4; ++m) { bf16* rowp = base + (size_t)(ai * 128 + m * 16) * PC;
#pragma unroll
                    for (int bj = 0; bj < 2; ++bj) { const f32x4 v0 = acc[ai][bj][m][0], v1 = acc[ai][bj][m][1];
                        u32x4 w; w.x = cvt_pk_bf16(v0[0], v0[1]); w.y = cvt_pk_bf16(v0[2], v0[3]); w.z = cvt_pk_bf16(v1[0], v1[1]); w.w = cvt_pk_bf16(v1[2], v1[3]);
                        *(u32x4*)(rowp + bj * 128) = w; } }
        } else {
            const float sc = (u.pn < 2) ? 0.08838834764831845f : 1.0f; const int d0 = 16 * wc + 4 * fq;
#pragma unroll
            for (int ai = 0; ai < 2; ++ai)
#pragma unroll
                for (int m = 0; m < 4; ++m) { const int row = row0 + ai * 128 + m * 16; const int b = row / PP, p = row - b * PP; const int n = p - PADF;
                    const f32x2* tb = rope + (size_t)n * 64 + d0; const f32x2 t0 = tb[0], t1 = tb[1], t2 = tb[2], t3 = tb[3];
                    bf16* rowp = O + (size_t)row * PC + u.pn * 256 + d0;
#pragma unroll
                    for (int bj = 0; bj < 2; ++bj) { const f32x4 x1 = acc[ai][bj][m][0], x2 = acc[ai][bj][m][1];
                        u32x2 o1, o2;
                        o1.x = cvt_pk_bf16((x1[0] * t0.x - x2[0] * t0.y) * sc, (x1[1] * t1.x - x2[1] * t1.y) * sc); o1.y = cvt_pk_bf16((x1[2] * t2.x - x2[2] * t2.y) * sc, (x1[3] * t3.x - x2[3] * t3.y) * sc);
                        o2.x = cvt_pk_bf16((x2[0] * t0.x + x1[0] * t0.y) * sc, (x2[1] * t1.x + x1[1] * t1.y) * sc); o2.y = cvt_pk_bf16((x2[2] * t2.x + x1[2] * t2.y) * sc, (x2[3] * t3.x + x1[3] * t3.y) * sc);
                        *(u32x2*)(rowp + bj * 128) = o1; *(u32x2*)(rowp + bj * 128 + 64) = o2; } }
        }
    }
};
struct EpiSwiglu {
    static constexpr bool PERM = true;
    unsigned char* HID;
    __device__ __forceinline__ void operator()(const f32x4 (&acc)[2][2][4][2], const Unit& u, int wr, int wc, int fr, int fq) const {
        unsigned char* base = HID + ((size_t)u.e * 4096 + (size_t)(u.pm * 256 + wr * 64 + fr)) * DFF + u.pn * 128 + wc * 32 + 8 * fq;
#pragma unroll
        for (int ai = 0; ai < 2; ++ai)
#pragma unroll
            for (int m = 0; m < 4; ++m) { unsigned char* rowp = base + (size_t)(ai * 128 + m * 16) * DFF;
                float h[8];
#pragma unroll
                for (int n = 0; n < 2; ++n)
#pragma unroll
                    for (int j = 0; j < 4; ++j) { const float g = acc[ai][0][m][n][j], up = acc[ai][1][m][n][j]; h[n * 4 + j] = fminf(fmaxf(siluf_(g) * up, -448.0f), 448.0f); }
                *(u32x2*)rowp = (u32x2){pk4_fp8(h[0], h[1], h[2], h[3]), pk4_fp8(h[4], h[5], h[6], h[7])}; }
    }
};
struct EpiDelta {
    static constexpr bool PERM = true;
    bf16* O; const float* X;
    __device__ __forceinline__ void operator()(const f32x4 (&acc)[2][2][4][2], const Unit& u, int wr, int wc, int fr, int fq) const {
        const int tok0 = (u.pm >> 5) * SEQ + 256 * (u.pm & 31) + wr * 64 + fr;
        const size_t off0 = (size_t)tok0 * D + u.pn * 256 + wc * 32 + 8 * fq;
#pragma unroll
        for (int ai = 0; ai < 2; ++ai) {
            f32x4 xv[4][2][2];
#pragma unroll
            for (int m = 0; m < 4; ++m)
#pragma unroll
                for (int bj = 0; bj < 2; ++bj) { const float* xp = X + off0 + (size_t)(ai * 128 + m * 16) * D + bj * 128; xv[m][bj][0] = *(const f32x4*)xp; xv[m][bj][1] = *(const f32x4*)(xp + 4); }
#pragma unroll
            for (int m = 0; m < 4; ++m) { bf16* rowp = O + off0 + (size_t)(ai * 128 + m * 16) * D;
#pragma unroll
                for (int bj = 0; bj < 2; ++bj) { const f32x4 v0 = acc[ai][bj][m][0] + xv[m][bj][0], v1 = acc[ai][bj][m][1] + xv[m][bj][1];
                    u32x4 w; w.x = cvt_pk_bf16(v0[0], v0[1]); w.y = cvt_pk_bf16(v0[2], v0[3]); w.z = cvt_pk_bf16(v1[0], v1[1]); w.w = cvt_pk_bf16(v1[2], v1[3]);
                    *(u32x4*)(rowp + bj * 128) = w; } }
        }
    }
};
}

struct Ctx {
    LAS unsigned char* lds; int tid, lane, wave, vcu, G;
    const float *x, *meta, *mix_g, *w_in, *b_gates, *conv_w, *conv_b, *ret_logit, *ret_gn, *ml_gn, *w_out, *ffn_g, *w_router, *w_gate, *w_up, *w_down, *fin_g;
    float* out; unsigned char* ws;
};

__device__ __forceinline__ int rope_row(int c) { if (c >= 1024) return c; const int d = c & 127, dd = d & 63; return (c & ~127) | (8 * (dd >> 2) + (d >> 6) * 4 + (dd & 3)); }
template <bool PAIRPERM = false>
__device__ __forceinline__ void transpose_item(const float* W, int K, int N, int ldw, bf16* WT, LAS float* scr, int item, int lane) {
    const int nblk = N / 32, kb = item / nblk, nb = item % nblk, k0 = 64 * kb, n0 = 32 * nb;
#pragma unroll 8
    for (int i = 0; i < 32; ++i) { const int kk = 2 * i + (lane >> 5); scr[kk * 33 + (lane & 31)] = W[(size_t)(k0 + kk) * ldw + n0 + (lane & 31)]; }
    LDS_WAIT(); asm volatile("" ::: "memory");
    const int c = lane & 7;
#pragma unroll
    for (int j = 0; j < 4; ++j) { const int n = (lane >> 3) + 8 * j; const LAS float* s = scr + (8 * c) * 33 + n;
        u32x4 o; o.x = pk2(s[0 * 33], s[1 * 33]); o.y = pk2(s[2 * 33], s[3 * 33]); o.z = pk2(s[4 * 33], s[5 * 33]); o.w = pk2(s[6 * 33], s[7 * 33]);
        *(u32x4*)(WT + (size_t)(PAIRPERM ? rope_row(n0 + n) : (n0 + n)) * K + k0 + 8 * c) = o; }
    LDS_WAIT(); asm volatile("" ::: "memory");
}
constexpr int F8SCR = 0;
__device__ __forceinline__ void transpose_item_f8(const float* W, int K, int N, int ldw, unsigned char* WT, LAS float*  , int item, int lane, float pre) {
    const int nblk = N / 64, kb = item / nblk, nb = item % nblk, k0 = 64 * kb + 16 * (lane >> 4), n0 = 64 * nb + 4 * (lane & 15);
    const float* src = W + (size_t)k0 * ldw + n0;
    f32x4 v[16];
#pragma unroll
    for (int i = 0; i < 16; ++i) v[i] = *(const f32x4*)(src + (size_t)i * ldw) * pre;
#pragma unroll
    for (int j = 0; j < 4; ++j) {
        u32x4 o;
        o.x = pk4_fp8(v[0][j], v[1][j], v[2][j], v[3][j]); o.y = pk4_fp8(v[4][j], v[5][j], v[6][j], v[7][j]); o.z = pk4_fp8(v[8][j], v[9][j], v[10][j], v[11][j]); o.w = pk4_fp8(v[12][j], v[13][j], v[14][j], v[15][j]);
        *(u32x4*)(WT + (size_t)(n0 + j) * K + k0) = o; }
}
__device__ __forceinline__ void f8_item_load(const float* W, int N, int ldw, int item, int lane, f32x4 (&v)[16]) {
    const int nblk = N / 64, kb = item / nblk, nb = item % nblk, k0 = 64 * kb + 16 * (lane >> 4), n0 = 64 * nb + 4 * (lane & 15);
    const float* src = W + (size_t)k0 * ldw + n0;
#pragma unroll
    for (int i = 0; i < 16; ++i) v[i] = *(const f32x4*)(src + (size_t)i * ldw);
}
__device__ __forceinline__ void f8_item_store(unsigned char* WT, int K, int N, int item, int lane, float pre, const f32x4 (&v)[16]) {
    const int nblk = N / 64, kb = item / nblk, nb = item % nblk, k0 = 64 * kb + 16 * (lane >> 4), n0 = 64 * nb + 4 * (lane & 15);
#pragma unroll
    for (int j = 0; j < 4; ++j) {
        u32x4 o;
        o.x = pk4_fp8(v[0][j] * pre, v[1][j] * pre, v[2][j] * pre, v[3][j] * pre); o.y = pk4_fp8(v[4][j] * pre, v[5][j] * pre, v[6][j] * pre, v[7][j] * pre);
        o.z = pk4_fp8(v[8][j] * pre, v[9][j] * pre, v[10][j] * pre, v[11][j] * pre); o.w = pk4_fp8(v[12][j] * pre, v[13][j] * pre, v[14][j] * pre, v[15][j] * pre);
        *(u32x4*)(WT + (size_t)(n0 + j) * K + k0) = o; }
}
__device__ __forceinline__ void row_load(const float* row, int lane, f32x4 (&u)[4]) {
#pragma unroll
    for (int jj = 0; jj < 4; ++jj) u[jj] = *(const f32x4*)(row + jj * 256 + lane * 4);
}
__device__ __forceinline__ void row_load_bf(const bf16* row, int lane, f32x4 (&u)[4]) {
    u32x2 dv[4];
#pragma unroll
    for (int jj = 0; jj < 4; ++jj) dv[jj] = *(const u32x2*)(row + jj * 256 + lane * 4);
#pragma unroll
    for (int jj = 0; jj < 4; ++jj) u[jj] = (f32x4){bflo(dv[jj].x), bfhi(dv[jj].x), bflo(dv[jj].y), bfhi(dv[jj].y)};
}
__device__ __forceinline__ void rms_apply(const float* g, int lane, f32x4 (&u)[4]) {
    float s = 0.f;
#pragma unroll
    for (int jj = 0; jj < 4; ++jj) s += u[jj].x * u[jj].x + u[jj].y * u[jj].y + u[jj].z * u[jj].z + u[jj].w * u[jj].w;
    const float rstd = rsqrtf(wave_sum(s) * (1.0f / D) + EPS);
#pragma unroll
    for (int jj = 0; jj < 4; ++jj) { const f32x4 gv = *(const f32x4*)(g + jj * 256 + lane * 4); u[jj] = u[jj] * rstd * gv; }
}
__device__ __forceinline__ void store_row_bf16(bf16* dst, int lane, const f32x4 (&u)[4]) {
#pragma unroll
    for (int jj = 0; jj < 4; ++jj) { u32x2 w; w.x = pk2(u[jj].x, u[jj].y); w.y = pk2(u[jj].z, u[jj].w); *(u32x2*)(dst + jj * 256 + lane * 4) = w; }
}
#define MFMA16(a, b, c) __builtin_amdgcn_mfma_f32_16x16x32_bf16(a, b, c, 0, 0, 0)
constexpr int RB_PITCH = 1032, RB_UH = 0, RB_UL = 16 * RB_PITCH * 2, RB_RED = 2 * RB_UL;
struct RowDots { bf16x8 bh[4], bl[4]; };
__device__ __forceinline__ void rowdots_init(RowDots& W, const float* wsrc, int ld, int w, int lane) {
    const int fr = lane & 15, fq = lane >> 4;
#pragma unroll
    for (int s_ = 0; s_ < 4; ++s_) { float v[8];
#pragma unroll
        for (int j = 0; j < 8; ++j) v[j] = wsrc[(size_t)(128 * w + 32 * s_ + 8 * fq + j) * ld + fr];
        unsigned hp[4], lp[4];
#pragma unroll
        for (int j = 0; j < 4; ++j) { hp[j] = pk2(v[2 * j], v[2 * j + 1]); lp[j] = pk2(v[2 * j] - bflo(hp[j]), v[2 * j + 1] - bfhi(hp[j])); }
        W.bh[s_] = __builtin_bit_cast(bf16x8, (u32x4){hp[0], hp[1], hp[2], hp[3]}); W.bl[s_] = __builtin_bit_cast(bf16x8, (u32x4){lp[0], lp[1], lp[2], lp[3]}); }
}
__device__ __forceinline__ void rowdots_put(LAS unsigned char* lds, int rs, int lane, const f32x4 (&u)[4]) {
#pragma unroll
    for (int jj = 0; jj < 4; ++jj) { const unsigned h0 = pk2(u[jj].x, u[jj].y), h1 = pk2(u[jj].z, u[jj].w);
        const unsigned l0 = pk2(u[jj].x - bflo(h0), u[jj].y - bfhi(h0)), l1 = pk2(u[jj].z - bflo(h1), u[jj].w - bfhi(h1));
        *(LAS u32x2*)(lds + RB_UH + (rs * RB_PITCH + jj * 256 + lane * 4) * 2) = (u32x2){h0, h1}; *(LAS u32x2*)(lds + RB_UL + (rs * RB_PITCH + jj * 256 + lane * 4) * 2) = (u32x2){l0, l1}; }
}
__device__ __forceinline__ void rowdots_mma(LAS unsigned char* lds, const RowDots& W, int w, int lane) {
    const int fr = lane & 15, fq = lane >> 4; f32x4 acc = (f32x4){0.f, 0.f, 0.f, 0.f};
#pragma unroll
    for (int s_ = 0; s_ < 4; ++s_) { const int off = (fr * RB_PITCH + 128 * w + 32 * s_ + 8 * fq) * 2;
        const bf16x8 ah = *(const LAS bf16x8*)(lds + RB_UH + off), al = *(const LAS bf16x8*)(lds + RB_UL + off);
        acc = MFMA16(ah, W.bh[s_], acc); acc = MFMA16(ah, W.bl[s_], acc); acc = MFMA16(al, W.bh[s_], acc); }
    *(LAS f32x4*)(lds + RB_RED + (w * 256 + lane * 4) * 4) = acc;
}
__device__ __forceinline__ float rowdots_get(const LAS unsigned char* lds, int row, int g) {
    const LAS float* red = (const LAS float*)(lds + RB_RED) + ((row >> 2) * 16 + g) * 4 + (row & 3); float s_ = 0.f;
#pragma unroll
    for (int w = 0; w < 8; ++w) s_ += red[w * 256];
    return s_;
}
__device__ __forceinline__ void phase_prep(Ctx& F) {
    bf16* WINT = (bf16*)(F.ws + WS_WINT); bf16* WOUTT = (bf16*)(F.ws + WS_WOUTT);
    LAS float* scr = (LAS float*)(F.lds + F.wave * 16384);
    const int gw = F.vcu * 8 + F.wave, NGW = F.G * 8;
    constexpr int I_IN = (D / 64) * (PC / 32), I_OUT = (D / 64) * (D / 32);
    for (int it = gw; it < I_IN + I_OUT; it += NGW) {
        if (it < I_IN) transpose_item<true>(F.w_in, D, PC, PCOLS, WINT, scr, it, F.lane);
        else transpose_item(F.w_out, D, D, D, WOUTT, scr, it - I_IN, F.lane);
    }
    f32x2* rope = (f32x2*)(F.ws + WS_ROPE);
    for (int idx = (F.vcu * 512 + F.tid); idx < NTOK * 64; idx += F.G * 512) {
        const int n = idx >> 6, i = idx & 63;
        const float inv = (float)exp(-(double)i * (9.210340371976184 / 64.0));
        const float angf = (float)n * inv;
        const double xd = (double)angf; const double kq = rint(xd * 0.6366197723675814);
        double r = fma(-kq, 1.5707963267948966, xd); r = fma(-kq, 6.123233995736766e-17, r);
        const double r2 = r * r;
        double sn = -1.0 / 1307674368000.0; sn = fma(sn, r2, 1.0 / 6227020800.0); sn = fma(sn, r2, -1.0 / 39916800.0); sn = fma(sn, r2, 1.0 / 362880.0); sn = fma(sn, r2, -1.0 / 5040.0); sn = fma(sn, r2, 1.0 / 120.0); sn = fma(sn, r2, -1.0 / 6.0); sn = fma(sn * r2, r, r);
        double cs = 1.0 / 20922789888000.0; cs = fma(cs, r2, -1.0 / 87178291200.0); cs = fma(cs, r2, 1.0 / 479001600.0); cs = fma(cs, r2, -1.0 / 3628800.0); cs = fma(cs, r2, 1.0 / 40320.0); cs = fma(cs, r2, -1.0 / 720.0); cs = fma(cs, r2, 1.0 / 24.0); cs = fma(cs, r2, -0.5); cs = fma(cs, r2, 1.0);
        const int q = ((int)kq) & 3;
        const double c = (q == 0) ? cs : (q == 1) ? -sn : (q == 2) ? -cs : sn;
        const double s = (q == 0) ? sn : (q == 1) ? cs : (q == 2) ? -sn : -cs;
        rope[idx] = (f32x2){(float)c, (float)s};
    }
    __syncthreads();
    bf16* U1 = (bf16*)(F.ws + WS_ACT1); float* GATES = (float*)(F.ws + WS_GATES);
    RowDots W; rowdots_init(W, F.w_in + PC, PCOLS, F.wave, F.lane);
    for (int bi = F.vcu; bi < R / 16; bi += F.G) {
        const int r0 = bi * 16;
        int rr[2]; bool ok[2]; f32x4 u[2][4];
#pragma unroll
        for (int t = 0; t < 2; ++t) { rr[t] = r0 + 2 * F.wave + t; const int b = rr[t] / PP, p = rr[t] - b * PP; ok[t] = p >= PADF;
            if (ok[t]) row_load((p < CHK) ? F.meta + (size_t)(p - PADF) * D : F.x + ((size_t)b * SEQ + (p - CHK)) * D, F.lane, u[t]);
            else {
#pragma unroll
                for (int jj = 0; jj < 4; ++jj) u[t][jj] = (f32x4){0.f, 0.f, 0.f, 0.f}; } }
#pragma unroll
        for (int t = 0; t < 2; ++t) {
            if (!ok[t]) {
                bf16* prow = (bf16*)(F.ws + WS_PROJ) + (size_t)rr[t] * PC;
#pragma unroll
                for (int jj = 0; jj < 8; ++jj) *(u32x4*)(prow + jj * 512 + F.lane * 8) = (u32x4){0u, 0u, 0u, 0u};
            } else { rms_apply(F.mix_g, F.lane, u[t]); store_row_bf16(U1 + (size_t)rr[t] * D, F.lane, u[t]); }
            rowdots_put(F.lds, 2 * F.wave + t, F.lane, u[t]);
        }
        __syncthreads();
        rowdots_mma(F.lds, W, F.wave, F.lane);
        __syncthreads();
        if (F.tid < 256) { const int row = F.tid >> 4, g = F.tid & 15, r = r0 + row; const int b = r / PP, p = r - b * PP;
            float gv = rowdots_get(F.lds, row, g) + F.b_gates[g]; if (g >= 8) gv = logsigmoidf_(gv);
            GATES[(size_t)r * 16 + g] = (p >= PADF) ? gv : ((g < 8) ? NEGF : 0.0f); }
    }
}

__device__ __forceinline__ void phase_rope_conv(Ctx& F) {
    const bf16* PROJ = (const bf16*)(F.ws + WS_PROJ); bf16* QKC = (bf16*)(F.ws + WS_ACT1);
    const int gw = F.vcu * 8 + F.wave, NGW = F.G * 8, lane = F.lane;
    const float qs = 0.08838834764831845f;
    float wv[2][5][8], bv[2][8];
#pragma unroll
    for (int jj = 0; jj < 2; ++jj) { const int ch0 = jj * 512 + lane * 8;
        { const f32x4 b0 = *(const f32x4*)(F.conv_b + ch0), b1 = *(const f32x4*)(F.conv_b + ch0 + 4); bv[jj][0] = b0.x; bv[jj][1] = b0.y; bv[jj][2] = b0.z; bv[jj][3] = b0.w; bv[jj][4] = b1.x; bv[jj][5] = b1.y; bv[jj][6] = b1.z; bv[jj][7] = b1.w; }
#pragma unroll
        for (int j = 0; j < 5; ++j) { const f32x4 w0 = *(const f32x4*)(F.conv_w + j * 1024 + ch0), w1 = *(const f32x4*)(F.conv_w + j * 1024 + ch0 + 4);
            wv[jj][j][0] = w0.x; wv[jj][j][1] = w0.y; wv[jj][j][2] = w0.z; wv[jj][j][3] = w0.w; wv[jj][j][4] = w1.x; wv[jj][j][5] = w1.y; wv[jj][j][6] = w1.z; wv[jj][j][7] = w1.w; } }
    for (int r = gw; r < R; r += NGW) {
        const int b = r / PP, p = r - b * PP;
        bf16* qrow = QKC + (size_t)r * D;
        if (p < PADF) {
#pragma unroll
            for (int jj = 0; jj < 2; ++jj) *(u32x4*)(qrow + jj * 512 + lane * 8) = (u32x4){0u, 0u, 0u, 0u};
            continue;
        }
        u32x4 xv[2][5];
#pragma unroll
        for (int jj = 0; jj < 2; ++jj)
#pragma unroll
            for (int j = 0; j < 5; ++j) { const int pj = p + j - 2; xv[jj][j] = (pj >= PADF && pj < PP) ? *(const u32x4*)(PROJ + (size_t)(r + j - 2) * PC + 2048 + jj * 512 + lane * 8) : (u32x4){0u, 0u, 0u, 0u}; }
#pragma unroll
        for (int jj = 0; jj < 2; ++jj) {
            float acc[8];
#pragma unroll
            for (int i = 0; i < 8; ++i) acc[i] = bv[jj][i];
#pragma unroll
            for (int j = 0; j < 5; ++j) { const u32x4 v = xv[jj][j];
                acc[0] += bflo(v.x) * wv[jj][j][0]; acc[1] += bfhi(v.x) * wv[jj][j][1]; acc[2] += bflo(v.y) * wv[jj][j][2]; acc[3] += bfhi(v.y) * wv[jj][j][3];
                acc[4] += bflo(v.z) * wv[jj][j][4]; acc[5] += bfhi(v.z) * wv[jj][j][5]; acc[6] += bflo(v.w) * wv[jj][j][6]; acc[7] += bfhi(v.w) * wv[jj][j][7]; }
            const float sc = (jj == 0) ? qs : 1.0f;
#pragma unroll
            for (int i = 0; i < 8; ++i) acc[i] = siluf_(acc[i]) * sc;
            *(u32x4*)(qrow + jj * 512 + lane * 8) = (u32x4){pk2(acc[0], acc[1]), pk2(acc[2], acc[3]), pk2(acc[4], acc[5]), pk2(acc[6], acc[7])};
        }
    }
}

__device__ __forceinline__ void zero_acc(f32x4 (&acc)[2][4]) {
#pragma unroll
    for (int mt = 0; mt < 2; ++mt)
#pragma unroll
        for (int nt = 0; nt < 4; ++nt) acc[mt][nt] = (f32x4){0.f, 0.f, 0.f, 0.f};
}
template <bool MAXOP, bool REV>
__device__ __forceinline__ void scan128(const LAS float* x, LAS float* out, int lane) {
    static_assert(!REV, "suffix scans are not used any more");
    const int i0 = 2 * lane, i1 = 2 * lane + 1;
    const float a0 = x[i0], a1r = x[i1]; const float a1 = MAXOP ? fmaxf(a0, a1r) : a0 + a1r;
    const float s = wave_scan_incl<MAXOP>(a1);
    const int idn = __builtin_bit_cast(int, MAXOP ? -3.0e38f : 0.0f);
    const float ex = __builtin_bit_cast(float, __builtin_amdgcn_update_dpp(idn, __builtin_bit_cast(int, s), 0x138, 0xF, 0xF, false));
    out[i0] = MAXOP ? fmaxf(ex, a0) : ex + a0; out[i1] = s;
}

typedef short s16x4 __attribute__((ext_vector_type(4)));
constexpr int NSEG = 4;
__device__ __forceinline__ int seg_begin(int s) { return s == 0 ? 0 : 1 + 16 * s; }
constexpr size_t SUMM_STRIDE = (size_t)(144 * 128 + 64);
constexpr size_t WS_SUMM = WS_STATE;
constexpr size_t WS_OUTD = WS_STATE + 16 * MiB;
static_assert(WS_OUTD + (size_t)2 * R * D * 2 <= WS_END && 64 * 3 * SUMM_STRIDE * 4 <= 16 * MiB, "mixer scratch map");
constexpr int VQ = VEC_OFF;
constexpr int V_LI = VQ, V_LF = VQ + 512, V_BC = VQ + 1024, V_GG = VQ + 1536, V_PM = VQ + 2048, V_E1 = VQ + 2560, V_WI = VQ + 3072, V_FL = VQ + 3584, V_WU = VQ + 4096,
              V_NV = VQ + 4608  , V_SC = VQ + 4864  ;

template <int KS, int NT> __device__ __forceinline__ void ld_rows(const LAS bf16* T, int rowbase, int fq, bf16x8 (&f)[NT]) {
#pragma unroll
    for (int t = 0; t < NT; ++t) f[t] = *(const LAS bf16x8*)(T + (rowbase + 16 * t) * TP + KS * 32 + 8 * fq);
}
template <int KS> __device__ __forceinline__ void tr_frag4(unsigned addr, bf16x8 (&f)[4]) {
    s16x4 r0, r1, r2, r3, r4, r5, r6, r7;
    asm volatile("ds_read_b64_tr_b16 %0, %8 offset:%9\n\tds_read_b64_tr_b16 %1, %8 offset:%10\n\tds_read_b64_tr_b16 %2, %8 offset:%11\n\tds_read_b64_tr_b16 %3, %8 offset:%12\n\t"
                 "ds_read_b64_tr_b16 %4, %8 offset:%13\n\tds_read_b64_tr_b16 %5, %8 offset:%14\n\tds_read_b64_tr_b16 %6, %8 offset:%15\n\tds_read_b64_tr_b16 %7, %8 offset:%16\n\ts_waitcnt lgkmcnt(0)"
                 : "=&v"(r0), "=&v"(r1), "=&v"(r2), "=&v"(r3), "=&v"(r4), "=&v"(r5), "=&v"(r6), "=&v"(r7)
                 : "v"(addr), "i"(KS * 8704), "i"(KS * 8704 + 1088), "i"(KS * 8704 + 32), "i"(KS * 8704 + 32 + 1088), "i"(KS * 8704 + 64), "i"(KS * 8704 + 64 + 1088), "i"(KS * 8704 + 96), "i"(KS * 8704 + 96 + 1088)
                 : "memory");
    f[0] = __builtin_shufflevector(r0, r1, 0, 1, 2, 3, 4, 5, 6, 7); f[1] = __builtin_shufflevector(r2, r3, 0, 1, 2, 3, 4, 5, 6, 7);
    f[2] = __builtin_shufflevector(r4, r5, 0, 1, 2, 3, 4, 5, 6, 7); f[3] = __builtin_shufflevector(r6, r7, 0, 1, 2, 3, 4, 5, 6, 7);
}
template <int KS> __device__ __forceinline__ void tr_frag2(unsigned addr, bf16x8 (&f)[2]) {
    s16x4 r0, r1, r2, r3;
    asm volatile("ds_read_b64_tr_b16 %0, %4 offset:%5\n\tds_read_b64_tr_b16 %1, %4 offset:%6\n\tds_read_b64_tr_b16 %2, %4 offset:%7\n\tds_read_b64_tr_b16 %3, %4 offset:%8\n\ts_waitcnt lgkmcnt(0)"
                 : "=&v"(r0), "=&v"(r1), "=&v"(r2), "=&v"(r3)
                 : "v"(addr), "i"(KS * 8704), "i"(KS * 8704 + 1088), "i"(KS * 8704 + 32), "i"(KS * 8704 + 32 + 1088)
                 : "memory");
    f[0] = __builtin_shufflevector(r0, r1, 0, 1, 2, 3, 4, 5, 6, 7); f[1] = __builtin_shufflevector(r2, r3, 0, 1, 2, 3, 4, 5, 6, 7);
}
__device__ __forceinline__ unsigned tr_lane_addr(const LAS bf16* T, int colbase, int lane) {
    const int g = lane >> 4, q = (lane & 15) >> 2, p = lane & 3;
    return (unsigned)(__UINTPTR_TYPE__)(T + (8 * g + q) * TP + colbase + 4 * p);
}

struct SeqUnit { int b, h, grp, dir, seg, combo; };
__device__ __forceinline__ SeqUnit seq_unit(int u) { SeqUnit q; q.seg = u & 3; q.combo = u >> 2; q.dir = q.combo & 1; q.grp = (q.combo >> 1) & 1; q.h = (q.combo >> 2) & 3; q.b = q.combo >> 4; return q; }
__device__ __forceinline__ int seq_chunk(const SeqUnit& q, int ci) { return q.dir ? NCH - 1 - ci : ci; }
__device__ __forceinline__ void tile_fetch(int tid, const bf16* src, size_t stride, int rev, u32x4 (&v)[4]) {
#pragma unroll
    for (int i = 0; i < 4; ++i) { const int q = tid + 512 * i, row = q >> 4, ch = q & 15, rs = rev ? 127 - row : row; v[i] = *(const u32x4*)(src + (size_t)rs * stride + ch * 8); }
}
__device__ __forceinline__ void tile_put(int tid, LAS bf16* T, const u32x4 (&v)[4]) {
#pragma unroll
    for (int i = 0; i < 4; ++i) { const int q = tid + 512 * i, row = q >> 4, ch = q & 15; *(LAS u32x4*)(T + row * TP + ch * 8) = v[i]; }
}
__device__ __forceinline__ void chunk_scans(LAS unsigned char* lds, int lane, bool nostab) {
    LAS float* LI = (LAS float*)(lds + V_LI); LAS float* LF = (LAS float*)(lds + V_LF); LAS float* BC = (LAS float*)(lds + V_BC); LAS float* GG = (LAS float*)(lds + V_GG); LAS float* PM = (LAS float*)(lds + V_PM);
    LAS float* E1 = (LAS float*)(lds + V_E1); LAS float* WI = (LAS float*)(lds + V_WI); LAS float* FL = (LAS float*)(lds + V_FL); LAS float* WU = (LAS float*)(lds + V_WU); LAS float* SC = (LAS float*)(lds + V_SC);
    scan128<false, false>(LF, BC, lane); LDS_WAIT();
    const int l0 = 2 * lane, l1 = 2 * lane + 1;
    const float bc0 = BC[l0], bc1 = BC[l1], li0 = LI[l0], li1 = LI[l1];
    GG[l0] = li0 - bc0; GG[l1] = li1 - bc1; LDS_WAIT();
    scan128<true, false>(GG, PM, lane); LDS_WAIT();
    const float blast = BC[127], m = SC[0];
    const float lu0 = blast - bc0 + li0, lu1 = blast - bc1 + li1;
    const float a = nostab ? 0.0f : wave_max(fmaxf(lu0, lu1));
    const float mnew = nostab ? 0.0f : fmaxf(blast + m, a);
    const float f = __expf(blast + m - mnew), g = __expf(a - mnew);
    const float mr0 = nostab ? 0.0f : fmaxf(bc0 + m, bc0 + PM[l0]), mr1 = nostab ? 0.0f : fmaxf(bc1 + m, bc1 + PM[l1]);
    E1[l0] = bc0 - mr0; E1[l1] = bc1 - mr1; WI[l0] = __expf(bc0 + m - mr0); WI[l1] = __expf(bc1 + m - mr1);
    FL[l0] = __expf(-mr0); FL[l1] = __expf(-mr1); WU[l0] = g * __expf(lu0 - a); WU[l1] = g * __expf(lu1 - a);
    if (lane == 0) { SC[1] = f; SC[2] = mnew; SC[3] += blast; }
}
__device__ __forceinline__ void scale_k(int tid, LAS bf16* TK, const LAS float* WU) {
#pragma unroll
    for (int i = 0; i < 4; ++i) { const int q = tid + 512 * i, row = q >> 4, ch = q & 15; LAS u32x4* p = (LAS u32x4*)(TK + row * TP + ch * 8); const u32x4 v = *p; const float wv = WU[row];
        *p = (u32x4){cvtpk(bflo(v.x) * wv, bfhi(v.x) * wv), cvtpk(bflo(v.y) * wv, bfhi(v.y) * wv), cvtpk(bflo(v.z) * wv, bfhi(v.z) * wv), cvtpk(bflo(v.w) * wv, bfhi(v.w) * wv)}; }
}
__device__ __forceinline__ void state_update(const LAS bf16* TV, const LAS bf16* TK, int w, int lane, float f, f32x4 (&C)[2][4], float (&nrow)[4]) {
    const int m0 = 32 * (w >> 1), n0 = 64 * (w & 1), fr = lane & 15;
#pragma unroll
    for (int mt = 0; mt < 2; ++mt)
#pragma unroll
        for (int nt = 0; nt < 4; ++nt) C[mt][nt] *= f;
    f32x4 nacc[4];
#pragma unroll
    for (int nt = 0; nt < 4; ++nt) nacc[nt] = (f32x4){nrow[nt] * f, 0.f, 0.f, 0.f};
    const unsigned aa = tr_lane_addr(TV, m0, lane), ab = tr_lane_addr(TK, n0, lane);
    bf16x8 ones; { const short o = (fr == 0) ? (short)0x3F80 : (short)0;
#pragma unroll
        for (int j = 0; j < 8; ++j) ones[j] = o; }
#define SU_STEP(KS) { bf16x8 a[2], b[4]; tr_frag2<KS>(aa, a); tr_frag4<KS>(ab, b); \
        _Pragma("unroll") for (int mt = 0; mt < 2; ++mt) _Pragma("unroll") for (int nt = 0; nt < 4; ++nt) C[mt][nt] = MFMA16(a[mt], b[nt], C[mt][nt]); \
        if (w < 2) { _Pragma("unroll") for (int nt = 0; nt < 4; ++nt) nacc[nt] = MFMA16(ones, b[nt], nacc[nt]); } }
    SU_STEP(0) SU_STEP(1) SU_STEP(2) SU_STEP(3)
#undef SU_STEP
#pragma unroll
    for (int nt = 0; nt < 4; ++nt) nrow[nt] = nacc[nt][0];
}
__device__ __forceinline__ const bf16* seq_src(const Ctx& F, const SeqUnit& q, int which  , size_t& stride) {
    const bf16* PROJ = (const bf16*)(F.ws + WS_PROJ); const bf16* QKC = (const bf16*)(F.ws + WS_ACT1);
    if (q.grp == 0) { stride = PC; return PROJ + which * 512 + q.h * 128; }
    if (which == 2) { stride = PC; return PROJ + 3072 + q.h * 128; }
    stride = D; return QKC + which * 512 + q.h * 128;
}
__device__ __forceinline__ void gates_fetch(const Ctx& F, const SeqUnit& q, int c, int tid, float lgam, float& li, float& lf) {
    if (q.grp == 0) { li = 0.0f; lf = lgam; return; }
    const float* GATES = (const float*)(F.ws + WS_GATES); const int row = q.dir ? 127 - tid : tid;
    const float* gp = GATES + ((size_t)q.b * PP + (size_t)c * CHK + row) * 16; li = gp[q.dir * 4 + q.h]; lf = gp[8 + q.dir * 4 + q.h];
}

constexpr int I_WD = (DFF / 64) * (D / 64);
constexpr int WD_SPLIT = 2800;
__device__ __forceinline__ void convert_wd(Ctx& F, int lo, int hi, int iw, int nw) {
    unsigned char* WdT = F.ws + WS_WD8; LAS float* scr = (LAS float*)(F.lds + F.wave * F8SCR);
    for (int it = lo + iw; it < hi; it += nw) { const int e = it / I_WD, item = it - e * I_WD;
        transpose_item_f8(F.w_down + (size_t)e * DFF * D, DFF, D, D, WdT + (size_t)e * D * DFF, scr, item, F.lane, WPRE_DN); }
}
__device__ __forceinline__ void phase_seg_summary(Ctx& F) {
    LAS bf16* TK = (LAS bf16*)(F.lds + T1_OFF); LAS bf16* TV = (LAS bf16*)(F.lds + T2_OFF);
    LAS float* SC = (LAS float*)(F.lds + V_SC); LAS float* LI = (LAS float*)(F.lds + V_LI); LAS float* LF = (LAS float*)(F.lds + V_LF); const LAS float* WU = (const LAS float*)(F.lds + V_WU);
    float* SUMM = (float*)(F.ws + WS_SUMM);
    const int w = F.wave;
    for (int u = F.vcu; u < 64 * NSEG; u += F.G) {
        const SeqUnit q = seq_unit(u);
        if (q.seg == NSEG - 1) { convert_wd(F, 0, WD_SPLIT, q.combo * 8 + F.wave, 64 * 8); continue; }
        int tid = F.tid; asm volatile("" : "+v"(tid));
        const int lane = tid & 63, fr = lane & 15, fq = lane >> 4;
        const bool nostab = (q.grp == 0);
        const float lgam = nostab ? logsigmoidf_(F.ret_logit[q.dir * NH + q.h]) : 0.0f;
        size_t sk, sv; const bf16* pk = seq_src(F, q, 1, sk); const bf16* pv = seq_src(F, q, 2, sv);
        f32x4 C[2][4]; float nrow[4] = {0.f, 0.f, 0.f, 0.f}; zero_acc(C);
        __syncthreads();
        if (tid == 0) { SC[0] = 0.f; SC[3] = 0.f; }
        const int ci0 = seg_begin(q.seg), ci1 = seg_begin(q.seg + 1);
        u32x4 rk[4], rv[4]; float gli = 0.f, glf = 0.f;
        {   const int c = seq_chunk(q, ci0); const size_t r0 = (size_t)q.b * PP + (size_t)c * CHK;
            tile_fetch(tid, pk + r0 * sk, sk, q.dir, rk); tile_fetch(tid, pv + r0 * sv, sv, q.dir, rv); if (tid < 128) gates_fetch(F, q, c, tid, lgam, gli, glf); }
#pragma unroll 1
        for (int ci = ci0; ci < ci1; ++ci) {
            tile_put(tid, TK, rk); tile_put(tid, TV, rv); if (tid < 128) { LI[tid] = gli; LF[tid] = glf; }
            __syncthreads();
            if (ci + 1 < ci1) { const int c = seq_chunk(q, ci + 1); const size_t r0 = (size_t)q.b * PP + (size_t)c * CHK;
                tile_fetch(tid, pk + r0 * sk, sk, q.dir, rk); tile_fetch(tid, pv + r0 * sv, sv, q.dir, rv); if (tid < 128) gates_fetch(F, q, c, tid, lgam, gli, glf); }
            if (w == 0) chunk_scans(F.lds, lane, nostab);
            __syncthreads();
            scale_k(tid, TK, WU);
            __syncthreads();
            const float f = SC[1];
            state_update(TV, TK, w, lane, f, C, nrow);
            __syncthreads();
            if (tid == 0) SC[0] = SC[2];
        }
        __syncthreads();
        float* dst = SUMM + ((size_t)q.combo * 3 + q.seg) * SUMM_STRIDE;
        const int m0 = 32 * (w >> 1), n0 = 64 * (w & 1);
#pragma unroll
        for (int mt = 0; mt < 2; ++mt)
#pragma unroll
            for (int nt = 0; nt < 4; ++nt)
#pragma unroll
                for (int rg = 0; rg < 4; ++rg) dst[(m0 + 16 * mt + 4 * fq + rg) * 128 + n0 + 16 * nt + fr] = C[mt][nt][rg];
        if (w < 2 && fq == 0) {
#pragma unroll
            for (int nt = 0; nt < 4; ++nt) dst[128 * 128 + n0 + 16 * nt + fr] = nrow[nt]; }
        if (tid == 0) { dst[144 * 128] = SC[0]; dst[144 * 128 + 1] = SC[3]; }
    }
}

__device__ __forceinline__ void phase_seq(Ctx& F) {
    LAS bf16* TQ = (LAS bf16*)(F.lds + T0_OFF); LAS bf16* TK = (LAS bf16*)(F.lds + T1_OFF); LAS bf16* TV = (LAS bf16*)(F.lds + T2_OFF); LAS bf16* TC = (LAS bf16*)(F.lds + T3_OFF);
    LAS float* SC = (LAS float*)(F.lds + V_SC); LAS float* LI = (LAS float*)(F.lds + V_LI); LAS float* LF = (LAS float*)(F.lds + V_LF);
    const LAS float* WU = (const LAS float*)(F.lds + V_WU); const LAS float* E1 = (const LAS float*)(F.lds + V_E1); const LAS float* GG = (const LAS float*)(F.lds + V_GG);
    const LAS float* WI = (const LAS float*)(F.lds + V_WI); const LAS float* FL = (const LAS float*)(F.lds + V_FL); LAS bf16* NV = (LAS bf16*)(F.lds + V_NV);
    const float* SUMM = (const float*)(F.ws + WS_SUMM); bf16* OUTD = (bf16*)(F.ws + WS_OUTD);
    const int w = F.wave, m0 = 32 * (w >> 1), n0 = 64 * (w & 1);
    for (int u = F.vcu; u < 64 * NSEG; u += F.G) {
        const SeqUnit q = seq_unit(u);
        int tid_u = F.tid; asm volatile("" : "+v"(tid_u));
        const int tid = tid_u, lane = tid & 63, fr = lane & 15, fq = lane >> 4;
        const bool nostab = (q.grp == 0);
        const float lgam = nostab ? logsigmoidf_(F.ret_logit[q.dir * NH + q.h]) : 0.0f;
        size_t sq, sk, sv; const bf16* pq = seq_src(F, q, 0, sq); const bf16* pk = seq_src(F, q, 1, sk); const bf16* pv = seq_src(F, q, 2, sv);
        f32x4 C[2][4]; float nrow[4] = {0.f, 0.f, 0.f, 0.f}; zero_acc(C);
        float mst = 0.f;
        for (int s = 0; s < q.seg; ++s) {
            const float* src = SUMM + ((size_t)q.combo * 3 + s) * SUMM_STRIDE;
            const float ms = src[144 * 128], Bs = src[144 * 128 + 1];
            const float mo_ = nostab ? 0.0f : fmaxf(Bs + mst, ms); const float fa = __expf(Bs + mst - mo_), fb = __expf(ms - mo_); mst = mo_;
#pragma unroll
            for (int mt = 0; mt < 2; ++mt)
#pragma unroll
                for (int nt = 0; nt < 4; ++nt)
#pragma unroll
                    for (int rg = 0; rg < 4; ++rg) C[mt][nt][rg] = fa * C[mt][nt][rg] + fb * src[(m0 + 16 * mt + 4 * fq + rg) * 128 + n0 + 16 * nt + fr];
            if (w < 2 && fq == 0) {
#pragma unroll
                for (int nt = 0; nt < 4; ++nt) nrow[nt] = fa * nrow[nt] + fb * src[128 * 128 + n0 + 16 * nt + fr]; }
        }
        __syncthreads();
        if (tid == 0) { SC[0] = mst; SC[3] = 0.f; }
        const int ci0 = seg_begin(q.seg), ci1 = seg_begin(q.seg + 1);
        u32x4 rq[4], rk[4], rv[4]; float gli = 0.f, glf = 0.f;
        {   const int c = seq_chunk(q, ci0); const size_t r0 = (size_t)q.b * PP + (size_t)c * CHK;
            tile_fetch(tid, pq + r0 * sq, sq, q.dir, rq); tile_fetch(tid, pk + r0 * sk, sk, q.dir, rk); tile_fetch(tid, pv + r0 * sv, sv, q.dir, rv); if (tid < 128) gates_fetch(F, q, c, tid, lgam, gli, glf); }
#pragma unroll 1
        for (int ci = ci0; ci < ci1; ++ci) {
            const int c = seq_chunk(q, ci); const size_t r0 = (size_t)q.b * PP + (size_t)c * CHK;
            int tid = tid_u; asm volatile("" : "+v"(tid));
            const int lane = tid & 63, fr = lane & 15, fq = lane >> 4;
            tile_put(tid, TQ, rq); tile_put(tid, TK, rk); tile_put(tid, TV, rv); if (tid < 128) { LI[tid] = gli; LF[tid] = glf; }
#pragma unroll
            for (int mt = 0; mt < 2; ++mt)
#pragma unroll
                for (int nt = 0; nt < 4; ++nt) *(LAS u32x2*)(TC + (n0 + 16 * nt + fr) * TP + m0 + 16 * mt + 4 * fq) = (u32x2){cvtpk(C[mt][nt][0], C[mt][nt][1]), cvtpk(C[mt][nt][2], C[mt][nt][3])};
            if (w < 2 && fq == 0) {
#pragma unroll
                for (int nt = 0; nt < 4; ++nt) NV[n0 + 16 * nt + fr] = (bf16)f2bf(nrow[nt]); }
            __syncthreads();
            if (w == 0) chunk_scans(F.lds, lane, nostab);
            f32x4 accN[2][4], accD[4], accS[2][4]; zero_acc(accN); zero_acc(accS);
#pragma unroll
            for (int nt = 0; nt < 4; ++nt) accD[nt] = (f32x4){0.f, 0.f, 0.f, 0.f};
            {   const unsigned ac = tr_lane_addr(TC, m0, lane);
#define SX_STEP(KS) { bf16x8 a[2], bq[4]; ld_rows<KS, 4>(TQ, n0 + fr, fq, bq); tr_frag2<KS>(ac, a); \
                bf16x8 an = *(const LAS bf16x8*)(NV + KS * 32 + 8 * fq); if (fr != 0) { _Pragma("unroll") for (int j = 0; j < 8; ++j) an[j] = 0; } \
                _Pragma("unroll") for (int nt = 0; nt < 4; ++nt) { _Pragma("unroll") for (int mt = 0; mt < 2; ++mt) accN[mt][nt] = MFMA16(a[mt], bq[nt], accN[mt][nt]); accD[nt] = MFMA16(an, bq[nt], accD[nt]); } }
                SX_STEP(0) SX_STEP(1) SX_STEP(2) SX_STEP(3)
#undef SX_STEP
            }
#define SS_STEP(KS) { bf16x8 a[2], bq[4]; ld_rows<KS, 2>(TK, m0 + fr, fq, a); ld_rows<KS, 4>(TQ, n0 + fr, fq, bq); \
                _Pragma("unroll") for (int mt = 0; mt < 2; ++mt) { _Pragma("unroll") for (int nt = 0; nt < 4; ++nt) accS[mt][nt] = MFMA16(a[mt], bq[nt], accS[mt][nt]); } }
            SS_STEP(0) SS_STEP(1) SS_STEP(2) SS_STEP(3)
#undef SS_STEP
            __syncthreads();
#pragma unroll
            for (int nt = 0; nt < 4; ++nt) { const int l = n0 + 16 * nt + fr; const float wi = WI[l], e1 = E1[l]; accD[nt][0] *= wi;
#pragma unroll
                for (int mt = 0; mt < 2; ++mt) { accN[mt][nt] *= wi; const int mb = m0 + 16 * mt + 4 * fq; float pv_[4];
#pragma unroll
                    for (int rg = 0; rg < 4; ++rg) pv_[rg] = (mb + rg <= l) ? accS[mt][nt][rg] * __expf(e1 + GG[mb + rg]) : 0.0f;
                    *(LAS u32x2*)(TC + l * TP + mb) = (u32x2){cvtpk(pv_[0], pv_[1]), cvtpk(pv_[2], pv_[3])}; } }
            scale_k(tid, TK, WU);
            if (ci + 1 < ci1) { const int cn = seq_chunk(q, ci + 1); const size_t rn = (size_t)q.b * PP + (size_t)cn * CHK;
                tile_fetch(tid, pq + rn * sq, sq, q.dir, rq); tile_fetch(tid, pk + rn * sk, sk, q.dir, rk); tile_fetch(tid, pv + rn * sv, sv, q.dir, rv); if (tid < 128) gates_fetch(F, q, cn, tid, lgam, gli, glf); }
            __syncthreads();
            {   const unsigned av = tr_lane_addr(TV, m0, lane);
                bf16x8 ones; { const short o = (fr == 0) ? (short)0x3F80 : (short)0;
#pragma unroll
                    for (int j = 0; j < 8; ++j) ones[j] = o; }
#define PV_STEP(KS) { bf16x8 a[2], bp[4]; ld_rows<KS, 4>(TC, n0 + fr, fq, bp); tr_frag2<KS>(av, a); \
                _Pragma("unroll") for (int nt = 0; nt < 4; ++nt) { _Pragma("unroll") for (int mt = 0; mt < 2; ++mt) accN[mt][nt] = MFMA16(a[mt], bp[nt], accN[mt][nt]); accD[nt] = MFMA16(ones, bp[nt], accD[nt]); } }
                PV_STEP(0) PV_STEP(1) PV_STEP(2) PV_STEP(3)
#undef PV_STEP
            }
#pragma unroll
            for (int nt = 0; nt < 4; ++nt) { const int l = n0 + 16 * nt + fr;
                const float den = __shfl(accD[nt][0], fr); const float inv = nostab ? 1.0f : __builtin_amdgcn_rcpf(fmaxf(fabsf(den), FL[l]));
#pragma unroll
                for (int mt = 0; mt < 2; ++mt) { const f32x4 o = accN[mt][nt] * inv; *(LAS u32x2*)(TQ + l * TP + m0 + 16 * mt + 4 * fq) = (u32x2){cvtpk(o[0], o[1]), cvtpk(o[2], o[3])}; } }
            state_update(TV, TK, w, lane, SC[1], C, nrow);
            __syncthreads();
            {   bf16* dst = OUTD + ((size_t)q.dir * R + r0) * D + q.grp * 512 + q.h * 128;
#pragma unroll
                for (int i = 0; i < 4; ++i) { const int qq = tid + 512 * i, row = qq >> 4, ch = qq & 15, rs = q.dir ? 127 - row : row; *(u32x4*)(dst + (size_t)rs * D + ch * 8) = *(const LAS u32x4*)(TQ + row * TP + ch * 8); } }
            if (tid == 0) SC[0] = SC[2];
            __syncthreads();
        }
    }
}

__device__ __forceinline__ void phase_combine(Ctx& F) {
    const bf16* PROJ = (const bf16*)(F.ws + WS_PROJ); const bf16* OUTD = (const bf16*)(F.ws + WS_OUTD); bf16* Y = (bf16*)(F.ws + WS_ACT2);
    const int gw = F.vcu * 8 + F.wave, NGW = F.G * 8, lane = F.lane;
    const int col = lane * 16, grp = col >> 9;
    const size_t goff = (grp == 0 ? 1536 + col : 3584 + (col - 512));
    u32x4 na[2], nc[2], ng[2];
    { const int p0 = gw - (gw / PP) * PP; if (gw < R && p0 >= PADF) {
#pragma unroll
        for (int hh = 0; hh < 2; ++hh) { na[hh] = *(const u32x4*)(OUTD + (size_t)gw * D + col + hh * 8); nc[hh] = *(const u32x4*)(OUTD + ((size_t)R + gw) * D + col + hh * 8); ng[hh] = *(const u32x4*)(PROJ + (size_t)gw * PC + goff + hh * 8); } } }
    for (int r = gw; r < R; r += NGW) {
        const int b = r / PP, p = r - b * PP; bf16* yrow = Y + (size_t)r * D + lane * 16;
        u32x4 ca[2], cc[2], cg[2];
#pragma unroll
        for (int hh = 0; hh < 2; ++hh) { ca[hh] = na[hh]; cc[hh] = nc[hh]; cg[hh] = ng[hh]; }
        { const int r2 = r + NGW; const int p2 = r2 - (r2 / PP) * PP; if (r2 < R && p2 >= PADF) {
#pragma unroll
            for (int hh = 0; hh < 2; ++hh) { na[hh] = *(const u32x4*)(OUTD + (size_t)r2 * D + col + hh * 8); nc[hh] = *(const u32x4*)(OUTD + ((size_t)R + r2) * D + col + hh * 8); ng[hh] = *(const u32x4*)(PROJ + (size_t)r2 * PC + goff + hh * 8); } } }
        if (p < PADF) { *(u32x4*)yrow = (u32x4){0u, 0u, 0u, 0u}; *(u32x4*)(yrow + 8) = (u32x4){0u, 0u, 0u, 0u}; continue; }
        float v[16], gt[16];
#pragma unroll
        for (int hh = 0; hh < 2; ++hh) { const u32x4 a = ca[hh], c = cc[hh], g = cg[hh];
            const unsigned aw[4] = {a.x, a.y, a.z, a.w}, cw[4] = {c.x, c.y, c.z, c.w}, gw_[4] = {g.x, g.y, g.z, g.w};
#pragma unroll
            for (int j = 0; j < 4; ++j) { v[hh * 8 + 2 * j] = bflo(aw[j]) + bflo(cw[j]); v[hh * 8 + 2 * j + 1] = bfhi(aw[j]) + bfhi(cw[j]); gt[hh * 8 + 2 * j] = bflo(gw_[j]); gt[hh * 8 + 2 * j + 1] = bfhi(gw_[j]); } }
        if (grp == 1) {
#pragma unroll
            for (int j = 0; j < 16; ++j) v[j] *= sigmoidf_(gt[j]); }
        float s = 0.f;
#pragma unroll
        for (int j = 0; j < 16; ++j) s += v[j];
        s += __shfl_xor(s, 1); s += __shfl_xor(s, 2); s += __shfl_xor(s, 4);
        const float mu = s * (1.0f / 128.0f); float qv = 0.f;
#pragma unroll
        for (int j = 0; j < 16; ++j) { v[j] -= mu; qv += v[j] * v[j]; }
        qv += __shfl_xor(qv, 1); qv += __shfl_xor(qv, 2); qv += __shfl_xor(qv, 4);
        const float rstd = rsqrtf(qv * (1.0f / 128.0f) + EPS);
        const float* gnp = (grp == 0 ? F.ret_gn + col : F.ml_gn + (col - 512)); float gn[16];
#pragma unroll
        for (int j4 = 0; j4 < 4; ++j4) { const f32x4 g4 = *(const f32x4*)(gnp + 4 * j4); gn[4 * j4] = g4.x; gn[4 * j4 + 1] = g4.y; gn[4 * j4 + 2] = g4.z; gn[4 * j4 + 3] = g4.w; }
        unsigned o[8];
#pragma unroll
        for (int j = 0; j < 8; ++j) { float y0 = v[2 * j] * rstd * gn[2 * j], y1 = v[2 * j + 1] * rstd * gn[2 * j + 1];
            if (grp == 0) { y0 *= siluf_(gt[2 * j]); y1 *= siluf_(gt[2 * j + 1]); }
            o[j] = pk2(y0, y1); }
        *(u32x4*)yrow = (u32x4){o[0], o[1], o[2], o[3]}; *(u32x4*)(yrow + 8) = (u32x4){o[4], o[5], o[6], o[7]};
    }
}

constexpr int SK_RED = 34816;
__device__ __forceinline__ f32x4 skinny16_ksplit(LAS unsigned char* lds, const bf16* btrow, int w, int lane) {
    const LAS bf16* A = (const LAS bf16*)lds; LAS float* RED = (LAS float*)(lds + SK_RED);
    const int fr = lane & 15, fq = lane >> 4;
    f32x4 acc = (f32x4){0.f, 0.f, 0.f, 0.f};
    bf16x8 bb[4];
#pragma unroll
    for (int j = 0; j < 4; ++j) bb[j] = *(const bf16x8*)(btrow + (4 * w + j) * 32 + 8 * fq);
#pragma unroll
    for (int j = 0; j < 4; ++j) { const bf16x8 a = *(const LAS bf16x8*)(A + fr * 1032 + (4 * w + j) * 32 + 8 * fq); acc = MFMA16(a, bb[j], acc); }
    *(LAS f32x4*)(RED + w * 256 + lane * 4) = acc;
    __syncthreads();
    if (w == 0) { acc = (f32x4){0.f, 0.f, 0.f, 0.f};
#pragma unroll
        for (int ww = 0; ww < 8; ++ww) acc += *(const LAS f32x4*)(RED + ww * 256 + lane * 4); }
    return acc;
}
__device__ __forceinline__ void proj_meta(Ctx& F) {
    const bf16* U1 = (const bf16*)(F.ws + WS_ACT1); const bf16* WINT = (const bf16*)(F.ws + WS_WINT); bf16* PROJ = (bf16*)(F.ws + WS_PROJ); const f32x2* rope = (const f32x2*)(F.ws + WS_ROPE);
    LAS bf16* AT = (LAS bf16*)F.lds;
    for (int it = F.vcu; it < PC / 16; it += F.G) {
        int tid = F.tid; asm volatile("" : "+v"(tid));
        const int lane = tid & 63, fr = lane & 15, fq = lane >> 4;
        __syncthreads();
        for (int i = tid; i < 16 * 128; i += 512) { const int r = i >> 7, ch = i & 127; *(LAS u32x4*)(AT + r * 1032 + ch * 8) = *(const u32x4*)(U1 + (size_t)(PADF + r) * D + ch * 8); }
        __syncthreads();
        const int t = it * 16 + fr;
        const f32x4 acc = skinny16_ksplit(F.lds, WINT + (size_t)t * D, F.wave, lane);
        if (F.wave == 0) {
#pragma unroll
            for (int rg = 0; rg < 4; ++rg) {
                const int n = 4 * fq + rg; float val = acc[rg]; int col = t;
                const float other = __shfl_xor(val, 4);
                if (t < 1024) {
                    const int tc = t & 127, dd = 4 * (tc >> 3) + (tc & 3); const f32x2 cs = rope[n * 64 + dd]; const float sc = (t < 512) ? 0.08838834764831845f : 1.0f;
                    if ((tc & 4) == 0) { val = (val * cs.x - other * cs.y) * sc; col = (t & ~127) + dd; } else { val = (val * cs.x + other * cs.y) * sc; col = (t & ~127) + 64 + dd; }
                }
                const bf16 hv = (bf16)f2bf(val);
#pragma unroll
                for (int b = 0; b < NB; ++b) PROJ[((size_t)b * PP + PADF + n) * PC + col] = hv;
            }
        }
    }
}
__device__ __forceinline__ void out_meta(Ctx& F) {
    const bf16* Y = (const bf16*)(F.ws + WS_ACT2); const bf16* WOUTT = (const bf16*)(F.ws + WS_WOUTT); float* H1M = (float*)(F.ws + WS_H1META);
    LAS bf16* AT = (LAS bf16*)F.lds;
    for (int it = F.vcu; it < NB * (D / 16); it += F.G) {
        int tid = F.tid; asm volatile("" : "+v"(tid));
        const int lane = tid & 63, fr = lane & 15, fq = lane >> 4;
        const int b = it >> 6, cg_ = it & 63;
        __syncthreads();
        for (int i = tid; i < 16 * 128; i += 512) { const int r = i >> 7, ch = i & 127; *(LAS u32x4*)(AT + r * 1032 + ch * 8) = *(const u32x4*)(Y + ((size_t)b * PP + PADF + r) * D + ch * 8); }
        __syncthreads();
        const int col = cg_ * 16 + fr;
        const f32x4 acc = skinny16_ksplit(F.lds, WOUTT + (size_t)col * D, F.wave, lane);
        if (F.wave == 0) {
#pragma unroll
            for (int rg = 0; rg < 4; ++rg) { const int n = 4 * fq + rg; H1M[(size_t)(b * NMETA + n) * D + col] = F.meta[(size_t)n * D + col] + acc[rg]; } }
    }
}

__device__ __forceinline__ void phase_router(Ctx& F) {
    const int gw = F.vcu * 8 + F.wave, NGW = F.G * 8;
    unsigned char* WgT = F.ws + WS_WEXP; unsigned char* WuT = F.ws + WS_WEXP + WEXP_ONE;
    constexpr int I_ONE = (D / 64) * (DFF / 64);
    constexpr int NIT = 2 * NE * I_ONE;
    unsigned char* U2 = F.ws + WS_ACT1; float* AFF = (float*)(F.ws + WS_AFF); const float* H1M = (const float*)(F.ws + WS_H1META);
    RowDots W; rowdots_init(W, F.w_router, NE, F.wave, F.lane);
    const int nstep_i = (NIT + NGW - 1) / NGW, nstep_b = (R / 16 + F.G - 1) / F.G, nstep = nstep_i > nstep_b ? nstep_i : nstep_b;
#pragma unroll 1
    for (int st = 0; st < nstep; ++st) {
        const int it = gw + st * NGW, bi = F.vcu + st * F.G;
        const bool has_i = it < NIT, has_b = bi < R / 16;
        f32x4 wv[16]; int mat = 0, e = 0, item = 0;
        if (has_i) { mat = it / (NE * I_ONE); const int rem = it - mat * (NE * I_ONE); e = rem / I_ONE; item = rem - e * I_ONE;
            f8_item_load((mat == 0 ? F.w_gate : F.w_up) + (size_t)e * D * DFF, DFF, DFF, item, F.lane, wv); }
        if (has_b) {
            const int r0 = bi * 16;
            int rr[2]; bool ok[2]; f32x4 u[2][4];
#pragma unroll
            for (int t = 0; t < 2; ++t) { rr[t] = r0 + 2 * F.wave + t; const int b = rr[t] / PP, p = rr[t] - b * PP; ok[t] = p >= PADF;
                if (ok[t]) { if (p < CHK) row_load(H1M + (size_t)(b * NMETA + p - PADF) * D, F.lane, u[t]); else { const size_t xo = ((size_t)b * SEQ + (p - CHK)) * D; row_load_bf((const bf16*)(F.ws + WS_DELTA) + xo, F.lane, u[t]); } }
                else {
#pragma unroll
                    for (int jj = 0; jj < 4; ++jj) u[t][jj] = (f32x4){0.f, 0.f, 0.f, 0.f}; } }
#pragma unroll
            for (int t = 0; t < 2; ++t) { if (ok[t]) { rms_apply(F.ffn_g, F.lane, u[t]); unsigned char* urow = U2 + (size_t)rr[t] * D;
#pragma unroll
                    for (int jj = 0; jj < 4; ++jj) *(unsigned*)(urow + jj * 256 + F.lane * 4) = pk4_fp8(u[t][jj].x, u[t][jj].y, u[t][jj].z, u[t][jj].w); }
                rowdots_put(F.lds, 2 * F.wave + t, F.lane, u[t]); }
            __syncthreads();
            rowdots_mma(F.lds, W, F.wave, F.lane);
            __syncthreads();
            if (F.tid < 256) { const int row = F.tid >> 4, g = F.tid & 15, r = r0 + row; const int b = r / PP, p = r - b * PP;
                const float lg = rowdots_get(F.lds, row, g);
                float mx = lg; mx = fmaxf(mx, __shfl_xor(mx, 1)); mx = fmaxf(mx, __shfl_xor(mx, 2)); mx = fmaxf(mx, __shfl_xor(mx, 4)); mx = fmaxf(mx, __shfl_xor(mx, 8));
                const float ev = expf(lg - mx); float sm = ev; sm += __shfl_xor(sm, 1); sm += __shfl_xor(sm, 2); sm += __shfl_xor(sm, 4); sm += __shfl_xor(sm, 8);
                if (p >= PADF) AFF[((size_t)b * NE + g) * NTOK + (p - PADF)] = ev / sm; }
        }
        if (has_i) f8_item_store((mat == 0 ? WgT : WuT) + (size_t)e * DFF * D, D, DFF, item, F.lane, WPRE_UP, wv);
    }
}

__device__ __forceinline__ void phase_topk(Ctx& F) {
    const float* AFF = (const float*)(F.ws + WS_AFF); int* IDX = (int*)(F.ws + WS_IDX); float* GV = (float*)(F.ws + WS_GV); int* SLOT = (int*)(F.ws + WS_SLOT); unsigned* ROWOFF = (unsigned*)(F.ws + WS_SCAL);
    LAS unsigned* keys = (LAS unsigned*)F.lds; LAS unsigned* hist = keys + 8448; LAS unsigned* misc = hist + 256; LAS unsigned* wtot = misc + 16;
    const int tid = F.tid, lane = F.lane, w = F.wave;
    if (F.vcu >= NB * NE) { convert_wd(F, WD_SPLIT, NE * I_WD, (F.vcu - NB * NE) * 8 + F.wave, (F.G - NB * NE) * 8); return; }
    for (int u = F.vcu; u < NB * NE; u += F.G) {
        const int b = u >> 4, e = u & 15; const float* a = AFF + (size_t)u * NTOK;
        __syncthreads();
        for (int i = tid; i < NTOK; i += 512) keys[i] = __builtin_bit_cast(unsigned, a[i]);
        unsigned prefix = 0u, need = CAP;
        for (int pass = 0; pass < 4; ++pass) {
            const int shift = 24 - 8 * pass;
            if (tid < 256) hist[tid] = 0u;
            __syncthreads();
            for (int i = tid; i < NTOK; i += 512) { const unsigned k = keys[i]; if (pass == 0 || (k >> (shift + 8)) == (prefix >> (shift + 8))) atomicAdd((unsigned*)&hist[(k >> shift) & 255u], 1u); }
            __syncthreads();
            if (w == 0) {
                const int bb = 255 - 4 * lane; const unsigned c0 = hist[bb], c1 = hist[bb - 1], c2 = hist[bb - 2], c3 = hist[bb - 3]; const unsigned tot = c0 + c1 + c2 + c3;
                const float incl_f = wave_scan_incl<false>((float)tot); const unsigned incl = (unsigned)incl_f, excl = incl - tot;
                const bool here = excl < need && need <= incl;
                if (here) { unsigned cum = excl; int sel = bb;
                    if (cum + c0 >= need) sel = bb; else { cum += c0; if (cum + c1 >= need) sel = bb - 1; else { cum += c1; if (cum + c2 >= need) sel = bb - 2; else { cum += c2; sel = bb - 3; } } }
                    misc[0] = prefix | ((unsigned)sel << shift); misc[1] = need - cum; }
            }
            __syncthreads();
            prefix = misc[0]; need = misc[1];
            __syncthreads();
        }
        const int i0 = tid * 17, i1 = (i0 + 17 < NTOK) ? i0 + 17 : NTOK;
        unsigned cg_ = 0u, ce = 0u;
        for (int i = i0; i < i1; ++i) { const unsigned k = keys[i]; cg_ += (k > prefix) ? 1u : 0u; ce += (k == prefix) ? 1u : 0u; }
        unsigned sg = cg_, se = ce;
#pragma unroll
        for (int o = 1; o < 64; o <<= 1) { const unsigned tg = __shfl_up(sg, o), te = __shfl_up(se, o); if (lane >= o) { sg += tg; se += te; } }
        if (lane == 63) { wtot[w] = sg; wtot[8 + w] = se; }
        __syncthreads();
        unsigned og = 0u, oe = 0u;
        for (int j = 0; j < w; ++j) { og += wtot[j]; oe += wtot[8 + j]; }
        unsigned gb = og + sg - cg_, eb = oe + se - ce;
        for (int i = i0; i < i1; ++i) { const unsigned k = keys[i]; int slot = -1;
            if (k > prefix) { slot = (int)(gb + (eb < need ? eb : need)); ++gb; }
            else if (k == prefix) { if (eb < need) slot = (int)(gb + eb); ++eb; }
            SLOT[((size_t)b * NTOK + i) * NE + e] = slot;
            if (slot >= 0) { IDX[(size_t)u * CAP + slot] = i; GV[(size_t)u * CAP + slot] = __builtin_bit_cast(float, k);
                const int j = b * CAP + slot; if (j < 4096) ROWOFF[e * 4096 + j] = (unsigned)(b * PP + PADF + i) * (unsigned)D; } }
    }
}

constexpr size_t WS_HIDT = WS_UN;
constexpr int XT_PITCH = D + 16, HT_PITCH = DFF + 16;
__device__ __forceinline__ void ffn_thin_up(Ctx& F) {
    const unsigned char* U2 = F.ws + WS_ACT1; const int* IDX = (const int*)(F.ws + WS_IDX);
    const unsigned char* WgT = F.ws + WS_WEXP; const unsigned char* WuT = F.ws + WS_WEXP + WEXP_ONE; unsigned char* HIDT = F.ws + WS_HIDT;
    LAS unsigned char* XT = F.lds;
    const int w = F.wave;
    for (int it = F.vcu; it < NE * 22; it += F.G) {
        int tid = F.tid; asm volatile("" : "+v"(tid));
        const int lane = tid & 63, fr = lane & 15, fq = lane >> 4;
        const int e = it / 22, ft = it % 22;
        __syncthreads();
        if (tid < 8 * 64) { const int r = tid >> 6, ch = tid & 63; const int j = 4096 + r, b = j / CAP, slot = j - b * CAP; const int n = IDX[(b * NE + e) * CAP + slot];
            *(LAS u32x4*)(XT + r * XT_PITCH + ch * 16) = *(const u32x4*)(U2 + ((size_t)b * PP + PADF + n) * D + ch * 16); }
        __syncthreads();
        const int f = ft * 128 + w * 16 + fr;
        const unsigned char* wg = WgT + ((size_t)e * DFF + f) * D + 8 * fq; const unsigned char* wu = WuT + ((size_t)e * DFF + f) * D + 8 * fq;
        f32x4 ag = (f32x4){0.f, 0.f, 0.f, 0.f}, au = ag;
#pragma unroll 1
        for (int k8 = 0; k8 < 32; k8 += 16) {
            long bg[16], bu[16];
#pragma unroll
            for (int j = 0; j < 16; ++j) { bg[j] = *(const long*)(wg + (k8 + j) * 32); bu[j] = *(const long*)(wu + (k8 + j) * 32); }
#pragma unroll
            for (int j = 0; j < 16; ++j) { long a = *(const LAS long*)(XT + (fr & 7) * XT_PITCH + (k8 + j) * 32 + 8 * fq); if (fr >= 8) a = 0;
                ag = __builtin_amdgcn_mfma_f32_16x16x32_fp8_fp8(a, bg[j], ag, 0, 0, 0); au = __builtin_amdgcn_mfma_f32_16x16x32_fp8_fp8(a, bu[j], au, 0, 0, 0); }
        }
        if (fq < 2) {
            float hv[4];
#pragma unroll
            for (int rg = 0; rg < 4; ++rg) hv[rg] = fminf(fmaxf(siluf_(ag[rg] * (1.0f / WPRE_UP)) * (au[rg] * (1.0f / WPRE_UP)), -448.0f), 448.0f);
            const unsigned pk = pk4_fp8(hv[0], hv[1], hv[2], hv[3]);
#pragma unroll
            for (int rg = 0; rg < 4; ++rg) HIDT[((size_t)e * 8 + 4 * fq + rg) * DFF + f] = (unsigned char)(pk >> (8 * rg)); }
    }
}
__device__ __forceinline__ void ffn_thin_down(Ctx& F) {
    const unsigned char* WdT = F.ws + WS_WD8; const unsigned char* HIDT = F.ws + WS_HIDT; bf16* YE = (bf16*)(F.ws + WS_YE);
    LAS unsigned char* HT = F.lds;
    const int w = F.wave;
    for (int it = F.vcu; it < NE * 8; it += F.G) {
        int tid = F.tid; asm volatile("" : "+v"(tid));
        const int lane = tid & 63, fr = lane & 15, fq = lane >> 4;
        const int e = it >> 3, dt = it & 7;
        __syncthreads();
        for (int i = tid; i < 8 * 176; i += 512) { const int r = i / 176, ch = i - r * 176; *(LAS u32x4*)(HT + r * HT_PITCH + ch * 16) = *(const u32x4*)(HIDT + ((size_t)e * 8 + r) * DFF + ch * 16); }
        __syncthreads();
        const int d = dt * 128 + w * 16 + fr;
        const unsigned char* wd = WdT + ((size_t)e * D + d) * DFF + 8 * fq;
        f32x4 ay = (f32x4){0.f, 0.f, 0.f, 0.f};
#pragma unroll 1
        for (int k8 = 0; k8 < 88; k8 += 22) {
            long bd[22];
#pragma unroll
            for (int j = 0; j < 22; ++j) bd[j] = *(const long*)(wd + (k8 + j) * 32);
#pragma unroll
            for (int j = 0; j < 22; ++j) { long a = *(const LAS long*)(HT + (fr & 7) * HT_PITCH + (k8 + j) * 32 + 8 * fq); if (fr >= 8) a = 0;
                ay = __builtin_amdgcn_mfma_f32_16x16x32_fp8_fp8(a, bd[j], ay, 0, 0, 0); }
        }
        if (fq < 2) {
#pragma unroll
            for (int rg = 0; rg < 4; ++rg) YE[((size_t)e * EROWSP + 4096 + 4 * fq + rg) * D + d] = (bf16)f2bf(ay[rg] * (1.0f / WPRE_DN)); }
    }
}

struct FinTok { f32x4 h[4]; int slot; };
struct FinY { u32x2 ya[4], yb[4]; float ga, gb; unsigned rest; };
__device__ __forceinline__ void phase_final(Ctx& F) {
    const int* SLOT = (const int*)(F.ws + WS_SLOT); const float* GV = (const float*)(F.ws + WS_GV); const bf16* YE = (const bf16*)(F.ws + WS_YE);
    const int gw = F.vcu * 8 + F.wave, NGW = F.G * 8, lane = F.lane;
    const bf16* DELTA = (const bf16*)(F.ws + WS_DELTA);
    constexpr int NT = NB * SEQ;
#define FIN_STAGE1(t_, K) do { const int _t = (t_); (K).slot = -1; if (_t < NT) { row_load_bf(DELTA + (size_t)_t * D, lane, (K).h); \
        const int _b = _t / SEQ, _n = _t - _b * SEQ + NMETA; (K).slot = (lane < 16) ? SLOT[((size_t)_b * NTOK + _n) * NE + lane] : -1; } } while (0)
#define FIN_STAGE2(t_, K, Y) do { const int _t = (t_); unsigned _em = (unsigned)(__ballot((K).slot >= 0) & 0xffffull); (Y).ga = 0.0f; (Y).gb = 0.0f; \
        _Pragma("unroll") for (int jj = 0; jj < 4; ++jj) { (Y).ya[jj] = (u32x2){0u, 0u}; (Y).yb[jj] = (u32x2){0u, 0u}; } \
        if (_em) { const int _b = _t / SEQ; const int _ea = __builtin_ctz(_em); _em &= _em - 1u; const bool _two = _em != 0u; const int _eb = _two ? __builtin_ctz(_em) : _ea; if (_two) _em &= _em - 1u; \
            const int _sa = __shfl((K).slot, _ea), _sb = __shfl((K).slot, _eb); \
            (Y).ga = GV[((size_t)_b * NE + _ea) * CAP + _sa]; (Y).gb = _two ? GV[((size_t)_b * NE + _eb) * CAP + _sb] : 0.0f; \
            const bf16* _ya = YE + ((size_t)_ea * EROWSP + (size_t)_b * CAP + _sa) * D; const bf16* _yb = YE + ((size_t)_eb * EROWSP + (size_t)_b * CAP + _sb) * D; \
            _Pragma("unroll") for (int jj = 0; jj < 4; ++jj) { (Y).ya[jj] = *(const u32x2*)(_ya + jj * 256 + lane * 4); (Y).yb[jj] = *(const u32x2*)(_yb + jj * 256 + lane * 4); } } \
        (Y).rest = _em; } while (0)
    FinTok k0, k1, k2; FinY y0, y1;
    FIN_STAGE1(gw, k0); FIN_STAGE1(gw + NGW, k1);
    FIN_STAGE2(gw, k0, y0);
    for (int t = gw; t < NT; t += NGW) {
        FIN_STAGE2(t + NGW, k1, y1);
        FIN_STAGE1(t + 2 * NGW, k2);
        const int b = t / SEQ;
        float* row = F.out + (size_t)t * D;
        f32x4 v[4];
#pragma unroll
        for (int jj = 0; jj < 4; ++jj) {
            v[jj].x = k0.h[jj].x + y0.ga * bflo(y0.ya[jj].x) + y0.gb * bflo(y0.yb[jj].x); v[jj].y = k0.h[jj].y + y0.ga * bfhi(y0.ya[jj].x) + y0.gb * bfhi(y0.yb[jj].x);
            v[jj].z = k0.h[jj].z + y0.ga * bflo(y0.ya[jj].y) + y0.gb * bflo(y0.yb[jj].y); v[jj].w = k0.h[jj].w + y0.ga * bfhi(y0.ya[jj].y) + y0.gb * bfhi(y0.yb[jj].y); }
        const int myslot = k0.slot;
        unsigned em = y0.rest;
        while (em) {
            const int ea = __builtin_ctz(em); em &= em - 1u; const bool two = em != 0u; const int eb = two ? __builtin_ctz(em) : ea; if (two) em &= em - 1u;
            const int sa = __shfl(myslot, ea), sb = __shfl(myslot, eb);
            const float ga = GV[((size_t)b * NE + ea) * CAP + sa], gb = two ? GV[((size_t)b * NE + eb) * CAP + sb] : 0.0f;
            const bf16* ya = YE + ((size_t)ea * EROWSP + (size_t)b * CAP + sa) * D; const bf16* yb = YE + ((size_t)eb * EROWSP + (size_t)b * CAP + sb) * D;
            u32x2 wa[4], wb[4];
#pragma unroll
            for (int jj = 0; jj < 4; ++jj) { wa[jj] = *(const u32x2*)(ya + jj * 256 + lane * 4); wb[jj] = *(const u32x2*)(yb + jj * 256 + lane * 4); }
#pragma unroll
            for (int jj = 0; jj < 4; ++jj) {
                v[jj].x += ga * bflo(wa[jj].x) + gb * bflo(wb[jj].x); v[jj].y += ga * bfhi(wa[jj].x) + gb * bfhi(wb[jj].x);
                v[jj].z += ga * bflo(wa[jj].y) + gb * bflo(wb[jj].y); v[jj].w += ga * bfhi(wa[jj].y) + gb * bfhi(wb[jj].y); }
        }
        float ss = 0.f;
#pragma unroll
        for (int jj = 0; jj < 4; ++jj) ss += v[jj].x * v[jj].x + v[jj].y * v[jj].y + v[jj].z * v[jj].z + v[jj].w * v[jj].w;
        const float rstd = rsqrtf(wave_sum(ss) * (1.0f / D) + EPS);
#pragma unroll
        for (int jj = 0; jj < 4; ++jj) { const f32x4 gv = *(const f32x4*)(F.fin_g + jj * 256 + lane * 4); *(f32x4*)(row + jj * 256 + lane * 4) = v[jj] * rstd * gv; }
        k0 = k1; k1 = k2; y0 = y1;
    }
#undef FIN_STAGE1
#undef FIN_STAGE2
}

constexpr int N_PHASES = 12;
struct Args { const float* in[17]; float* out; unsigned char* ws; };
#define XB_TMO      128
#define XB_XCNT(j)  (256  + 64 * (j))
#define XB_XSUB(j)  (1280 + 64 * (j))
#define XB_XGEN(j)  (2304 + 64 * (j))
#define XB_TOP      3328
#define XB_TOPGEN   3392
#define XCD_BAR_WORDS 3456
#define XB_SPIN_CAP (1u << 22)
__device__ __forceinline__ unsigned xb_ld(unsigned* p)              { return __hip_atomic_load(p, __ATOMIC_RELAXED, __HIP_MEMORY_SCOPE_AGENT); }
__device__ __forceinline__ unsigned xb_add(unsigned* p, unsigned v) { return __hip_atomic_fetch_add(p, v, __ATOMIC_RELAXED, __HIP_MEMORY_SCOPE_AGENT); }
__device__ __forceinline__ unsigned xb_xcc_id() { return (unsigned)__builtin_amdgcn_s_getreg((3 << 11) | 20) & 0xFu; }
#define XB_SPIN(cond, bar) do { unsigned _sp = 0; while (cond) { __builtin_amdgcn_s_sleep(1); \
    if ((++_sp & 255u) == 0u) { if (xb_ld(&(bar)[XB_TMO])) break; if (_sp > XB_SPIN_CAP) { atomicAdd(&(bar)[XB_TMO], 1u); break; } } } } while (0)
struct XcdBarrier { unsigned* bar; unsigned x; volatile LAS unsigned* st; };
__device__ __forceinline__ XcdBarrier xcd_barrier_post(unsigned* bar, volatile LAS unsigned* st) {
    XcdBarrier b; b.bar = bar; b.x = xb_xcc_id(); b.st = st;
    if (threadIdx.x == 0) (void)xb_add(&bar[XB_XCNT(b.x)], 1u);
    return b;
}
__device__ __forceinline__ void xcd_barrier_complete(unsigned* bar, unsigned x, unsigned& nloc, unsigned& nx) {
    const unsigned G = gridDim.x * gridDim.y * gridDim.z;
    unsigned sum, cnt, mine, sp = 0u;
    for (;;) {
        sum = 0u; cnt = 0u; mine = 0u;
#pragma unroll
        for (unsigned j = 0; j < 16; ++j) { const unsigned c = xb_ld(&bar[XB_XCNT(j)]); sum += c; cnt += (c > 0u) ? 1u : 0u; mine = (j == x) ? c : mine; }
        if (sum == G) break;
        __builtin_amdgcn_s_sleep(1);
        if ((++sp & 255u) == 0u) { if (xb_ld(&bar[XB_TMO])) break; if (sp > XB_SPIN_CAP) { atomicAdd(&bar[XB_TMO], 1u); break; } }
    }
    nloc = mine > 0u ? mine : 1u; nx = cnt > 0u ? cnt : 1u;
}
__device__ __forceinline__ void xcd_barrier(const XcdBarrier& b) {
    asm volatile("s_waitcnt vmcnt(0)" ::: "memory");
    __syncthreads();
    if (threadIdx.x == 0) {
        unsigned* bar = b.bar;
        __builtin_amdgcn_s_waitcnt(0);
        unsigned nloc = b.st[0], nx = b.st[1];
        if (nloc == 0u) { xcd_barrier_complete(bar, b.x, nloc, nx); b.st[0] = nloc; b.st[1] = nx; }
        const unsigned old = xb_add(&bar[XB_XSUB(b.x)], 1u);
        const unsigned gen = old / nloc;
        if (old + 1u == (gen + 1u) * nloc) {
            __builtin_amdgcn_fence(__ATOMIC_RELEASE, "agent");
            asm volatile("s_waitcnt vmcnt(0)" ::: "memory");
            const unsigned og = xb_add(&bar[XB_TOP], 1u);
            const unsigned tg = og / nx;
            if (og + 1u == (tg + 1u) * nx) xb_add(&bar[XB_TOPGEN], 1u);
            else XB_SPIN(xb_ld(&bar[XB_TOPGEN]) == tg, bar);
            __builtin_amdgcn_fence(__ATOMIC_ACQUIRE, "agent");
            xb_add(&bar[XB_XGEN(b.x)], 1u);
            asm volatile("s_waitcnt vmcnt(0)" ::: "memory");
        } else {
            XB_SPIN(xb_ld(&bar[XB_XGEN(b.x)]) == gen, bar);
            __builtin_amdgcn_fence(__ATOMIC_ACQUIRE, "agent");
            asm volatile("s_waitcnt vmcnt(0)" ::: "memory");
        }
    }
    __syncthreads();
}
constexpr int MISC_OFF = LDS_BYTES - 16;

typedef const __attribute__((address_space(4))) Args* ArgsP;
__device__ __forceinline__ void make_ctx(Ctx& F, unsigned char* lds_raw) {
    ArgsP A = (ArgsP)__builtin_amdgcn_kernarg_segment_ptr(); asm volatile("" : "+s"(A));
    F.lds = (LAS unsigned char*)lds_raw;
    { int t = threadIdx.x; asm volatile("" : "+v"(t)); F.tid = t; } F.lane = F.tid & 63; F.wave = __builtin_amdgcn_readfirstlane(F.tid >> 6);
    F.G = gridDim.x; { const int bx = blockIdx.x; F.vcu = (F.G % 8 == 0) ? (bx % 8) * (F.G / 8) + bx / 8 : bx; }
    F.x = A->in[0]; F.meta = A->in[1]; F.mix_g = A->in[2]; F.w_in = A->in[3]; F.b_gates = A->in[4]; F.conv_w = A->in[5]; F.conv_b = A->in[6];
    F.ret_logit = A->in[7]; F.ret_gn = A->in[8]; F.ml_gn = A->in[9]; F.w_out = A->in[10]; F.ffn_g = A->in[11]; F.w_router = A->in[12];
    F.w_gate = A->in[13]; F.w_up = A->in[14]; F.w_down = A->in[15]; F.fin_g = A->in[16];
    F.out = A->out; F.ws = A->ws;
}
template <int LO, int HI> __global__ void __launch_bounds__(512, 2) mk_fwd(Args args) {
    extern __shared__ __attribute__((aligned(16))) unsigned char lds_raw[];
#if MK_SPLIT
#define GRID_BAR() do {} while (0)
#elif MK_BARRIER == 0
    cg::grid_group grid = cg::this_grid();
#define GRID_BAR() grid.sync()
#else
    XcdBarrier xbar;
    {   volatile LAS unsigned* st = (volatile LAS unsigned*)((LAS unsigned char*)lds_raw + MISC_OFF);
        if (threadIdx.x < 4) st[threadIdx.x] = 0u;
        __syncthreads();
        ArgsP A0 = (ArgsP)__builtin_amdgcn_kernarg_segment_ptr();
        xbar = xcd_barrier_post((unsigned*)A0->ws, st); }
#define GRID_BAR() xcd_barrier(xbar)
#endif
#define IN(k) (LO <= (k) && (k) < HI)
#define SEAM(k) do { if (IN(k) && IN((k) + 1)) GRID_BAR(); } while (0)
#define CTX() Ctx F; make_ctx(F, lds_raw)

    if (IN(0)) { CTX(); phase_prep(F); } SEAM(0);
    if (IN(1)) {
        CTX();
        pg8::DenseOrder S{(const bf16*)(F.ws + WS_ACT1), (const bf16*)(F.ws + WS_WINT), D, D, NB * SEQ / 256, PC / 256, (NB * SEQ / 256) * (PC / 256), F.G, (int)blockIdx.x};
        pg8::EpiProj E{(bf16*)(F.ws + WS_PROJ), (const f32x2*)(F.ws + WS_ROPE)};
        pg8::gemm_phase(F.lds, D, S, E);
        proj_meta(F);
    } SEAM(1);
    if (IN(2)) { CTX(); phase_rope_conv(F); } SEAM(2);
    if (IN(3)) { CTX(); phase_seg_summary(F); } SEAM(3);
    if (IN(4)) { CTX(); phase_seq(F); } SEAM(4);
    if (IN(5)) { CTX(); phase_combine(F); } SEAM(5);
    if (IN(6)) {
        CTX();
        pg8::DenseOrder S{(const bf16*)(F.ws + WS_ACT2), (const bf16*)(F.ws + WS_WOUTT), D, D, NB * SEQ / 256, D / 256, (NB * SEQ / 256) * (D / 256), F.G, (int)blockIdx.x};
        pg8::EpiDelta E{(bf16*)(F.ws + WS_DELTA), F.x};
        pg8::gemm_phase(F.lds, D, S, E);
        out_meta(F);
    } SEAM(6);
    if (IN(7)) { CTX(); phase_router(F); } SEAM(7);
    if (IN(8)) { CTX(); phase_topk(F); } SEAM(8);
    if (IN(9)) {
        CTX();
        pg8::FfnUpOrder S{F.ws + WS_ACT1, (const unsigned*)(F.ws + WS_SCAL), F.ws + WS_WEXP, F.ws + WS_WEXP + WEXP_ONE, D / 2, D / 2, NE * 22 * 16, F.G, F.vcu};
        pg8::EpiSwiglu E{F.ws + WS_HID};
        pg8::gemm_phase(F.lds, D / 2, S, E);
        ffn_thin_up(F);
    } SEAM(9);
    if (IN(10)) {
        CTX();
        pg8::FfnDownOrder S{F.ws + WS_HID, F.ws + WS_WD8, DFF / 2, DFF / 2, NE * 4 * 16, F.G, F.vcu};
        pg8::EpiStoreBf16 E{(bf16*)(F.ws + WS_YE), D, (size_t)EROWSP * D};
        pg8::gemm_phase(F.lds, DFF / 2, S, E);
        ffn_thin_down(F);
    } SEAM(10);
    if (IN(11)) { CTX(); phase_final(F); }
#undef IN
#undef SEAM
#undef CTX
}

template <int PH> static void launch_split(int grid, hipStream_t stream, const Args& a) {
    if constexpr (PH < N_PHASES) {
        static bool attr = false;
        if (!attr) { (void)hipFuncSetAttribute((const void*)mk_fwd<PH, PH + 1>, hipFuncAttributeMaxDynamicSharedMemorySize, LDS_BYTES); attr = true; }
        hipLaunchKernelGGL((mk_fwd<PH, PH + 1>), dim3(grid), dim3(512), LDS_BYTES, stream, a);
        if ((PROBE_MASK >> PH) & 1) hipLaunchKernelGGL((mk_fwd<PH, PH + 1>), dim3(grid), dim3(512), LDS_BYTES, stream, a);
        launch_split<PH + 1>(grid, stream, a);
    }
}
extern "C" void kernel_launch(void* const* d_in, const int* in_sizes, int n_in, void* d_out, int out_size, void* d_ws, size_t ws_size, hipStream_t stream) {
    static int grid = 0;
    if (grid == 0) {
        if (n_in != 17 || out_size != NB * SEQ * D || ws_size < WS_END) { fprintf(stderr, "kernel_launch: unexpected shapes (n_in %d out %d ws %zu need %zu)\n", n_in, out_size, ws_size, (size_t)WS_END); grid = -1; return; }
        int dev = 0, cus = 0;
        if (hipGetDevice(&dev) != hipSuccess || hipDeviceGetAttribute(&cus, hipDeviceAttributeMultiprocessorCount, dev) != hipSuccess) { grid = -1; return; }
#if !MK_SPLIT
        int per_cu = 0;
        if (hipFuncSetAttribute((const void*)mk_fwd<0, N_PHASES>, hipFuncAttributeMaxDynamicSharedMemorySize, LDS_BYTES) != hipSuccess) { fprintf(stderr, "kernel_launch: hipFuncSetAttribute failed\n"); grid = -1; return; }
        if (hipOccupancyMaxActiveBlocksPerMultiprocessor(&per_cu, (const void*)mk_fwd<0, N_PHASES>, 512, LDS_BYTES) != hipSuccess || per_cu < 1) { fprintf(stderr, "kernel_launch: occupancy query says %d\n", per_cu); }
#endif
        (void)hipGetLastError();
        grid = cus;
    }
    if (grid < 0) return;
    Args a{};
    for (int i = 0; i < 17; ++i) a.in[i] = (const float*)d_in[i];
    a.out = (float*)d_out; a.ws = (unsigned char*)d_ws;
#if MK_SPLIT
    launch_split<0>(grid, stream, a);
#else
#if MK_BARRIER == 0
    void* kargs[] = {&a};
    hipError_t e = hipLaunchCooperativeKernel((const void*)mk_fwd<0, N_PHASES>, dim3(grid), dim3(512), kargs, LDS_BYTES, stream);
    if (e != hipSuccess) fprintf(stderr, "cooperative launch failed: %s (grid %d)\n", hipGetErrorString(e), grid);
#else
    if (hipMemsetAsync(d_ws, 0, 16384, stream) != hipSuccess) { fprintf(stderr, "kernel_launch: memset of barrier words failed\n"); return; }
    hipLaunchKernelGGL((mk_fwd<0, N_PHASES>), dim3(grid), dim3(512), LDS_BYTES, stream, a);
#endif
#endif
}
```

```cpp
#include <hip/hip_runtime.h>
#include <hip/hip_cooperative_groups.h>
#include <cstdio>
#include <cstdint>
namespace cg = cooperative_groups;

#ifndef MK_SPLIT
#define MK_SPLIT 0
#endif
#ifndef PROBE_MASK
#define PROBE_MASK 0
#endif
#ifndef MK_BARRIER
#define MK_BARRIER 1
#endif

#define GAS __attribute__((address_space(1)))
#define LAS __attribute__((address_space(3)))
typedef unsigned short bf16;
typedef short bf16x8 __attribute__((ext_vector_type(8)));
typedef float f32x4 __attribute__((ext_vector_type(4)));
typedef float f32x2 __attribute__((ext_vector_type(2)));
typedef unsigned u32x4 __attribute__((ext_vector_type(4)));
typedef unsigned u32x2 __attribute__((ext_vector_type(2)));
typedef int i32x8 __attribute__((ext_vector_type(8)));
typedef int i32x4 __attribute__((ext_vector_type(4)));

constexpr int NB = 4, SEQ = 8192, D = 1024, NMETA = 16, CHK = 128, PADF = 112;
constexpr int NTOK = NMETA + SEQ;
constexpr int PP = NTOK + PADF;
constexpr int NCH = PP / CHK;
constexpr int R = NB * PP;
constexpr int PCOLS = 4112, PC = 4096;
constexpr int NE = 16, CAP = 1026, DFF = 2816, EROWS = NB * CAP, EROWSP = 4352;
constexpr int NH = 4;
constexpr float EPS = 1e-6f, NEGF = -1e30f;
constexpr int WSC_UP = 0x7A7A7A7A, WSC_DN = 0x79797979;
constexpr float WPRE_UP = 32.0f, WPRE_DN = 64.0f;

constexpr size_t MiB = 1u << 20;
constexpr size_t WS_ROPE = 1 * MiB, WS_GATES = 6 * MiB, WS_AFF = 9 * MiB, WS_IDX = 12 * MiB, WS_GV = 13 * MiB, WS_SLOT = 14 * MiB;
constexpr size_t WS_H1META = 17 * MiB, WS_UN = 18 * MiB, WS_SCAL = 21 * MiB, WS_WINT = 22 * MiB, WS_WOUTT = 30 * MiB;
constexpr size_t WS_ACT1 = 32 * MiB;
constexpr size_t WS_ACT2 = 97 * MiB;
constexpr size_t WS_PROJ = 162 * MiB;
constexpr size_t WS_STATE = 422 * MiB;
constexpr size_t WS_DELTA = 162 * MiB;
constexpr size_t WS_YE = 226 * MiB;
constexpr size_t WS_HID = 365 * MiB;
constexpr size_t WS_WD8 = 568 * MiB;
constexpr size_t WS_WEXP = 612 * MiB;
constexpr size_t WS_END = 700 * MiB;
constexpr size_t WEXP_ONE = (size_t)NE * DFF * D;
constexpr size_t WS_OUTD_END = WS_STATE + 16 * MiB + (size_t)2 * R * D * 2;
static_assert(WS_PROJ + (size_t)R * PC * 2 <= WS_STATE && WS_OUTD_END <= WS_WD8, "mixer map");
static_assert(WS_DELTA + (size_t)NB * SEQ * D * 2 <= WS_YE && WS_YE + (size_t)NE * EROWSP * D * 2 <= WS_HID && WS_HID + (size_t)NE * 4096 * DFF <= WS_WD8 && WS_WD8 + WEXP_ONE <= WS_WEXP && WS_WEXP + 2 * WEXP_ONE <= WS_END, "ffn map");

constexpr int LDS_BYTES = 155648;
constexpr int TP = 136;
constexpr int T0_OFF = 0, T1_OFF = 34816, T2_OFF = 69632, T3_OFF = 104448, VEC_OFF = 139264;

__device__ __forceinline__ unsigned f2bf(float f) { unsigned u = __builtin_bit_cast(unsigned, f); return (u + 0x7fffu + ((u >> 16) & 1u)) >> 16; }
__device__ __forceinline__ unsigned pk2(float lo, float hi) { unsigned r; asm("v_cvt_pk_bf16_f32 %0, %1, %2" : "=v"(r) : "v"(lo), "v"(hi)); return r; }
__device__ __forceinline__ unsigned cvtpk(float lo, float hi) { unsigned r; asm("v_cvt_pk_bf16_f32 %0, %1, %2" : "=v"(r) : "v"(lo), "v"(hi)); return r; }
__device__ __forceinline__ unsigned pk4_fp8(float a, float b, float c, float d) { int p = __builtin_amdgcn_cvt_pk_fp8_f32(a, b, 0, false); p = __builtin_amdgcn_cvt_pk_fp8_f32(c, d, p, true); return (unsigned)p; }
__device__ __forceinline__ float bf2f(unsigned b) { return __builtin_bit_cast(float, b << 16); }
__device__ __forceinline__ float bflo(unsigned w) { return __builtin_bit_cast(float, w << 16); }
__device__ __forceinline__ float bfhi(unsigned w) { return __builtin_bit_cast(float, w & 0xffff0000u); }
template <bool MAXOP>
__device__ __forceinline__ float wave_scan_incl(float v) {
    const int idn = __builtin_bit_cast(int, MAXOP ? -3.0e38f : 0.0f);
#define DPP_STEP(ctrl, rmask) { const float t = __builtin_bit_cast(float, __builtin_amdgcn_update_dpp(idn, __builtin_bit_cast(int, v), ctrl, rmask, 0xF, false)); v = MAXOP ? fmaxf(v, t) : v + t; }
    DPP_STEP(0x111, 0xF) DPP_STEP(0x112, 0xF) DPP_STEP(0x114, 0xF) DPP_STEP(0x118, 0xF) DPP_STEP(0x142, 0xA) DPP_STEP(0x143, 0xC)
#undef DPP_STEP
    return v;
}
__device__ __forceinline__ float wave_sum(float v) { v = wave_scan_incl<false>(v); return __builtin_bit_cast(float, __builtin_amdgcn_readlane(__builtin_bit_cast(int, v), 63)); }
__device__ __forceinline__ float wave_max(float v) { v = wave_scan_incl<true>(v); return __builtin_bit_cast(float, __builtin_amdgcn_readlane(__builtin_bit_cast(int, v), 63)); }
__device__ __forceinline__ float sigmoidf_(float x) { return __builtin_amdgcn_rcpf(1.0f + __expf(-x)); }
__device__ __forceinline__ float siluf_(float x) { return x * __builtin_amdgcn_rcpf(1.0f + __expf(-x)); }
__device__ __forceinline__ float logsigmoidf_(float x) { return fminf(x, 0.0f) - log1pf(__expf(-fabsf(x))); }
#define LDS_WAIT() asm volatile("s_waitcnt lgkmcnt(0)" ::: "memory")

namespace pg8 {
constexpr int BM = 256, BK = 64, HALF = 128, HTB = HALF * BK * 2, STAGE_BYTES = 8 * HTB;
__device__ __forceinline__ int lds_byte(int r, int c) { const int st = (r >> 4) * 2 + (c >> 5), rr = r & 15, cc = c & 31, ob = rr * 64 + cc * 2; return st * 1024 + (ob ^ (((ob >> 9) & 1) << 5)); }
__device__ __forceinline__ void stage_rc(int b, int& Rr, int& C) { const int st = b / 1024, sb = b % 1024, swz = sb ^ (((sb >> 9) & 1) << 5); Rr = (st >> 1) * 16 + swz / 64; C = (st & 1) * 32 + (swz % 64) / 2; }
__device__ __forceinline__ int perm32(int rho) { const int n = rho >> 4, i = rho & 15; return 8 * (i >> 2) + 4 * n + (i & 3); }
__device__ __forceinline__ unsigned cvt_pk_bf16(float lo, float hi) { unsigned r; asm volatile("v_cvt_pk_bf16_f32 %0, %1, %2" : "=v"(r) : "v"(lo), "v"(hi)); return r; }

struct Unit { int pm, pn, e, row0; };
struct UAddr { const char* a0; const char* a1; const char* b0; const char* b1; };

template <class Epi, class Sched>
__device__ __forceinline__ void gemm_phase(LAS unsigned char* lds, const int K, const Sched& S, const Epi& E) {
    int tid_ = threadIdx.x; asm volatile("" : "+v"(tid_));
    const int tid = tid_, wid = __builtin_amdgcn_readfirstlane(tid >> 6), lane = tid & 63, wr = wid >> 2, wc = wid & 3, fr = lane & 15, fq = lane >> 4;
    const int nt = K / BK;
    unsigned voffB[2], voffA0 = 0, voffA1 = 0, colb = 0;
    int sR0, sC0;
    {   int sR1, sC1; stage_rc(tid * 16, sR0, sC0); stage_rc(tid * 16 + 8192, sR1, sC1);
        const int Rb0 = Epi::PERM ? ((sR0 & ~31) + perm32(sR0 & 31)) : sR0, Rb1 = Epi::PERM ? ((sR1 & ~31) + perm32(sR1 & 31)) : sR1;
        voffB[0] = (unsigned)(Rb0 * S.ldb + sC0) * 2u; voffB[1] = (unsigned)(Rb1 * S.ldb + sC1) * 2u;
        if constexpr (!Sched::GATHER) { voffA0 = (unsigned)(sR0 * S.lda + sC0) * 2u; voffA1 = (unsigned)(sR1 * S.lda + sC1) * 2u; } else colb = (unsigned)sC0 * 2u; }
    LAS unsigned* const tab = (LAS unsigned*)(lds + STAGE_BYTES);
    const LAS unsigned* const tabp = tab + sR0;
    const size_t kstep = (size_t)(BK * 2);
    const unsigned ldsw = (unsigned)wid * 1024u;
    constexpr bool FP8 = Sched::FP8;
    const int aoff = FP8 ? lds_byte(wr * 64 + fr, fq * 16) : lds_byte(wr * 64 + fr, fq * 8), boff = FP8 ? lds_byte(wc * 32 + fr, fq * 16) : lds_byte(wc * 32 + fr, fq * 8);
    int wsc_v = S.wscale, one_v = 0x7F7F7F7F; asm volatile("" : "+v"(wsc_v), "+v"(one_v));
#define PG8_SA(b, h) (((b) * 2 + (h)) * HTB)
#define PG8_SB(b, h) ((4 + (b) * 2 + (h)) * HTB)
#define PG8_STAGE(bufoff, gbase, v0, v1) do { \
        __builtin_amdgcn_global_load_lds((const unsigned*)((const char*)(gbase) + (v0)), (LAS unsigned*)(lds + (bufoff) + ldsw), 16, 0, 0); \
        __builtin_amdgcn_global_load_lds((const unsigned*)((const char*)(gbase) + (v1)), (LAS unsigned*)(lds + (bufoff) + ldsw + 8192), 16, 0, 0); } while (0)
#define PG8_STAGE_A(bufoff, gbase, slot, h) do { if constexpr (Sched::GATHER) { const unsigned _r0 = tabp[(slot) * 256 + (h) * 128] + colb, _r1 = tabp[(slot) * 256 + (h) * 128 + 64] + colb; PG8_STAGE(bufoff, gbase, _r0, _r1); } \
        else PG8_STAGE(bufoff, gbase, voffA0, voffA1); } while (0)
#define PG8_LD32(p) __builtin_shufflevector(*(const LAS i32x4*)(p), *(const LAS i32x4*)((p) + 16), 0, 1, 2, 3, 4, 5, 6, 7)
#define PG8_LDA(dst, b, h) do { if constexpr (FP8) { _Pragma("unroll") for (int m = 0; m < 4; ++m) dst##8[m] = PG8_LD32(lds + PG8_SA(b, h) + aoff + m * 2048); } \
        else { _Pragma("unroll") for (int m = 0; m < 4; ++m) _Pragma("unroll") for (int k = 0; k < 2; ++k) dst[m][k] = *(const LAS bf16x8*)(lds + PG8_SA(b, h) + aoff + m * 2048 + k * 1024); } } while (0)
#define PG8_LDB(dst, b, h) do { if constexpr (FP8) { _Pragma("unroll") for (int n = 0; n < 2; ++n) dst##8[n] = PG8_LD32(lds + PG8_SB(b, h) + boff + n * 2048); } \
        else { _Pragma("unroll") for (int n = 0; n < 2; ++n) _Pragma("unroll") for (int k = 0; k < 2; ++k) dst[n][k] = *(const LAS bf16x8*)(lds + PG8_SB(b, h) + boff + n * 2048 + k * 1024); } } while (0)
#define PG8_MMA_FULL(ai, bj, At, Bt) do { __builtin_amdgcn_s_setprio(1); \
        if constexpr (FP8) { _Pragma("unroll") for (int m = 0; m < 4; ++m) _Pragma("unroll") for (int n = 0; n < 2; ++n) \
            asm volatile("v_mfma_scale_f32_16x16x128_f8f6f4 %0, %1, %2, %0, %3, %4 op_sel_hi:[0,0,0]" : "+v"(acc[ai][bj][m][n]) : "v"(Bt##8[n]), "v"(At##8[m]), "v"(wsc_v), "v"(one_v)); } \
        else { _Pragma("unroll") for (int m = 0; m < 4; ++m) _Pragma("unroll") for (int n = 0; n < 2; ++n) _Pragma("unroll") for (int k = 0; k < 2; ++k) \
            acc[ai][bj][m][n] = __builtin_amdgcn_mfma_f32_16x16x32_bf16(Bt[n][k], At[m][k], acc[ai][bj][m][n], 0, 0, 0); } \
        __builtin_amdgcn_s_setprio(0); } while (0)
#define PG8_MMA_THIN(ai, bj, At, Bt) do { if (!FP8 && (ai) == 0 && wr == 0) { _Pragma("unroll") for (int n = 0; n < 2; ++n) _Pragma("unroll") for (int k = 0; k < 2; ++k) \
        acc[0][bj][0][n] = __builtin_amdgcn_mfma_f32_16x16x32_bf16(Bt[n][k], At[0][k], acc[0][bj][0][n], 0, 0, 0); } } while (0)
#define PG8_WAIT_V(n) asm volatile("s_waitcnt vmcnt(" #n ")" ::: "memory")
#define PG8_WAIT_L(n) asm volatile("s_waitcnt lgkmcnt(" #n ")" ::: "memory")
#define PG8_BAR __builtin_amdgcn_s_barrier()
#define PG8_SCHED __builtin_amdgcn_sched_barrier(0)
    Unit cur, nxt; int ui = 0;
    if (!S.next(0, cur)) return;
    f32x4 acc[2][2][4][2];
#pragma unroll
    for (int a = 0; a < 2; ++a)
#pragma unroll
        for (int b = 0; b < 2; ++b)
#pragma unroll
            for (int m = 0; m < 4; ++m)
#pragma unroll
                for (int n = 0; n < 2; ++n) acc[a][b][m][n] = (f32x4){0.f, 0.f, 0.f, 0.f};
    bf16x8 At[4][2], B0[2][2], B1[2][2]; i32x8 At8[4], B08[2], B18[2];
    UAddr cu, nx;
    S.addr(cur, cu);
    if constexpr (Sched::GATHER) {
        if (tid < 256) __builtin_amdgcn_global_load_lds((const unsigned*)(S.rowoff_ptr(cur) + tid), (LAS unsigned*)(tab + wid * 64), 4, 0, 0);
        asm volatile("s_waitcnt vmcnt(0)" ::: "memory"); __syncthreads(); }
    PG8_STAGE(PG8_SB(0, 0), cu.b0, voffB[0], voffB[1]); PG8_STAGE(PG8_SB(0, 1), cu.b1, voffB[0], voffB[1]); PG8_STAGE_A(PG8_SA(0, 0), cu.a0, 0, 0); PG8_STAGE_A(PG8_SA(0, 1), cu.a1, 0, 1);
    if (wr == 1) PG8_BAR;
    PG8_WAIT_V(2); PG8_BAR;
    PG8_STAGE(PG8_SB(1, 0), cu.b0 + kstep, voffB[0], voffB[1]); PG8_STAGE_A(PG8_SA(1, 0), cu.a0 + kstep, 0, 0); PG8_STAGE(PG8_SB(1, 1), cu.b1 + kstep, voffB[0], voffB[1]);
    PG8_WAIT_V(6); PG8_BAR;
    for (;;) {
        const bool has_next = S.next(ui + 1, nxt);
        const bool thin = Sched::HAS_THIN && S.thin(cur);
        const int cs = ui & 1, ns = has_next ? (cs ^ 1) : cs;
        if (has_next) { S.addr(nxt, nx); if constexpr (Sched::GATHER) { if (tid < 256) __builtin_amdgcn_global_load_lds((const unsigned*)(S.rowoff_ptr(nxt) + tid), (LAS unsigned*)(tab + (cs ^ 1) * 256 + wid * 64), 4, 0, 0); } } else nx = cu;
#define PG8_KLOOP(MMA) \
        for (int t = 0; t < nt; t += 2) { \
            const bool last = (t == nt - 2); \
            const char* a1h1 = cu.a1 + (size_t)(t + 1) * kstep; \
            const char* a2h0 = last ? nx.a0 : cu.a0 + (size_t)(t + 2) * kstep; const char* a2h1 = last ? nx.a1 : cu.a1 + (size_t)(t + 2) * kstep; \
            const char* b2h0 = last ? nx.b0 : cu.b0 + (size_t)(t + 2) * kstep; const char* b2h1 = last ? nx.b1 : cu.b1 + (size_t)(t + 2) * kstep; \
            const int s2 = last ? ns : cs; \
              \
            PG8_LDB(B0, 0, 0); PG8_LDB(B1, 0, 1); PG8_SCHED; PG8_LDA(At, 0, 0); PG8_STAGE_A(PG8_SA(1, 1), a1h1, cs, 1); \
            PG8_WAIT_V(8); PG8_WAIT_L(0); PG8_BAR; MMA(0, 0, At, B0); MMA(0, 1, At, B1); PG8_BAR; PG8_SCHED; \
              \
            PG8_LDA(At, 0, 1); PG8_STAGE(PG8_SB(0, 0), b2h0, voffB[0], voffB[1]); PG8_STAGE(PG8_SB(0, 1), b2h1, voffB[0], voffB[1]); PG8_STAGE_A(PG8_SA(0, 0), a2h0, s2, 0); \
            PG8_WAIT_V(8); PG8_WAIT_L(0); PG8_BAR; MMA(1, 0, At, B0); MMA(1, 1, At, B1); PG8_BAR; PG8_SCHED; \
              \
            PG8_LDB(B0, 1, 0); PG8_LDB(B1, 1, 1); PG8_SCHED; PG8_LDA(At, 1, 0); PG8_STAGE_A(PG8_SA(0, 1), a2h1, s2, 1); \
            PG8_WAIT_V(8); PG8_WAIT_L(0); PG8_BAR; MMA(0, 0, At, B0); MMA(0, 1, At, B1); PG8_BAR; PG8_SCHED; \
              \
            PG8_LDA(At, 1, 1); PG8_STAGE(PG8_SB(1, 0), b2h0 + kstep, voffB[0], voffB[1]); PG8_STAGE(PG8_SB(1, 1), b2h1 + kstep, voffB[0], voffB[1]); PG8_STAGE_A(PG8_SA(1, 0), a2h0 + kstep, s2, 0); \
            PG8_WAIT_V(8); PG8_WAIT_L(0); PG8_BAR; MMA(1, 0, At, B0); MMA(1, 1, At, B1); PG8_BAR; PG8_SCHED; \
        }
        if (Sched::HAS_THIN && thin) { PG8_KLOOP(PG8_MMA_THIN) } else { PG8_KLOOP(PG8_MMA_FULL) }
#undef PG8_KLOOP
        if (wr == 0) PG8_BAR;
        if constexpr (FP8) asm volatile("s_nop 15\n\ts_nop 15" ::: "memory");
        { int fr_e = fr, fq_e = fq; asm volatile("" : "+v"(fr_e), "+v"(fq_e));
          E(acc, cur, wr, wc, fr_e, fq_e); }
        if (!has_next) break;
#pragma unroll
        for (int a = 0; a < 2; ++a)
#pragma unroll
            for (int b = 0; b < 2; ++b)
#pragma unroll
                for (int m = 0; m < 4; ++m)
#pragma unroll
                    for (int n = 0; n < 2; ++n) acc[a][b][m][n] = (f32x4){0.f, 0.f, 0.f, 0.f};
        cur = nxt; cu = nx; ++ui;
        if (wr == 1) PG8_BAR;
    }
    PG8_WAIT_V(0);
    PG8_BAR;
#undef PG8_SA
#undef PG8_SB
#undef PG8_STAGE
#undef PG8_STAGE_A
#undef PG8_LDA
#undef PG8_LDB
#undef PG8_MMA_THIN
#undef PG8_LD32
#undef PG8_MMA_FULL
#undef PG8_WAIT_V
#undef PG8_WAIT_L
#undef PG8_BAR
#undef PG8_SCHED
}

struct DenseOrder {
    static constexpr bool GATHER = false, HAS_THIN = false, FP8 = false; static constexpr int wscale = 0;
    __device__ __forceinline__ bool thin(const Unit&) const { return false; }
    const bf16* A; const bf16* Bt; int lda, ldb; int nM, nN, nwg, G, c;
    __device__ __forceinline__ const unsigned* rowoff_ptr(const Unit&) const { return nullptr; }
    __device__ __forceinline__ bool next(int i, Unit& u) const {
        const long L = (long)i * G + c; if (L >= nwg) return false;
        int wgid = (int)L; { const int q = nwg / 8, r = nwg % 8, xcd = wgid % 8, off = wgid / 8; wgid = (xcd < r ? xcd * (q + 1) : r * (q + 1) + (xcd - r) * q) + off; }
        const int nig = 8 * nN, gid = wgid / nig, fm = gid * 8, gsz = (nM - fm) < 8 ? (nM - fm) : 8;
        u.pm = fm + ((wgid % nig) % gsz); u.pn = (wgid % nig) / gsz; u.e = 0; u.row0 = (u.pm >> 5) * PP + CHK + 256 * (u.pm & 31); return true;
    }
    __device__ __forceinline__ void addr(const Unit& u, UAddr& g) const {
        g.a0 = (const char*)(A + (size_t)u.row0 * lda); g.a1 = g.a0 + (size_t)128 * lda * 2;
        g.b0 = (const char*)(Bt + (size_t)u.pn * 256 * ldb); g.b1 = g.b0 + (size_t)128 * ldb * 2;
    }
};
struct FfnUpOrder {
    static constexpr bool GATHER = true, HAS_THIN = false, FP8 = true; static constexpr int wscale = WSC_UP;
    __device__ __forceinline__ bool thin(const Unit&) const { return false; }
    const unsigned char* U2; const unsigned* ROWOFF; const unsigned char* WgT; const unsigned char* WuT; int lda, ldb; int nunits, G, c;
    __device__ __forceinline__ bool next(int i, Unit& u) const {
        const int L = i * G + c; if (L >= nunits) return false;
        const int e = L / (22 * 16), rem = L - e * (22 * 16); u.e = e;
        if (rem < 320) { const int blk = rem >> 5, idx = rem & 31, h = blk / 5, pq = blk - 5 * h; u.pn = 4 * pq + (idx >> 3); u.pm = 8 * h + (idx & 7); }
        else { const int r = rem - 320, h = r >> 4, idx = r & 15; u.pn = 20 + (idx >> 3); u.pm = 8 * h + (idx & 7); }
        u.row0 = u.pm * 256; return true;
    }
    __device__ __forceinline__ const unsigned* rowoff_ptr(const Unit& u) const { return ROWOFF + u.e * 4096 + u.pm * 256; }
    __device__ __forceinline__ void addr(const Unit& u, UAddr& g) const {
        g.a0 = (const char*)U2; g.a1 = g.a0;
        g.b0 = (const char*)(WgT + ((size_t)u.e * DFF + (size_t)u.pn * 128) * D); g.b1 = (const char*)(WuT + ((size_t)u.e * DFF + (size_t)u.pn * 128) * D);
    }
};
struct FfnDownOrder {
    static constexpr bool GATHER = false, HAS_THIN = false, FP8 = true; static constexpr int wscale = WSC_DN;
    __device__ __forceinline__ bool thin(const Unit&) const { return false; }
    const unsigned char* HID; const unsigned char* WdT; int lda, ldb; int nunits, G, c;
    __device__ __forceinline__ const unsigned* rowoff_ptr(const Unit&) const { return nullptr; }
    __device__ __forceinline__ bool next(int i, Unit& u) const {
        const int L = i * G + c; if (L >= nunits) return false;
        u.e = L >> 6; const int rem = L & 63; u.pn = rem >> 4; u.pm = rem & 15; u.row0 = u.pm * 256; return true;
    }
    __device__ __forceinline__ void addr(const Unit& u, UAddr& g) const {
        g.a0 = (const char*)(HID + ((size_t)u.e * 4096 + (size_t)u.pm * 256) * DFF); g.a1 = g.a0 + (size_t)128 * DFF;
        g.b0 = (const char*)(WdT + ((size_t)u.e * D + (size_t)u.pn * 256) * DFF); g.b1 = g.b0 + (size_t)128 * DFF;
    }
};

struct EpiStoreBf16 {
    static constexpr bool PERM = true;
    bf16* O; int ldc; size_t estride;
    __device__ __forceinline__ void operator()(const f32x4 (&acc)[2][2][4][2], const Unit& u, int wr, int wc, int fr, int fq) const {
        bf16* base = O + (size_t)u.e * estride + (size_t)(u.pm * 256 + wr * 64 + fr) * ldc + u.pn * 256 + wc * 32 + 8 * fq;
#pragma unroll
        for (int ai = 0; ai < 2; ++ai)
#pragma unroll
            for (int m = 0; m < 4; ++m) { bf16* rowp = base + (size_t)(ai * 128 + m * 16) * ldc;
#pragma unroll
                for (int bj = 0; bj < 2; ++bj) { const f32x4 v0 = acc[ai][bj][m][0], v1 = acc[ai][bj][m][1];
                    u32x4 w; w.x = cvt_pk_bf16(v0[0], v0[1]); w.y = cvt_pk_bf16(v0[2], v0[3]); w.z = cvt_pk_bf16(v1[0], v1[1]); w.w = cvt_pk_bf16(v1[2], v1[3]);
                    *(u32x4*)(rowp + bj * 128) = w; } }
    }
};
struct EpiProj {
    static constexpr bool PERM = true;
    bf16* O; const f32x2* rope;
    __device__ __forceinline__ void operator()(const f32x4 (&acc)[2][2][4][2], const Unit& u, int wr, int wc, int fr, int fq) const {
        const int row0 = u.row0 + wr * 64 + fr;
        if (u.pn >= 4) {
            bf16* base = O + (size_t)row0 * PC + u.pn * 256 + wc * 32 + 8 * fq;
#pragma unroll
            for (int ai = 0; ai < 2; ++ai)
#pragma unroll
                for (int m = 0; m < 4; ++m) { bf16* rowp = base + (size_t)(ai * 128 + m * 16) * PC;
#pragma unroll
                    for (int bj = 0; bj < 2; ++bj) { const f32x4 v0 = acc[ai][bj][m][0], v1 = acc[ai][bj][m][1];
                        u32x4 w; w.x = cvt_pk_bf16(v0[0], v0[1]); w.y = cvt_pk_bf16(v0[2], v0[3]); w.z = cvt_pk_bf16(v1[0], v1[1]); w.w = cvt_pk_bf16(v1[2], v1[3]);
                        *(u32x4*)(rowp + bj * 128) = w; } }
        } else {
            const float sc = (u.pn < 2) ? 0.08838834764831845f : 1.0f; const int d0 = 16 * wc + 4 * fq;
#pragma unroll
            for (int ai = 0; ai < 2; ++ai)
#pragma unroll
                for (int m = 0; m < 4; ++m) { const int row = row0 + ai * 128 + m * 16; const int b = row / PP, p = row - b * PP; const int n = p - PADF;
                    const f32x2* tb = rope + (size_t)n * 64 + d0; const f32x2 t0 = tb[0], t1 = tb[1], t2 = tb[2], t3 = tb[3];
                    bf16* rowp = O + (size_t)row * PC + u.pn * 256 + d0;
#pragma unroll
                    for (int bj = 0; bj < 2; ++bj) { const f32x4 x1 = acc[ai][bj][m][0], x2 = acc[ai][bj][m][1];
                        u32x2 o1, o2;
                        o1.x = cvt_pk_bf16((x1[0] * t0.x - x2[0] * t0.y) * sc, (x1[1] * t1.x - x2[1] * t1.y) * sc); o1.y = cvt_pk_bf16((x1[2] * t2.x - x2[2] * t2.y) * sc, (x1[3] * t3.x - x2[3] * t3.y) * sc);
                        o2.x = cvt_pk_bf16((x2[0] * t0.x + x1[0] * t0.y) * sc, (x2[1] * t1.x + x1[1] * t1.y) * sc); o2.y = cvt_pk_bf16((x2[2] * t2.x + x1[2] * t2.y) * sc, (x2[3] * t3.x + x1[3] * t3.y) * sc);
                        *(u32x2*)(rowp + bj * 128) = o1; *(u32x2*)(rowp + bj * 128 + 64) = o2; } }
        }
    }
};
struct EpiSwiglu {
    static constexpr bool PERM = true;
    unsigned char* HID;
    __device__ __forceinline__ void operator()(const f32x4 (&acc)[2][2][4][2], const Unit& u, int wr, int wc, int fr, int fq) const {
        unsigned char* base = HID + ((size_t)u.e * 4096 + (size_t)(u.pm * 256 + wr * 64 + fr)) * DFF + u.pn * 128 + wc * 32 + 8 * fq;
#pragma unroll
        for (int ai = 0; ai < 2; ++ai)
#pragma unroll
            for (int m = 0; m < 4; ++m) { unsigned char* rowp = base + (size_t)(ai * 128 + m * 16) * DFF;
                float h[8];
#pragma unroll
                for (int n = 0; n < 2; ++n)
#pragma unroll
                    for (int j = 0; j < 4; ++j) { const float g = acc[ai][0][m][n][j], up = acc[ai][1][m][n][j]; h[n * 4 + j] = fminf(fmaxf(siluf_(g) * up, -448.0f), 448.0f); }
                *(u32x2*)rowp = (u32x2){pk4_fp8(h[0], h[1], h[2], h[3]), pk4_fp8(h[4], h[5], h[6], h[7])}; }
    }
};
struct EpiDelta {
    static constexpr bool PERM = true;
    bf16* O; const float* X;
    __device__ __forceinline__ void operator()(const f32x4 (&acc)[2][2][4][2], const Unit& u, int wr, int wc, int fr, int fq) const {
        const int tok0 = (u.pm >> 5) * SEQ + 256 * (u.pm & 31) + wr * 64 + fr;
        const size_t off0 = (size_t)tok0 * D + u.pn * 256 + wc * 32 + 8 * fq;
#pragma unroll
        for (int ai = 0; ai < 2; ++ai) {
            f32x4 xv[4][2][2];
#pragma unroll
            for (int m = 0; m < 4; ++m)
#pragma unroll
                for (int bj = 0; bj < 2; ++bj) { const float* xp = X + off0 + (size_t)(ai * 128 + m * 16) * D + bj * 128; xv[m][bj][0] = *(const f32x4*)xp; xv[m][bj][1] = *(const f32x4*)(xp + 4); }
#pragma unroll
            for (int m = 0; m < 4; ++m) { bf16* rowp = O + off0 + (size_t)(ai * 128 + m * 16) * D;
#pragma unroll
                for (int bj = 0; bj < 2; ++bj) { const f32x4 v0 = acc[ai][bj][m][0] + xv[m][bj][0], v1 = acc[ai][bj][m][1] + xv[m][bj][1];
                    u32x4 w; w.x = cvt_pk_bf16(v0[0], v0[1]); w.y = cvt_pk_bf16(v0[2], v0[3]); w.z = cvt_pk_bf16(v1[0], v1[1]); w.w = cvt_pk_bf16(v1[2], v1[3]);
                    *(u32x4*)(rowp + bj * 128) = w; } }
        }
    }
};
}

struct Ctx {
    LAS unsigned char* lds; int tid, lane, wave, vcu, G;
    const float *x, *meta, *mix_g, *w_in, *b_gates, *conv_w, *conv_b, *ret_logit, *ret_gn, *ml_gn, *w_out, *ffn_g, *w_router, *w_gate, *w_up, *w_down, *fin_g;
    float* out; unsigned char* ws;
};

__device__ __forceinline__ int rope_row(int c) { if (c >= 1024) return c; const int d = c & 127, dd = d & 63; return (c & ~127) | (8 * (dd >> 2) + (d >> 6) * 4 + (dd & 3)); }
template <bool PAIRPERM = false>
__device__ __forceinline__ void transpose_item(const float* W, int K, int N, int ldw, bf16* WT, LAS float* scr, int item, int lane) {
    const int nblk = N / 32, kb = item / nblk, nb = item % nblk, k0 = 64 * kb, n0 = 32 * nb;
#pragma unroll 8
    for (int i = 0; i < 32; ++i) { const int kk = 2 * i + (lane >> 5); scr[kk * 33 + (lane & 31)] = W[(size_t)(k0 + kk) * ldw + n0 + (lane & 31)]; }
    LDS_WAIT(); asm volatile("" ::: "memory");
    const int c = lane & 7;
#pragma unroll
    for (int j = 0; j < 4; ++j) { const int n = (lane >> 3) + 8 * j; const LAS float* s = scr + (8 * c) * 33 + n;
        u32x4 o; o.x = pk2(s[0 * 33], s[1 * 33]); o.y = pk2(s[2 * 33], s[3 * 33]); o.z = pk2(s[4 * 33], s[5 * 33]); o.w = pk2(s[6 * 33], s[7 * 33]);
        *(u32x4*)(WT + (size_t)(PAIRPERM ? rope_row(n0 + n) : (n0 + n)) * K + k0 + 8 * c) = o; }
    LDS_WAIT(); asm volatile("" ::: "memory");
}
constexpr int F8SCR = 0;
__device__ __forceinline__ void transpose_item_f8(const float* W, int K, int N, int ldw, unsigned char* WT, LAS float*  , int item, int lane, float pre) {
    const int nblk = N / 64, kb = item / nblk, nb = item % nblk, k0 = 64 * kb + 16 * (lane >> 4), n0 = 64 * nb + 4 * (lane & 15);
    const float* src = W + (size_t)k0 * ldw + n0;
    f32x4 v[16];
#pragma unroll
    for (int i = 0; i < 16; ++i) v[i] = *(const f32x4*)(src + (size_t)i * ldw) * pre;
#pragma unroll
    for (int j = 0; j < 4; ++j) {
        u32x4 o;
        o.x = pk4_fp8(v[0][j], v[1][j], v[2][j], v[3][j]); o.y = pk4_fp8(v[4][j], v[5][j], v[6][j], v[7][j]); o.z = pk4_fp8(v[8][j], v[9][j], v[10][j], v[11][j]); o.w = pk4_fp8(v[12][j], v[13][j], v[14][j], v[15][j]);
        *(u32x4*)(WT + (size_t)(n0 + j) * K + k0) = o; }
}
__device__ __forceinline__ void f8_item_load(const float* W, int N, int ldw, int item, int lane, f32x4 (&v)[16]) {
    const int nblk = N / 64, kb = item / nblk, nb = item % nblk, k0 = 64 * kb + 16 * (lane >> 4), n0 = 64 * nb + 4 * (lane & 15);
    const float* src = W + (size_t)k0 * ldw + n0;
#pragma unroll
    for (int i = 0; i < 16; ++i) v[i] = *(const f32x4*)(src + (size_t)i * ldw);
}
__device__ __forceinline__ void f8_item_store(unsigned char* WT, int K, int N, int item, int lane, float pre, const f32x4 (&v)[16]) {
    const int nblk = N / 64, kb = item / nblk, nb = item % nblk, k0 = 64 * kb + 16 * (lane >> 4), n0 = 64 * nb + 4 * (lane & 15);
#pragma unroll
    for (int j = 0; j < 4; ++j) {
        u32x4 o;
        o.x = pk4_fp8(v[0][j] * pre, v[1][j] * pre, v[2][j] * pre, v[3][j] * pre); o.y = pk4_fp8(v[4][j] * pre, v[5][j] * pre, v[6][j] * pre, v[7][j] * pre);
        o.z = pk4_fp8(v[8][j] * pre, v[9][j] * pre, v[10][j] * pre, v[11][j] * pre); o.w = pk4_fp8(v[12][j] * pre, v[13][j] * pre, v[14][j] * pre, v[15][j] * pre);
        *(u32x4*)(WT + (size_t)(n0 + j) * K + k0) = o; }
}
constexpr int I_ONE = (D / 64) * (DFF / 64);
constexpr int NIT_GU = 2 * NE * I_ONE;
constexpr int GU_P4 = 16384;
__device__ __forceinline__ void gu_item_load(const float* w_gate, const float* w_up, int it, int lane, f32x4 (&v)[16]) {
    const int mat = it / (NE * I_ONE), rem = it - mat * (NE * I_ONE), e = rem / I_ONE, item = rem - e * I_ONE;
    f8_item_load((mat == 0 ? w_gate : w_up) + (size_t)e * D * DFF, DFF, DFF, item, lane, v);
}
__device__ __forceinline__ void gu_item_store(unsigned char* ws, int it, int lane, const f32x4 (&v)[16]) {
    const int mat = it / (NE * I_ONE), rem = it - mat * (NE * I_ONE), e = rem / I_ONE, item = rem - e * I_ONE;
    f8_item_store(ws + WS_WEXP + (size_t)mat * WEXP_ONE + (size_t)e * DFF * D, D, DFF, item, lane, WPRE_UP, v);
}
__device__ __forceinline__ void row_load(const float* row, int lane, f32x4 (&u)[4]) {
#pragma unroll
    for (int jj = 0; jj < 4; ++jj) u[jj] = *(const f32x4*)(row + jj * 256 + lane * 4);
}
__device__ __forceinline__ void row_load_bf(const bf16* row, int lane, f32x4 (&u)[4]) {
    u32x2 dv[4];
#pragma unroll
    for (int jj = 0; jj < 4; ++jj) dv[jj] = *(const u32x2*)(row + jj * 256 + lane * 4);
#pragma unroll
    for (int jj = 0; jj < 4; ++jj) u[jj] = (f32x4){bflo(dv[jj].x), bfhi(dv[jj].x), bflo(dv[jj].y), bfhi(dv[jj].y)};
}
__device__ __forceinline__ void rms_apply(const float* g, int lane, f32x4 (&u)[4]) {
    float s = 0.f;
#pragma unroll
    for (int jj = 0; jj < 4; ++jj) s += u[jj].x * u[jj].x + u[jj].y * u[jj].y + u[jj].z * u[jj].z + u[jj].w * u[jj].w;
    const float rstd = rsqrtf(wave_sum(s) * (1.0f / D) + EPS);
#pragma unroll
    for (int jj = 0; jj < 4; ++jj) { const f32x4 gv = *(const f32x4*)(g + jj * 256 + lane * 4); u[jj] = u[jj] * rstd * gv; }
}
__device__ __forceinline__ void store_row_bf16(bf16* dst, int lane, const f32x4 (&u)[4]) {
#pragma unroll
    for (int jj = 0; jj < 4; ++jj) { u32x2 w; w.x = pk2(u[jj].x, u[jj].y); w.y = pk2(u[jj].z, u[jj].w); *(u32x2*)(dst + jj * 256 + lane * 4) = w; }
}
#define MFMA16(a, b, c) __builtin_amdgcn_mfma_f32_16x16x32_bf16(a, b, c, 0, 0, 0)
constexpr int RB_PITCH = 1032, RB_UH = 0, RB_UL = 16 * RB_PITCH * 2, RB_RED = 2 * RB_UL;
struct RowDots { bf16x8 bh[4], bl[4]; };
__device__ __forceinline__ void rowdots_init(RowDots& W, const float* wsrc, int ld, int w, int lane) {
    const int fr = lane & 15, fq = lane >> 4;
#pragma unroll
    for (int s_ = 0; s_ < 4; ++s_) { float v[8];
#pragma unroll
        for (int j = 0; j < 8; ++j) v[j] = wsrc[(size_t)(128 * w + 32 * s_ + 8 * fq + j) * ld + fr];
        unsigned hp[4], lp[4];
#pragma unroll
        for (int j = 0; j < 4; ++j) { hp[j] = pk2(v[2 * j], v[2 * j + 1]); lp[j] = pk2(v[2 * j] - bflo(hp[j]), v[2 * j + 1] - bfhi(hp[j])); }
        W.bh[s_] = __builtin_bit_cast(bf16x8, (u32x4){hp[0], hp[1], hp[2], hp[3]}); W.bl[s_] = __builtin_bit_cast(bf16x8, (u32x4){lp[0], lp[1], lp[2], lp[3]}); }
}
__device__ __forceinline__ void rowdots_put(LAS unsigned char* lds, int rs, int lane, const f32x4 (&u)[4]) {
#pragma unroll
    for (int jj = 0; jj < 4; ++jj) { const unsigned h0 = pk2(u[jj].x, u[jj].y), h1 = pk2(u[jj].z, u[jj].w);
        const unsigned l0 = pk2(u[jj].x - bflo(h0), u[jj].y - bfhi(h0)), l1 = pk2(u[jj].z - bflo(h1), u[jj].w - bfhi(h1));
        *(LAS u32x2*)(lds + RB_UH + (rs * RB_PITCH + jj * 256 + lane * 4) * 2) = (u32x2){h0, h1}; *(LAS u32x2*)(lds + RB_UL + (rs * RB_PITCH + jj * 256 + lane * 4) * 2) = (u32x2){l0, l1}; }
}
__device__ __forceinline__ void rowdots_mma(LAS unsigned char* lds, const RowDots& W, int w, int lane) {
    const int fr = lane & 15, fq = lane >> 4; f32x4 acc = (f32x4){0.f, 0.f, 0.f, 0.f};
#pragma unroll
    for (int s_ = 0; s_ < 4; ++s_) { const int off = (fr * RB_PITCH + 128 * w + 32 * s_ + 8 * fq) * 2;
        const bf16x8 ah = *(const LAS bf16x8*)(lds + RB_UH + off), al = *(const LAS bf16x8*)(lds + RB_UL + off);
        acc = MFMA16(ah, W.bh[s_], acc); acc = MFMA16(ah, W.bl[s_], acc); acc = MFMA16(al, W.bh[s_], acc); }
    *(LAS f32x4*)(lds + RB_RED + (w * 256 + lane * 4) * 4) = acc;
}
__device__ __forceinline__ float rowdots_get(const LAS unsigned char* lds, int row, int g) {
    const LAS float* red = (const LAS float*)(lds + RB_RED) + ((row >> 2) * 16 + g) * 4 + (row & 3); float s_ = 0.f;
#pragma unroll
    for (int w = 0; w < 8; ++w) s_ += red[w * 256];
    return s_;
}
__device__ __forceinline__ void phase_prep(Ctx& F) {
    bf16* WINT = (bf16*)(F.ws + WS_WINT); bf16* WOUTT = (bf16*)(F.ws + WS_WOUTT);
    LAS float* scr = (LAS float*)(F.lds + F.wave * 16384);
    const int gw = F.vcu * 8 + F.wave, NGW = F.G * 8;
    constexpr int I_IN = (D / 64) * (PC / 32), I_OUT = (D / 64) * (D / 32);
    for (int it = gw; it < I_IN + I_OUT; it += NGW) {
        if (it < I_IN) transpose_item<true>(F.w_in, D, PC, PCOLS, WINT, scr, it, F.lane);
        else transpose_item(F.w_out, D, D, D, WOUTT, scr, it - I_IN, F.lane);
    }
    f32x2* rope = (f32x2*)(F.ws + WS_ROPE);
    for (int idx = (F.vcu * 512 + F.tid); idx < NTOK * 64; idx += F.G * 512) {
        const int n = idx >> 6, i = idx & 63;
        const float inv = (float)exp(-(double)i * (9.210340371976184 / 64.0));
        const float angf = (float)n * inv;
        const double xd = (double)angf; const double kq = rint(xd * 0.6366197723675814);
        double r = fma(-kq, 1.5707963267948966, xd); r = fma(-kq, 6.123233995736766e-17, r);
        const double r2 = r * r;
        double sn = -1.0 / 1307674368000.0; sn = fma(sn, r2, 1.0 / 6227020800.0); sn = fma(sn, r2, -1.0 / 39916800.0); sn = fma(sn, r2, 1.0 / 362880.0); sn = fma(sn, r2, -1.0 / 5040.0); sn = fma(sn, r2, 1.0 / 120.0); sn = fma(sn, r2, -1.0 / 6.0); sn = fma(sn * r2, r, r);
        double cs = 1.0 / 20922789888000.0; cs = fma(cs, r2, -1.0 / 87178291200.0); cs = fma(cs, r2, 1.0 / 479001600.0); cs = fma(cs, r2, -1.0 / 3628800.0); cs = fma(cs, r2, 1.0 / 40320.0); cs = fma(cs, r2, -1.0 / 720.0); cs = fma(cs, r2, 1.0 / 24.0); cs = fma(cs, r2, -0.5); cs = fma(cs, r2, 1.0);
        const int q = ((int)kq) & 3;
        const double c = (q == 0) ? cs : (q == 1) ? -sn : (q == 2) ? -cs : sn;
        const double s = (q == 0) ? sn : (q == 1) ? cs : (q == 2) ? -sn : -cs;
        rope[idx] = (f32x2){(float)c, (float)s};
    }
    __syncthreads();
    bf16* U1 = (bf16*)(F.ws + WS_ACT1); float* GATES = (float*)(F.ws + WS_GATES);
    RowDots W; rowdots_init(W, F.w_in + PC, PCOLS, F.wave, F.lane);
    for (int bi = F.vcu; bi < R / 16; bi += F.G) {
        const int r0 = bi * 16;
        int rr[2]; bool ok[2]; f32x4 u[2][4];
#pragma unroll
        for (int t = 0; t < 2; ++t) { rr[t] = r0 + 2 * F.wave + t; const int b = rr[t] / PP, p = rr[t] - b * PP; ok[t] = p >= PADF;
            if (ok[t]) row_load((p < CHK) ? F.meta + (size_t)(p - PADF) * D : F.x + ((size_t)b * SEQ + (p - CHK)) * D, F.lane, u[t]);
            else {
#pragma unroll
                for (int jj = 0; jj < 4; ++jj) u[t][jj] = (f32x4){0.f, 0.f, 0.f, 0.f}; } }
#pragma unroll
        for (int t = 0; t < 2; ++t) {
            if (!ok[t]) {
                bf16* prow = (bf16*)(F.ws + WS_PROJ) + (size_t)rr[t] * PC;
#pragma unroll
                for (int jj = 0; jj < 8; ++jj) *(u32x4*)(prow + jj * 512 + F.lane * 8) = (u32x4){0u, 0u, 0u, 0u};
            } else { rms_apply(F.mix_g, F.lane, u[t]); store_row_bf16(U1 + (size_t)rr[t] * D, F.lane, u[t]); }
            rowdots_put(F.lds, 2 * F.wave + t, F.lane, u[t]);
        }
        __syncthreads();
        rowdots_mma(F.lds, W, F.wave, F.lane);
        __syncthreads();
        if (F.tid < 256) { const int row = F.tid >> 4, g = F.tid & 15, r = r0 + row; const int b = r / PP, p = r - b * PP;
            float gv = rowdots_get(F.lds, row, g) + F.b_gates[g]; if (g >= 8) gv = logsigmoidf_(gv);
            GATES[(size_t)r * 16 + g] = (p >= PADF) ? gv : ((g < 8) ? NEGF : 0.0f); }
    }
}

__device__ __forceinline__ void phase_rope_conv(Ctx& F) {
    const bf16* PROJ = (const bf16*)(F.ws + WS_PROJ); bf16* QKC = (bf16*)(F.ws + WS_ACT1);
    const int gw = F.vcu * 8 + F.wave, NGW = F.G * 8, lane = F.lane;
    const float qs = 0.08838834764831845f;
    float wv[2][5][8], bv[2][8];
#pragma unroll
    for (int jj = 0; jj < 2; ++jj) { const int ch0 = jj * 512 + lane * 8;
        { const f32x4 b0 = *(const f32x4*)(F.conv_b + ch0), b1 = *(const f32x4*)(F.conv_b + ch0 + 4); bv[jj][0] = b0.x; bv[jj][1] = b0.y; bv[jj][2] = b0.z; bv[jj][3] = b0.w; bv[jj][4] = b1.x; bv[jj][5] = b1.y; bv[jj][6] = b1.z; bv[jj][7] = b1.w; }
#pragma unroll
        for (int j = 0; j < 5; ++j) { const f32x4 w0 = *(const f32x4*)(F.conv_w + j * 1024 + ch0), w1 = *(const f32x4*)(F.conv_w + j * 1024 + ch0 + 4);
            wv[jj][j][0] = w0.x; wv[jj][j][1] = w0.y; wv[jj][j][2] = w0.z; wv[jj][j][3] = w0.w; wv[jj][j][4] = w1.x; wv[jj][j][5] = w1.y; wv[jj][j][6] = w1.z; wv[jj][j][7] = w1.w; } }
    for (int r = gw; r < R; r += NGW) {
        const int b = r / PP, p = r - b * PP;
        bf16* qrow = QKC + (size_t)r * D;
        if (p < PADF) {
#pragma unroll
            for (int jj = 0; jj < 2; ++jj) *(u32x4*)(qrow + jj * 512 + lane * 8) = (u32x4){0u, 0u, 0u, 0u};
            continue;
        }
        u32x4 xv[2][5];
#pragma unroll
        for (int jj = 0; jj < 2; ++jj)
#pragma unroll
            for (int j = 0; j < 5; ++j) { const int pj = p + j - 2; xv[jj][j] = (pj >= PADF && pj < PP) ? *(const u32x4*)(PROJ + (size_t)(r + j - 2) * PC + 2048 + jj * 512 + lane * 8) : (u32x4){0u, 0u, 0u, 0u}; }
#pragma unroll
        for (int jj = 0; jj < 2; ++jj) {
            float acc[8];
#pragma unroll
            for (int i = 0; i < 8; ++i) acc[i] = bv[jj][i];
#pragma unroll
            for (int j = 0; j < 5; ++j) { const u32x4 v = xv[jj][j];
                acc[0] += bflo(v.x) * wv[jj][j][0]; acc[1] += bfhi(v.x) * wv[jj][j][1]; acc[2] += bflo(v.y) * wv[jj][j][2]; acc[3] += bfhi(v.y) * wv[jj][j][3];
                acc[4] += bflo(v.z) * wv[jj][j][4]; acc[5] += bfhi(v.z) * wv[jj][j][5]; acc[6] += bflo(v.w) * wv[jj][j][6]; acc[7] += bfhi(v.w) * wv[jj][j][7]; }
            const float sc = (jj == 0) ? qs : 1.0f;
#pragma unroll
            for (int i = 0; i < 8; ++i) acc[i] = siluf_(acc[i]) * sc;
            *(u32x4*)(qrow + jj * 512 + lane * 8) = (u32x4){pk2(acc[0], acc[1]), pk2(acc[2], acc[3]), pk2(acc[4], acc[5]), pk2(acc[6], acc[7])};
        }
    }
}

__device__ __forceinline__ void zero_acc(f32x4 (&acc)[2][4]) {
#pragma unroll
    for (int mt = 0; mt < 2; ++mt)
#pragma unroll
        for (int nt = 0; nt < 4; ++nt) acc[mt][nt] = (f32x4){0.f, 0.f, 0.f, 0.f};
}
template <bool MAXOP, bool REV>
__device__ __forceinline__ void scan128(const LAS float* x, LAS float* out, int lane) {
    static_assert(!REV, "suffix scans are not used any more");
    const int i0 = 2 * lane, i1 = 2 * lane + 1;
    const float a0 = x[i0], a1r = x[i1]; const float a1 = MAXOP ? fmaxf(a0, a1r) : a0 + a1r;
    const float s = wave_scan_incl<MAXOP>(a1);
    const int idn = __builtin_bit_cast(int, MAXOP ? -3.0e38f : 0.0f);
    const float ex = __builtin_bit_cast(float, __builtin_amdgcn_update_dpp(idn, __builtin_bit_cast(int, s), 0x138, 0xF, 0xF, false));
    out[i0] = MAXOP ? fmaxf(ex, a0) : ex + a0; out[i1] = s;
}

typedef short s16x4 __attribute__((ext_vector_type(4)));
constexpr int NSEG = 4;
__device__ __forceinline__ int seg_begin(int s) { return s == 0 ? 0 : 1 + 16 * s; }
constexpr size_t SUMM_STRIDE = (size_t)(144 * 128 + 64);
constexpr size_t WS_SUMM = WS_STATE;
constexpr size_t WS_OUTD = WS_STATE + 16 * MiB;
static_assert(WS_OUTD + (size_t)2 * R * D * 2 <= WS_END && 64 * 3 * SUMM_STRIDE * 4 <= 16 * MiB, "mixer scratch map");
constexpr int VQ = VEC_OFF;
constexpr int V_LI = VQ, V_LF = VQ + 512, V_BC = VQ + 1024, V_GG = VQ + 1536, V_PM = VQ + 2048, V_E1 = VQ + 2560, V_WI = VQ + 3072, V_FL = VQ + 3584, V_WU = VQ + 4096,
              V_NV = VQ + 4608  , V_SC = VQ + 4864  ;

template <int KS, int NT> __device__ __forceinline__ void ld_rows(const LAS bf16* T, int rowbase, int fq, bf16x8 (&f)[NT]) {
#pragma unroll
    for (int t = 0; t < NT; ++t) f[t] = *(const LAS bf16x8*)(T + (rowbase + 16 * t) * TP + KS * 32 + 8 * fq);
}
template <int KS> __device__ __forceinline__ void tr_frag4(unsigned addr, bf16x8 (&f)[4]) {
    s16x4 r0, r1, r2, r3, r4, r5, r6, r7;
    asm volatile("ds_read_b64_tr_b16 %0, %8 offset:%9\n\tds_read_b64_tr_b16 %1, %8 offset:%10\n\tds_read_b64_tr_b16 %2, %8 offset:%11\n\tds_read_b64_tr_b16 %3, %8 offset:%12\n\t"
                 "ds_read_b64_tr_b16 %4, %8 offset:%13\n\tds_read_b64_tr_b16 %5, %8 offset:%14\n\tds_read_b64_tr_b16 %6, %8 offset:%15\n\tds_read_b64_tr_b16 %7, %8 offset:%16\n\ts_waitcnt lgkmcnt(0)"
                 : "=&v"(r0), "=&v"(r1), "=&v"(r2), "=&v"(r3), "=&v"(r4), "=&v"(r5), "=&v"(r6), "=&v"(r7)
                 : "v"(addr), "i"(KS * 8704), "i"(KS * 8704 + 1088), "i"(KS * 8704 + 32), "i"(KS * 8704 + 32 + 1088), "i"(KS * 8704 + 64), "i"(KS * 8704 + 64 + 1088), "i"(KS * 8704 + 96), "i"(KS * 8704 + 96 + 1088)
                 : "memory");
    f[0] = __builtin_shufflevector(r0, r1, 0, 1, 2, 3, 4, 5, 6, 7); f[1] = __builtin_shufflevector(r2, r3, 0, 1, 2, 3, 4, 5, 6, 7);
    f[2] = __builtin_shufflevector(r4, r5, 0, 1, 2, 3, 4, 5, 6, 7); f[3] = __builtin_shufflevector(r6, r7, 0, 1, 2, 3, 4, 5, 6, 7);
}
template <int KS> __device__ __forceinline__ void tr_frag2(unsigned addr, bf16x8 (&f)[2]) {
    s16x4 r0, r1, r2, r3;
    asm volatile("ds_read_b64_tr_b16 %0, %4 offset:%5\n\tds_read_b64_tr_b16 %1, %4 offset:%6\n\tds_read_b64_tr_b16 %2, %4 offset:%7\n\tds_read_b64_tr_b16 %3, %4 offset:%8\n\ts_waitcnt lgkmcnt(0)"
                 : "=&v"(r0), "=&v"(r1), "=&v"(r2), "=&v"(r3)
                 : "v"(addr), "i"(KS * 8704), "i"(KS * 8704 + 1088), "i"(KS * 8704 + 32), "i"(KS * 8704 + 32 + 1088)
                 : "memory");
    f[0] = __builtin_shufflevector(r0, r1, 0, 1, 2, 3, 4, 5, 6, 7); f[1] = __builtin_shufflevector(r2, r3, 0, 1, 2, 3, 4, 5, 6, 7);
}
__device__ __forceinline__ unsigned tr_lane_addr(const LAS bf16* T, int colbase, int lane) {
    const int g = lane >> 4, q = (lane & 15) >> 2, p = lane & 3;
    return (unsigned)(__UINTPTR_TYPE__)(T + (8 * g + q) * TP + colbase + 4 * p);
}

struct SeqUnit { int b, h, grp, dir, seg, combo; };
__device__ __forceinline__ SeqUnit seq_unit(int u) { SeqUnit q; q.seg = u & 3; q.combo = u >> 2; q.dir = q.combo & 1; q.grp = (q.combo >> 1) & 1; q.h = (q.combo >> 2) & 3; q.b = q.combo >> 4; return q; }
__device__ __forceinline__ int seq_chunk(const SeqUnit& q, int ci) { return q.dir ? NCH - 1 - ci : ci; }
__device__ __forceinline__ void tile_fetch(int tid, const bf16* src, size_t stride, int rev, u32x4 (&v)[4]) {
#pragma unroll
    for (int i = 0; i < 4; ++i) { const int q = tid + 512 * i, row = q >> 4, ch = q & 15, rs = rev ? 127 - row : row; v[i] = *(const u32x4*)(src + (size_t)rs * stride + ch * 8); }
}
__device__ __forceinline__ void tile_put(int tid, LAS bf16* T, const u32x4 (&v)[4]) {
#pragma unroll
    for (int i = 0; i < 4; ++i) { const int q = tid + 512 * i, row = q >> 4, ch = q & 15; *(LAS u32x4*)(T + row * TP + ch * 8) = v[i]; }
}
__device__ __forceinline__ void chunk_scans(LAS unsigned char* lds, int lane, bool nostab) {
    LAS float* LI = (LAS float*)(lds + V_LI); LAS float* LF = (LAS float*)(lds + V_LF); LAS float* BC = (LAS float*)(lds + V_BC); LAS float* GG = (LAS float*)(lds + V_GG); LAS float* PM = (LAS float*)(lds + V_PM);
    LAS float* E1 = (LAS float*)(lds + V_E1); LAS float* WI = (LAS float*)(lds + V_WI); LAS float* FL = (LAS float*)(lds + V_FL); LAS float* WU = (LAS float*)(lds + V_WU); LAS float* SC = (LAS float*)(lds + V_SC);
    scan128<false, false>(LF, BC, lane); LDS_WAIT();
    const int l0 = 2 * lane, l1 = 2 * lane + 1;
    const float bc0 = BC[l0], bc1 = BC[l1], li0 = LI[l0], li1 = LI[l1];
    GG[l0] = li0 - bc0; GG[l1] = li1 - bc1; LDS_WAIT();
    scan128<true, false>(GG, PM, lane); LDS_WAIT();
    const float blast = BC[127], m = SC[0];
    const float lu0 = blast - bc0 + li0, lu1 = blast - bc1 + li1;
    const float a = nostab ? 0.0f : wave_max(fmaxf(lu0, lu1));
    const float mnew = nostab ? 0.0f : fmaxf(blast + m, a);
    const float f = __expf(blast + m - mnew), g = __expf(a - mnew);
    const float mr0 = nostab ? 0.0f : fmaxf(bc0 + m, bc0 + PM[l0]), mr1 = nostab ? 0.0f : fmaxf(bc1 + m, bc1 + PM[l1]);
    E1[l0] = bc0 - mr0; E1[l1] = bc1 - mr1; WI[l0] = __expf(bc0 + m - mr0); WI[l1] = __expf(bc1 + m - mr1);
    FL[l0] = __expf(-mr0); FL[l1] = __expf(-mr1); WU[l0] = g * __expf(lu0 - a); WU[l1] = g * __expf(lu1 - a);
    if (lane == 0) { SC[1] = f; SC[2] = mnew; SC[3] += blast; }
}
__device__ __forceinline__ void scale_k(int tid, LAS bf16* TK, const LAS float* WU) {
#pragma unroll
    for (int i = 0; i < 4; ++i) { const int q = tid + 512 * i, row = q >> 4, ch = q & 15; LAS u32x4* p = (LAS u32x4*)(TK + row * TP + ch * 8); const u32x4 v = *p; const float wv = WU[row];
        *p = (u32x4){cvtpk(bflo(v.x) * wv, bfhi(v.x) * wv), cvtpk(bflo(v.y) * wv, bfhi(v.y) * wv), cvtpk(bflo(v.z) * wv, bfhi(v.z) * wv), cvtpk(bflo(v.w) * wv, bfhi(v.w) * wv)}; }
}
__device__ __forceinline__ void state_update(const LAS bf16* TV, const LAS bf16* TK, int w, int lane, float f, f32x4 (&C)[2][4], float (&nrow)[4]) {
    const int m0 = 32 * (w >> 1), n0 = 64 * (w & 1), fr = lane & 15;
#pragma unroll
    for (int mt = 0; mt < 2; ++mt)
#pragma unroll
        for (int nt = 0; nt < 4; ++nt) C[mt][nt] *= f;
    f32x4 nacc[4];
#pragma unroll
    for (int nt = 0; nt < 4; ++nt) nacc[nt] = (f32x4){nrow[nt] * f, 0.f, 0.f, 0.f};
    const unsigned aa = tr_lane_addr(TV, m0, lane), ab = tr_lane_addr(TK, n0, lane);
    bf16x8 ones; { const short o = (fr == 0) ? (short)0x3F80 : (short)0;
#pragma unroll
        for (int j = 0; j < 8; ++j) ones[j] = o; }
#define SU_STEP(KS) { bf16x8 a[2], b[4]; tr_frag2<KS>(aa, a); tr_frag4<KS>(ab, b); \
        _Pragma("unroll") for (int mt = 0; mt < 2; ++mt) _Pragma("unroll") for (int nt = 0; nt < 4; ++nt) C[mt][nt] = MFMA16(a[mt], b[nt], C[mt][nt]); \
        if (w < 2) { _Pragma("unroll") for (int nt = 0; nt < 4; ++nt) nacc[nt] = MFMA16(ones, b[nt], nacc[nt]); } }
    SU_STEP(0) SU_STEP(1) SU_STEP(2) SU_STEP(3)
#undef SU_STEP
#pragma unroll
    for (int nt = 0; nt < 4; ++nt) nrow[nt] = nacc[nt][0];
}
__device__ __forceinline__ const bf16* seq_src(const Ctx& F, const SeqUnit& q, int which  , size_t& stride) {
    const bf16* PROJ = (const bf16*)(F.ws + WS_PROJ); const bf16* QKC = (const bf16*)(F.ws + WS_ACT1);
    if (q.grp == 0) { stride = PC; return PROJ + which * 512 + q.h * 128; }
    if (which == 2) { stride = PC; return PROJ + 3072 + q.h * 128; }
    stride = D; return QKC + which * 512 + q.h * 128;
}
__device__ __forceinline__ void gates_fetch(const Ctx& F, const SeqUnit& q, int c, int tid, float lgam, float& li, float& lf) {
    if (q.grp == 0) { li = 0.0f; lf = lgam; return; }
    const float* GATES = (const float*)(F.ws + WS_GATES); const int row = q.dir ? 127 - tid : tid;
    const float* gp = GATES + ((size_t)q.b * PP + (size_t)c * CHK + row) * 16; li = gp[q.dir * 4 + q.h]; lf = gp[8 + q.dir * 4 + q.h];
}

constexpr int I_WD = (DFF / 64) * (D / 64);
constexpr int WD_SPLIT = 2800;
__device__ __forceinline__ void convert_wd(Ctx& F, int lo, int hi, int iw, int nw) {
    unsigned char* WdT = F.ws + WS_WD8; LAS float* scr = (LAS float*)(F.lds + F.wave * F8SCR);
    for (int it = lo + iw; it < hi; it += nw) { const int e = it / I_WD, item = it - e * I_WD;
        transpose_item_f8(F.w_down + (size_t)e * DFF * D, DFF, D, D, WdT + (size_t)e * D * DFF, scr, item, F.lane, WPRE_DN); }
}
__device__ __forceinline__ void phase_seg_summary(Ctx& F) {
    LAS bf16* TK = (LAS bf16*)(F.lds + T1_OFF); LAS bf16* TV = (LAS bf16*)(F.lds + T2_OFF);
    LAS float* SC = (LAS float*)(F.lds + V_SC); LAS float* LI = (LAS float*)(F.lds + V_LI); LAS float* LF = (LAS float*)(F.lds + V_LF); const LAS float* WU = (const LAS float*)(F.lds + V_WU);
    float* SUMM = (float*)(F.ws + WS_SUMM);
    const int w = F.wave;
    for (int u = F.vcu; u < 64 * NSEG; u += F.G) {
        const SeqUnit q = seq_unit(u);
        if (q.seg == NSEG - 1) { convert_wd(F, 0, WD_SPLIT, q.combo * 8 + F.wave, 64 * 8); continue; }
        int tid = F.tid; asm volatile("" : "+v"(tid));
        const int lane = tid & 63, fr = lane & 15, fq = lane >> 4;
        const bool nostab = (q.grp == 0);
        const float lgam = nostab ? logsigmoidf_(F.ret_logit[q.dir * NH + q.h]) : 0.0f;
        size_t sk, sv; const bf16* pk = seq_src(F, q, 1, sk); const bf16* pv = seq_src(F, q, 2, sv);
        f32x4 C[2][4]; float nrow[4] = {0.f, 0.f, 0.f, 0.f}; zero_acc(C);
        __syncthreads();
        if (tid == 0) { SC[0] = 0.f; SC[3] = 0.f; }
        const int ci0 = seg_begin(q.seg), ci1 = seg_begin(q.seg + 1);
        u32x4 rk[4], rv[4]; float gli = 0.f, glf = 0.f;
        {   const int c = seq_chunk(q, ci0); const size_t r0 = (size_t)q.b * PP + (size_t)c * CHK;
            tile_fetch(tid, pk + r0 * sk, sk, q.dir, rk); tile_fetch(tid, pv + r0 * sv, sv, q.dir, rv); if (tid < 128) gates_fetch(F, q, c, tid, lgam, gli, glf); }
#pragma unroll 1
        for (int ci = ci0; ci < ci1; ++ci) {
            tile_put(tid, TK, rk); tile_put(tid, TV, rv); if (tid < 128) { LI[tid] = gli; LF[tid] = glf; }
            __syncthreads();
            if (ci + 1 < ci1) { const int c = seq_chunk(q, ci + 1); const size_t r0 = (size_t)q.b * PP + (size_t)c * CHK;
                tile_fetch(tid, pk + r0 * sk, sk, q.dir, rk); tile_fetch(tid, pv + r0 * sv, sv, q.dir, rv); if (tid < 128) gates_fetch(F, q, c, tid, lgam, gli, glf); }
            if (w == 0) chunk_scans(F.lds, lane, nostab);
            __syncthreads();
            scale_k(tid, TK, WU);
            __syncthreads();
            const float f = SC[1];
            state_update(TV, TK, w, lane, f, C, nrow);
            __syncthreads();
            if (tid == 0) SC[0] = SC[2];
        }
        __syncthreads();
        float* dst = SUMM + ((size_t)q.combo * 3 + q.seg) * SUMM_STRIDE;
        const int m0 = 32 * (w >> 1), n0 = 64 * (w & 1);
#pragma unroll
        for (int mt = 0; mt < 2; ++mt)
#pragma unroll
            for (int nt = 0; nt < 4; ++nt)
#pragma unroll
                for (int rg = 0; rg < 4; ++rg) dst[(m0 + 16 * mt + 4 * fq + rg) * 128 + n0 + 16 * nt + fr] = C[mt][nt][rg];
        if (w < 2 && fq == 0) {
#pragma unroll
            for (int nt = 0; nt < 4; ++nt) dst[128 * 128 + n0 + 16 * nt + fr] = nrow[nt]; }
        if (tid == 0) { dst[144 * 128] = SC[0]; dst[144 * 128 + 1] = SC[3]; }
    }
}

__device__ __forceinline__ void phase_seq(Ctx& F) {
    LAS bf16* TQ = (LAS bf16*)(F.lds + T0_OFF); LAS bf16* TK = (LAS bf16*)(F.lds + T1_OFF); LAS bf16* TV = (LAS bf16*)(F.lds + T2_OFF); LAS bf16* TC = (LAS bf16*)(F.lds + T3_OFF);
    LAS float* SC = (LAS float*)(F.lds + V_SC); LAS float* LI = (LAS float*)(F.lds + V_LI); LAS float* LF = (LAS float*)(F.lds + V_LF);
    const LAS float* WU = (const LAS float*)(F.lds + V_WU); const LAS float* E1 = (const LAS float*)(F.lds + V_E1); const LAS float* GG = (const LAS float*)(F.lds + V_GG);
    const LAS float* WI = (const LAS float*)(F.lds + V_WI); const LAS float* FL = (const LAS float*)(F.lds + V_FL); LAS bf16* NV = (LAS bf16*)(F.lds + V_NV);
    const float* SUMM = (const float*)(F.ws + WS_SUMM); bf16* OUTD = (bf16*)(F.ws + WS_OUTD);
    const int w = F.wave, m0 = 32 * (w >> 1), n0 = 64 * (w & 1);
    int git = F.vcu * 8 + F.wave; const int gstride = F.G * 8; f32x4 bgv[16]; bool bg_pending = false;
    for (int u = F.vcu; u < 64 * NSEG; u += F.G) {
        const SeqUnit q = seq_unit(u);
        int tid_u = F.tid; asm volatile("" : "+v"(tid_u));
        const int tid = tid_u, lane = tid & 63, fr = lane & 15, fq = lane >> 4;
        const bool nostab = (q.grp == 0);
        const float lgam = nostab ? logsigmoidf_(F.ret_logit[q.dir * NH + q.h]) : 0.0f;
        size_t sq, sk, sv; const bf16* pq = seq_src(F, q, 0, sq); const bf16* pk = seq_src(F, q, 1, sk); const bf16* pv = seq_src(F, q, 2, sv);
        f32x4 C[2][4]; float nrow[4] = {0.f, 0.f, 0.f, 0.f}; zero_acc(C);
        float mst = 0.f;
        for (int s = 0; s < q.seg; ++s) {
            const float* src = SUMM + ((size_t)q.combo * 3 + s) * SUMM_STRIDE;
            const float ms = src[144 * 128], Bs = src[144 * 128 + 1];
            const float mo_ = nostab ? 0.0f : fmaxf(Bs + mst, ms); const float fa = __expf(Bs + mst - mo_), fb = __expf(ms - mo_); mst = mo_;
#pragma unroll
            for (int mt = 0; mt < 2; ++mt)
#pragma unroll
                for (int nt = 0; nt < 4; ++nt)
#pragma unroll
                    for (int rg = 0; rg < 4; ++rg) C[mt][nt][rg] = fa * C[mt][nt][rg] + fb * src[(m0 + 16 * mt + 4 * fq + rg) * 128 + n0 + 16 * nt + fr];
            if (w < 2 && fq == 0) {
#pragma unroll
                for (int nt = 0; nt < 4; ++nt) nrow[nt] = fa * nrow[nt] + fb * src[128 * 128 + n0 + 16 * nt + fr]; }
        }
        __syncthreads();
        if (tid == 0) { SC[0] = mst; SC[3] = 0.f; }
        const int ci0 = seg_begin(q.seg), ci1 = seg_begin(q.seg + 1);
        u32x4 rq[4], rk[4], rv[4]; float gli = 0.f, glf = 0.f;
        {   const int c = seq_chunk(q, ci0); const size_t r0 = (size_t)q.b * PP + (size_t)c * CHK;
            tile_fetch(tid, pq + r0 * sq, sq, q.dir, rq); tile_fetch(tid, pk + r0 * sk, sk, q.dir, rk); tile_fetch(tid, pv + r0 * sv, sv, q.dir, rv); if (tid < 128) gates_fetch(F, q, c, tid, lgam, gli, glf); }
#pragma unroll 1
        for (int ci = ci0; ci < ci1; ++ci) {
            const int c = seq_chunk(q, ci); const size_t r0 = (size_t)q.b * PP + (size_t)c * CHK;
            int tid = tid_u; asm volatile("" : "+v"(tid));
            const int lane = tid & 63, fr = lane & 15, fq = lane >> 4;
            tile_put(tid, TQ, rq); tile_put(tid, TK, rk); tile_put(tid, TV, rv); if (tid < 128) { LI[tid] = gli; LF[tid] = glf; }
#pragma unroll
            for (int mt = 0; mt < 2; ++mt)
#pragma unroll
                for (int nt = 0; nt < 4; ++nt) *(LAS u32x2*)(TC + (n0 + 16 * nt + fr) * TP + m0 + 16 * mt + 4 * fq) = (u32x2){cvtpk(C[mt][nt][0], C[mt][nt][1]), cvtpk(C[mt][nt][2], C[mt][nt][3])};
            if (w < 2 && fq == 0) {
#pragma unroll
                for (int nt = 0; nt < 4; ++nt) NV[n0 + 16 * nt + fr] = (bf16)f2bf(nrow[nt]); }
            if (bg_pending) { gu_item_store(F.ws, git, lane, bgv); git += gstride; bg_pending = false; }
            __syncthreads();
            if (w == 0) chunk_scans(F.lds, lane, nostab);
            f32x4 accN[2][4], accD[4], accS[2][4]; zero_acc(accN); zero_acc(accS);
#pragma unroll
            for (int nt = 0; nt < 4; ++nt) accD[nt] = (f32x4){0.f, 0.f, 0.f, 0.f};
            {   const unsigned ac = tr_lane_addr(TC, m0, lane);
#define SX_STEP(KS) { bf16x8 a[2], bq[4]; ld_rows<KS, 4>(TQ, n0 + fr, fq, bq); tr_frag2<KS>(ac, a); \
                bf16x8 an = *(const LAS bf16x8*)(NV + KS * 32 + 8 * fq); if (fr != 0) { _Pragma("unroll") for (int j = 0; j < 8; ++j) an[j] = 0; } \
                _Pragma("unroll") for (int nt = 0; nt < 4; ++nt) { _Pragma("unroll") for (int mt = 0; mt < 2; ++mt) accN[mt][nt] = MFMA16(a[mt], bq[nt], accN[mt][nt]); accD[nt] = MFMA16(an, bq[nt], accD[nt]); } }
                SX_STEP(0) SX_STEP(1) SX_STEP(2) SX_STEP(3)
#undef SX_STEP
            }
#define SS_STEP(KS) { bf16x8 a[2], bq[4]; ld_rows<KS, 2>(TK, m0 + fr, fq, a); ld_rows<KS, 4>(TQ, n0 + fr, fq, bq); \
                _Pragma("unroll") for (int mt = 0; mt < 2; ++mt) { _Pragma("unroll") for (int nt = 0; nt < 4; ++nt) accS[mt][nt] = MFMA16(a[mt], bq[nt], accS[mt][nt]); } }
            SS_STEP(0) SS_STEP(1) SS_STEP(2) SS_STEP(3)
#undef SS_STEP
            __syncthreads();
#pragma unroll
            for (int nt = 0; nt < 4; ++nt) { const int l = n0 + 16 * nt + fr; const float wi = WI[l], e1 = E1[l]; accD[nt][0] *= wi;
#pragma unroll
                for (int mt = 0; mt < 2; ++mt) { accN[mt][nt] *= wi; const int mb = m0 + 16 * mt + 4 * fq; float pv_[4];
#pragma unroll
                    for (int rg = 0; rg < 4; ++rg) pv_[rg] = (mb + rg <= l) ? accS[mt][nt][rg] * __expf(e1 + GG[mb + rg]) : 0.0f;
                    *(LAS u32x2*)(TC + l * TP + mb) = (u32x2){cvtpk(pv_[0], pv_[1]), cvtpk(pv_[2], pv_[3])}; } }
            scale_k(tid, TK, WU);
            if (ci + 1 < ci1) { const int cn = seq_chunk(q, ci + 1); const size_t rn = (size_t)q.b * PP + (size_t)cn * CHK;
                tile_fetch(tid, pq + rn * sq, sq, q.dir, rq); tile_fetch(tid, pk + rn * sk, sk, q.dir, rk); tile_fetch(tid, pv + rn * sv, sv, q.dir, rv); if (tid < 128) gates_fetch(F, q, cn, tid, lgam, gli, glf); }
            __syncthreads();
            {   const unsigned av = tr_lane_addr(TV, m0, lane);
                bf16x8 ones; { const short o = (fr == 0) ? (short)0x3F80 : (short)0;
#pragma unroll
                    for (int j = 0; j < 8; ++j) ones[j] = o; }
#define PV_STEP(KS) { bf16x8 a[2], bp[4]; ld_rows<KS, 4>(TC, n0 + fr, fq, bp); tr_frag2<KS>(av, a); \
                _Pragma("unroll") for (int nt = 0; nt < 4; ++nt) { _Pragma("unroll") for (int mt = 0; mt < 2; ++mt) accN[mt][nt] = MFMA16(a[mt], bp[nt], accN[mt][nt]); accD[nt] = MFMA16(ones, bp[nt], accD[nt]); } }
                PV_STEP(0) PV_STEP(1) PV_STEP(2) PV_STEP(3)
#undef PV_STEP
            }
#pragma unroll
            for (int nt = 0; nt < 4; ++nt) { const int l = n0 + 16 * nt + fr;
                const float den = __shfl(accD[nt][0], fr); const float inv = nostab ? 1.0f : __builtin_amdgcn_rcpf(fmaxf(fabsf(den), FL[l]));
#pragma unroll
                for (int mt = 0; mt < 2; ++mt) { const f32x4 o = accN[mt][nt] * inv; *(LAS u32x2*)(TQ + l * TP + m0 + 16 * mt + 4 * fq) = (u32x2){cvtpk(o[0], o[1]), cvtpk(o[2], o[3])}; } }
            state_update(TV, TK, w, lane, SC[1], C, nrow);
            __syncthreads();
            if (git < GU_P4) { gu_item_load(F.w_gate, F.w_up, git, lane, bgv); bg_pending = true; }
            else {
#pragma unroll
                for (int i = 0; i < 16; ++i) bgv[i] = (f32x4){0.f, 0.f, 0.f, 0.f}; }
            {   bf16* dst = OUTD + ((size_t)q.dir * R + r0) * D + q.grp * 512 + q.h * 128;
#pragma unroll
                for (int i = 0; i < 4; ++i) { const int qq = tid + 512 * i, row = qq >> 4, ch = qq & 15, rs = q.dir ? 127 - row : row; *(u32x4*)(dst + (size_t)rs * D + ch * 8) = *(const LAS u32x4*)(TQ + row * TP + ch * 8); } }
            if (tid == 0) SC[0] = SC[2];
            __syncthreads();
        }
    }
    if (bg_pending) { gu_item_store(F.ws, git, F.lane, bgv); git += gstride; }
    for (; git < GU_P4; git += gstride) { gu_item_load(F.w_gate, F.w_up, git, F.lane, bgv); gu_item_store(F.ws, git, F.lane, bgv); }
}

__device__ __forceinline__ void phase_combine(Ctx& F) {
    const bf16* PROJ = (const bf16*)(F.ws + WS_PROJ); const bf16* OUTD = (const bf16*)(F.ws + WS_OUTD); bf16* Y = (bf16*)(F.ws + WS_ACT2);
    const int gw = F.vcu * 8 + F.wave, NGW = F.G * 8, lane = F.lane;
    const int col = lane * 16, grp = col >> 9;
    const size_t goff = (grp == 0 ? 1536 + col : 3584 + (col - 512));
    u32x4 na[2], nc[2], ng[2];
    { const int p0 = gw - (gw / PP) * PP; if (gw < R && p0 >= PADF) {
#pragma unroll
        for (int hh = 0; hh < 2; ++hh) { na[hh] = *(const u32x4*)(OUTD + (size_t)gw * D + col + hh * 8); nc[hh] = *(const u32x4*)(OUTD + ((size_t)R + gw) * D + col + hh * 8); ng[hh] = *(const u32x4*)(PROJ + (size_t)gw * PC + goff + hh * 8); } } }
    for (int r = gw; r < R; r += NGW) {
        const int b = r / PP, p = r - b * PP; bf16* yrow = Y + (size_t)r * D + lane * 16;
        u32x4 ca[2], cc[2], cg[2];
#pragma unroll
        for (int hh = 0; hh < 2; ++hh) { ca[hh] = na[hh]; cc[hh] = nc[hh]; cg[hh] = ng[hh]; }
        { const int r2 = r + NGW; const int p2 = r2 - (r2 / PP) * PP; if (r2 < R && p2 >= PADF) {
#pragma unroll
            for (int hh = 0; hh < 2; ++hh) { na[hh] = *(const u32x4*)(OUTD + (size_t)r2 * D + col + hh * 8); nc[hh] = *(const u32x4*)(OUTD + ((size_t)R + r2) * D + col + hh * 8); ng[hh] = *(const u32x4*)(PROJ + (size_t)r2 * PC + goff + hh * 8); } } }
        if (p < PADF) { *(u32x4*)yrow = (u32x4){0u, 0u, 0u, 0u}; *(u32x4*)(yrow + 8) = (u32x4){0u, 0u, 0u, 0u}; continue; }
        float v[16], gt[16];
#pragma unroll
        for (int hh = 0; hh < 2; ++hh) { const u32x4 a = ca[hh], c = cc[hh], g = cg[hh];
            const unsigned aw[4] = {a.x, a.y, a.z, a.w}, cw[4] = {c.x, c.y, c.z, c.w}, gw_[4] = {g.x, g.y, g.z, g.w};
#pragma unroll
            for (int j = 0; j < 4; ++j) { v[hh * 8 + 2 * j] = bflo(aw[j]) + bflo(cw[j]); v[hh * 8 + 2 * j + 1] = bfhi(aw[j]) + bfhi(cw[j]); gt[hh * 8 + 2 * j] = bflo(gw_[j]); gt[hh * 8 + 2 * j + 1] = bfhi(gw_[j]); } }
        if (grp == 1) {
#pragma unroll
            for (int j = 0; j < 16; ++j) v[j] *= sigmoidf_(gt[j]); }
        float s = 0.f;
#pragma unroll
        for (int j = 0; j < 16; ++j) s += v[j];
        s += __shfl_xor(s, 1); s += __shfl_xor(s, 2); s += __shfl_xor(s, 4);
        const float mu = s * (1.0f / 128.0f); float qv = 0.f;
#pragma unroll
        for (int j = 0; j < 16; ++j) { v[j] -= mu; qv += v[j] * v[j]; }
        qv += __shfl_xor(qv, 1); qv += __shfl_xor(qv, 2); qv += __shfl_xor(qv, 4);
        const float rstd = rsqrtf(qv * (1.0f / 128.0f) + EPS);
        const float* gnp = (grp == 0 ? F.ret_gn + col : F.ml_gn + (col - 512)); float gn[16];
#pragma unroll
        for (int j4 = 0; j4 < 4; ++j4) { const f32x4 g4 = *(const f32x4*)(gnp + 4 * j4); gn[4 * j4] = g4.x; gn[4 * j4 + 1] = g4.y; gn[4 * j4 + 2] = g4.z; gn[4 * j4 + 3] = g4.w; }
        unsigned o[8];
#pragma unroll
        for (int j = 0; j < 8; ++j) { float y0 = v[2 * j] * rstd * gn[2 * j], y1 = v[2 * j + 1] * rstd * gn[2 * j + 1];
            if (grp == 0) { y0 *= siluf_(gt[2 * j]); y1 *= siluf_(gt[2 * j + 1]); }
            o[j] = pk2(y0, y1); }
        *(u32x4*)yrow = (u32x4){o[0], o[1], o[2], o[3]}; *(u32x4*)(yrow + 8) = (u32x4){o[4], o[5], o[6], o[7]};
    }
}

constexpr int SK_RED = 34816;
__device__ __forceinline__ f32x4 skinny16_ksplit(LAS unsigned char* lds, const bf16* btrow, int w, int lane) {
    const LAS bf16* A = (const LAS bf16*)lds; LAS float* RED = (LAS float*)(lds + SK_RED);
    const int fr = lane & 15, fq = lane >> 4;
    f32x4 acc = (f32x4){0.f, 0.f, 0.f, 0.f};
    bf16x8 bb[4];
#pragma unroll
    for (int j = 0; j < 4; ++j) bb[j] = *(const bf16x8*)(btrow + (4 * w + j) * 32 + 8 * fq);
#pragma unroll
    for (int j = 0; j < 4; ++j) { const bf16x8 a = *(const LAS bf16x8*)(A + fr * 1032 + (4 * w + j) * 32 + 8 * fq); acc = MFMA16(a, bb[j], acc); }
    *(LAS f32x4*)(RED + w * 256 + lane * 4) = acc;
    __syncthreads();
    if (w == 0) { acc = (f32x4){0.f, 0.f, 0.f, 0.f};
#pragma unroll
        for (int ww = 0; ww < 8; ++ww) acc += *(const LAS f32x4*)(RED + ww * 256 + lane * 4); }
    return acc;
}
__device__ __forceinline__ void proj_meta(Ctx& F) {
    const bf16* U1 = (const bf16*)(F.ws + WS_ACT1); const bf16* WINT = (const bf16*)(F.ws + WS_WINT); bf16* PROJ = (bf16*)(F.ws + WS_PROJ); const f32x2* rope = (const f32x2*)(F.ws + WS_ROPE);
    LAS bf16* AT = (LAS bf16*)F.lds;
    for (int it = F.vcu; it < PC / 16; it += F.G) {
        int tid = F.tid; asm volatile("" : "+v"(tid));
        const int lane = tid & 63, fr = lane & 15, fq = lane >> 4;
        __syncthreads();
        for (int i = tid; i < 16 * 128; i += 512) { const int r = i >> 7, ch = i & 127; *(LAS u32x4*)(AT + r * 1032 + ch * 8) = *(const u32x4*)(U1 + (size_t)(PADF + r) * D + ch * 8); }
        __syncthreads();
        const int t = it * 16 + fr;
        const f32x4 acc = skinny16_ksplit(F.lds, WINT + (size_t)t * D, F.wave, lane);
        if (F.wave == 0) {
#pragma unroll
            for (int rg = 0; rg < 4; ++rg) {
                const int n = 4 * fq + rg; float val = acc[rg]; int col = t;
                const float other = __shfl_xor(val, 4);
                if (t < 1024) {
                    const int tc = t & 127, dd = 4 * (tc >> 3) + (tc & 3); const f32x2 cs = rope[n * 64 + dd]; const float sc = (t < 512) ? 0.08838834764831845f : 1.0f;
                    if ((tc & 4) == 0) { val = (val * cs.x - other * cs.y) * sc; col = (t & ~127) + dd; } else { val = (val * cs.x + other * cs.y) * sc; col = (t & ~127) + 64 + dd; }
                }
                const bf16 hv = (bf16)f2bf(val);
#pragma unroll
                for (int b = 0; b < NB; ++b) PROJ[((size_t)b * PP + PADF + n) * PC + col] = hv;
            }
        }
    }
}
__device__ __forceinline__ void out_meta(Ctx& F) {
    const bf16* Y = (const bf16*)(F.ws + WS_ACT2); const bf16* WOUTT = (const bf16*)(F.ws + WS_WOUTT); float* H1M = (float*)(F.ws + WS_H1META);
    LAS bf16* AT = (LAS bf16*)F.lds;
    for (int it = F.vcu; it < NB * (D / 16); it += F.G) {
        int tid = F.tid; asm volatile("" : "+v"(tid));
        const int lane = tid & 63, fr = lane & 15, fq = lane >> 4;
        const int b = it >> 6, cg_ = it & 63;
        __syncthreads();
        for (int i = tid; i < 16 * 128; i += 512) { const int r = i >> 7, ch = i & 127; *(LAS u32x4*)(AT + r * 1032 + ch * 8) = *(const u32x4*)(Y + ((size_t)b * PP + PADF + r) * D + ch * 8); }
        __syncthreads();
        const int col = cg_ * 16 + fr;
        const f32x4 acc = skinny16_ksplit(F.lds, WOUTT + (size_t)col * D, F.wave, lane);
        if (F.wave == 0) {
#pragma unroll
            for (int rg = 0; rg < 4; ++rg) { const int n = 4 * fq + rg; H1M[(size_t)(b * NMETA + n) * D + col] = F.meta[(size_t)n * D + col] + acc[rg]; } }
    }
}

__device__ __forceinline__ void phase_router(Ctx& F) {
    const int gw = F.vcu * 8 + F.wave, NGW = F.G * 8;
    constexpr int NIT = NIT_GU - GU_P4;
    unsigned char* U2 = F.ws + WS_ACT1; float* AFF = (float*)(F.ws + WS_AFF); const float* H1M = (const float*)(F.ws + WS_H1META);
    RowDots W; rowdots_init(W, F.w_router, NE, F.wave, F.lane);
    const int nstep_i = (NIT + NGW - 1) / NGW, nstep_b = (R / 16 + F.G - 1) / F.G, nstep = nstep_i > nstep_b ? nstep_i : nstep_b;
#pragma unroll 1
    for (int st = 0; st < nstep; ++st) {
        const int it = gw + st * NGW, bi = F.vcu + st * F.G;
        const bool has_i = it < NIT, has_b = bi < R / 16;
        f32x4 wv[16];
        if (has_i) gu_item_load(F.w_gate, F.w_up, GU_P4 + it, F.lane, wv);
        if (has_b) {
            const int r0 = bi * 16;
            int rr[2]; bool ok[2]; f32x4 u[2][4];
#pragma unroll
            for (int t = 0; t < 2; ++t) { rr[t] = r0 + 2 * F.wave + t; const int b = rr[t] / PP, p = rr[t] - b * PP; ok[t] = p >= PADF;
                if (ok[t]) { if (p < CHK) row_load(H1M + (size_t)(b * NMETA + p - PADF) * D, F.lane, u[t]); else { const size_t xo = ((size_t)b * SEQ + (p - CHK)) * D; row_load_bf((const bf16*)(F.ws + WS_DELTA) + xo, F.lane, u[t]); } }
                else {
#pragma unroll
                    for (int jj = 0; jj < 4; ++jj) u[t][jj] = (f32x4){0.f, 0.f, 0.f, 0.f}; } }
#pragma unroll
            for (int t = 0; t < 2; ++t) { if (ok[t]) { rms_apply(F.ffn_g, F.lane, u[t]); unsigned char* urow = U2 + (size_t)rr[t] * D;
#pragma unroll
                    for (int jj = 0; jj < 4; ++jj) *(unsigned*)(urow + jj * 256 + F.lane * 4) = pk4_fp8(u[t][jj].x, u[t][jj].y, u[t][jj].z, u[t][jj].w); }
                rowdots_put(F.lds, 2 * F.wave + t, F.lane, u[t]); }
            __syncthreads();
            rowdots_mma(F.lds, W, F.wave, F.lane);
            __syncthreads();
            if (F.tid < 256) { const int row = F.tid >> 4, g = F.tid & 15, r = r0 + row; const int b = r / PP, p = r - b * PP;
                const float lg = rowdots_get(F.lds, row, g);
                float mx = lg; mx = fmaxf(mx, __shfl_xor(mx, 1)); mx = fmaxf(mx, __shfl_xor(mx, 2)); mx = fmaxf(mx, __shfl_xor(mx, 4)); mx = fmaxf(mx, __shfl_xor(mx, 8));
                const float ev = expf(lg - mx); float sm = ev; sm += __shfl_xor(sm, 1); sm += __shfl_xor(sm, 2); sm += __shfl_xor(sm, 4); sm += __shfl_xor(sm, 8);
                if (p >= PADF) AFF[((size_t)b * NE + g) * NTOK + (p - PADF)] = ev / sm; }
        }
        if (has_i) gu_item_store(F.ws, GU_P4 + it, F.lane, wv);
    }
}

__device__ __forceinline__ void phase_topk(Ctx& F) {
    const float* AFF = (const float*)(F.ws + WS_AFF); int* IDX = (int*)(F.ws + WS_IDX); float* GV = (float*)(F.ws + WS_GV); int* SLOT = (int*)(F.ws + WS_SLOT); unsigned* ROWOFF = (unsigned*)(F.ws + WS_SCAL);
    LAS unsigned* keys = (LAS unsigned*)F.lds; LAS unsigned* hist = keys + 8448; LAS unsigned* misc = hist + 256; LAS unsigned* wtot = misc + 16;
    const int tid = F.tid, lane = F.lane, w = F.wave;
    if (F.vcu >= NB * NE) { convert_wd(F, WD_SPLIT, NE * I_WD, (F.vcu - NB * NE) * 8 + F.wave, (F.G - NB * NE) * 8); return; }
    for (int u = F.vcu; u < NB * NE; u += F.G) {
        const int b = u >> 4, e = u & 15; const float* a = AFF + (size_t)u * NTOK;
        __syncthreads();
        for (int i = tid; i < NTOK; i += 512) keys[i] = __builtin_bit_cast(unsigned, a[i]);
        unsigned prefix = 0u, need = CAP;
        for (int pass = 0; pass < 4; ++pass) {
            const int shift = 24 - 8 * pass;
            if (tid < 256) hist[tid] = 0u;
            __syncthreads();
            {
                unsigned cb = 0xffffffffu, cn = 0u;
                for (int i = tid; i < NTOK; i += 512) { const unsigned k = keys[i];
                    if (pass == 0 || (k >> (shift + 8)) == (prefix >> (shift + 8))) { const unsigned bn = (k >> shift) & 255u;
                        if (bn == cb) ++cn; else { if (cn) atomicAdd((unsigned*)&hist[cb], cn); cb = bn; cn = 1u; } } }
                if (cn) atomicAdd((unsigned*)&hist[cb], cn); }
            __syncthreads();
            if (w == 0) {
                const int bb = 255 - 4 * lane; const unsigned c0 = hist[bb], c1 = hist[bb - 1], c2 = hist[bb - 2], c3 = hist[bb - 3]; const unsigned tot = c0 + c1 + c2 + c3;
                const float incl_f = wave_scan_incl<false>((float)tot); const unsigned incl = (unsigned)incl_f, excl = incl - tot;
                const bool here = excl < need && need <= incl;
                if (here) { unsigned cum = excl; int sel = bb;
                    if (cum + c0 >= need) sel = bb; else { cum += c0; if (cum + c1 >= need) sel = bb - 1; else { cum += c1; if (cum + c2 >= need) sel = bb - 2; else { cum += c2; sel = bb - 3; } } }
                    misc[0] = prefix | ((unsigned)sel << shift); misc[1] = need - cum; }
            }
            __syncthreads();
            prefix = misc[0]; need = misc[1];
            __syncthreads();
        }
        const int i0 = tid * 17, i1 = (i0 + 17 < NTOK) ? i0 + 17 : NTOK;
        unsigned cg_ = 0u, ce = 0u;
        for (int i = i0; i < i1; ++i) { const unsigned k = keys[i]; cg_ += (k > prefix) ? 1u : 0u; ce += (k == prefix) ? 1u : 0u; }
        unsigned sg = cg_, se = ce;
#pragma unroll
        for (int o = 1; o < 64; o <<= 1) { const unsigned tg = __shfl_up(sg, o), te = __shfl_up(se, o); if (lane >= o) { sg += tg; se += te; } }
        if (lane == 63) { wtot[w] = sg; wtot[8 + w] = se; }
        __syncthreads();
        unsigned og = 0u, oe = 0u;
        for (int j = 0; j < w; ++j) { og += wtot[j]; oe += wtot[8 + j]; }
        unsigned gb = og + sg - cg_, eb = oe + se - ce;
        for (int i = i0; i < i1; ++i) { const unsigned k = keys[i]; int slot = -1;
            if (k > prefix) { slot = (int)(gb + (eb < need ? eb : need)); ++gb; }
            else if (k == prefix) { if (eb < need) slot = (int)(gb + eb); ++eb; }
            SLOT[((size_t)b * NTOK + i) * NE + e] = slot;
            if (slot >= 0) { IDX[(size_t)u * CAP + slot] = i; GV[(size_t)u * CAP + slot] = __builtin_bit_cast(float, k);
                const int j = b * CAP + slot; if (j < 4096) ROWOFF[e * 4096 + j] = (unsigned)(b * PP + PADF + i) * (unsigned)D; } }
    }
}

constexpr size_t WS_HIDT = WS_UN;
constexpr int XT_PITCH = D + 16, HT_PITCH = DFF + 16;
__device__ __forceinline__ void ffn_thin_up(Ctx& F) {
    const unsigned char* U2 = F.ws + WS_ACT1; const int* IDX = (const int*)(F.ws + WS_IDX);
    const unsigned char* WgT = F.ws + WS_WEXP; const unsigned char* WuT = F.ws + WS_WEXP + WEXP_ONE; unsigned char* HIDT = F.ws + WS_HIDT;
    LAS unsigned char* XT = F.lds;
    const int w = F.wave;
    for (int it = F.vcu; it < NE * 22; it += F.G) {
        int tid = F.tid; asm volatile("" : "+v"(tid));
        const int lane = tid & 63, fr = lane & 15, fq = lane >> 4;
        const int e = it / 22, ft = it % 22;
        __syncthreads();
        if (tid < 8 * 64) { const int r = tid >> 6, ch = tid & 63; const int j = 4096 + r, b = j / CAP, slot = j - b * CAP; const int n = IDX[(b * NE + e) * CAP + slot];
            *(LAS u32x4*)(XT + r * XT_PITCH + ch * 16) = *(const u32x4*)(U2 + ((size_t)b * PP + PADF + n) * D + ch * 16); }
        __syncthreads();
        const int f = ft * 128 + w * 16 + fr;
        const unsigned char* wg = WgT + ((size_t)e * DFF + f) * D + 8 * fq; const unsigned char* wu = WuT + ((size_t)e * DFF + f) * D + 8 * fq;
        f32x4 ag = (f32x4){0.f, 0.f, 0.f, 0.f}, au = ag;
#pragma unroll 1
        for (int k8 = 0; k8 < 32; k8 += 16) {
            long bg[16], bu[16];
#pragma unroll
            for (int j = 0; j < 16; ++j) { bg[j] = *(const long*)(wg + (k8 + j) * 32); bu[j] = *(const long*)(wu + (k8 + j) * 32); }
#pragma unroll
            for (int j = 0; j < 16; ++j) { long a = *(const LAS long*)(XT + (fr & 7) * XT_PITCH + (k8 + j) * 32 + 8 * fq); if (fr >= 8) a = 0;
                ag = __builtin_amdgcn_mfma_f32_16x16x32_fp8_fp8(a, bg[j], ag, 0, 0, 0); au = __builtin_amdgcn_mfma_f32_16x16x32_fp8_fp8(a, bu[j], au, 0, 0, 0); }
        }
        if (fq < 2) {
            float hv[4];
#pragma unroll
            for (int rg = 0; rg < 4; ++rg) hv[rg] = fminf(fmaxf(siluf_(ag[rg] * (1.0f / WPRE_UP)) * (au[rg] * (1.0f / WPRE_UP)), -448.0f), 448.0f);
            const unsigned pk = pk4_fp8(hv[0], hv[1], hv[2], hv[3]);
#pragma unroll
            for (int rg = 0; rg < 4; ++rg) HIDT[((size_t)e * 8 + 4 * fq + rg) * DFF + f] = (unsigned char)(pk >> (8 * rg)); }
    }
}
__device__ __forceinline__ void ffn_thin_down(Ctx& F) {
    const unsigned char* WdT = F.ws + WS_WD8; const unsigned char* HIDT = F.ws + WS_HIDT; bf16* YE = (bf16*)(F.ws + WS_YE);
    LAS unsigned char* HT = F.lds;
    const int w = F.wave;
    for (int it = F.vcu; it < NE * 8; it += F.G) {
        int tid = F.tid; asm volatile("" : "+v"(tid));
        const int lane = tid & 63, fr = lane & 15, fq = lane >> 4;
        const int e = it >> 3, dt = it & 7;
        __syncthreads();
        for (int i = tid; i < 8 * 176; i += 512) { const int r = i / 176, ch = i - r * 176; *(LAS u32x4*)(HT + r * HT_PITCH + ch * 16) = *(const u32x4*)(HIDT + ((size_t)e * 8 + r) * DFF + ch * 16); }
        __syncthreads();
        const int d = dt * 128 + w * 16 + fr;
        const unsigned char* wd = WdT + ((size_t)e * D + d) * DFF + 8 * fq;
        f32x4 ay = (f32x4){0.f, 0.f, 0.f, 0.f};
#pragma unroll 1
        for (int k8 = 0; k8 < 88; k8 += 22) {
            long bd[22];
#pragma unroll
            for (int j = 0; j < 22; ++j) bd[j] = *(const long*)(wd + (k8 + j) * 32);
#pragma unroll
            for (int j = 0; j < 22; ++j) { long a = *(const LAS long*)(HT + (fr & 7) * HT_PITCH + (k8 + j) * 32 + 8 * fq); if (fr >= 8) a = 0;
                ay = __builtin_amdgcn_mfma_f32_16x16x32_fp8_fp8(a, bd[j], ay, 0, 0, 0); }
        }
        if (fq < 2) {
#pragma unroll
            for (int rg = 0; rg < 4; ++rg) YE[((size_t)e * EROWSP + 4096 + 4 * fq + rg) * D + d] = (bf16)f2bf(ay[rg] * (1.0f / WPRE_DN)); }
    }
}

struct FinTok { f32x4 h[4]; int slot; };
struct FinY { u32x2 ya[4], yb[4]; float ga, gb; unsigned rest; };
__device__ __forceinline__ void phase_final(Ctx& F) {
    const int* SLOT = (const int*)(F.ws + WS_SLOT); const float* GV = (const float*)(F.ws + WS_GV); const bf16* YE = (const bf16*)(F.ws + WS_YE);
    const int gw = F.vcu * 8 + F.wave, NGW = F.G * 8, lane = F.lane;
    const bf16* DELTA = (const bf16*)(F.ws + WS_DELTA);
    constexpr int NT = NB * SEQ;
#define FIN_STAGE1(t_, K) do { const int _t = (t_); (K).slot = -1; if (_t < NT) { row_load_bf(DELTA + (size_t)_t * D, lane, (K).h); \
        const int _b = _t / SEQ, _n = _t - _b * SEQ + NMETA; (K).slot = (lane < 16) ? SLOT[((size_t)_b * NTOK + _n) * NE + lane] : -1; } } while (0)
#define FIN_STAGE2(t_, K, Y) do { const int _t = (t_); unsigned _em = (unsigned)(__ballot((K).slot >= 0) & 0xffffull); (Y).ga = 0.0f; (Y).gb = 0.0f; \
        _Pragma("unroll") for (int jj = 0; jj < 4; ++jj) { (Y).ya[jj] = (u32x2){0u, 0u}; (Y).yb[jj] = (u32x2){0u, 0u}; } \
        if (_em) { const int _b = _t / SEQ; const int _ea = __builtin_ctz(_em); _em &= _em - 1u; const bool _two = _em != 0u; const int _eb = _two ? __builtin_ctz(_em) : _ea; if (_two) _em &= _em - 1u; \
            const int _sa = __shfl((K).slot, _ea), _sb = __shfl((K).slot, _eb); \
            (Y).ga = GV[((size_t)_b * NE + _ea) * CAP + _sa]; (Y).gb = _two ? GV[((size_t)_b * NE + _eb) * CAP + _sb] : 0.0f; \
            const bf16* _ya = YE + ((size_t)_ea * EROWSP + (size_t)_b * CAP + _sa) * D; const bf16* _yb = YE + ((size_t)_eb * EROWSP + (size_t)_b * CAP + _sb) * D; \
            _Pragma("unroll") for (int jj = 0; jj < 4; ++jj) { (Y).ya[jj] = *(const u32x2*)(_ya + jj * 256 + lane * 4); (Y).yb[jj] = *(const u32x2*)(_yb + jj * 256 + lane * 4); } } \
        (Y).rest = _em; } while (0)
    FinTok k0, k1, k2; FinY y0, y1;
    FIN_STAGE1(gw, k0); FIN_STAGE1(gw + NGW, k1);
    FIN_STAGE2(gw, k0, y0);
    for (int t = gw; t < NT; t += NGW) {
        FIN_STAGE2(t + NGW, k1, y1);
        FIN_STAGE1(t + 2 * NGW, k2);
        const int b = t / SEQ;
        float* row = F.out + (size_t)t * D;
        f32x4 v[4];
#pragma unroll
        for (int jj = 0; jj < 4; ++jj) {
            v[jj].x = k0.h[jj].x + y0.ga * bflo(y0.ya[jj].x) + y0.gb * bflo(y0.yb[jj].x); v[jj].y = k0.h[jj].y + y0.ga * bfhi(y0.ya[jj].x) + y0.gb * bfhi(y0.yb[jj].x);
            v[jj].z = k0.h[jj].z + y0.ga * bflo(y0.ya[jj].y) + y0.gb * bflo(y0.yb[jj].y); v[jj].w = k0.h[jj].w + y0.ga * bfhi(y0.ya[jj].y) + y0.gb * bfhi(y0.yb[jj].y); }
        const int myslot = k0.slot;
        unsigned em = y0.rest;
        while (em) {
            const int ea = __builtin_ctz(em); em &= em - 1u; const bool two = em != 0u; const int eb = two ? __builtin_ctz(em) : ea; if (two) em &= em - 1u;
            const int sa = __shfl(myslot, ea), sb = __shfl(myslot, eb);
            const float ga = GV[((size_t)b * NE + ea) * CAP + sa], gb = two ? GV[((size_t)b * NE + eb) * CAP + sb] : 0.0f;
            const bf16* ya = YE + ((size_t)ea * EROWSP + (size_t)b * CAP + sa) * D; const bf16* yb = YE + ((size_t)eb * EROWSP + (size_t)b * CAP + sb) * D;
            u32x2 wa[4], wb[4];
#pragma unroll
            for (int jj = 0; jj < 4; ++jj) { wa[jj] = *(const u32x2*)(ya + jj * 256 + lane * 4); wb[jj] = *(const u32x2*)(yb + jj * 256 + lane * 4); }
#pragma unroll
            for (int jj = 0; jj < 4; ++jj) {
                v[jj].x += ga * bflo(wa[jj].x) + gb * bflo(wb[jj].x); v[jj].y += ga * bfhi(wa[jj].x) + gb * bfhi(wb[jj].x);
                v[jj].z += ga * bflo(wa[jj].y) + gb * bflo(wb[jj].y); v[jj].w += ga * bfhi(wa[jj].y) + gb * bfhi(wb[jj].y); }
        }
        float ss = 0.f;
#pragma unroll
        for (int jj = 0; jj < 4; ++jj) ss += v[jj].x * v[jj].x + v[jj].y * v[jj].y + v[jj].z * v[jj].z + v[jj].w * v[jj].w;
        const float rstd = rsqrtf(wave_sum(ss) * (1.0f / D) + EPS);
#pragma unroll
        for (int jj = 0; jj < 4; ++jj) { const f32x4 gv = *(const f32x4*)(F.fin_g + jj * 256 + lane * 4); *(f32x4*)(row + jj * 256 + lane * 4) = v[jj] * rstd * gv; }
        k0 = k1; k1 = k2; y0 = y1;
    }
#undef FIN_STAGE1
#undef FIN_STAGE2
}

constexpr int N_PHASES = 12;
struct Args { const float* in[17]; float* out; unsigned char* ws; };
#define XB_TMO      128
#define XB_XCNT(j)  (256  + 64 * (j))
#define XB_XSUB(j)  (1280 + 64 * (j))
#define XB_XGEN(j)  (2304 + 64 * (j))
#define XB_TOP      3328
#define XB_TOPGEN   3392
#define XCD_BAR_WORDS 3456
#define XB_SPIN_CAP (1u << 22)
__device__ __forceinline__ unsigned xb_ld(unsigned* p)              { return __hip_atomic_load(p, __ATOMIC_RELAXED, __HIP_MEMORY_SCOPE_AGENT); }
__device__ __forceinline__ unsigned xb_add(unsigned* p, unsigned v) { return __hip_atomic_fetch_add(p, v, __ATOMIC_RELAXED, __HIP_MEMORY_SCOPE_AGENT); }
__device__ __forceinline__ unsigned xb_xcc_id() { return (unsigned)__builtin_amdgcn_s_getreg((3 << 11) | 20) & 0xFu; }
#define XB_SPIN(cond, bar) do { unsigned _sp = 0; while (cond) { __builtin_amdgcn_s_sleep(1); \
    if ((++_sp & 255u) == 0u) { if (xb_ld(&(bar)[XB_TMO])) break; if (_sp > XB_SPIN_CAP) { atomicAdd(&(bar)[XB_TMO], 1u); break; } } } } while (0)
struct XcdBarrier { unsigned* bar; unsigned x; volatile LAS unsigned* st; };
__device__ __forceinline__ XcdBarrier xcd_barrier_post(unsigned* bar, volatile LAS unsigned* st) {
    XcdBarrier b; b.bar = bar; b.x = xb_xcc_id(); b.st = st;
    if (threadIdx.x == 0) (void)xb_add(&bar[XB_XCNT(b.x)], 1u);
    return b;
}
__device__ __forceinline__ void xcd_barrier_complete(unsigned* bar, unsigned x, unsigned& nloc, unsigned& nx) {
    const unsigned G = gridDim.x * gridDim.y * gridDim.z;
    unsigned sum, cnt, mine, sp = 0u;
    for (;;) {
        sum = 0u; cnt = 0u; mine = 0u;
#pragma unroll
        for (unsigned j = 0; j < 16; ++j) { const unsigned c = xb_ld(&bar[XB_XCNT(j)]); sum += c; cnt += (c > 0u) ? 1u : 0u; mine = (j == x) ? c : mine; }
        if (sum == G) break;
        __builtin_amdgcn_s_sleep(1);
        if ((++sp & 255u) == 0u) { if (xb_ld(&bar[XB_TMO])) break; if (sp > XB_SPIN_CAP) { atomicAdd(&bar[XB_TMO], 1u); break; } }
    }
    nloc = mine > 0u ? mine : 1u; nx = cnt > 0u ? cnt : 1u;
}
__device__ __forceinline__ void xcd_barrier(const XcdBarrier& b) {
    asm volatile("s_waitcnt vmcnt(0)" ::: "memory");
    __syncthreads();
    if (threadIdx.x == 0) {
        unsigned* bar = b.bar;
        __builtin_amdgcn_s_waitcnt(0);
        unsigned nloc = b.st[0], nx = b.st[1];
        if (nloc == 0u) { xcd_barrier_complete(bar, b.x, nloc, nx); b.st[0] = nloc; b.st[1] = nx; }
        const unsigned old = xb_add(&bar[XB_XSUB(b.x)], 1u);
        const unsigned gen = old / nloc;
        if (old + 1u == (gen + 1u) * nloc) {
            __builtin_amdgcn_fence(__ATOMIC_RELEASE, "agent");
            asm volatile("s_waitcnt vmcnt(0)" ::: "memory");
            const unsigned og = xb_add(&bar[XB_TOP], 1u);
            const unsigned tg = og / nx;
            if (og + 1u == (tg + 1u) * nx) xb_add(&bar[XB_TOPGEN], 1u);
            else XB_SPIN(xb_ld(&bar[XB_TOPGEN]) == tg, bar);
            __builtin_amdgcn_fence(__ATOMIC_ACQUIRE, "agent");
            xb_add(&bar[XB_XGEN(b.x)], 1u);
            asm volatile("s_waitcnt vmcnt(0)" ::: "memory");
        } else {
            XB_SPIN(xb_ld(&bar[XB_XGEN(b.x)]) == gen, bar);
            __builtin_amdgcn_fence(__ATOMIC_ACQUIRE, "agent");
            asm volatile("s_waitcnt vmcnt(0)" ::: "memory");
        }
    }
    __syncthreads();
}
constexpr int MISC_OFF = LDS_BYTES - 16;

typedef const __attribute__((address_space(4))) Args* ArgsP;
__device__ __forceinline__ void make_ctx(Ctx& F, unsigned char* lds_raw) {
    ArgsP A = (ArgsP)__builtin_amdgcn_kernarg_segment_ptr(); asm volatile("" : "+s"(A));
    F.lds = (LAS unsigned char*)lds_raw;
    { int t = threadIdx.x; asm volatile("" : "+v"(t)); F.tid = t; } F.lane = F.tid & 63; F.wave = __builtin_amdgcn_readfirstlane(F.tid >> 6);
    F.G = gridDim.x; { const int bx = blockIdx.x; F.vcu = (F.G % 8 == 0) ? (bx % 8) * (F.G / 8) + bx / 8 : bx; }
    F.x = A->in[0]; F.meta = A->in[1]; F.mix_g = A->in[2]; F.w_in = A->in[3]; F.b_gates = A->in[4]; F.conv_w = A->in[5]; F.conv_b = A->in[6];
    F.ret_logit = A->in[7]; F.ret_gn = A->in[8]; F.ml_gn = A->in[9]; F.w_out = A->in[10]; F.ffn_g = A->in[11]; F.w_router = A->in[12];
    F.w_gate = A->in[13]; F.w_up = A->in[14]; F.w_down = A->in[15]; F.fin_g = A->in[16];
    F.out = A->out; F.ws = A->ws;
}
template <int LO, int HI> __global__ void __launch_bounds__(512, 2) mk_fwd(Args args) {
    extern __shared__ __attribute__((aligned(16))) unsigned char lds_raw[];
#if MK_SPLIT
#define GRID_BAR() do {} while (0)
#elif MK_BARRIER == 0
    cg::grid_group grid = cg::this_grid();
#define GRID_BAR() grid.sync()
#else
    XcdBarrier xbar;
    {   volatile LAS unsigned* st = (volatile LAS unsigned*)((LAS unsigned char*)lds_raw + MISC_OFF);
        if (threadIdx.x < 4) st[threadIdx.x] = 0u;
        __syncthreads();
        ArgsP A0 = (ArgsP)__builtin_amdgcn_kernarg_segment_ptr();
        xbar = xcd_barrier_post((unsigned*)A0->ws, st); }
#define GRID_BAR() xcd_barrier(xbar)
#endif
#define IN(k) (LO <= (k) && (k) < HI)
#define SEAM(k) do { if (IN(k) && IN((k) + 1)) GRID_BAR(); } while (0)
#define CTX() Ctx F; make_ctx(F, lds_raw)

    if (IN(0)) { CTX(); phase_prep(F); } SEAM(0);
    if (IN(1)) {
        CTX();
        pg8::DenseOrder S{(const bf16*)(F.ws + WS_ACT1), (const bf16*)(F.ws + WS_WINT), D, D, NB * SEQ / 256, PC / 256, (NB * SEQ / 256) * (PC / 256), F.G, (int)blockIdx.x};
        pg8::EpiProj E{(bf16*)(F.ws + WS_PROJ), (const f32x2*)(F.ws + WS_ROPE)};
        pg8::gemm_phase(F.lds, D, S, E);
        proj_meta(F);
    } SEAM(1);
    if (IN(2)) { CTX(); phase_rope_conv(F); } SEAM(2);
    if (IN(3)) { CTX(); phase_seg_summary(F); } SEAM(3);
    if (IN(4)) { CTX(); phase_seq(F); } SEAM(4);
    if (IN(5)) { CTX(); phase_combine(F); } SEAM(5);
    if (IN(6)) {
        CTX();
        pg8::DenseOrder S{(const bf16*)(F.ws + WS_ACT2), (const bf16*)(F.ws + WS_WOUTT), D, D, NB * SEQ / 256, D / 256, (NB * SEQ / 256) * (D / 256), F.G, (int)blockIdx.x};
        pg8::EpiDelta E{(bf16*)(F.ws + WS_DELTA), F.x};
        pg8::gemm_phase(F.lds, D, S, E);
        out_meta(F);
    } SEAM(6);
    if (IN(7)) { CTX(); phase_router(F); } SEAM(7);
    if (IN(8)) { CTX(); phase_topk(F); } SEAM(8);
    if (IN(9)) {
        CTX();
        pg8::FfnUpOrder S{F.ws + WS_ACT1, (const unsigned*)(F.ws + WS_SCAL), F.ws + WS_WEXP, F.ws + WS_WEXP + WEXP_ONE, D / 2, D / 2, NE * 22 * 16, F.G, F.vcu};
        pg8::EpiSwiglu E{F.ws + WS_HID};
        pg8::gemm_phase(F.lds, D / 2, S, E);
        ffn_thin_up(F);
    } SEAM(9);
    if (IN(10)) {
        CTX();
        pg8::FfnDownOrder S{F.ws + WS_HID, F.ws + WS_WD8, DFF / 2, DFF / 2, NE * 4 * 16, F.G, F.vcu};
        pg8::EpiStoreBf16 E{(bf16*)(F.ws + WS_YE), D, (size_t)EROWSP * D};
        pg8::gemm_phase(F.lds, DFF / 2, S, E);
        ffn_thin_down(F);
    } SEAM(10);
    if (IN(11)) { CTX(); phase_final(F); }
#undef IN
#undef SEAM
#undef CTX
}

template <int PH> static void launch_split(int grid, hipStream_t stream, const Args& a) {
    if constexpr (PH < N_PHASES) {
        static bool attr = false;
        if (!attr) { (void)hipFuncSetAttribute((const void*)mk_fwd<PH, PH + 1>, hipFuncAttributeMaxDynamicSharedMemorySize, LDS_BYTES); attr = true; }
        hipLaunchKernelGGL((mk_fwd<PH, PH + 1>), dim3(grid), dim3(512), LDS_BYTES, stream, a);
        if ((PROBE_MASK >> PH) & 1) hipLaunchKernelGGL((mk_fwd<PH, PH + 1>), dim3(grid), dim3(512), LDS_BYTES, stream, a);
        launch_split<PH + 1>(grid, stream, a);
    }
}
extern "C" void kernel_launch(void* const* d_in, const int* in_sizes, int n_in, void* d_out, int out_size, void* d_ws, size_t ws_size, hipStream_t stream) {
    static int grid = 0;
    if (grid == 0) {
        if (n_in != 17 || out_size != NB * SEQ * D || ws_size < WS_END) { fprintf(stderr, "kernel_launch: unexpected shapes (n_in %d out %d ws %zu need %zu)\n", n_in, out_size, ws_size, (size_t)WS_END); grid = -1; return; }
        int dev = 0, cus = 0;
        if (hipGetDevice(&dev) != hipSuccess || hipDeviceGetAttribute(&cus, hipDeviceAttributeMultiprocessorCount, dev) != hipSuccess) { grid = -1; return; }
#if !MK_SPLIT
        int per_cu = 0;
        if (hipFuncSetAttribute((const void*)mk_fwd<0, N_PHASES>, hipFuncAttributeMaxDynamicSharedMemorySize, LDS_BYTES) != hipSuccess) { fprintf(stderr, "kernel_launch: hipFuncSetAttribute failed\n"); grid = -1; return; }
        if (hipOccupancyMaxActiveBlocksPerMultiprocessor(&per_cu, (const void*)mk_fwd<0, N_PHASES>, 512, LDS_BYTES) != hipSuccess || per_cu < 1) { fprintf(stderr, "kernel_launch: occupancy query says %d\n", per_cu); }
#endif
        (void)hipGetLastError();
        grid = cus;
    }
    if (grid < 0) return;
    Args a{};
    for (int i = 0; i < 17; ++i) a.in[i] = (const float*)d_in[i];
    a.out = (float*)d_out; a.ws = (unsigned char*)d_ws;
#if MK_SPLIT
    launch_split<0>(grid, stream, a);
#else
#if MK_BARRIER == 0
    void* kargs[] = {&a};
    hipError_t e = hipLaunchCooperativeKernel((const void*)mk_fwd<0, N_PHASES>, dim3(grid), dim3(512), kargs, LDS_BYTES, stream);
    if (e != hipSuccess) fprintf(stderr, "cooperative launch failed: %s (grid %d)\n", hipGetErrorString(e), grid);
#else
    if (hipMemsetAsync(d_ws, 0, 16384, stream) != hipSuccess) { fprintf(stderr, "kernel_launch: memset of barrier words failed\n"); return; }
    hipLaunchKernelGGL((mk_fwd<0, N_PHASES>), dim3(grid), dim3(512), LDS_BYTES, stream, a);
#endif
#endif
}
```

```cpp
#include <hip/hip_runtime.h>
#include <hip/hip_cooperative_groups.h>
#include <cstdio>
#include <cstdint>
namespace cg = cooperative_groups;

#ifndef MK_SPLIT
#define MK_SPLIT 0
#endif
#ifndef PROBE_MASK
#define PROBE_MASK 0
#endif
#ifndef MK_BARRIER
#define MK_BARRIER 1
#endif

#define GAS __attribute__((address_space(1)))
#define LAS __attribute__((address_space(3)))
typedef unsigned short bf16;
typedef short bf16x8 __attribute__((ext_vector_type(8)));
typedef float f32x4 __attribute__((ext_vector_type(4)));
typedef float f32x2 __attribute__((ext_vector_type(2)));
typedef unsigned u32x4 __attribute__((ext_vector_type(4)));
typedef unsigned u32x2 __attribute__((ext_vector_type(2)));
typedef int i32x8 __attribute__((ext_vector_type(8)));
typedef int i32x4 __attribute__((ext_vector_type(4)));

constexpr int NB = 4, SEQ = 8192, D = 1024, NMETA = 16, CHK = 128, PADF = 112;
constexpr int NTOK = NMETA + SEQ;
constexpr int PP = NTOK + PADF;
constexpr int NCH = PP / CHK;
constexpr int R = NB * PP;
constexpr int PCOLS = 4112, PC = 4096;
constexpr int NE = 16, CAP = 1026, DFF = 2816, EROWS = NB * CAP, EROWSP = 4352;
constexpr int NH = 4;
constexpr float EPS = 1e-6f, NEGF = -1e30f;
constexpr int WSC_UP = 0x7A7A7A7A, WSC_DN = 0x79797979;
constexpr float WPRE_UP = 32.0f, WPRE_DN = 64.0f;

constexpr size_t MiB = 1u << 20;
constexpr size_t WS_ROPE = 1 * MiB, WS_GATES = 6 * MiB, WS_AFF = 9 * MiB, WS_IDX = 12 * MiB, WS_GV = 13 * MiB, WS_SLOT = 14 * MiB;
constexpr size_t WS_H1META = 17 * MiB, WS_UN = 18 * MiB, WS_SCAL = 21 * MiB, WS_WINT = 22 * MiB, WS_WOUTT = 30 * MiB;
constexpr size_t WS_ACT1 = 32 * MiB;
constexpr size_t WS_ACT2 = 97 * MiB;
constexpr size_t WS_PROJ = 162 * MiB;
constexpr size_t WS_STATE = 422 * MiB;
constexpr size_t WS_DELTA = 162 * MiB;
constexpr size_t WS_YE = 226 * MiB;
constexpr size_t WS_HID = 365 * MiB;
constexpr size_t WS_WD8 = 568 * MiB;
constexpr size_t WS_WEXP = 612 * MiB;
constexpr size_t WS_END = 700 * MiB;
constexpr size_t WEXP_ONE = (size_t)NE * DFF * D;
constexpr size_t WS_OUTD_END = WS_STATE + 16 * MiB + (size_t)2 * R * D * 2;
static_assert(WS_PROJ + (size_t)R * PC * 2 <= WS_STATE && WS_OUTD_END <= WS_WD8, "mixer map");
static_assert(WS_DELTA + (size_t)NB * SEQ * D * 2 <= WS_YE && WS_YE + (size_t)NE * EROWSP * D * 2 <= WS_HID && WS_HID + (size_t)NE * 4096 * DFF <= WS_WD8 && WS_WD8 + WEXP_ONE <= WS_WEXP && WS_WEXP + 2 * WEXP_ONE <= WS_END, "ffn map");

constexpr int LDS_BYTES = 155648;
constexpr int TP = 136;
constexpr int T0_OFF = 0, T1_OFF = 34816, T2_OFF = 69632, T3_OFF = 104448, VEC_OFF = 139264;

__device__ __forceinline__ unsigned f2bf(float f) { unsigned u = __builtin_bit_cast(unsigned, f); return (u + 0x7fffu + ((u >> 16) & 1u)) >> 16; }
__device__ __forceinline__ unsigned pk2(float lo, float hi) { unsigned r; asm("v_cvt_pk_bf16_f32 %0, %1, %2" : "=v"(r) : "v"(lo), "v"(hi)); return r; }
__device__ __forceinline__ unsigned cvtpk(float lo, float hi) { unsigned r; asm("v_cvt_pk_bf16_f32 %0, %1, %2" : "=v"(r) : "v"(lo), "v"(hi)); return r; }
__device__ __forceinline__ unsigned pk4_fp8(float a, float b, float c, float d) { int p = __builtin_amdgcn_cvt_pk_fp8_f32(a, b, 0, false); p = __builtin_amdgcn_cvt_pk_fp8_f32(c, d, p, true); return (unsigned)p; }
__device__ __forceinline__ float bf2f(unsigned b) { return __builtin_bit_cast(float, b << 16); }
__device__ __forceinline__ float bflo(unsigned w) { return __builtin_bit_cast(float, w << 16); }
__device__ __forceinline__ float bfhi(unsigned w) { return __builtin_bit_cast(float, w & 0xffff0000u); }
template <bool MAXOP>
__device__ __forceinline__ float wave_scan_incl(float v) {
    const int idn = __builtin_bit_cast(int, MAXOP ? -3.0e38f : 0.0f);
#define DPP_STEP(ctrl, rmask) { const float t = __builtin_bit_cast(float, __builtin_amdgcn_update_dpp(idn, __builtin_bit_cast(int, v), ctrl, rmask, 0xF, false)); v = MAXOP ? fmaxf(v, t) : v + t; }
    DPP_STEP(0x111, 0xF) DPP_STEP(0x112, 0xF) DPP_STEP(0x114, 0xF) DPP_STEP(0x118, 0xF) DPP_STEP(0x142, 0xA) DPP_STEP(0x143, 0xC)
#undef DPP_STEP
    return v;
}
__device__ __forceinline__ float wave_sum(float v) { v = wave_scan_incl<false>(v); return __builtin_bit_cast(float, __builtin_amdgcn_readlane(__builtin_bit_cast(int, v), 63)); }
__device__ __forceinline__ float wave_max(float v) { v = wave_scan_incl<true>(v); return __builtin_bit_cast(float, __builtin_amdgcn_readlane(__builtin_bit_cast(int, v), 63)); }
__device__ __forceinline__ float sigmoidf_(float x) { return __builtin_amdgcn_rcpf(1.0f + __expf(-x)); }
__device__ __forceinline__ float siluf_(float x) { return x * __builtin_amdgcn_rcpf(1.0f + __expf(-x)); }
__device__ __forceinline__ float logsigmoidf_(float x) { return fminf(x, 0.0f) - log1pf(__expf(-fabsf(x))); }
#define LDS_WAIT() asm volatile("s_waitcnt lgkmcnt(0)" ::: "memory")

namespace pg8 {
constexpr int BM = 256, BK = 64, HALF = 128, HTB = HALF * BK * 2, STAGE_BYTES = 8 * HTB;
__device__ __forceinline__ int lds_byte(int r, int c) { const int st = (r >> 4) * 2 + (c >> 5), rr = r & 15, cc = c & 31, ob = rr * 64 + cc * 2; return st * 1024 + (ob ^ (((ob >> 9) & 1) << 5)); }
__device__ __forceinline__ void stage_rc(int b, int& Rr, int& C) { const int st = b / 1024, sb = b % 1024, swz = sb ^ (((sb >> 9) & 1) << 5); Rr = (st >> 1) * 16 + swz / 64; C = (st & 1) * 32 + (swz % 64) / 2; }
__device__ __forceinline__ int perm32(int rho) { const int n = rho >> 4, i = rho & 15; return 8 * (i >> 2) + 4 * n + (i & 3); }
__device__ __forceinline__ unsigned cvt_pk_bf16(float lo, float hi) { unsigned r; asm volatile("v_cvt_pk_bf16_f32 %0, %1, %2" : "=v"(r) : "v"(lo), "v"(hi)); return r; }

struct Unit { int pm, pn, e, row0; };
struct UAddr { const char* a0; const char* a1; const char* b0; const char* b1; };

template <class Epi, class Sched>
__device__ __forceinline__ void gemm_phase(LAS unsigned char* lds, const int K, const Sched& S, const Epi& E) {
    int tid_ = threadIdx.x; asm volatile("" : "+v"(tid_));
    const int tid = tid_, wid = __builtin_amdgcn_readfirstlane(tid >> 6), lane = tid & 63, wr = wid >> 2, wc = wid & 3, fr = lane & 15, fq = lane >> 4;
    const int nt = K / BK;
    unsigned voffB[2], voffA0 = 0, voffA1 = 0, colb = 0;
    int sR0, sC0;
    {   int sR1, sC1; stage_rc(tid * 16, sR0, sC0); stage_rc(tid * 16 + 8192, sR1, sC1);
        const int Rb0 = Epi::PERM ? ((sR0 & ~31) + perm32(sR0 & 31)) : sR0, Rb1 = Epi::PERM ? ((sR1 & ~31) + perm32(sR1 & 31)) : sR1;
        voffB[0] = (unsigned)(Rb0 * S.ldb + sC0) * 2u; voffB[1] = (unsigned)(Rb1 * S.ldb + sC1) * 2u;
        if constexpr (!Sched::GATHER) { voffA0 = (unsigned)(sR0 * S.lda + sC0) * 2u; voffA1 = (unsigned)(sR1 * S.lda + sC1) * 2u; } else colb = (unsigned)sC0 * 2u; }
    LAS unsigned* const tab = (LAS unsigned*)(lds + STAGE_BYTES);
    const LAS unsigned* const tabp = tab + sR0;
    const size_t kstep = (size_t)(BK * 2);
    const unsigned ldsw = (unsigned)wid * 1024u;
    constexpr bool FP8 = Sched::FP8;
    const int aoff = FP8 ? lds_byte(wr * 64 + fr, fq * 16) : lds_byte(wr * 64 + fr, fq * 8), boff = FP8 ? lds_byte(wc * 32 + fr, fq * 16) : lds_byte(wc * 32 + fr, fq * 8);
    int wsc_v = S.wscale, one_v = 0x7F7F7F7F; asm volatile("" : "+v"(wsc_v), "+v"(one_v));
#define PG8_SA(b, h) (((b) * 2 + (h)) * HTB)
#define PG8_SB(b, h) ((4 + (b) * 2 + (h)) * HTB)
#define PG8_STAGE(bufoff, gbase, v0, v1) do { \
        __builtin_amdgcn_global_load_lds((const unsigned*)((const char*)(gbase) + (v0)), (LAS unsigned*)(lds + (bufoff) + ldsw), 16, 0, 0); \
        __builtin_amdgcn_global_load_lds((const unsigned*)((const char*)(gbase) + (v1)), (LAS unsigned*)(lds + (bufoff) + ldsw + 8192), 16, 0, 0); } while (0)
#define PG8_STAGE_A(bufoff, gbase, slot, h) do { if constexpr (Sched::GATHER) { const unsigned _r0 = tabp[(slot) * 256 + (h) * 128] + colb, _r1 = tabp[(slot) * 256 + (h) * 128 + 64] + colb; PG8_STAGE(bufoff, gbase, _r0, _r1); } \
        else PG8_STAGE(bufoff, gbase, voffA0, voffA1); } while (0)
#define PG8_LD32(p) __builtin_shufflevector(*(const LAS i32x4*)(p), *(const LAS i32x4*)((p) + 16), 0, 1, 2, 3, 4, 5, 6, 7)
#define PG8_LDA(dst, b, h) do { if constexpr (FP8) { _Pragma("unroll") for (int m = 0; m < 4; ++m) dst##8[m] = PG8_LD32(lds + PG8_SA(b, h) + aoff + m * 2048); } \
        else { _Pragma("unroll") for (int m = 0; m < 4; ++m) _Pragma("unroll") for (int k = 0; k < 2; ++k) dst[m][k] = *(const LAS bf16x8*)(lds + PG8_SA(b, h) + aoff + m * 2048 + k * 1024); } } while (0)
#define PG8_LDB(dst, b, h) do { if constexpr (FP8) { _Pragma("unroll") for (int n = 0; n < 2; ++n) dst##8[n] = PG8_LD32(lds + PG8_SB(b, h) + boff + n * 2048); } \
        else { _Pragma("unroll") for (int n = 0; n < 2; ++n) _Pragma("unroll") for (int k = 0; k < 2; ++k) dst[n][k] = *(const LAS bf16x8*)(lds + PG8_SB(b, h) + boff + n * 2048 + k * 1024); } } while (0)
#define PG8_MMA_FULL(ai, bj, At, Bt) do { __builtin_amdgcn_s_setprio(1); \
        if constexpr (FP8) { _Pragma("unroll") for (int m = 0; m < 4; ++m) _Pragma("unroll") for (int n = 0; n < 2; ++n) \
            asm volatile("v_mfma_scale_f32_16x16x128_f8f6f4 %0, %1, %2, %0, %3, %4 op_sel_hi:[0,0,0]" : "+v"(acc[ai][bj][m][n]) : "v"(Bt##8[n]), "v"(At##8[m]), "v"(wsc_v), "v"(one_v)); } \
        else { _Pragma("unroll") for (int m = 0; m < 4; ++m) _Pragma("unroll") for (int n = 0; n < 2; ++n) _Pragma("unroll") for (int k = 0; k < 2; ++k) \
            acc[ai][bj][m][n] = __builtin_amdgcn_mfma_f32_16x16x32_bf16(Bt[n][k], At[m][k], acc[ai][bj][m][n], 0, 0, 0); } \
        __builtin_amdgcn_s_setprio(0); } while (0)
#define PG8_MMA_THIN(ai, bj, At, Bt) do { if (!FP8 && (ai) == 0 && wr == 0) { _Pragma("unroll") for (int n = 0; n < 2; ++n) _Pragma("unroll") for (int k = 0; k < 2; ++k) \
        acc[0][bj][0][n] = __builtin_amdgcn_mfma_f32_16x16x32_bf16(Bt[n][k], At[0][k], acc[0][bj][0][n], 0, 0, 0); } } while (0)
#define PG8_WAIT_V(n) asm volatile("s_waitcnt vmcnt(" #n ")" ::: "memory")
#define PG8_WAIT_L(n) asm volatile("s_waitcnt lgkmcnt(" #n ")" ::: "memory")
#define PG8_BAR __builtin_amdgcn_s_barrier()
#define PG8_SCHED __builtin_amdgcn_sched_barrier(0)
    Unit cur, nxt; int ui = 0;
    if (!S.next(0, cur)) return;
    f32x4 acc[2][2][4][2];
#pragma unroll
    for (int a = 0; a < 2; ++a)
#pragma unroll
        for (int b = 0; b < 2; ++b)
#pragma unroll
            for (int m = 0; m < 4; ++m)
#pragma unroll
                for (int n = 0; n < 2; ++n) acc[a][b][m][n] = (f32x4){0.f, 0.f, 0.f, 0.f};
    bf16x8 At[4][2], B0[2][2], B1[2][2]; i32x8 At8[4], B08[2], B18[2];
    UAddr cu, nx;
    S.addr(cur, cu);
    if constexpr (Sched::GATHER) {
        if (tid < 256) __builtin_amdgcn_global_load_lds((const unsigned*)(S.rowoff_ptr(cur) + tid), (LAS unsigned*)(tab + wid * 64), 4, 0, 0);
        asm volatile("s_waitcnt vmcnt(0)" ::: "memory"); __syncthreads(); }
    PG8_STAGE(PG8_SB(0, 0), cu.b0, voffB[0], voffB[1]); PG8_STAGE(PG8_SB(0, 1), cu.b1, voffB[0], voffB[1]); PG8_STAGE_A(PG8_SA(0, 0), cu.a0, 0, 0); PG8_STAGE_A(PG8_SA(0, 1), cu.a1, 0, 1);
    if (wr == 1) PG8_BAR;
    PG8_WAIT_V(2); PG8_BAR;
    PG8_STAGE(PG8_SB(1, 0), cu.b0 + kstep, voffB[0], voffB[1]); PG8_STAGE_A(PG8_SA(1, 0), cu.a0 + kstep, 0, 0); PG8_STAGE(PG8_SB(1, 1), cu.b1 + kstep, voffB[0], voffB[1]);
    PG8_WAIT_V(6); PG8_BAR;
    for (;;) {
        const bool has_next = S.next(ui + 1, nxt);
        const bool thin = Sched::HAS_THIN && S.thin(cur);
        const int cs = ui & 1, ns = has_next ? (cs ^ 1) : cs;
        if (has_next) { S.addr(nxt, nx); if constexpr (Sched::GATHER) { if (tid < 256) __builtin_amdgcn_global_load_lds((const unsigned*)(S.rowoff_ptr(nxt) + tid), (LAS unsigned*)(tab + (cs ^ 1) * 256 + wid * 64), 4, 0, 0); } } else nx = cu;
#define PG8_KLOOP(MMA) \
        for (int t = 0; t < nt; t += 2) { \
            const bool last = (t == nt - 2); \
            const char* a1h1 = cu.a1 + (size_t)(t + 1) * kstep; \
            const char* a2h0 = last ? nx.a0 : cu.a0 + (size_t)(t + 2) * kstep; const char* a2h1 = last ? nx.a1 : cu.a1 + (size_t)(t + 2) * kstep; \
            const char* b2h0 = last ? nx.b0 : cu.b0 + (size_t)(t + 2) * kstep; const char* b2h1 = last ? nx.b1 : cu.b1 + (size_t)(t + 2) * kstep; \
            const int s2 = last ? ns : cs; \
              \
            PG8_LDB(B0, 0, 0); PG8_LDB(B1, 0, 1); PG8_SCHED; PG8_LDA(At, 0, 0); PG8_STAGE_A(PG8_SA(1, 1), a1h1, cs, 1); \
            PG8_WAIT_V(8); PG8_WAIT_L(0); PG8_BAR; MMA(0, 0, At, B0); MMA(0, 1, At, B1); PG8_BAR; PG8_SCHED; \
              \
            PG8_LDA(At, 0, 1); PG8_STAGE(PG8_SB(0, 0), b2h0, voffB[0], voffB[1]); PG8_STAGE(PG8_SB(0, 1), b2h1, voffB[0], voffB[1]); PG8_STAGE_A(PG8_SA(0, 0), a2h0, s2, 0); \
            PG8_WAIT_V(8); PG8_WAIT_L(0); PG8_BAR; MMA(1, 0, At, B0); MMA(1, 1, At, B1); PG8_BAR; PG8_SCHED; \
              \
            PG8_LDB(B0, 1, 0); PG8_LDB(B1, 1, 1); PG8_SCHED; PG8_LDA(At, 1, 0); PG8_STAGE_A(PG8_SA(0, 1), a2h1, s2, 1); \
            PG8_WAIT_V(8); PG8_WAIT_L(0); PG8_BAR; MMA(0, 0, At, B0); MMA(0, 1, At, B1); PG8_BAR; PG8_SCHED; \
              \
            PG8_LDA(At, 1, 1); PG8_STAGE(PG8_SB(1, 0), b2h0 + kstep, voffB[0], voffB[1]); PG8_STAGE(PG8_SB(1, 1), b2h1 + kstep, voffB[0], voffB[1]); PG8_STAGE_A(PG8_SA(1, 0), a2h0 + kstep, s2, 0); \
            PG8_WAIT_V(8); PG8_WAIT_L(0); PG8_BAR; MMA(1, 0, At, B0); MMA(1, 1, At, B1); PG8_BAR; PG8_SCHED; \
        }
        if (Sched::HAS_THIN && thin) { PG8_KLOOP(PG8_MMA_THIN) } else { PG8_KLOOP(PG8_MMA_FULL) }
#undef PG8_KLOOP
        if (wr == 0) PG8_BAR;
        if constexpr (FP8) asm volatile("s_nop 15\n\ts_nop 15" ::: "memory");
        { int fr_e = fr, fq_e = fq; asm volatile("" : "+v"(fr_e), "+v"(fq_e));
          E(acc, cur, wr, wc, fr_e, fq_e); }
        if (!has_next) break;
#pragma unroll
        for (int a = 0; a < 2; ++a)
#pragma unroll
            for (int b = 0; b < 2; ++b)
#pragma unroll
                for (int m = 0; m < 4; ++m)
#pragma unroll
                    for (int n = 0; n < 2; ++n) acc[a][b][m][n] = (f32x4){0.f, 0.f, 0.f, 0.f};
        cur = nxt; cu = nx; ++ui;
        if (wr == 1) PG8_BAR;
    }
    PG8_WAIT_V(0);
    PG8_BAR;
#undef PG8_SA
#undef PG8_SB
#undef PG8_STAGE
#undef PG8_STAGE_A
#undef PG8_LDA
#undef PG8_LDB
#undef PG8_MMA_THIN
#undef PG8_LD32
#undef PG8_MMA_FULL
#undef PG8_WAIT_V
#undef PG8_WAIT_L
#undef PG8_BAR
#undef PG8_SCHED
}

struct DenseOrder {
    static constexpr bool GATHER = false, HAS_THIN = false, FP8 = false; static constexpr int wscale = 0;
    __device__ __forceinline__ bool thin(const Unit&) const { return false; }
    const bf16* A; const bf16* Bt; int lda, ldb; int nM, nN, nwg, G, c;
    __device__ __forceinline__ const unsigned* rowoff_ptr(const Unit&) const { return nullptr; }
    __device__ __forceinline__ bool next(int i, Unit& u) const {
        const long L = (long)i * G + c; if (L >= nwg) return false;
        int wgid = (int)L; { const int q = nwg / 8, r = nwg % 8, xcd = wgid % 8, off = wgid / 8; wgid = (xcd < r ? xcd * (q + 1) : r * (q + 1) + (xcd - r) * q) + off; }
        const int nig = 8 * nN, gid = wgid / nig, fm = gid * 8, gsz = (nM - fm) < 8 ? (nM - fm) : 8;
        u.pm = fm + ((wgid % nig) % gsz); u.pn = (wgid % nig) / gsz; u.e = 0; u.row0 = (u.pm >> 5) * PP + CHK + 256 * (u.pm & 31); return true;
    }
    __device__ __forceinline__ void addr(const Unit& u, UAddr& g) const {
        g.a0 = (const char*)(A + (size_t)u.row0 * lda); g.a1 = g.a0 + (size_t)128 * lda * 2;
        g.b0 = (const char*)(Bt + (size_t)u.pn * 256 * ldb); g.b1 = g.b0 + (size_t)128 * ldb * 2;
    }
};
struct FfnUpOrder {
    static constexpr bool GATHER = true, HAS_THIN = false, FP8 = true; static constexpr int wscale = WSC_UP;
    __device__ __forceinline__ bool thin(const Unit&) const { return false; }
    const unsigned char* U2; const unsigned* ROWOFF; const unsigned char* WgT; const unsigned char* WuT; int lda, ldb; int nunits, G, c;
    __device__ __forceinline__ bool next(int i, Unit& u) const {
        const int L = i * G + c; if (L >= nunits) return false;
        const int e = L / (22 * 16), rem = L - e * (22 * 16); u.e = e;
        if (rem < 320) { const int blk = rem >> 5, idx = rem & 31, h = blk / 5, pq = blk - 5 * h; u.pn = 4 * pq + (idx >> 3); u.pm = 8 * h + (idx & 7); }
        else { const int r = rem - 320, h = r >> 4, idx = r & 15; u.pn = 20 + (idx >> 3); u.pm = 8 * h + (idx & 7); }
        u.row0 = u.pm * 256; return true;
    }
    __device__ __forceinline__ const unsigned* rowoff_ptr(const Unit& u) const { return ROWOFF + u.e * 4096 + u.pm * 256; }
    __device__ __forceinline__ void addr(const Unit& u, UAddr& g) const {
        g.a0 = (const char*)U2; g.a1 = g.a0;
        g.b0 = (const char*)(WgT + ((size_t)u.e * DFF + (size_t)u.pn * 128) * D); g.b1 = (const char*)(WuT + ((size_t)u.e * DFF + (size_t)u.pn * 128) * D);
    }
};
struct FfnDownOrder {
    static constexpr bool GATHER = false, HAS_THIN = false, FP8 = true; static constexpr int wscale = WSC_DN;
    __device__ __forceinline__ bool thin(const Unit&) const { return false; }
    const unsigned char* HID; const unsigned char* WdT; int lda, ldb; int nunits, G, c;
    __device__ __forceinline__ const unsigned* rowoff_ptr(const Unit&) const { return nullptr; }
    __device__ __forceinline__ bool next(int i, Unit& u) const {
        const int L = i * G + c; if (L >= nunits) return false;
        u.e = L >> 6; const int rem = L & 63; u.pn = rem >> 4; u.pm = rem & 15; u.row0 = u.pm * 256; return true;
    }
    __device__ __forceinline__ void addr(const Unit& u, UAddr& g) const {
        g.a0 = (const char*)(HID + ((size_t)u.e * 4096 + (size_t)u.pm * 256) * DFF); g.a1 = g.a0 + (size_t)128 * DFF;
        g.b0 = (const char*)(WdT + ((size_t)u.e * D + (size_t)u.pn * 256) * DFF); g.b1 = g.b0 + (size_t)128 * DFF;
    }
};

struct EpiStoreBf16 {
    static constexpr bool PERM = true;
    bf16* O; int ldc; size_t estride;
    __device__ __forceinline__ void operator()(const f32x4 (&acc)[2][2][4][2], const Unit& u, int wr, int wc, int fr, int fq) const {
        bf16* base = O + (size_t)u.e * estride + (size_t)(u.pm * 256 + wr * 64 + fr) * ldc + u.pn * 256 + wc * 32 + 8 * fq;
#pragma unroll
        for (int ai = 0; ai < 2; ++ai)
#pragma unroll
            for (int m = 0; m < 4; ++m) { bf16* rowp = base + (size_t)(ai * 128 + m * 16) * ldc;
#pragma unroll
                for (int bj = 0; bj < 2; ++bj) { const f32x4 v0 = acc[ai][bj][m][0], v1 = acc[ai][bj][m][1];
                    u32x4 w; w.x = cvt_pk_bf16(v0[0], v0[1]); w.y = cvt_pk_bf16(v0[2], v0[3]); w.z = cvt_pk_bf16(v1[0], v1[1]); w.w = cvt_pk_bf16(v1[2], v1[3]);
                    *(u32x4*)(rowp + bj * 128) = w; } }
    }
};
struct EpiProj {
    static constexpr bool PERM = true;
    bf16* O; const f32x2* rope;
    __device__ __forceinline__ void operator()(const f32x4 (&acc)[2][2][4][2], const Unit& u, int wr, int wc, int fr, int fq) const {
        const int row0 = u.row0 + wr * 64 + fr;
        if (u.pn >= 4) {
            bf16* base = O + (size_t)row0 * PC + u.pn * 256 + wc * 32 + 8 * fq;
#pragma unroll
            for (int ai = 0; ai < 2; ++ai)
#pragma unroll
                for (int m = 0; m < 4; ++m) { bf16* rowp = base + (size_t)(ai * 128 + m * 16) * PC;
#pragma unroll
                    for (int bj = 0; bj < 2; ++bj) { const f32x4 v0 = acc[ai][bj][m][0], v1 = acc[ai][bj][m][1];
                        u32x4 w; w.x = cvt_pk_bf16(v0[0], v0[1]); w.y = cvt_pk_bf16(v0[2], v0[3]); w.z = cvt_pk_bf16(v1[0], v1[1]); w.w = cvt_pk_bf16(v1[2], v1[3]);
                        *(u32x4*)(rowp + bj * 128) = w; } }
        } else {
            const float sc = (u.pn < 2) ? 0.08838834764831845f : 1.0f; const int d0 = 16 * wc + 4 * fq;
#pragma unroll
            for (int ai = 0; ai < 2; ++ai)
#pragma unroll
                for (int m = 0; m < 4; ++m) { const int row = row0 + ai * 128 + m * 16; const int b = row / PP, p = row - b * PP; const int n = p - PADF;
                    const f32x2* tb = rope + (size_t)n * 64 + d0; const f32x2 t0 = tb[0], t1 = tb[1], t2 = tb[2], t3 = tb[3];
                    bf16* rowp = O + (size_t)row * PC + u.pn * 256 + d0;
#pragma unroll
                    for (int bj = 0; bj < 2; ++bj) { const f32x4 x1 = acc[ai][bj][m][0], x2 = acc[ai][bj][m][1];
                        u32x2 o1, o2;
                        o1.x = cvt_pk_bf16((x1[0] * t0.x - x2[0] * t0.y) * sc, (x1[1] * t1.x - x2[1] * t1.y) * sc); o1.y = cvt_pk_bf16((x1[2] * t2.x - x2[2] * t2.y) * sc, (x1[3] * t3.x - x2[3] * t3.y) * sc);
                        o2.x = cvt_pk_bf16((x2[0] * t0.x + x1[0] * t0.y) * sc, (x2[1] * t1.x + x1[1] * t1.y) * sc); o2.y = cvt_pk_bf16((x2[2] * t2.x + x1[2] * t2.y) * sc, (x2[3] * t3.x + x1[3] * t3.y) * sc);
                        *(u32x2*)(rowp + bj * 128) = o1; *(u32x2*)(rowp + bj * 128 + 64) = o2; } }
        }
    }
};
struct EpiSwiglu {
    static constexpr bool PERM = true;
    unsigned char* HID;
    __device__ __forceinline__ void operator()(const f32x4 (&acc)[2][2][4][2], const Unit& u, int wr, int wc, int fr, int fq) const {
        unsigned char* base = HID + ((size_t)u.e * 4096 + (size_t)(u.pm * 256 + wr * 64 + fr)) * DFF + u.pn * 128 + wc * 32 + 8 * fq;
#pragma unroll
        for (int ai = 0; ai < 2; ++ai)
#pragma unroll
            for (int m = 0; m < 4; ++m) { unsigned char* rowp = base + (size_t)(ai * 128 + m * 16) * DFF;
                float h[8];
#pragma unroll
                for (int n = 0; n < 2; ++n)
#pragma unroll
                    for (int j = 0; j < 4; ++j) { const float g = acc[ai][0][m][n][j], up = acc[ai][1][m][n][j]; h[n * 4 + j] = fminf(fmaxf(siluf_(g) * up, -448.0f), 448.0f); }
                *(u32x2*)rowp = (u32x2){pk4_fp8(h[0], h[1], h[2], h[3]), pk4_fp8(h[4], h[5], h[6], h[7])}; }
    }
};
struct EpiDelta {
    static constexpr bool PERM = true;
    bf16* O; const float* X;
    __device__ __forceinline__ void operator()(const f32x4 (&acc)[2][2][4][2], const Unit& u, int wr, int wc, int fr, int fq) const {
        const int tok0 = (u.pm >> 5) * SEQ + 256 * (u.pm & 31) + wr * 64 + fr;
        const size_t off0 = (size_t)tok0 * D + u.pn * 256 + wc * 32 + 8 * fq;
#pragma unroll
        for (int ai = 0; ai < 2; ++ai) {
            f32x4 xv[4][2][2];
#pragma unroll
            for (int m = 0; m < 4; ++m)
#pragma unroll
                for (int bj = 0; bj < 2; ++bj) { const float* xp = X + off0 + (size_t)(ai * 128 + m * 16) * D + bj * 128; xv[m][bj][0] = *(const f32x4*)xp; xv[m][bj][1] = *(const f32x4*)(xp + 4); }
#pragma unroll
            for (int m = 0; m < 4; ++m) { bf16* rowp = O + off0 + (size_t)(ai * 128 + m * 16) * D;
#pragma unroll
                for (int bj = 0; bj < 2; ++bj) { const f32x4 v0 = acc[ai][bj][m][0] + xv[m][bj][0], v1 = acc[ai][bj][m][1] + xv[m][bj][1];
                    u32x4 w; w.x = cvt_pk_bf16(v0[0], v0[1]); w.y = cvt_pk_bf16(v0[2], v0[3]); w.z = cvt_pk_bf16(v1[0], v1[1]); w.w = cvt_pk_bf16(v1[2], v1[3]);
                    *(u32x4*)(rowp + bj * 128) = w; } }
        }
    }
};
}

struct Ctx {
    LAS unsigned char* lds; int tid, lane, wave, vcu, G;
    const float *x, *meta, *mix_g, *w_in, *b_gates, *conv_w, *conv_b, *ret_logit, *ret_gn, *ml_gn, *w_out, *ffn_g, *w_router, *w_gate, *w_up, *w_down, *fin_g;
    float* out; unsigned char* ws;
};

__device__ __forceinline__ int rope_row(int c) { if (c >= 1024) return c; const int d = c & 127, dd = d & 63; return (c & ~127) | (8 * (dd >> 2) + (d >> 6) * 4 + (dd & 3)); }
template <bool PAIRPERM = false>
__device__ __forceinline__ void transpose_item(const float* W, int K, int N, int ldw, bf16* WT, LAS float* scr, int item, int lane) {
    const int nblk = N / 32, kb = item / nblk, nb = item % nblk, k0 = 64 * kb, n0 = 32 * nb;
#pragma unroll 8
    for (int i = 0; i < 32; ++i) { const int kk = 2 * i + (lane >> 5); scr[kk * 33 + (lane & 31)] = W[(size_t)(k0 + kk) * ldw + n0 + (lane & 31)]; }
    LDS_WAIT(); asm volatile("" ::: "memory");
    const int c = lane & 7;
#pragma unroll
    for (int j = 0; j < 4; ++j) { const int n = (lane >> 3) + 8 * j; const LAS float* s = scr + (8 * c) * 33 + n;
        u32x4 o; o.x = pk2(s[0 * 33], s[1 * 33]); o.y = pk2(s[2 * 33], s[3 * 33]); o.z = pk2(s[4 * 33], s[5 * 33]); o.w = pk2(s[6 * 33], s[7 * 33]);
        *(u32x4*)(WT + (size_t)(PAIRPERM ? rope_row(n0 + n) : (n0 + n)) * K + k0 + 8 * c) = o; }
    LDS_WAIT(); asm volatile("" ::: "memory");
}
constexpr int F8SCR = 0;
__device__ __forceinline__ void transpose_item_f8(const float* W, int K, int N, int ldw, unsigned char* WT, LAS float*  , int item, int lane, float pre) {
    const int nblk = N / 64, kb = item / nblk, nb = item % nblk, k0 = 64 * kb + 16 * (lane >> 4), n0 = 64 * nb + 4 * (lane & 15);
    const float* src = W + (size_t)k0 * ldw + n0;
    f32x4 v[16];
#pragma unroll
    for (int i = 0; i < 16; ++i) v[i] = *(const f32x4*)(src + (size_t)i * ldw) * pre;
#pragma unroll
    for (int j = 0; j < 4; ++j) {
        u32x4 o;
        o.x = pk4_fp8(v[0][j], v[1][j], v[2][j], v[3][j]); o.y = pk4_fp8(v[4][j], v[5][j], v[6][j], v[7][j]); o.z = pk4_fp8(v[8][j], v[9][j], v[10][j], v[11][j]); o.w = pk4_fp8(v[12][j], v[13][j], v[14][j], v[15][j]);
        *(u32x4*)(WT + (size_t)(n0 + j) * K + k0) = o; }
}
__device__ __forceinline__ void f8_item_load(const float* W, int N, int ldw, int item, int lane, f32x4 (&v)[16]) {
    const int nblk = N / 64, kb = item / nblk, nb = item % nblk, k0 = 64 * kb + 16 * (lane >> 4), n0 = 64 * nb + 4 * (lane & 15);
    const float* src = W + (size_t)k0 * ldw + n0;
#pragma unroll
    for (int i = 0; i < 16; ++i) v[i] = *(const f32x4*)(src + (size_t)i * ldw);
}
__device__ __forceinline__ void f8_item_store(unsigned char* WT, int K, int N, int item, int lane, float pre, const f32x4 (&v)[16]) {
    const int nblk = N / 64, kb = item / nblk, nb = item % nblk, k0 = 64 * kb + 16 * (lane >> 4), n0 = 64 * nb + 4 * (lane & 15);
#pragma unroll
    for (int j = 0; j < 4; ++j) {
        u32x4 o;
        o.x = pk4_fp8(v[0][j] * pre, v[1][j] * pre, v[2][j] * pre, v[3][j] * pre); o.y = pk4_fp8(v[4][j] * pre, v[5][j] * pre, v[6][j] * pre, v[7][j] * pre);
        o.z = pk4_fp8(v[8][j] * pre, v[9][j] * pre, v[10][j] * pre, v[11][j] * pre); o.w = pk4_fp8(v[12][j] * pre, v[13][j] * pre, v[14][j] * pre, v[15][j] * pre);
        *(u32x4*)(WT + (size_t)(n0 + j) * K + k0) = o; }
}
constexpr int I_ONE = (D / 64) * (DFF / 64);
constexpr int NIT_GU = 2 * NE * I_ONE;
constexpr int GU_P4 = NIT_GU;
__device__ __forceinline__ void gu_item_load(const float* w_gate, const float* w_up, int it, int lane, f32x4 (&v)[16]) {
    const int mat = it / (NE * I_ONE), rem = it - mat * (NE * I_ONE), e = rem / I_ONE, item = rem - e * I_ONE;
    f8_item_load((mat == 0 ? w_gate : w_up) + (size_t)e * D * DFF, DFF, DFF, item, lane, v);
}
__device__ __forceinline__ void gu_item_store(unsigned char* ws, int it, int lane, const f32x4 (&v)[16]) {
    const int mat = it / (NE * I_ONE), rem = it - mat * (NE * I_ONE), e = rem / I_ONE, item = rem - e * I_ONE;
    f8_item_store(ws + WS_WEXP + (size_t)mat * WEXP_ONE + (size_t)e * DFF * D, D, DFF, item, lane, WPRE_UP, v);
}
__device__ __forceinline__ void row_load(const float* row, int lane, f32x4 (&u)[4]) {
#pragma unroll
    for (int jj = 0; jj < 4; ++jj) u[jj] = *(const f32x4*)(row + jj * 256 + lane * 4);
}
__device__ __forceinline__ void row_load_bf(const bf16* row, int lane, f32x4 (&u)[4]) {
    u32x2 dv[4];
#pragma unroll
    for (int jj = 0; jj < 4; ++jj) dv[jj] = *(const u32x2*)(row + jj * 256 + lane * 4);
#pragma unroll
    for (int jj = 0; jj < 4; ++jj) u[jj] = (f32x4){bflo(dv[jj].x), bfhi(dv[jj].x), bflo(dv[jj].y), bfhi(dv[jj].y)};
}
__device__ __forceinline__ void rms_apply(const float* g, int lane, f32x4 (&u)[4]) {
    float s = 0.f;
#pragma unroll
    for (int jj = 0; jj < 4; ++jj) s += u[jj].x * u[jj].x + u[jj].y * u[jj].y + u[jj].z * u[jj].z + u[jj].w * u[jj].w;
    const float rstd = rsqrtf(wave_sum(s) * (1.0f / D) + EPS);
#pragma unroll
    for (int jj = 0; jj < 4; ++jj) { const f32x4 gv = *(const f32x4*)(g + jj * 256 + lane * 4); u[jj] = u[jj] * rstd * gv; }
}
__device__ __forceinline__ void store_row_bf16(bf16* dst, int lane, const f32x4 (&u)[4]) {
#pragma unroll
    for (int jj = 0; jj < 4; ++jj) { u32x2 w; w.x = pk2(u[jj].x, u[jj].y); w.y = pk2(u[jj].z, u[jj].w); *(u32x2*)(dst + jj * 256 + lane * 4) = w; }
}
#define MFMA16(a, b, c) __builtin_amdgcn_mfma_f32_16x16x32_bf16(a, b, c, 0, 0, 0)
constexpr int RB_PITCH = 1032, RB_UH = 0, RB_UL = 16 * RB_PITCH * 2, RB_RED = 2 * RB_UL;
struct RowDots { bf16x8 bh[4], bl[4]; };
__device__ __forceinline__ void rowdots_init(RowDots& W, const float* wsrc, int ld, int w, int lane) {
    const int fr = lane & 15, fq = lane >> 4;
#pragma unroll
    for (int s_ = 0; s_ < 4; ++s_) { float v[8];
#pragma unroll
        for (int j = 0; j < 8; ++j) v[j] = wsrc[(size_t)(128 * w + 32 * s_ + 8 * fq + j) * ld + fr];
        unsigned hp[4], lp[4];
#pragma unroll
        for (int j = 0; j < 4; ++j) { hp[j] = pk2(v[2 * j], v[2 * j + 1]); lp[j] = pk2(v[2 * j] - bflo(hp[j]), v[2 * j + 1] - bfhi(hp[j])); }
        W.bh[s_] = __builtin_bit_cast(bf16x8, (u32x4){hp[0], hp[1], hp[2], hp[3]}); W.bl[s_] = __builtin_bit_cast(bf16x8, (u32x4){lp[0], lp[1], lp[2], lp[3]}); }
}
__device__ __forceinline__ void rowdots_put(LAS unsigned char* lds, int rs, int lane, const f32x4 (&u)[4]) {
#pragma unroll
    for (int jj = 0; jj < 4; ++jj) { const unsigned h0 = pk2(u[jj].x, u[jj].y), h1 = pk2(u[jj].z, u[jj].w);
        const unsigned l0 = pk2(u[jj].x - bflo(h0), u[jj].y - bfhi(h0)), l1 = pk2(u[jj].z - bflo(h1), u[jj].w - bfhi(h1));
        *(LAS u32x2*)(lds + RB_UH + (rs * RB_PITCH + jj * 256 + lane * 4) * 2) = (u32x2){h0, h1}; *(LAS u32x2*)(lds + RB_UL + (rs * RB_PITCH + jj * 256 + lane * 4) * 2) = (u32x2){l0, l1}; }
}
__device__ __forceinline__ void rowdots_mma(LAS unsigned char* lds, const RowDots& W, int w, int lane) {
    const int fr = lane & 15, fq = lane >> 4; f32x4 acc = (f32x4){0.f, 0.f, 0.f, 0.f};
#pragma unroll
    for (int s_ = 0; s_ < 4; ++s_) { const int off = (fr * RB_PITCH + 128 * w + 32 * s_ + 8 * fq) * 2;
        const bf16x8 ah = *(const LAS bf16x8*)(lds + RB_UH + off), al = *(const LAS bf16x8*)(lds + RB_UL + off);
        acc = MFMA16(ah, W.bh[s_], acc); acc = MFMA16(ah, W.bl[s_], acc); acc = MFMA16(al, W.bh[s_], acc); }
    *(LAS f32x4*)(lds + RB_RED + (w * 256 + lane * 4) * 4) = acc;
}
__device__ __forceinline__ float rowdots_get(const LAS unsigned char* lds, int row, int g) {
    const LAS float* red = (const LAS float*)(lds + RB_RED) + ((row >> 2) * 16 + g) * 4 + (row & 3); float s_ = 0.f;
#pragma unroll
    for (int w = 0; w < 8; ++w) s_ += red[w * 256];
    return s_;
}
__device__ __forceinline__ void phase_prep(Ctx& F) {
    bf16* WINT = (bf16*)(F.ws + WS_WINT); bf16* WOUTT = (bf16*)(F.ws + WS_WOUTT);
    LAS float* scr = (LAS float*)(F.lds + F.wave * 16384);
    const int gw = F.vcu * 8 + F.wave, NGW = F.G * 8;
    constexpr int I_IN = (D / 64) * (PC / 32), I_OUT = (D / 64) * (D / 32);
    for (int it = gw; it < I_IN + I_OUT; it += NGW) {
        if (it < I_IN) transpose_item<true>(F.w_in, D, PC, PCOLS, WINT, scr, it, F.lane);
        else transpose_item(F.w_out, D, D, D, WOUTT, scr, it - I_IN, F.lane);
    }
    f32x2* rope = (f32x2*)(F.ws + WS_ROPE);
    for (int idx = (F.vcu * 512 + F.tid); idx < NTOK * 64; idx += F.G * 512) {
        const int n = idx >> 6, i = idx & 63;
        const float inv = (float)exp(-(double)i * (9.210340371976184 / 64.0));
        const float angf = (float)n * inv;
        const double xd = (double)angf; const double kq = rint(xd * 0.6366197723675814);
        double r = fma(-kq, 1.5707963267948966, xd); r = fma(-kq, 6.123233995736766e-17, r);
        const double r2 = r * r;
        double sn = -1.0 / 1307674368000.0; sn = fma(sn, r2, 1.0 / 6227020800.0); sn = fma(sn, r2, -1.0 / 39916800.0); sn = fma(sn, r2, 1.0 / 362880.0); sn = fma(sn, r2, -1.0 / 5040.0); sn = fma(sn, r2, 1.0 / 120.0); sn = fma(sn, r2, -1.0 / 6.0); sn = fma(sn * r2, r, r);
        double cs = 1.0 / 20922789888000.0; cs = fma(cs, r2, -1.0 / 87178291200.0); cs = fma(cs, r2, 1.0 / 479001600.0); cs = fma(cs, r2, -1.0 / 3628800.0); cs = fma(cs, r2, 1.0 / 40320.0); cs = fma(cs, r2, -1.0 / 720.0); cs = fma(cs, r2, 1.0 / 24.0); cs = fma(cs, r2, -0.5); cs = fma(cs, r2, 1.0);
        const int q = ((int)kq) & 3;
        const double c = (q == 0) ? cs : (q == 1) ? -sn : (q == 2) ? -cs : sn;
        const double s = (q == 0) ? sn : (q == 1) ? cs : (q == 2) ? -sn : -cs;
        rope[idx] = (f32x2){(float)c, (float)s};
    }
    __syncthreads();
    bf16* U1 = (bf16*)(F.ws + WS_ACT1); float* GATES = (float*)(F.ws + WS_GATES);
    RowDots W; rowdots_init(W, F.w_in + PC, PCOLS, F.wave, F.lane);
    for (int bi = F.vcu; bi < R / 16; bi += F.G) {
        const int r0 = bi * 16;
        int rr[2]; bool ok[2]; f32x4 u[2][4];
#pragma unroll
        for (int t = 0; t < 2; ++t) { rr[t] = r0 + 2 * F.wave + t; const int b = rr[t] / PP, p = rr[t] - b * PP; ok[t] = p >= PADF;
            if (ok[t]) row_load((p < CHK) ? F.meta + (size_t)(p - PADF) * D : F.x + ((size_t)b * SEQ + (p - CHK)) * D, F.lane, u[t]);
            else {
#pragma unroll
                for (int jj = 0; jj < 4; ++jj) u[t][jj] = (f32x4){0.f, 0.f, 0.f, 0.f}; } }
#pragma unroll
        for (int t = 0; t < 2; ++t) {
            if (!ok[t]) {
                bf16* prow = (bf16*)(F.ws + WS_PROJ) + (size_t)rr[t] * PC;
#pragma unroll
                for (int jj = 0; jj < 8; ++jj) *(u32x4*)(prow + jj * 512 + F.lane * 8) = (u32x4){0u, 0u, 0u, 0u};
            } else { rms_apply(F.mix_g, F.lane, u[t]); store_row_bf16(U1 + (size_t)rr[t] * D, F.lane, u[t]); }
            rowdots_put(F.lds, 2 * F.wave + t, F.lane, u[t]);
        }
        __syncthreads();
        rowdots_mma(F.lds, W, F.wave, F.lane);
        __syncthreads();
        if (F.tid < 256) { const int row = F.tid >> 4, g = F.tid & 15, r = r0 + row; const int b = r / PP, p = r - b * PP;
            float gv = rowdots_get(F.lds, row, g) + F.b_gates[g]; if (g >= 8) gv = logsigmoidf_(gv);
            GATES[(size_t)r * 16 + g] = (p >= PADF) ? gv : ((g < 8) ? NEGF : 0.0f); }
    }
}

__device__ __forceinline__ void phase_rope_conv(Ctx& F) {
    const bf16* PROJ = (const bf16*)(F.ws + WS_PROJ); bf16* QKC = (bf16*)(F.ws + WS_ACT1);
    const int gw = F.vcu * 8 + F.wave, NGW = F.G * 8, lane = F.lane;
    const float qs = 0.08838834764831845f;
    float wv[2][5][8], bv[2][8];
#pragma unroll
    for (int jj = 0; jj < 2; ++jj) { const int ch0 = jj * 512 + lane * 8;
        { const f32x4 b0 = *(const f32x4*)(F.conv_b + ch0), b1 = *(const f32x4*)(F.conv_b + ch0 + 4); bv[jj][0] = b0.x; bv[jj][1] = b0.y; bv[jj][2] = b0.z; bv[jj][3] = b0.w; bv[jj][4] = b1.x; bv[jj][5] = b1.y; bv[jj][6] = b1.z; bv[jj][7] = b1.w; }
#pragma unroll
        for (int j = 0; j < 5; ++j) { const f32x4 w0 = *(const f32x4*)(F.conv_w + j * 1024 + ch0), w1 = *(const f32x4*)(F.conv_w + j * 1024 + ch0 + 4);
            wv[jj][j][0] = w0.x; wv[jj][j][1] = w0.y; wv[jj][j][2] = w0.z; wv[jj][j][3] = w0.w; wv[jj][j][4] = w1.x; wv[jj][j][5] = w1.y; wv[jj][j][6] = w1.z; wv[jj][j][7] = w1.w; } }
    for (int r = gw; r < R; r += NGW) {
        const int b = r / PP, p = r - b * PP;
        bf16* qrow = QKC + (size_t)r * D;
        if (p < PADF) {
#pragma unroll
            for (int jj = 0; jj < 2; ++jj) *(u32x4*)(qrow + jj * 512 + lane * 8) = (u32x4){0u, 0u, 0u, 0u};
            continue;
        }
        u32x4 xv[2][5];
#pragma unroll
        for (int jj = 0; jj < 2; ++jj)
#pragma unroll
            for (int j = 0; j < 5; ++j) { const int pj = p + j - 2; xv[jj][j] = (pj >= PADF && pj < PP) ? *(const u32x4*)(PROJ + (size_t)(r + j - 2) * PC + 2048 + jj * 512 + lane * 8) : (u32x4){0u, 0u, 0u, 0u}; }
#pragma unroll
        for (int jj = 0; jj < 2; ++jj) {
            float acc[8];
#pragma unroll
            for (int i = 0; i < 8; ++i) acc[i] = bv[jj][i];
#pragma unroll
            for (int j = 0; j < 5; ++j) { const u32x4 v = xv[jj][j];
                acc[0] += bflo(v.x) * wv[jj][j][0]; acc[1] += bfhi(v.x) * wv[jj][j][1]; acc[2] += bflo(v.y) * wv[jj][j][2]; acc[3] += bfhi(v.y) * wv[jj][j][3];
                acc[4] += bflo(v.z) * wv[jj][j][4]; acc[5] += bfhi(v.z) * wv[jj][j][5]; acc[6] += bflo(v.w) * wv[jj][j][6]; acc[7] += bfhi(v.w) * wv[jj][j][7]; }
            const float sc = (jj == 0) ? qs : 1.0f;
#pragma unroll
            for (int i = 0; i < 8; ++i) acc[i] = siluf_(acc[i]) * sc;
            *(u32x4*)(qrow + jj * 512 + lane * 8) = (u32x4){pk2(acc[0], acc[1]), pk2(acc[2], acc[3]), pk2(acc[4], acc[5]), pk2(acc[6], acc[7])};
        }
    }
}

__device__ __forceinline__ void zero_acc(f32x4 (&acc)[2][4]) {
#pragma unroll
    for (int mt = 0; mt < 2; ++mt)
#pragma unroll
        for (int nt = 0; nt < 4; ++nt) acc[mt][nt] = (f32x4){0.f, 0.f, 0.f, 0.f};
}
template <bool MAXOP, bool REV>
__device__ __forceinline__ void scan128(const LAS float* x, LAS float* out, int lane) {
    static_assert(!REV, "suffix scans are not used any more");
    const int i0 = 2 * lane, i1 = 2 * lane + 1;
    const float a0 = x[i0], a1r = x[i1]; const float a1 = MAXOP ? fmaxf(a0, a1r) : a0 + a1r;
    const float s = wave_scan_incl<MAXOP>(a1);
    const int idn = __builtin_bit_cast(int, MAXOP ? -3.0e38f : 0.0f);
    const float ex = __builtin_bit_cast(float, __builtin_amdgcn_update_dpp(idn, __builtin_bit_cast(int, s), 0x138, 0xF, 0xF, false));
    out[i0] = MAXOP ? fmaxf(ex, a0) : ex + a0; out[i1] = s;
}

typedef short s16x4 __attribute__((ext_vector_type(4)));
constexpr int NSEG = 4;
__device__ __forceinline__ int seg_begin(int s) { return s == 0 ? 0 : 1 + 16 * s; }
constexpr size_t SUMM_STRIDE = (size_t)(144 * 128 + 64);
constexpr size_t WS_SUMM = WS_STATE;
constexpr size_t WS_OUTD = WS_STATE + 16 * MiB;
static_assert(WS_OUTD + (size_t)2 * R * D * 2 <= WS_END && 64 * 3 * SUMM_STRIDE * 4 <= 16 * MiB, "mixer scratch map");
constexpr int VQ = VEC_OFF;
constexpr int V_LI = VQ, V_LF = VQ + 512, V_BC = VQ + 1024, V_GG = VQ + 1536, V_PM = VQ + 2048, V_E1 = VQ + 2560, V_WI = VQ + 3072, V_FL = VQ + 3584, V_WU = VQ + 4096,
              V_NV = VQ + 4608  , V_SC = VQ + 4864  ;

template <int KS, int NT> __device__ __forceinline__ void ld_rows(const LAS bf16* T, int rowbase, int fq, bf16x8 (&f)[NT]) {
#pragma unroll
    for (int t = 0; t < NT; ++t) f[t] = *(const LAS bf16x8*)(T + (rowbase + 16 * t) * TP + KS * 32 + 8 * fq);
}
template <int KS> __device__ __forceinline__ void tr_frag4(unsigned addr, bf16x8 (&f)[4]) {
    s16x4 r0, r1, r2, r3, r4, r5, r6, r7;
    asm volatile("ds_read_b64_tr_b16 %0, %8 offset:%9\n\tds_read_b64_tr_b16 %1, %8 offset:%10\n\tds_read_b64_tr_b16 %2, %8 offset:%11\n\tds_read_b64_tr_b16 %3, %8 offset:%12\n\t"
                 "ds_read_b64_tr_b16 %4, %8 offset:%13\n\tds_read_b64_tr_b16 %5, %8 offset:%14\n\tds_read_b64_tr_b16 %6, %8 offset:%15\n\tds_read_b64_tr_b16 %7, %8 offset:%16\n\ts_waitcnt lgkmcnt(0)"
                 : "=&v"(r0), "=&v"(r1), "=&v"(r2), "=&v"(r3), "=&v"(r4), "=&v"(r5), "=&v"(r6), "=&v"(r7)
                 : "v"(addr), "i"(KS * 8704), "i"(KS * 8704 + 1088), "i"(KS * 8704 + 32), "i"(KS * 8704 + 32 + 1088), "i"(KS * 8704 + 64), "i"(KS * 8704 + 64 + 1088), "i"(KS * 8704 + 96), "i"(KS * 8704 + 96 + 1088)
                 : "memory");
    f[0] = __builtin_shufflevector(r0, r1, 0, 1, 2, 3, 4, 5, 6, 7); f[1] = __builtin_shufflevector(r2, r3, 0, 1, 2, 3, 4, 5, 6, 7);
    f[2] = __builtin_shufflevector(r4, r5, 0, 1, 2, 3, 4, 5, 6, 7); f[3] = __builtin_shufflevector(r6, r7, 0, 1, 2, 3, 4, 5, 6, 7);
}
template <int KS> __device__ __forceinline__ void tr_frag2(unsigned addr, bf16x8 (&f)[2]) {
    s16x4 r0, r1, r2, r3;
    asm volatile("ds_read_b64_tr_b16 %0, %4 offset:%5\n\tds_read_b64_tr_b16 %1, %4 offset:%6\n\tds_read_b64_tr_b16 %2, %4 offset:%7\n\tds_read_b64_tr_b16 %3, %4 offset:%8\n\ts_waitcnt lgkmcnt(0)"
                 : "=&v"(r0), "=&v"(r1), "=&v"(r2), "=&v"(r3)
                 : "v"(addr), "i"(KS * 8704), "i"(KS * 8704 + 1088), "i"(KS * 8704 + 32), "i"(KS * 8704 + 32 + 1088)
                 : "memory");
    f[0] = __builtin_shufflevector(r0, r1, 0, 1, 2, 3, 4, 5, 6, 7); f[1] = __builtin_shufflevector(r2, r3, 0, 1, 2, 3, 4, 5, 6, 7);
}
__device__ __forceinline__ unsigned tr_lane_addr(const LAS bf16* T, int colbase, int lane) {
    const int g = lane >> 4, q = (lane & 15) >> 2, p = lane & 3;
    return (unsigned)(__UINTPTR_TYPE__)(T + (8 * g + q) * TP + colbase + 4 * p);
}

struct SeqUnit { int b, h, grp, dir, seg, combo; };
__device__ __forceinline__ SeqUnit seq_unit(int u) { SeqUnit q; q.seg = u & 3; q.combo = u >> 2; q.dir = q.combo & 1; q.grp = (q.combo >> 1) & 1; q.h = (q.combo >> 2) & 3; q.b = q.combo >> 4; return q; }
__device__ __forceinline__ int seq_chunk(const SeqUnit& q, int ci) { return q.dir ? NCH - 1 - ci : ci; }
__device__ __forceinline__ void tile_fetch(int tid, const bf16* src, size_t stride, int rev, u32x4 (&v)[4]) {
#pragma unroll
    for (int i = 0; i < 4; ++i) { const int q = tid + 512 * i, row = q >> 4, ch = q & 15, rs = rev ? 127 - row : row; v[i] = *(const u32x4*)(src + (size_t)rs * stride + ch * 8); }
}
__device__ __forceinline__ void tile_put(int tid, LAS bf16* T, const u32x4 (&v)[4]) {
#pragma unroll
    for (int i = 0; i < 4; ++i) { const int q = tid + 512 * i, row = q >> 4, ch = q & 15; *(LAS u32x4*)(T + row * TP + ch * 8) = v[i]; }
}
__device__ __forceinline__ void chunk_scans(LAS unsigned char* lds, int lane, bool nostab) {
    LAS float* LI = (LAS float*)(lds + V_LI); LAS float* LF = (LAS float*)(lds + V_LF); LAS float* BC = (LAS float*)(lds + V_BC); LAS float* GG = (LAS float*)(lds + V_GG); LAS float* PM = (LAS float*)(lds + V_PM);
    LAS float* E1 = (LAS float*)(lds + V_E1); LAS float* WI = (LAS float*)(lds + V_WI); LAS float* FL = (LAS float*)(lds + V_FL); LAS float* WU = (LAS float*)(lds + V_WU); LAS float* SC = (LAS float*)(lds + V_SC);
    scan128<false, false>(LF, BC, lane); LDS_WAIT();
    const int l0 = 2 * lane, l1 = 2 * lane + 1;
    const float bc0 = BC[l0], bc1 = BC[l1], li0 = LI[l0], li1 = LI[l1];
    GG[l0] = li0 - bc0; GG[l1] = li1 - bc1; LDS_WAIT();
    scan128<true, false>(GG, PM, lane); LDS_WAIT();
    const float blast = BC[127], m = SC[0];
    const float lu0 = blast - bc0 + li0, lu1 = blast - bc1 + li1;
    const float a = nostab ? 0.0f : wave_max(fmaxf(lu0, lu1));
    const float mnew = nostab ? 0.0f : fmaxf(blast + m, a);
    const float f = __expf(blast + m - mnew), g = __expf(a - mnew);
    const float mr0 = nostab ? 0.0f : fmaxf(bc0 + m, bc0 + PM[l0]), mr1 = nostab ? 0.0f : fmaxf(bc1 + m, bc1 + PM[l1]);
    E1[l0] = bc0 - mr0; E1[l1] = bc1 - mr1; WI[l0] = __expf(bc0 + m - mr0); WI[l1] = __expf(bc1 + m - mr1);
    FL[l0] = __expf(-mr0); FL[l1] = __expf(-mr1); WU[l0] = g * __expf(lu0 - a); WU[l1] = g * __expf(lu1 - a);
    if (lane == 0) { SC[1] = f; SC[2] = mnew; SC[3] += blast; }
}
__device__ __forceinline__ void scale_k(int tid, LAS bf16* TK, const LAS float* WU) {
#pragma unroll
    for (int i = 0; i < 4; ++i) { const int q = tid + 512 * i, row = q >> 4, ch = q & 15; LAS u32x4* p = (LAS u32x4*)(TK + row * TP + ch * 8); const u32x4 v = *p; const float wv = WU[row];
        *p = (u32x4){cvtpk(bflo(v.x) * wv, bfhi(v.x) * wv), cvtpk(bflo(v.y) * wv, bfhi(v.y) * wv), cvtpk(bflo(v.z) * wv, bfhi(v.z) * wv), cvtpk(bflo(v.w) * wv, bfhi(v.w) * wv)}; }
}
__device__ __forceinline__ void state_update(const LAS bf16* TV, const LAS bf16* TK, int w, int lane, float f, f32x4 (&C)[2][4], float (&nrow)[4]) {
    const int m0 = 32 * (w >> 1), n0 = 64 * (w & 1), fr = lane & 15;
#pragma unroll
    for (int mt = 0; mt < 2; ++mt)
#pragma unroll
        for (int nt = 0; nt < 4; ++nt) C[mt][nt] *= f;
    f32x4 nacc[4];
#pragma unroll
    for (int nt = 0; nt < 4; ++nt) nacc[nt] = (f32x4){nrow[nt] * f, 0.f, 0.f, 0.f};
    const unsigned aa = tr_lane_addr(TV, m0, lane), ab = tr_lane_addr(TK, n0, lane);
    bf16x8 ones; { const short o = (fr == 0) ? (short)0x3F80 : (short)0;
#pragma unroll
        for (int j = 0; j < 8; ++j) ones[j] = o; }
#define SU_STEP(KS) { bf16x8 a[2], b[4]; tr_frag2<KS>(aa, a); tr_frag4<KS>(ab, b); \
        _Pragma("unroll") for (int mt = 0; mt < 2; ++mt) _Pragma("unroll") for (int nt = 0; nt < 4; ++nt) C[mt][nt] = MFMA16(a[mt], b[nt], C[mt][nt]); \
        if (w < 2) { _Pragma("unroll") for (int nt = 0; nt < 4; ++nt) nacc[nt] = MFMA16(ones, b[nt], nacc[nt]); } }
    SU_STEP(0) SU_STEP(1) SU_STEP(2) SU_STEP(3)
#undef SU_STEP
#pragma unroll
    for (int nt = 0; nt < 4; ++nt) nrow[nt] = nacc[nt][0];
}
__device__ __forceinline__ const bf16* seq_src(const Ctx& F, const SeqUnit& q, int which  , size_t& stride) {
    const bf16* PROJ = (const bf16*)(F.ws + WS_PROJ); const bf16* QKC = (const bf16*)(F.ws + WS_ACT1);
    if (q.grp == 0) { stride = PC; return PROJ + which * 512 + q.h * 128; }
    if (which == 2) { stride = PC; return PROJ + 3072 + q.h * 128; }
    stride = D; return QKC + which * 512 + q.h * 128;
}
__device__ __forceinline__ void gates_fetch(const Ctx& F, const SeqUnit& q, int c, int tid, float lgam, float& li, float& lf) {
    if (q.grp == 0) { li = 0.0f; lf = lgam; return; }
    const float* GATES = (const float*)(F.ws + WS_GATES); const int row = q.dir ? 127 - tid : tid;
    const float* gp = GATES + ((size_t)q.b * PP + (size_t)c * CHK + row) * 16; li = gp[q.dir * 4 + q.h]; lf = gp[8 + q.dir * 4 + q.h];
}

constexpr int I_WD = (DFF / 64) * (D / 64);
constexpr int WD_SPLIT = 2800;
__device__ __forceinline__ void convert_wd(Ctx& F, int lo, int hi, int iw, int nw) {
    unsigned char* WdT = F.ws + WS_WD8; LAS float* scr = (LAS float*)(F.lds + F.wave * F8SCR);
    for (int it = lo + iw; it < hi; it += nw) { const int e = it / I_WD, item = it - e * I_WD;
        transpose_item_f8(F.w_down + (size_t)e * DFF * D, DFF, D, D, WdT + (size_t)e * D * DFF, scr, item, F.lane, WPRE_DN); }
}
__device__ __forceinline__ void phase_seg_summary(Ctx& F) {
    LAS bf16* TK = (LAS bf16*)(F.lds + T1_OFF); LAS bf16* TV = (LAS bf16*)(F.lds + T2_OFF);
    LAS float* SC = (LAS float*)(F.lds + V_SC); LAS float* LI = (LAS float*)(F.lds + V_LI); LAS float* LF = (LAS float*)(F.lds + V_LF); const LAS float* WU = (const LAS float*)(F.lds + V_WU);
    float* SUMM = (float*)(F.ws + WS_SUMM);
    const int w = F.wave;
    for (int u = F.vcu; u < 64 * NSEG; u += F.G) {
        const SeqUnit q = seq_unit(u);
        if (q.seg == NSEG - 1) { convert_wd(F, 0, WD_SPLIT, q.combo * 8 + F.wave, 64 * 8); continue; }
        int tid = F.tid; asm volatile("" : "+v"(tid));
        const int lane = tid & 63, fr = lane & 15, fq = lane >> 4;
        const bool nostab = (q.grp == 0);
        const float lgam = nostab ? logsigmoidf_(F.ret_logit[q.dir * NH + q.h]) : 0.0f;
        size_t sk, sv; const bf16* pk = seq_src(F, q, 1, sk); const bf16* pv = seq_src(F, q, 2, sv);
        f32x4 C[2][4]; float nrow[4] = {0.f, 0.f, 0.f, 0.f}; zero_acc(C);
        __syncthreads();
        if (tid == 0) { SC[0] = 0.f; SC[3] = 0.f; }
        const int ci0 = seg_begin(q.seg), ci1 = seg_begin(q.seg + 1);
        u32x4 rk[4], rv[4]; float gli = 0.f, glf = 0.f;
        {   const int c = seq_chunk(q, ci0); const size_t r0 = (size_t)q.b * PP + (size_t)c * CHK;
            tile_fetch(tid, pk + r0 * sk, sk, q.dir, rk); tile_fetch(tid, pv + r0 * sv, sv, q.dir, rv); if (tid < 128) gates_fetch(F, q, c, tid, lgam, gli, glf); }
#pragma unroll 1
        for (int ci = ci0; ci < ci1; ++ci) {
            tile_put(tid, TK, rk); tile_put(tid, TV, rv); if (tid < 128) { LI[tid] = gli; LF[tid] = glf; }
            __syncthreads();
            if (ci + 1 < ci1) { const int c = seq_chunk(q, ci + 1); const size_t r0 = (size_t)q.b * PP + (size_t)c * CHK;
                tile_fetch(tid, pk + r0 * sk, sk, q.dir, rk); tile_fetch(tid, pv + r0 * sv, sv, q.dir, rv); if (tid < 128) gates_fetch(F, q, c, tid, lgam, gli, glf); }
            if (w == 0) chunk_scans(F.lds, lane, nostab);
            __syncthreads();
            scale_k(tid, TK, WU);
            __syncthreads();
            const float f = SC[1];
            state_update(TV, TK, w, lane, f, C, nrow);
            __syncthreads();
            if (tid == 0) SC[0] = SC[2];
        }
        __syncthreads();
        float* dst = SUMM + ((size_t)q.combo * 3 + q.seg) * SUMM_STRIDE;
        const int m0 = 32 * (w >> 1), n0 = 64 * (w & 1);
#pragma unroll
        for (int mt = 0; mt < 2; ++mt)
#pragma unroll
            for (int nt = 0; nt < 4; ++nt)
#pragma unroll
                for (int rg = 0; rg < 4; ++rg) dst[(m0 + 16 * mt + 4 * fq + rg) * 128 + n0 + 16 * nt + fr] = C[mt][nt][rg];
        if (w < 2 && fq == 0) {
#pragma unroll
            for (int nt = 0; nt < 4; ++nt) dst[128 * 128 + n0 + 16 * nt + fr] = nrow[nt]; }
        if (tid == 0) { dst[144 * 128] = SC[0]; dst[144 * 128 + 1] = SC[3]; }
    }
}

__device__ __forceinline__ void phase_seq(Ctx& F) {
    LAS bf16* TQ = (LAS bf16*)(F.lds + T0_OFF); LAS bf16* TK = (LAS bf16*)(F.lds + T1_OFF); LAS bf16* TV = (LAS bf16*)(F.lds + T2_OFF); LAS bf16* TC = (LAS bf16*)(F.lds + T3_OFF);
    LAS float* SC = (LAS float*)(F.lds + V_SC); LAS float* LI = (LAS float*)(F.lds + V_LI); LAS float* LF = (LAS float*)(F.lds + V_LF);
    const LAS float* WU = (const LAS float*)(F.lds + V_WU); const LAS float* E1 = (const LAS float*)(F.lds + V_E1); const LAS float* GG = (const LAS float*)(F.lds + V_GG);
    const LAS float* WI = (const LAS float*)(F.lds + V_WI); const LAS float* FL = (const LAS float*)(F.lds + V_FL); LAS bf16* NV = (LAS bf16*)(F.lds + V_NV);
    const float* SUMM = (const float*)(F.ws + WS_SUMM); bf16* OUTD = (bf16*)(F.ws + WS_OUTD);
    const int w = F.wave, m0 = 32 * (w >> 1), n0 = 64 * (w & 1);
    int git = F.vcu * 8 + F.wave; const int gstride = F.G * 8; f32x4 bgv[16]; bool bg_pending = false;
    for (int u = F.vcu; u < 64 * NSEG; u += F.G) {
        const SeqUnit q = seq_unit(u);
        int tid_u = F.tid; asm volatile("" : "+v"(tid_u));
        const int tid = tid_u, lane = tid & 63, fr = lane & 15, fq = lane >> 4;
        const bool nostab = (q.grp == 0);
        const float lgam = nostab ? logsigmoidf_(F.ret_logit[q.dir * NH + q.h]) : 0.0f;
        size_t sq, sk, sv; const bf16* pq = seq_src(F, q, 0, sq); const bf16* pk = seq_src(F, q, 1, sk); const bf16* pv = seq_src(F, q, 2, sv);
        f32x4 C[2][4]; float nrow[4] = {0.f, 0.f, 0.f, 0.f}; zero_acc(C);
        float mst = 0.f;
        for (int s = 0; s < q.seg; ++s) {
            const float* src = SUMM + ((size_t)q.combo * 3 + s) * SUMM_STRIDE;
            const float ms = src[144 * 128], Bs = src[144 * 128 + 1];
            const float mo_ = nostab ? 0.0f : fmaxf(Bs + mst, ms); const float fa = __expf(Bs + mst - mo_), fb = __expf(ms - mo_); mst = mo_;
#pragma unroll
            for (int mt = 0; mt < 2; ++mt)
#pragma unroll
                for (int nt = 0; nt < 4; ++nt)
#pragma unroll
                    for (int rg = 0; rg < 4; ++rg) C[mt][nt][rg] = fa * C[mt][nt][rg] + fb * src[(m0 + 16 * mt + 4 * fq + rg) * 128 + n0 + 16 * nt + fr];
            if (w < 2 && fq == 0) {
#pragma unroll
                for (int nt = 0; nt < 4; ++nt) nrow[nt] = fa * nrow[nt] + fb * src[128 * 128 + n0 + 16 * nt + fr]; }
        }
        __syncthreads();
        if (tid == 0) { SC[0] = mst; SC[3] = 0.f; }
        const int ci0 = seg_begin(q.seg), ci1 = seg_begin(q.seg + 1);
        u32x4 rq[4], rk[4], rv[4]; float gli = 0.f, glf = 0.f;
        {   const int c = seq_chunk(q, ci0); const size_t r0 = (size_t)q.b * PP + (size_t)c * CHK;
            tile_fetch(tid, pq + r0 * sq, sq, q.dir, rq); tile_fetch(tid, pk + r0 * sk, sk, q.dir, rk); tile_fetch(tid, pv + r0 * sv, sv, q.dir, rv); if (tid < 128) gates_fetch(F, q, c, tid, lgam, gli, glf); }
#pragma unroll 1
        for (int ci = ci0; ci < ci1; ++ci) {
            const int c = seq_chunk(q, ci); const size_t r0 = (size_t)q.b * PP + (size_t)c * CHK;
            int tid = tid_u; asm volatile("" : "+v"(tid));
            const int lane = tid & 63, fr = lane & 15, fq = lane >> 4;
            tile_put(tid, TQ, rq); tile_put(tid, TK, rk); tile_put(tid, TV, rv); if (tid < 128) { LI[tid] = gli; LF[tid] = glf; }
#pragma unroll
            for (int mt = 0; mt < 2; ++mt)
#pragma unroll
                for (int nt = 0; nt < 4; ++nt) *(LAS u32x2*)(TC + (n0 + 16 * nt + fr) * TP + m0 + 16 * mt + 4 * fq) = (u32x2){cvtpk(C[mt][nt][0], C[mt][nt][1]), cvtpk(C[mt][nt][2], C[mt][nt][3])};
            if (w < 2 && fq == 0) {
#pragma unroll
                for (int nt = 0; nt < 4; ++nt) NV[n0 + 16 * nt + fr] = (bf16)f2bf(nrow[nt]); }
            if (bg_pending) { gu_item_store(F.ws, git, lane, bgv); git += gstride; bg_pending = false; }
            __syncthreads();
            if (w == 0) chunk_scans(F.lds, lane, nostab);
            f32x4 accN[2][4], accD[4], accS[2][4]; zero_acc(accN); zero_acc(accS);
#pragma unroll
            for (int nt = 0; nt < 4; ++nt) accD[nt] = (f32x4){0.f, 0.f, 0.f, 0.f};
            {   const unsigned ac = tr_lane_addr(TC, m0, lane);
#define SX_STEP(KS) { bf16x8 a[2], bq[4]; ld_rows<KS, 4>(TQ, n0 + fr, fq, bq); tr_frag2<KS>(ac, a); \
                bf16x8 an = *(const LAS bf16x8*)(NV + KS * 32 + 8 * fq); if (fr != 0) { _Pragma("unroll") for (int j = 0; j < 8; ++j) an[j] = 0; } \
                _Pragma("unroll") for (int nt = 0; nt < 4; ++nt) { _Pragma("unroll") for (int mt = 0; mt < 2; ++mt) accN[mt][nt] = MFMA16(a[mt], bq[nt], accN[mt][nt]); accD[nt] = MFMA16(an, bq[nt], accD[nt]); } }
                SX_STEP(0) SX_STEP(1) SX_STEP(2) SX_STEP(3)
#undef SX_STEP
            }
#define SS_STEP(KS) { bf16x8 a[2], bq[4]; ld_rows<KS, 2>(TK, m0 + fr, fq, a); ld_rows<KS, 4>(TQ, n0 + fr, fq, bq); \
                _Pragma("unroll") for (int mt = 0; mt < 2; ++mt) { _Pragma("unroll") for (int nt = 0; nt < 4; ++nt) accS[mt][nt] = MFMA16(a[mt], bq[nt], accS[mt][nt]); } }
            SS_STEP(0) SS_STEP(1) SS_STEP(2) SS_STEP(3)
#undef SS_STEP
            __syncthreads();
#pragma unroll
            for (int nt = 0; nt < 4; ++nt) { const int l = n0 + 16 * nt + fr; const float wi = WI[l], e1 = E1[l]; accD[nt][0] *= wi;
#pragma unroll
                for (int mt = 0; mt < 2; ++mt) { accN[mt][nt] *= wi; const int mb = m0 + 16 * mt + 4 * fq; float pv_[4];
#pragma unroll
                    for (int rg = 0; rg < 4; ++rg) pv_[rg] = (mb + rg <= l) ? accS[mt][nt][rg] * __expf(e1 + GG[mb + rg]) : 0.0f;
                    *(LAS u32x2*)(TC + l * TP + mb) = (u32x2){cvtpk(pv_[0], pv_[1]), cvtpk(pv_[2], pv_[3])}; } }
            scale_k(tid, TK, WU);
            if (ci + 1 < ci1) { const int cn = seq_chunk(q, ci + 1); const size_t rn = (size_t)q.b * PP + (size_t)cn * CHK;
                tile_fetch(tid, pq + rn * sq, sq, q.dir, rq); tile_fetch(tid, pk + rn * sk, sk, q.dir, rk); tile_fetch(tid, pv + rn * sv, sv, q.dir, rv); if (tid < 128) gates_fetch(F, q, cn, tid, lgam, gli, glf); }
            __syncthreads();
            {   const unsigned av = tr_lane_addr(TV, m0, lane);
                bf16x8 ones; { const short o = (fr == 0) ? (short)0x3F80 : (short)0;
#pragma unroll
                    for (int j = 0; j < 8; ++j) ones[j] = o; }
#define PV_STEP(KS) { bf16x8 a[2], bp[4]; ld_rows<KS, 4>(TC, n0 + fr, fq, bp); tr_frag2<KS>(av, a); \
                _Pragma("unroll") for (int nt = 0; nt < 4; ++nt) { _Pragma("unroll") for (int mt = 0; mt < 2; ++mt) accN[mt][nt] = MFMA16(a[mt], bp[nt], accN[mt][nt]); accD[nt] = MFMA16(ones, bp[nt], accD[nt]); } }
                PV_STEP(0) PV_STEP(1) PV_STEP(2) PV_STEP(3)
#undef PV_STEP
            }
#pragma unroll
            for (int nt = 0; nt < 4; ++nt) { const int l = n0 + 16 * nt + fr;
                const float den = __shfl(accD[nt][0], fr); const float inv = nostab ? 1.0f : __builtin_amdgcn_rcpf(fmaxf(fabsf(den), FL[l]));
#pragma unroll
                for (int mt = 0; mt < 2; ++mt) { const f32x4 o = accN[mt][nt] * inv; *(LAS u32x2*)(TQ + l * TP + m0 + 16 * mt + 4 * fq) = (u32x2){cvtpk(o[0], o[1]), cvtpk(o[2], o[3])}; } }
            state_update(TV, TK, w, lane, SC[1], C, nrow);
            __syncthreads();
            if (git < GU_P4) { gu_item_load(F.w_gate, F.w_up, git, lane, bgv); bg_pending = true; }
            else {
#pragma unroll
                for (int i = 0; i < 16; ++i) bgv[i] = (f32x4){0.f, 0.f, 0.f, 0.f}; }
            {   bf16* dst = OUTD + ((size_t)q.dir * R + r0) * D + q.grp * 512 + q.h * 128;
#pragma unroll
                for (int i = 0; i < 4; ++i) { const int qq = tid + 512 * i, row = qq >> 4, ch = qq & 15, rs = q.dir ? 127 - row : row; *(u32x4*)(dst + (size_t)rs * D + ch * 8) = *(const LAS u32x4*)(TQ + row * TP + ch * 8); } }
            if (tid == 0) SC[0] = SC[2];
            __syncthreads();
        }
    }
    if (bg_pending) { gu_item_store(F.ws, git, F.lane, bgv); git += gstride; }
    for (; git < GU_P4; git += gstride) { gu_item_load(F.w_gate, F.w_up, git, F.lane, bgv); gu_item_store(F.ws, git, F.lane, bgv); }
}

__device__ __forceinline__ void phase_combine(Ctx& F) {
    const bf16* PROJ = (const bf16*)(F.ws + WS_PROJ); const bf16* OUTD = (const bf16*)(F.ws + WS_OUTD); bf16* Y = (bf16*)(F.ws + WS_ACT2);
    const int gw = F.vcu * 8 + F.wave, NGW = F.G * 8, lane = F.lane;
    const int col = lane * 16, grp = col >> 9;
    const size_t goff = (grp == 0 ? 1536 + col : 3584 + (col - 512));
    u32x4 na[2], nc[2], ng[2];
    { const int p0 = gw - (gw / PP) * PP; if (gw < R && p0 >= PADF) {
#pragma unroll
        for (int hh = 0; hh < 2; ++hh) { na[hh] = *(const u32x4*)(OUTD + (size_t)gw * D + col + hh * 8); nc[hh] = *(const u32x4*)(OUTD + ((size_t)R + gw) * D + col + hh * 8); ng[hh] = *(const u32x4*)(PROJ + (size_t)gw * PC + goff + hh * 8); } } }
    for (int r = gw; r < R; r += NGW) {
        const int b = r / PP, p = r - b * PP; bf16* yrow = Y + (size_t)r * D + lane * 16;
        u32x4 ca[2], cc[2], cg[2];
#pragma unroll
        for (int hh = 0; hh < 2; ++hh) { ca[hh] = na[hh]; cc[hh] = nc[hh]; cg[hh] = ng[hh]; }
        { const int r2 = r + NGW; const int p2 = r2 - (r2 / PP) * PP; if (r2 < R && p2 >= PADF) {
#pragma unroll
            for (int hh = 0; hh < 2; ++hh) { na[hh] = *(const u32x4*)(OUTD + (size_t)r2 * D + col + hh * 8); nc[hh] = *(const u32x4*)(OUTD + ((size_t)R + r2) * D + col + hh * 8); ng[hh] = *(const u32x4*)(PROJ + (size_t)r2 * PC + goff + hh * 8); } } }
        if (p < PADF) { *(u32x4*)yrow = (u32x4){0u, 0u, 0u, 0u}; *(u32x4*)(yrow + 8) = (u32x4){0u, 0u, 0u, 0u}; continue; }
        float v[16], gt[16];
#pragma unroll
        for (int hh = 0; hh < 2; ++hh) { const u32x4 a = ca[hh], c = cc[hh], g = cg[hh];
            const unsigned aw[4] = {a.x, a.y, a.z, a.w}, cw[4] = {c.x, c.y, c.z, c.w}, gw_[4] = {g.x, g.y, g.z, g.w};
#pragma unroll
            for (int j = 0; j < 4; ++j) { v[hh * 8 + 2 * j] = bflo(aw[j]) + bflo(cw[j]); v[hh * 8 + 2 * j + 1] = bfhi(aw[j]) + bfhi(cw[j]); gt[hh * 8 + 2 * j] = bflo(gw_[j]); gt[hh * 8 + 2 * j + 1] = bfhi(gw_[j]); } }
        if (grp == 1) {
#pragma unroll
            for (int j = 0; j < 16; ++j) v[j] *= sigmoidf_(gt[j]); }
        float s = 0.f;
#pragma unroll
        for (int j = 0; j < 16; ++j) s += v[j];
        s += __shfl_xor(s, 1); s += __shfl_xor(s, 2); s += __shfl_xor(s, 4);
        const float mu = s * (1.0f / 128.0f); float qv = 0.f;
#pragma unroll
        for (int j = 0; j < 16; ++j) { v[j] -= mu; qv += v[j] * v[j]; }
        qv += __shfl_xor(qv, 1); qv += __shfl_xor(qv, 2); qv += __shfl_xor(qv, 4);
        const float rstd = rsqrtf(qv * (1.0f / 128.0f) + EPS);
        const float* gnp = (grp == 0 ? F.ret_gn + col : F.ml_gn + (col - 512)); float gn[16];
#pragma unroll
        for (int j4 = 0; j4 < 4; ++j4) { const f32x4 g4 = *(const f32x4*)(gnp + 4 * j4); gn[4 * j4] = g4.x; gn[4 * j4 + 1] = g4.y; gn[4 * j4 + 2] = g4.z; gn[4 * j4 + 3] = g4.w; }
        unsigned o[8];
#pragma unroll
        for (int j = 0; j < 8; ++j) { float y0 = v[2 * j] * rstd * gn[2 * j], y1 = v[2 * j + 1] * rstd * gn[2 * j + 1];
            if (grp == 0) { y0 *= siluf_(gt[2 * j]); y1 *= siluf_(gt[2 * j + 1]); }
            o[j] = pk2(y0, y1); }
        *(u32x4*)yrow = (u32x4){o[0], o[1], o[2], o[3]}; *(u32x4*)(yrow + 8) = (u32x4){o[4], o[5], o[6], o[7]};
    }
}

constexpr int SK_RED = 34816;
__device__ __forceinline__ f32x4 skinny16_ksplit(LAS unsigned char* lds, const bf16* btrow, int w, int lane) {
    const LAS bf16* A = (const LAS bf16*)lds; LAS float* RED = (LAS float*)(lds + SK_RED);
    const int fr = lane & 15, fq = lane >> 4;
    f32x4 acc = (f32x4){0.f, 0.f, 0.f, 0.f};
    bf16x8 bb[4];
#pragma unroll
    for (int j = 0; j < 4; ++j) bb[j] = *(const bf16x8*)(btrow + (4 * w + j) * 32 + 8 * fq);
#pragma unroll
    for (int j = 0; j < 4; ++j) { const bf16x8 a = *(const LAS bf16x8*)(A + fr * 1032 + (4 * w + j) * 32 + 8 * fq); acc = MFMA16(a, bb[j], acc); }
    *(LAS f32x4*)(RED + w * 256 + lane * 4) = acc;
    __syncthreads();
    if (w == 0) { acc = (f32x4){0.f, 0.f, 0.f, 0.f};
#pragma unroll
        for (int ww = 0; ww < 8; ++ww) acc += *(const LAS f32x4*)(RED + ww * 256 + lane * 4); }
    return acc;
}
__device__ __forceinline__ void proj_meta(Ctx& F) {
    const bf16* U1 = (const bf16*)(F.ws + WS_ACT1); const bf16* WINT = (const bf16*)(F.ws + WS_WINT); bf16* PROJ = (bf16*)(F.ws + WS_PROJ); const f32x2* rope = (const f32x2*)(F.ws + WS_ROPE);
    LAS bf16* AT = (LAS bf16*)F.lds;
    for (int it = F.vcu; it < PC / 16; it += F.G) {
        int tid = F.tid; asm volatile("" : "+v"(tid));
        const int lane = tid & 63, fr = lane & 15, fq = lane >> 4;
        __syncthreads();
        for (int i = tid; i < 16 * 128; i += 512) { const int r = i >> 7, ch = i & 127; *(LAS u32x4*)(AT + r * 1032 + ch * 8) = *(const u32x4*)(U1 + (size_t)(PADF + r) * D + ch * 8); }
        __syncthreads();
        const int t = it * 16 + fr;
        const f32x4 acc = skinny16_ksplit(F.lds, WINT + (size_t)t * D, F.wave, lane);
        if (F.wave == 0) {
#pragma unroll
            for (int rg = 0; rg < 4; ++rg) {
                const int n = 4 * fq + rg; float val = acc[rg]; int col = t;
                const float other = __shfl_xor(val, 4);
                if (t < 1024) {
                    const int tc = t & 127, dd = 4 * (tc >> 3) + (tc & 3); const f32x2 cs = rope[n * 64 + dd]; const float sc = (t < 512) ? 0.08838834764831845f : 1.0f;
                    if ((tc & 4) == 0) { val = (val * cs.x - other * cs.y) * sc; col = (t & ~127) + dd; } else { val = (val * cs.x + other * cs.y) * sc; col = (t & ~127) + 64 + dd; }
                }
                const bf16 hv = (bf16)f2bf(val);
#pragma unroll
                for (int b = 0; b < NB; ++b) PROJ[((size_t)b * PP + PADF + n) * PC + col] = hv;
            }
        }
    }
}
__device__ __forceinline__ void out_meta(Ctx& F) {
    const bf16* Y = (const bf16*)(F.ws + WS_ACT2); const bf16* WOUTT = (const bf16*)(F.ws + WS_WOUTT); float* H1M = (float*)(F.ws + WS_H1META);
    LAS bf16* AT = (LAS bf16*)F.lds;
    for (int it = F.vcu; it < NB * (D / 16); it += F.G) {
        int tid = F.tid; asm volatile("" : "+v"(tid));
        const int lane = tid & 63, fr = lane & 15, fq = lane >> 4;
        const int b = it >> 6, cg_ = it & 63;
        __syncthreads();
        for (int i = tid; i < 16 * 128; i += 512) { const int r = i >> 7, ch = i & 127; *(LAS u32x4*)(AT + r * 1032 + ch * 8) = *(const u32x4*)(Y + ((size_t)b * PP + PADF + r) * D + ch * 8); }
        __syncthreads();
        const int col = cg_ * 16 + fr;
        const f32x4 acc = skinny16_ksplit(F.lds, WOUTT + (size_t)col * D, F.wave, lane);
        if (F.wave == 0) {
#pragma unroll
            for (int rg = 0; rg < 4; ++rg) { const int n = 4 * fq + rg; H1M[(size_t)(b * NMETA + n) * D + col] = F.meta[(size_t)n * D + col] + acc[rg]; } }
    }
}

__device__ __forceinline__ void phase_router(Ctx& F) {
    const int gw = F.vcu * 8 + F.wave, NGW = F.G * 8;
    constexpr int NIT = NIT_GU - GU_P4;
    unsigned char* U2 = F.ws + WS_ACT1; float* AFF = (float*)(F.ws + WS_AFF); const float* H1M = (const float*)(F.ws + WS_H1META);
    RowDots W; rowdots_init(W, F.w_router, NE, F.wave, F.lane);
    const int nstep_i = (NIT + NGW - 1) / NGW, nstep_b = (R / 16 + F.G - 1) / F.G, nstep = nstep_i > nstep_b ? nstep_i : nstep_b;
#pragma unroll 1
    for (int st = 0; st < nstep; ++st) {
        const int it = gw + st * NGW, bi = F.vcu + st * F.G;
        const bool has_i = it < NIT, has_b = bi < R / 16;
        f32x4 wv[16];
        if (has_i) gu_item_load(F.w_gate, F.w_up, GU_P4 + it, F.lane, wv);
        if (has_b) {
            const int r0 = bi * 16;
            int rr[2]; bool ok[2]; f32x4 u[2][4];
#pragma unroll
            for (int t = 0; t < 2; ++t) { rr[t] = r0 + 2 * F.wave + t; const int b = rr[t] / PP, p = rr[t] - b * PP; ok[t] = p >= PADF;
                if (ok[t]) { if (p < CHK) row_load(H1M + (size_t)(b * NMETA + p - PADF) * D, F.lane, u[t]); else { const size_t xo = ((size_t)b * SEQ + (p - CHK)) * D; row_load_bf((const bf16*)(F.ws + WS_DELTA) + xo, F.lane, u[t]); } }
                else {
#pragma unroll
                    for (int jj = 0; jj < 4; ++jj) u[t][jj] = (f32x4){0.f, 0.f, 0.f, 0.f}; } }
#pragma unroll
            for (int t = 0; t < 2; ++t) { if (ok[t]) { rms_apply(F.ffn_g, F.lane, u[t]); unsigned char* urow = U2 + (size_t)rr[t] * D;
#pragma unroll
                    for (int jj = 0; jj < 4; ++jj) *(unsigned*)(urow + jj * 256 + F.lane * 4) = pk4_fp8(u[t][jj].x, u[t][jj].y, u[t][jj].z, u[t][jj].w); }
                rowdots_put(F.lds, 2 * F.wave + t, F.lane, u[t]); }
            __syncthreads();
            rowdots_mma(F.lds, W, F.wave, F.lane);
            __syncthreads();
            if (F.tid < 256) { const int row = F.tid >> 4, g = F.tid & 15, r = r0 + row; const int b = r / PP, p = r - b * PP;
                const float lg = rowdots_get(F.lds, row, g);
                float mx = lg; mx = fmaxf(mx, __shfl_xor(mx, 1)); mx = fmaxf(mx, __shfl_xor(mx, 2)); mx = fmaxf(mx, __shfl_xor(mx, 4)); mx = fmaxf(mx, __shfl_xor(mx, 8));
                const float ev = expf(lg - mx); float sm = ev; sm += __shfl_xor(sm, 1); sm += __shfl_xor(sm, 2); sm += __shfl_xor(sm, 4); sm += __shfl_xor(sm, 8);
                if (p >= PADF) AFF[((size_t)b * NE + g) * NTOK + (p - PADF)] = ev / sm; }
        }
        if (has_i) gu_item_store(F.ws, GU_P4 + it, F.lane, wv);
    }
}

__device__ __forceinline__ void phase_topk(Ctx& F) {
    const float* AFF = (const float*)(F.ws + WS_AFF); int* IDX = (int*)(F.ws + WS_IDX); float* GV = (float*)(F.ws + WS_GV); int* SLOT = (int*)(F.ws + WS_SLOT); unsigned* ROWOFF = (unsigned*)(F.ws + WS_SCAL);
    LAS unsigned* keys = (LAS unsigned*)F.lds; LAS unsigned* hist = keys + 8448; LAS unsigned* misc = hist + 256; LAS unsigned* wtot = misc + 16;
    const int tid = F.tid, lane = F.lane, w = F.wave;
    if (F.vcu >= NB * NE) { convert_wd(F, WD_SPLIT, NE * I_WD, (F.vcu - NB * NE) * 8 + F.wave, (F.G - NB * NE) * 8); return; }
    for (int u = F.vcu; u < NB * NE; u += F.G) {
        const int b = u >> 4, e = u & 15; const float* a = AFF + (size_t)u * NTOK;
        __syncthreads();
        for (int i = tid; i < NTOK; i += 512) keys[i] = __builtin_bit_cast(unsigned, a[i]);
        unsigned prefix = 0u, need = CAP;
        for (int pass = 0; pass < 4; ++pass) {
            const int shift = 24 - 8 * pass;
            if (tid < 256) hist[tid] = 0u;
            __syncthreads();
            {
                unsigned cb = 0xffffffffu, cn = 0u;
                for (int i = tid; i < NTOK; i += 512) { const unsigned k = keys[i];
                    if (pass == 0 || (k >> (shift + 8)) == (prefix >> (shift + 8))) { const unsigned bn = (k >> shift) & 255u;
                        if (bn == cb) ++cn; else { if (cn) atomicAdd((unsigned*)&hist[cb], cn); cb = bn; cn = 1u; } } }
                if (cn) atomicAdd((unsigned*)&hist[cb], cn); }
            __syncthreads();
            if (w == 0) {
                const int bb = 255 - 4 * lane; const unsigned c0 = hist[bb], c1 = hist[bb - 1], c2 = hist[bb - 2], c3 = hist[bb - 3]; const unsigned tot = c0 + c1 + c2 + c3;
                const float incl_f = wave_scan_incl<false>((float)tot); const unsigned incl = (unsigned)incl_f, excl = incl - tot;
                const bool here = excl < need && need <= incl;
                if (here) { unsigned cum = excl; int sel = bb;
                    if (cum + c0 >= need) sel = bb; else { cum += c0; if (cum + c1 >= need) sel = bb - 1; else { cum += c1; if (cum + c2 >= need) sel = bb - 2; else { cum += c2; sel = bb - 3; } } }
                    misc[0] = prefix | ((unsigned)sel << shift); misc[1] = need - cum; }
            }
            __syncthreads();
            prefix = misc[0]; need = misc[1];
            __syncthreads();
        }
        const int i0 = tid * 17, i1 = (i0 + 17 < NTOK) ? i0 + 17 : NTOK;
        unsigned cg_ = 0u, ce = 0u;
        for (int i = i0; i < i1; ++i) { const unsigned k = keys[i]; cg_ += (k > prefix) ? 1u : 0u; ce += (k == prefix) ? 1u : 0u; }
        unsigned sg = cg_, se = ce;
#pragma unroll
        for (int o = 1; o < 64; o <<= 1) { const unsigned tg = __shfl_up(sg, o), te = __shfl_up(se, o); if (lane >= o) { sg += tg; se += te; } }
        if (lane == 63) { wtot[w] = sg; wtot[8 + w] = se; }
        __syncthreads();
        unsigned og = 0u, oe = 0u;
        for (int j = 0; j < w; ++j) { og += wtot[j]; oe += wtot[8 + j]; }
        unsigned gb = og + sg - cg_, eb = oe + se - ce;
        for (int i = i0; i < i1; ++i) { const unsigned k = keys[i]; int slot = -1;
            if (k > prefix) { slot = (int)(gb + (eb < need ? eb : need)); ++gb; }
            else if (k == prefix) { if (eb < need) slot = (int)(gb + eb); ++eb; }
            SLOT[((size_t)b * NTOK + i) * NE + e] = slot;
            if (slot >= 0) { IDX[(size_t)u * CAP + slot] = i; GV[(size_t)u * CAP + slot] = __builtin_bit_cast(float, k);
                const int j = b * CAP + slot; if (j < 4096) ROWOFF[e * 4096 + j] = (unsigned)(b * PP + PADF + i) * (unsigned)D; } }
    }
}

constexpr size_t WS_HIDT = WS_UN;
constexpr int XT_PITCH = D + 16, HT_PITCH = DFF + 16;
__device__ __forceinline__ void ffn_thin_up(Ctx& F) {
    const unsigned char* U2 = F.ws + WS_ACT1; const int* IDX = (const int*)(F.ws + WS_IDX);
    const unsigned char* WgT = F.ws + WS_WEXP; const unsigned char* WuT = F.ws + WS_WEXP + WEXP_ONE; unsigned char* HIDT = F.ws + WS_HIDT;
    LAS unsigned char* XT = F.lds;
    const int w = F.wave;
    for (int it = F.vcu; it < NE * 22; it += F.G) {
        int tid = F.tid; asm volatile("" : "+v"(tid));
        const int lane = tid & 63, fr = lane & 15, fq = lane >> 4;
        const int e = it / 22, ft = it % 22;
        __syncthreads();
        if (tid < 8 * 64) { const int r = tid >> 6, ch = tid & 63; const int j = 4096 + r, b = j / CAP, slot = j - b * CAP; const int n = IDX[(b * NE + e) * CAP + slot];
            *(LAS u32x4*)(XT + r * XT_PITCH + ch * 16) = *(const u32x4*)(U2 + ((size_t)b * PP + PADF + n) * D + ch * 16); }
        __syncthreads();
        const int f = ft * 128 + w * 16 + fr;
        const unsigned char* wg = WgT + ((size_t)e * DFF + f) * D + 8 * fq; const unsigned char* wu = WuT + ((size_t)e * DFF + f) * D + 8 * fq;
        f32x4 ag = (f32x4){0.f, 0.f, 0.f, 0.f}, au = ag;
#pragma unroll 1
        for (int k8 = 0; k8 < 32; k8 += 16) {
            long bg[16], bu[16];
#pragma unroll
            for (int j = 0; j < 16; ++j) { bg[j] = *(const long*)(wg + (k8 + j) * 32); bu[j] = *(const long*)(wu + (k8 + j) * 32); }
#pragma unroll
            for (int j = 0; j < 16; ++j) { long a = *(const LAS long*)(XT + (fr & 7) * XT_PITCH + (k8 + j) * 32 + 8 * fq); if (fr >= 8) a = 0;
                ag = __builtin_amdgcn_mfma_f32_16x16x32_fp8_fp8(a, bg[j], ag, 0, 0, 0); au = __builtin_amdgcn_mfma_f32_16x16x32_fp8_fp8(a, bu[j], au, 0, 0, 0); }
        }
        if (fq < 2) {
            float hv[4];
#pragma unroll
            for (int rg = 0; rg < 4; ++rg) hv[rg] = fminf(fmaxf(siluf_(ag[rg] * (1.0f / WPRE_UP)) * (au[rg] * (1.0f / WPRE_UP)), -448.0f), 448.0f);
            const unsigned pk = pk4_fp8(hv[0], hv[1], hv[2], hv[3]);
#pragma unroll
            for (int rg = 0; rg < 4; ++rg) HIDT[((size_t)e * 8 + 4 * fq + rg) * DFF + f] = (unsigned char)(pk >> (8 * rg)); }
    }
}
__device__ __forceinline__ void ffn_thin_down(Ctx& F) {
    const unsigned char* WdT = F.ws + WS_WD8; const unsigned char* HIDT = F.ws + WS_HIDT; bf16* YE = (bf16*)(F.ws + WS_YE);
    LAS unsigned char* HT = F.lds;
    const int w = F.wave;
    for (int it = F.vcu; it < NE * 8; it += F.G) {
        int tid = F.tid; asm volatile("" : "+v"(tid));
        const int lane = tid & 63, fr = lane & 15, fq = lane >> 4;
        const int e = it >> 3, dt = it & 7;
        __syncthreads();
        for (int i = tid; i < 8 * 176; i += 512) { const int r = i / 176, ch = i - r * 176; *(LAS u32x4*)(HT + r * HT_PITCH + ch * 16) = *(const u32x4*)(HIDT + ((size_t)e * 8 + r) * DFF + ch * 16); }
        __syncthreads();
        const int d = dt * 128 + w * 16 + fr;
        const unsigned char* wd = WdT + ((size_t)e * D + d) * DFF + 8 * fq;
        f32x4 ay = (f32x4){0.f, 0.f, 0.f, 0.f};
#pragma unroll 1
        for (int k8 = 0; k8 < 88; k8 += 22) {
            long bd[22];
#pragma unroll
            for (int j = 0; j < 22; ++j) bd[j] = *(const long*)(wd + (k8 + j) * 32);
#pragma unroll
            for (int j = 0; j < 22; ++j) { long a = *(const LAS long*)(HT + (fr & 7) * HT_PITCH + (k8 + j) * 32 + 8 * fq); if (fr >= 8) a = 0;
                ay = __builtin_amdgcn_mfma_f32_16x16x32_fp8_fp8(a, bd[j], ay, 0, 0, 0); }
        }
        if (fq < 2) {
#pragma unroll
            for (int rg = 0; rg < 4; ++rg) YE[((size_t)e * EROWSP + 4096 + 4 * fq + rg) * D + d] = (bf16)f2bf(ay[rg] * (1.0f / WPRE_DN)); }
    }
}

struct FinTok { f32x4 h[4]; int slot; };
struct FinY { u32x2 ya[4], yb[4]; float ga, gb; unsigned rest; };
__device__ __forceinline__ void phase_final(Ctx& F) {
    const int* SLOT = (const int*)(F.ws + WS_SLOT); const float* GV = (const float*)(F.ws + WS_GV); const bf16* YE = (const bf16*)(F.ws + WS_YE);
    const int gw = F.vcu * 8 + F.wave, NGW = F.G * 8, lane = F.lane;
    const bf16* DELTA = (const bf16*)(F.ws + WS_DELTA);
    constexpr int NT = NB * SEQ;
#define FIN_STAGE1(t_, K) do { const int _t = (t_); (K).slot = -1; if (_t < NT) { row_load_bf(DELTA + (size_t)_t * D, lane, (K).h); \
        const int _b = _t / SEQ, _n = _t - _b * SEQ + NMETA; (K).slot = (lane < 16) ? SLOT[((size_t)_b * NTOK + _n) * NE + lane] : -1; } } while (0)
#define FIN_STAGE2(t_, K, Y) do { const int _t = (t_); unsigned _em = (unsigned)(__ballot((K).slot >= 0) & 0xffffull); (Y).ga = 0.0f; (Y).gb = 0.0f; \
        _Pragma("unroll") for (int jj = 0; jj < 4; ++jj) { (Y).ya[jj] = (u32x2){0u, 0u}; (Y).yb[jj] = (u32x2){0u, 0u}; } \
        if (_em) { const int _b = _t / SEQ; const int _ea = __builtin_ctz(_em); _em &= _em - 1u; const bool _two = _em != 0u; const int _eb = _two ? __builtin_ctz(_em) : _ea; if (_two) _em &= _em - 1u; \
            const int _sa = __shfl((K).slot, _ea), _sb = __shfl((K).slot, _eb); \
            (Y).ga = GV[((size_t)_b * NE + _ea) * CAP + _sa]; (Y).gb = _two ? GV[((size_t)_b * NE + _eb) * CAP + _sb] : 0.0f; \
            const bf16* _ya = YE + ((size_t)_ea * EROWSP + (size_t)_b * CAP + _sa) * D; const bf16* _yb = YE + ((size_t)_eb * EROWSP + (size_t)_b * CAP + _sb) * D; \
            _Pragma("unroll") for (int jj = 0; jj < 4; ++jj) { (Y).ya[jj] = *(const u32x2*)(_ya + jj * 256 + lane * 4); (Y).yb[jj] = *(const u32x2*)(_yb + jj * 256 + lane * 4); } } \
        (Y).rest = _em; } while (0)
    FinTok k0, k1, k2; FinY y0, y1;
    FIN_STAGE1(gw, k0); FIN_STAGE1(gw + NGW, k1);
    FIN_STAGE2(gw, k0, y0);
    for (int t = gw; t < NT; t += NGW) {
        FIN_STAGE2(t + NGW, k1, y1);
        FIN_STAGE1(t + 2 * NGW, k2);
        const int b = t / SEQ;
        float* row = F.out + (size_t)t * D;
        f32x4 v[4];
#pragma unroll
        for (int jj = 0; jj < 4; ++jj) {
            v[jj].x = k0.h[jj].x + y0.ga * bflo(y0.ya[jj].x) + y0.gb * bflo(y0.yb[jj].x); v[jj].y = k0.h[jj].y + y0.ga * bfhi(y0.ya[jj].x) + y0.gb * bfhi(y0.yb[jj].x);
            v[jj].z = k0.h[jj].z + y0.ga * bflo(y0.ya[jj].y) + y0.gb * bflo(y0.yb[jj].y); v[jj].w = k0.h[jj].w + y0.ga * bfhi(y0.ya[jj].y) + y0.gb * bfhi(y0.yb[jj].y); }
        const int myslot = k0.slot;
        unsigned em = y0.rest;
        while (em) {
            const int ea = __builtin_ctz(em); em &= em - 1u; const bool two = em != 0u; const int eb = two ? __builtin_ctz(em) : ea; if (two) em &= em - 1u;
            const int sa = __shfl(myslot, ea), sb = __shfl(myslot, eb);
            const float ga = GV[((size_t)b * NE + ea) * CAP + sa], gb = two ? GV[((size_t)b * NE + eb) * CAP + sb] : 0.0f;
            const bf16* ya = YE + ((size_t)ea * EROWSP + (size_t)b * CAP + sa) * D; const bf16* yb = YE + ((size_t)eb * EROWSP + (size_t)b * CAP + sb) * D;
            u32x2 wa[4], wb[4];
#pragma unroll
            for (int jj = 0; jj < 4; ++jj) { wa[jj] = *(const u32x2*)(ya + jj * 256 + lane * 4); wb[jj] = *(const u32x2*)(yb + jj * 256 + lane * 4); }
#pragma unroll
            for (int jj = 0; jj < 4; ++jj) {
                v[jj].x += ga * bflo(wa[jj].x) + gb * bflo(wb[jj].x); v[jj].y += ga * bfhi(wa[jj].x) + gb * bfhi(wb[jj].x);
                v[jj].z += ga * bflo(wa[jj].y) + gb * bflo(wb[jj].y); v[jj].w += ga * bfhi(wa[jj].y) + gb * bfhi(wb[jj].y); }
        }
        float ss = 0.f;
#pragma unroll
        for (int jj = 0; jj < 4; ++jj) ss += v[jj].x * v[jj].x + v[jj].y * v[jj].y + v[jj].z * v[jj].z + v[jj].w * v[jj].w;
        const float rstd = rsqrtf(wave_sum(ss) * (1.0f / D) + EPS);
#pragma unroll
        for (int jj = 0; jj < 4; ++jj) { const f32x4 gv = *(const f32x4*)(F.fin_g + jj * 256 + lane * 4); *(f32x4*)(row + jj * 256 + lane * 4) = v[jj] * rstd * gv; }
        k0 = k1; k1 = k2; y0 = y1;
    }
#undef FIN_STAGE1
#undef FIN_STAGE2
}

constexpr int N_PHASES = 12;
struct Args { const float* in[17]; float* out; unsigned char* ws; };
#define XB_TMO      128
#define XB_XCNT(j)  (256  + 64 * (j))
#define XB_XSUB(j)  (1280 + 64 * (j))
#define XB_XGEN(j)  (2304 + 64 * (j))
#define XB_TOP      3328
#define XB_TOPGEN   3392
#define XCD_BAR_WORDS 3456
#define XB_SPIN_CAP (1u << 22)
__device__ __forceinline__ unsigned xb_ld(unsigned* p)              { return __hip_atomic_load(p, __ATOMIC_RELAXED, __HIP_MEMORY_SCOPE_AGENT); }
__device__ __forceinline__ unsigned xb_add(unsigned* p, unsigned v) { return __hip_atomic_fetch_add(p, v, __ATOMIC_RELAXED, __HIP_MEMORY_SCOPE_AGENT); }
__device__ __forceinline__ unsigned xb_xcc_id() { return (unsigned)__builtin_amdgcn_s_getreg((3 << 11) | 20) & 0xFu; }
#define XB_SPIN(cond, bar) do { unsigned _sp = 0; while (cond) { __builtin_amdgcn_s_sleep(1); \
    if ((++_sp & 255u) == 0u) { if (xb_ld(&(bar)[XB_TMO])) break; if (_sp > XB_SPIN_CAP) { atomicAdd(&(bar)[XB_TMO], 1u); break; } } } } while (0)
struct XcdBarrier { unsigned* bar; unsigned x; volatile LAS unsigned* st; };
__device__ __forceinline__ XcdBarrier xcd_barrier_post(unsigned* bar, volatile LAS unsigned* st) {
    XcdBarrier b; b.bar = bar; b.x = xb_xcc_id(); b.st = st;
    if (threadIdx.x == 0) (void)xb_add(&bar[XB_XCNT(b.x)], 1u);
    return b;
}
__device__ __forceinline__ void xcd_barrier_complete(unsigned* bar, unsigned x, unsigned& nloc, unsigned& nx) {
    const unsigned G = gridDim.x * gridDim.y * gridDim.z;
    unsigned sum, cnt, mine, sp = 0u;
    for (;;) {
        sum = 0u; cnt = 0u; mine = 0u;
#pragma unroll
        for (unsigned j = 0; j < 16; ++j) { const unsigned c = xb_ld(&bar[XB_XCNT(j)]); sum += c; cnt += (c > 0u) ? 1u : 0u; mine = (j == x) ? c : mine; }
        if (sum == G) break;
        __builtin_amdgcn_s_sleep(1);
        if ((++sp & 255u) == 0u) { if (xb_ld(&bar[XB_TMO])) break; if (sp > XB_SPIN_CAP) { atomicAdd(&bar[XB_TMO], 1u); break; } }
    }
    nloc = mine > 0u ? mine : 1u; nx = cnt > 0u ? cnt : 1u;
}
__device__ __forceinline__ void xcd_barrier(const XcdBarrier& b) {
    asm volatile("s_waitcnt vmcnt(0)" ::: "memory");
    __syncthreads();
    if (threadIdx.x == 0) {
        unsigned* bar = b.bar;
        __builtin_amdgcn_s_waitcnt(0);
        unsigned nloc = b.st[0], nx = b.st[1];
        if (nloc == 0u) { xcd_barrier_complete(bar, b.x, nloc, nx); b.st[0] = nloc; b.st[1] = nx; }
        const unsigned old = xb_add(&bar[XB_XSUB(b.x)], 1u);
        const unsigned gen = old / nloc;
        if (old + 1u == (gen + 1u) * nloc) {
            __builtin_amdgcn_fence(__ATOMIC_RELEASE, "agent");
            asm volatile("s_waitcnt vmcnt(0)" ::: "memory");
            const unsigned og = xb_add(&bar[XB_TOP], 1u);
            const unsigned tg = og / nx;
            if (og + 1u == (tg + 1u) * nx) xb_add(&bar[XB_TOPGEN], 1u);
            else XB_SPIN(xb_ld(&bar[XB_TOPGEN]) == tg, bar);
            __builtin_amdgcn_fence(__ATOMIC_ACQUIRE, "agent");
            xb_add(&bar[XB_XGEN(b.x)], 1u);
            asm volatile("s_waitcnt vmcnt(0)" ::: "memory");
        } else {
            XB_SPIN(xb_ld(&bar[XB_XGEN(b.x)]) == gen, bar);
            __builtin_amdgcn_fence(__ATOMIC_ACQUIRE, "agent");
            asm volatile("s_waitcnt vmcnt(0)" ::: "memory");
        }
    }
    __syncthreads();
}
constexpr int MISC_OFF = LDS_BYTES - 16;

typedef const __attribute__((address_space(4))) Args* ArgsP;
__device__ __forceinline__ void make_ctx(Ctx& F, unsigned char* lds_raw) {
    ArgsP A = (ArgsP)__builtin_amdgcn_kernarg_segment_ptr(); asm volatile("" : "+s"(A));
    F.lds = (LAS unsigned char*)lds_raw;
    { int t = threadIdx.x; asm volatile("" : "+v"(t)); F.tid = t; } F.lane = F.tid & 63; F.wave = __builtin_amdgcn_readfirstlane(F.tid >> 6);
    F.G = gridDim.x; { const int bx = blockIdx.x; F.vcu = (F.G % 8 == 0) ? (bx % 8) * (F.G / 8) + bx / 8 : bx; }
    F.x = A->in[0]; F.meta = A->in[1]; F.mix_g = A->in[2]; F.w_in = A->in[3]; F.b_gates = A->in[4]; F.conv_w = A->in[5]; F.conv_b = A->in[6];
    F.ret_logit = A->in[7]; F.ret_gn = A->in[8]; F.ml_gn = A->in[9]; F.w_out = A->in[10]; F.ffn_g = A->in[11]; F.w_router = A->in[12];
    F.w_gate = A->in[13]; F.w_up = A->in[14]; F.w_down = A->in[15]; F.fin_g = A->in[16];
    F.out = A->out; F.ws = A->ws;
}
template <int LO, int HI> __global__ void __launch_bounds__(512, 2) mk_fwd(Args args) {
    extern __shared__ __attribute__((aligned(16))) unsigned char lds_raw[];
#if MK_SPLIT
#define GRID_BAR() do {} while (0)
#elif MK_BARRIER == 0
    cg::grid_group grid = cg::this_grid();
#define GRID_BAR() grid.sync()
#else
    XcdBarrier xbar;
    {   volatile LAS unsigned* st = (volatile LAS unsigned*)((LAS unsigned char*)lds_raw + MISC_OFF);
        if (threadIdx.x < 4) st[threadIdx.x] = 0u;
        __syncthreads();
        ArgsP A0 = (ArgsP)__builtin_amdgcn_kernarg_segment_ptr();
        xbar = xcd_barrier_post((unsigned*)A0->ws, st); }
#define GRID_BAR() xcd_barrier(xbar)
#endif
#define IN(k) (LO <= (k) && (k) < HI)
#define SEAM(k) do { if (IN(k) && IN((k) + 1)) GRID_BAR(); } while (0)
#define CTX() Ctx F; make_ctx(F, lds_raw)

    if (IN(0)) { CTX(); phase_prep(F); } SEAM(0);
    if (IN(1)) {
        CTX();
        pg8::DenseOrder S{(const bf16*)(F.ws + WS_ACT1), (const bf16*)(F.ws + WS_WINT), D, D, NB * SEQ / 256, PC / 256, (NB * SEQ / 256) * (PC / 256), F.G, (int)blockIdx.x};
        pg8::EpiProj E{(bf16*)(F.ws + WS_PROJ), (const f32x2*)(F.ws + WS_ROPE)};
        pg8::gemm_phase(F.lds, D, S, E);
        proj_meta(F);
    } SEAM(1);
    if (IN(2)) { CTX(); phase_rope_conv(F); } SEAM(2);
    if (IN(3)) { CTX(); phase_seg_summary(F); } SEAM(3);
    if (IN(4)) { CTX(); phase_seq(F); } SEAM(4);
    if (IN(5)) { CTX(); phase_combine(F); } SEAM(5);
    if (IN(6)) {
        CTX();
        pg8::DenseOrder S{(const bf16*)(F.ws + WS_ACT2), (const bf16*)(F.ws + WS_WOUTT), D, D, NB * SEQ / 256, D / 256, (NB * SEQ / 256) * (D / 256), F.G, (int)blockIdx.x};
        pg8::EpiDelta E{(bf16*)(F.ws + WS_DELTA), F.x};
        pg8::gemm_phase(F.lds, D, S, E);
        out_meta(F);
    } SEAM(6);
    if (IN(7)) { CTX(); phase_router(F); } SEAM(7);
    if (IN(8)) { CTX(); phase_topk(F); } SEAM(8);
    if (IN(9)) {
        CTX();
        pg8::FfnUpOrder S{F.ws + WS_ACT1, (const unsigned*)(F.ws + WS_SCAL), F.ws + WS_WEXP, F.ws + WS_WEXP + WEXP_ONE, D / 2, D / 2, NE * 22 * 16, F.G, F.vcu};
        pg8::EpiSwiglu E{F.ws + WS_HID};
        pg8::gemm_phase(F.lds, D / 2, S, E);
        ffn_thin_up(F);
    } SEAM(9);
    if (IN(10)) {
        CTX();
        pg8::FfnDownOrder S{F.ws + WS_HID, F.ws + WS_WD8, DFF / 2, DFF / 2, NE * 4 * 16, F.G, F.vcu};
        pg8::EpiStoreBf16 E{(bf16*)(F.ws + WS_YE), D, (size_t)EROWSP * D};
        pg8::gemm_phase(F.lds, DFF / 2, S, E);
        ffn_thin_down(F);
    } SEAM(10);
    if (IN(11)) { CTX(); phase_final(F); }
#undef IN
#undef SEAM
#undef CTX
}

template <int PH> static void launch_split(int grid, hipStream_t stream, const Args& a) {
    if constexpr (PH < N_PHASES) {
        static bool attr = false;
        if (!attr) { (void)hipFuncSetAttribute((const void*)mk_fwd<PH, PH + 1>, hipFuncAttributeMaxDynamicSharedMemorySize, LDS_BYTES); attr = true; }
        hipLaunchKernelGGL((mk_fwd<PH, PH + 1>), dim3(grid), dim3(512), LDS_BYTES, stream, a);
        if ((PROBE_MASK >> PH) & 1) hipLaunchKernelGGL((mk_fwd<PH, PH + 1>), dim3(grid), dim3(512), LDS_BYTES, stream, a);
        launch_split<PH + 1>(grid, stream, a);
    }
}
extern "C" void kernel_launch(void* const* d_in, const int* in_sizes, int n_in, void* d_out, int out_size, void* d_ws, size_t ws_size, hipStream_t stream) {
    static int grid = 0;
    if (grid == 0) {
        if (n_in != 17 || out_size != NB * SEQ * D || ws_size < WS_END) { fprintf(stderr, "kernel_launch: unexpected shapes (n_in %d out %d ws %zu need %zu)\n", n_in, out_size, ws_size, (size_t)WS_END); grid = -1; return; }
        int dev = 0, cus = 0;
        if (hipGetDevice(&dev) != hipSuccess || hipDeviceGetAttribute(&cus, hipDeviceAttributeMultiprocessorCount, dev) != hipSuccess) { grid = -1; return; }
#if !MK_SPLIT
        int per_cu = 0;
        if (hipFuncSetAttribute((const void*)mk_fwd<0, N_PHASES>, hipFuncAttributeMaxDynamicSharedMemorySize, LDS_BYTES) != hipSuccess) { fprintf(stderr, "kernel_launch: hipFuncSetAttribute failed\n"); grid = -1; return; }
        if (hipOccupancyMaxActiveBlocksPerMultiprocessor(&per_cu, (const void*)mk_fwd<0, N_PHASES>, 512, LDS_BYTES) != hipSuccess || per_cu < 1) { fprintf(stderr, "kernel_launch: occupancy query says %d\n", per_cu); }
#endif
        (void)hipGetLastError();
        grid = cus;
    }
    if (grid < 0) return;
    Args a{};
    for (int i = 0; i < 17; ++i) a.in[i] = (const float*)d_in[i];
    a.out = (float*)d_out; a.ws = (unsigned char*)d_ws;
#if MK_SPLIT
    launch_split<0>(grid, stream, a);
#else
#if MK_BARRIER == 0
    void* kargs[] = {&a};
    hipError_t e = hipLaunchCooperativeKernel((const void*)mk_fwd<0, N_PHASES>, dim3(grid), dim3(512), kargs, LDS_BYTES, stream);
    if (e != hipSuccess) fprintf(stderr, "cooperative launch failed: %s (grid %d)\n", hipGetErrorString(e), grid);
#else
    if (hipMemsetAsync(d_ws, 0, 16384, stream) != hipSuccess) { fprintf(stderr, "kernel_launch: memset of barrier words failed\n"); return; }
    hipLaunchKernelGGL((mk_fwd<0, N_PHASES>), dim3(grid), dim3(512), LDS_BYTES, stream, a);
#endif
#endif
}
```
